# Optimizing an MI355X kernel written in HIP

```python
import jax
import jax.numpy as jnp
from jax import lax
import numpy as np

D_MODEL = 1024
BATCH = 8
SEQ = 4096
DEPTH = 2

HEAD_DIM = 64
N_HEADS = 4
MIX_WIDTH = N_HEADS * HEAD_DIM
N_BRANCH = 4
NORM_EPS = 1e-6
MASK_VALUE = -1e30

SB_QBLOCK = 128

RWKV_DECAY_LORA = 64
RWKV_AAA_LORA = 64
RWKV_MV_LORA = 32
RWKV_GATE_LORA = 128
RWKV_GN_EPS = 64e-5

MOBA_BLOCK = 256
MOBA_TOPK = 3
MOBA_QCHUNK = 32
ROPE_THETA = 500000.0
ROPE_DIM = HEAD_DIM // 4

HGRN_CHUNK = 16

D_FF = -(-(8 * D_MODEL) // (3 * 256)) * 256

SB_COLS = 3 * MIX_WIDTH
RWKV_COLS = 3 * MIX_WIDTH + RWKV_DECAY_LORA + RWKV_AAA_LORA + RWKV_GATE_LORA
MOBA_COLS = 3 * MIX_WIDTH
HGRN_COLS = 4 * MIX_WIDTH
SB_OFF = 0
RWKV_OFF = SB_OFF + SB_COLS
MOBA_OFF = RWKV_OFF + RWKV_COLS
HGRN_OFF = MOBA_OFF + MOBA_COLS
GATE_OFF = HGRN_OFF + HGRN_COLS
IN_COLS = GATE_OFF + N_BRANCH * D_MODEL

kernel_name = 'hybrid_gated_four_mixer_trunk'


def rms_norm(x, g):
    xf = x.astype(jnp.float32)
    y = xf * lax.rsqrt(jnp.mean(xf * xf, axis=-1, keepdims=True) + NORM_EPS)
    return (y * g.astype(jnp.float32)).astype(x.dtype)


def split_heads(t):
    b, s, _ = t.shape
    return t.reshape(b, s, N_HEADS, HEAD_DIM).transpose(0, 2, 1, 3)


def merge_heads(t):
    b, h, s, d = t.shape
    return t.transpose(0, 2, 1, 3).reshape(b, s, h * d)


def stick_breaking_attention(q, k, v):
    seq = q.shape[2]
    scale = HEAD_DIM ** -0.5
    qf = q.astype(jnp.float32)
    kf = k.astype(jnp.float32)
    vf = v.astype(jnp.float32)
    outs = []
    for blk in range(seq // SB_QBLOCK):
        t0 = blk * SB_QBLOCK
        kv_len = t0 + SB_QBLOCK
        z = jnp.einsum('bhtd,bhsd->bhts', qf[:, :, t0:kv_len], kf[:, :, :kv_len]) * scale
        t_pos = t0 + jnp.arange(SB_QBLOCK)[:, None]
        s_pos = jnp.arange(kv_len)[None, :]
        past = s_pos < t_pos
        log_keep = jnp.where(past, jax.nn.log_sigmoid(-z), 0.0)
        log_between = lax.cumsum(log_keep, axis=3, reverse=True) - log_keep
        att = jnp.where(past, jnp.exp(jax.nn.log_sigmoid(z) + log_between), 0.0)
        outs.append(jnp.einsum('bhts,bhsd->bhtd', att, vf[:, :, :kv_len]))
    return jnp.concatenate(outs, axis=2).astype(v.dtype)


def token_shift(p, mu):
    prev = jnp.pad(p, ((0, 0), (1, 0), (0, 0)))[:, :-1]
    return p + (prev - p) * mu


def rwkv7_recurrence(r, w, k, v, a, b):
    bsz, _, nh, nd = r.shape

    def step(state, inp):
        r_t, w_t, k_t, v_t, a_t, b_t = inp
        sa = jnp.einsum('bhvk,bhk->bhv', state, a_t)
        state = (state * w_t[:, :, None, :] + sa[..., None] * b_t[:, :, None, :]
                 + v_t[..., None] * k_t[:, :, None, :])
        return state, jnp.einsum('bhvk,bhk->bhv', state, r_t)

    xs = (jnp.moveaxis(r, 1, 0), jnp.moveaxis(w, 1, 0), jnp.moveaxis(k, 1, 0),
          jnp.moveaxis(v, 1, 0), jnp.moveaxis(a, 1, 0), jnp.moveaxis(b, 1, 0))
    init = jnp.zeros((bsz, nh, nd, nd), jnp.float32)
    _, y = lax.scan(step, init, xs)
    return jnp.moveaxis(y, 0, 1)


def rwkv7_time_mix(p, mu, w0, w2, a0, a2, g2, k_k, k_a, r_k, gn_w, gn_b, v_first, v0, v1, v2):
    bsz, seq, _ = p.shape
    p = token_shift(p, mu).astype(jnp.float32)
    c = MIX_WIDTH
    r = p[..., :c]
    k = p[..., c:2 * c]
    v = p[..., 2 * c:3 * c]
    o = 3 * c
    wl = p[..., o:o + RWKV_DECAY_LORA]
    o += RWKV_DECAY_LORA
    al = p[..., o:o + RWKV_AAA_LORA]
    o += RWKV_AAA_LORA
    gl = p[..., o:o + RWKV_GATE_LORA]
    w_log = -jax.nn.softplus(-(w0 + jnp.tanh(wl) @ w2)) - 0.5
    decay = jnp.exp(-jnp.exp(w_log))
    if v_first is None:
        v_first = v
    else:
        v = v + (v_first - v) * jax.nn.sigmoid(v0 + (v @ v1) @ v2)
    a = jax.nn.sigmoid(a0 + al @ a2)
    g = jax.nn.sigmoid(gl) @ g2

    def hs(t):
        return t.reshape(bsz, seq, N_HEADS, HEAD_DIM)

    kk = hs(k * k_k)
    kk = kk / jnp.maximum(jnp.sqrt(jnp.sum(kk * kk, axis=-1, keepdims=True)), 1e-12)
    k = k * (1.0 + (a - 1.0) * k_a)
    rh, kh, vh, ah = hs(r), hs(k), hs(v), hs(a)
    y = rwkv7_recurrence(rh, hs(decay), kh, vh, -kk, kk * ah)
    mean = jnp.mean(y, axis=-1, keepdims=True)
    var = jnp.mean(jnp.square(y - mean), axis=-1, keepdims=True)
    y = ((y - mean) * lax.rsqrt(var + RWKV_GN_EPS)).reshape(bsz, seq, c) * gn_w + gn_b
    bonus = jnp.sum(rh * kh * r_k, axis=-1, keepdims=True) * vh
    y = (y + bonus.reshape(bsz, seq, c)) * g
    return y, v_first


def rotary_tables(seq):
    inv_freq = ROPE_THETA ** (-jnp.arange(0, ROPE_DIM, 2, dtype=jnp.float32) / ROPE_DIM)
    ang = jnp.arange(seq, dtype=jnp.float32)[:, None] * inv_freq[None, :]
    return jnp.cos(ang), jnp.sin(ang)


def partial_rotary(t, cos, sin):
    half = ROPE_DIM // 2
    x1 = t[..., :half]
    x2 = t[..., half:ROPE_DIM]
    return jnp.concatenate([x1 * cos - x2 * sin, x2 * cos + x1 * sin, t[..., ROPE_DIM:]], axis=-1)


def moba_attention(q, k, v):
    bsz, nh, seq, hd = q.shape
    dt = v.dtype
    seq_pad = -(-seq // MOBA_BLOCK) * MOBA_BLOCK
    pad = ((0, 0), (0, 0), (0, seq_pad - seq), (0, 0))
    q = jnp.pad(q.astype(jnp.float32), pad)
    k = jnp.pad(k.astype(jnp.float32), pad)
    v = jnp.pad(v.astype(jnp.float32), pad)
    n_blk = seq_pad // MOBA_BLOCK
    k_blocks = k.reshape(bsz, nh, n_blk, MOBA_BLOCK, hd)
    v_blocks = v.reshape(bsz, nh, n_blk, MOBA_BLOCK, hd)
    k_mean = jnp.mean(k_blocks, axis=3)
    gate = jnp.einsum('bhtd,bhnd->bhtn', q, k_mean)
    q_blk = jnp.arange(seq_pad) // MOBA_BLOCK
    fully_past = jnp.arange(n_blk)[None, :] < q_blk[:, None]
    gate = jnp.where(fully_past, gate, MASK_VALUE)
    n_sel = min(MOBA_TOPK, n_blk)
    _, sel_idx = lax.top_k(gate, n_sel)
    sel_valid = sel_idx < q_blk[None, None, :, None]
    bi = jnp.arange(bsz)[:, None, None, None]
    hi = jnp.arange(nh)[None, :, None, None]
    scale = hd ** -0.5
    n_gathered = n_sel * MOBA_BLOCK

    def attend_chunk(t0):
        qc = lax.dynamic_slice_in_dim(q, t0, MOBA_QCHUNK, axis=2)
        idx = lax.dynamic_slice_in_dim(sel_idx, t0, MOBA_QCHUNK, axis=2)
        valid = lax.dynamic_slice_in_dim(sel_valid, t0, MOBA_QCHUNK, axis=2)
        k_sel = k_blocks[bi, hi, idx]
        v_sel = v_blocks[bi, hi, idx]
        s_sel = jnp.einsum('bhqd,bhqnkd->bhqnk', qc, k_sel) * scale
        s_sel = jnp.where(valid[..., None], s_sel, MASK_VALUE)
        own = t0 // MOBA_BLOCK
        k_own = lax.dynamic_index_in_dim(k_blocks, own, axis=2, keepdims=False)
        v_own = lax.dynamic_index_in_dim(v_blocks, own, axis=2, keepdims=False)
        s_own = jnp.einsum('bhqd,bhkd->bhqk', qc, k_own) * scale
        q_pos = t0 + jnp.arange(MOBA_QCHUNK)
        k_pos = own * MOBA_BLOCK + jnp.arange(MOBA_BLOCK)
        s_own = jnp.where(k_pos[None, :] <= q_pos[:, None], s_own, MASK_VALUE)
        scores = jnp.concatenate([s_sel.reshape(bsz, nh, MOBA_QCHUNK, n_gathered), s_own], axis=-1)
        probs = jax.nn.softmax(scores, axis=-1)
        p_sel = probs[..., :n_gathered].reshape(bsz, nh, MOBA_QCHUNK, n_sel, MOBA_BLOCK)
        p_own = probs[..., n_gathered:]
        return (jnp.einsum('bhqnk,bhqnkd->bhqd', p_sel, v_sel)
                + jnp.einsum('bhqk,bhkd->bhqd', p_own, v_own))

    starts = jnp.arange(seq_pad // MOBA_QCHUNK) * MOBA_QCHUNK
    out = lax.map(attend_chunk, starts)
    out = out.transpose(1, 2, 0, 3, 4).reshape(bsz, nh, seq_pad, hd)[:, :, :seq]
    return out.astype(dt)


def hgrn2_mixer(q, f_logit, i, g, lb, gn_g):
    bsz, seq, _ = q.shape
    n_chunk = seq // HGRN_CHUNK
    q = q.astype(jnp.float32)
    i = i.astype(jnp.float32)
    f_logit = f_logit.astype(jnp.float32)
    lb = lb.astype(jnp.float32)
    sig = jax.nn.sigmoid(f_logit)
    log_f = jnp.log(lb + (1.0 - lb) * sig)
    key = (1.0 - lb) * (1.0 - sig)

    def chunks(t):
        return t.reshape(bsz, n_chunk, HGRN_CHUNK, N_HEADS, HEAD_DIM).transpose(0, 3, 1, 2, 4)

    qc, kc, vc, lc = chunks(q), chunks(key), chunks(i), chunks(log_f)
    b = jnp.cumsum(lc, axis=3)
    b_end = b[:, :, :, -1:, :]
    causal = jnp.tril(jnp.ones((HGRN_CHUNK, HGRN_CHUNK), dtype=bool))
    diff = b[:, :, :, :, None, :] - b[:, :, :, None, :, :]
    pair_decay = jnp.exp(jnp.where(causal[:, :, None], diff, 0.0))
    scores = jnp.einsum('bhnck,bhnsk,bhncsk->bhncs', qc, kc, pair_decay)
    scores = jnp.where(causal, scores, 0.0)
    o = jnp.einsum('bhncs,bhnsv->bhncv', scores, vc)
    q_dec = qc * jnp.exp(b)
    k_end = kc * jnp.exp(b_end - b)
    chunk_kv = jnp.einsum('bhnsk,bhnsv->bhnkv', k_end, vc)
    chunk_decay = jnp.exp(b_end[:, :, :, 0, :])

    def step(state, inp):
        dec, kv = inp
        return dec[..., None] * state + kv, state

    init = jnp.zeros((bsz, N_HEADS, HEAD_DIM, HEAD_DIM), jnp.float32)
    _, prev = lax.scan(step, init, (jnp.moveaxis(chunk_decay, 2, 0), jnp.moveaxis(chunk_kv, 2, 0)))
    prev = jnp.moveaxis(prev, 0, 2)
    o = o + jnp.einsum('bhnck,bhnkv->bhncv', q_dec, prev)
    o = o.transpose(0, 2, 3, 1, 4).reshape(bsz, seq, N_HEADS, HEAD_DIM)
    o = o * lax.rsqrt(jnp.mean(o * o, axis=-1, keepdims=True) + NORM_EPS)
    return o.reshape(bsz, seq, MIX_WIDTH) * gn_g * jax.nn.silu(g.astype(jnp.float32))


def setup_inputs(seed: int = 0) -> dict:
    key = jax.random.key(seed)
    ks = jax.random.split(key, 32)
    L, D, W = DEPTH, D_MODEL, MIX_WIDTH
    LV = max(DEPTH - 1, 0)

    def nrm(k, shape, scale):
        return jax.random.normal(k, shape, jnp.float32) * scale

    return {
        'x': nrm(ks[0], (BATCH, SEQ, D), 1.0),
        'norm1_g': 1.0 + nrm(ks[1], (L, D), 0.02),
        'w_in': nrm(ks[2], (L, D, IN_COLS), D ** -0.5),
        'rwkv_mu': jax.random.uniform(ks[3], (L, RWKV_COLS), jnp.float32),
        'rwkv_w0': nrm(ks[4], (L, W), 0.5),
        'rwkv_w2': nrm(ks[5], (L, RWKV_DECAY_LORA, W), 0.1),
        'rwkv_a0': nrm(ks[6], (L, W), 0.1),
        'rwkv_a2': nrm(ks[7], (L, RWKV_AAA_LORA, W), 0.1),
        'rwkv_g2': nrm(ks[8], (L, RWKV_GATE_LORA, W), RWKV_GATE_LORA ** -0.5),
        'rwkv_k_k': 1.0 + nrm(ks[9], (L, W), 0.1),
        'rwkv_k_a': 1.0 + nrm(ks[10], (L, W), 0.1),
        'rwkv_r_k': nrm(ks[11], (L, N_HEADS, HEAD_DIM), 0.1),
        'rwkv_gn_w': 1.0 + nrm(ks[12], (L, W), 0.02),
        'rwkv_gn_b': nrm(ks[13], (L, W), 0.02),
        'rwkv_v0': nrm(ks[14], (LV, W), 0.1),
        'rwkv_v1': nrm(ks[15], (LV, W, RWKV_MV_LORA), W ** -0.5),
        'rwkv_v2': nrm(ks[16], (LV, RWKV_MV_LORA, W), 0.1),
        'hgrn_lb_logits': nrm(ks[17], (L, W), 1.0),
        'hgrn_gn_g': 1.0 + nrm(ks[18], (L, W), 0.02),
        'w_branch': nrm(ks[19], (L, N_BRANCH, W, D), W ** -0.5),
        'w_out': nrm(ks[20], (L, D, D), D ** -0.5),
        'norm2_g': 1.0 + nrm(ks[21], (L, D), 0.02),
        'w_ffn_gate': nrm(ks[22], (L, D, D_FF), D ** -0.5),
        'w_ffn_up': nrm(ks[23], (L, D, D_FF), D ** -0.5),
        'w_ffn_down': nrm(ks[24], (L, D_FF, D), D_FF ** -0.5),
        'final_g': 1.0 + nrm(ks[25], (D,), 0.02),
    }


def reference(x, norm1_g, w_in, rwkv_mu, rwkv_w0, rwkv_w2, rwkv_a0, rwkv_a2, rwkv_g2,
              rwkv_k_k, rwkv_k_a, rwkv_r_k, rwkv_gn_w, rwkv_gn_b, rwkv_v0, rwkv_v1, rwkv_v2,
              hgrn_lb_logits, hgrn_gn_g, w_branch, w_out, norm2_g, w_ffn_gate, w_ffn_up,
              w_ffn_down, final_g):
    seq = x.shape[1]
    W = MIX_WIDTH
    cos, sin = rotary_tables(seq)
    lb_w = jax.nn.softmax(hgrn_lb_logits.astype(jnp.float32), axis=0)
    lower_bounds = jnp.cumsum(lb_w, axis=0) - lb_w[0]
    v_first = None
    for layer in range(DEPTH):
        h = rms_norm(x, norm1_g[layer])
        w_l = w_in[layer]

        def cols(lo, width):
            return h @ w_l[:, lo:lo + width]

        sb = cols(SB_OFF, SB_COLS)
        y_sb = merge_heads(stick_breaking_attention(
            split_heads(sb[..., :W]), split_heads(sb[..., W:2 * W]), split_heads(sb[..., 2 * W:])))
        if layer == 0:
            v0 = v1 = v2 = None
        else:
            v0, v1, v2 = rwkv_v0[layer - 1], rwkv_v1[layer - 1], rwkv_v2[layer - 1]
        y_rwkv, v_first = rwkv7_time_mix(
            cols(RWKV_OFF, RWKV_COLS), rwkv_mu[layer], rwkv_w0[layer], rwkv_w2[layer],
            rwkv_a0[layer], rwkv_a2[layer], rwkv_g2[layer], rwkv_k_k[layer], rwkv_k_a[layer],
            rwkv_r_k[layer], rwkv_gn_w[layer], rwkv_gn_b[layer], v_first, v0, v1, v2)
        mc = cols(MOBA_OFF, MOBA_COLS)
        q_m = partial_rotary(split_heads(mc[..., :W]), cos, sin)
        k_m = partial_rotary(split_heads(mc[..., W:2 * W]), cos, sin)
        y_moba = merge_heads(moba_attention(q_m, k_m, split_heads(mc[..., 2 * W:])))
        hc = cols(HGRN_OFF, HGRN_COLS)
        y_hgrn = hgrn2_mixer(hc[..., :W], hc[..., W:2 * W], hc[..., 2 * W:3 * W], hc[..., 3 * W:],
                             lower_bounds[layer], hgrn_gn_g[layer])
        merged = None
        for n, y_n in enumerate((y_sb, y_rwkv, y_moba, y_hgrn)):
            gate = jax.nn.sigmoid(cols(GATE_OFF + n * D_MODEL, D_MODEL))
            term = gate * (y_n.astype(x.dtype) @ w_branch[layer, n])
            merged = term if merged is None else merged + term
        x = x + merged @ w_out[layer]
        h2 = rms_norm(x, norm2_g[layer])
        x = x + (jax.nn.silu(h2 @ w_ffn_gate[layer]) * (h2 @ w_ffn_up[layer])) @ w_ffn_down[layer]
    return rms_norm(x, final_g)
```

```cpp
#include <hip/hip_runtime.h>
#include <cstdio>
#include <cstdint>

#ifndef MK_ONE_LAUNCH
#define MK_ONE_LAUNCH 0
#endif

#define LAS __attribute__((address_space(3)))
#define GAS __attribute__((address_space(1)))
typedef unsigned short bf16;
typedef short bf16x8 __attribute__((ext_vector_type(8)));
typedef float f32x4 __attribute__((ext_vector_type(4)));
typedef float f32x2 __attribute__((ext_vector_type(2)));
typedef unsigned u32x4 __attribute__((ext_vector_type(4)));
typedef unsigned u32x2 __attribute__((ext_vector_type(2)));

constexpr int D = 1024, NBATCH = 8, SEQ = 4096, M = NBATCH * SEQ, DFF = 2816, NH = 4, HD = 64, MW = 256;
constexpr int PMW = 3584;
constexpr int C_SB = 0, C_RW = 768, C_MB = 1792, C_HG = 2560;
constexpr int NPH = 21;

constexpr size_t MiB = 1u << 20;
constexpr size_t WS_CTL = 0, CTL_ZERO_BYTES = 1 * MiB;
constexpr size_t WS_ROPE = 1 * MiB;
constexpr size_t WS_KMP = 1 * MiB + 512 * 1024;
constexpr size_t WS_W = 4 * MiB;
constexpr size_t W_IN = 0, W_B = 15728640, W_O = W_B + 2097152, W_GU = W_O + 2097152, W_D = W_GU + 11534336, W_L = W_D + 5767168, W_V = W_L + 393216, W_END = W_V + 131072;
static_assert(W_END == 36 * MiB, "weights");
constexpr size_t WS_H = 40 * MiB;
constexpr size_t WS_PM = 104 * MiB;
constexpr size_t WS_LA = 328 * MiB;
constexpr size_t WS_LO = 360 * MiB;
constexpr size_t WS_Y = 424 * MiB;
constexpr size_t WS_VF = 488 * MiB;
constexpr size_t WS_END = 504 * MiB;
constexpr int CW_TMO = 0;
constexpr int CW_BAR = 4096;
constexpr int CW_WORK = 16384;

constexpr int RING_BYTES = 131072;
constexpr int LDSCTL_OFF = RING_BYTES, MISC_OFF = LDSCTL_OFF + 320;
constexpr int LDS_BYTES = 147456;

__device__ __forceinline__ unsigned f2bf(float f) { unsigned u = __builtin_bit_cast(unsigned, f); return (u + 0x7fffu + ((u >> 16) & 1u)) >> 16; }
__device__ __forceinline__ unsigned pk2(float lo, float hi) { return f2bf(lo) | (f2bf(hi) << 16); }
__device__ __forceinline__ float bf2f(unsigned short b) { return __builtin_bit_cast(float, ((unsigned)b) << 16); }
__device__ __forceinline__ float bflo(unsigned w) { return __builtin_bit_cast(float, w << 16); }
__device__ __forceinline__ float bfhi(unsigned w) { return __builtin_bit_cast(float, w & 0xffff0000u); }
typedef __bf16 bf16x2_t __attribute__((ext_vector_type(2)));
__device__ __forceinline__ unsigned cvt_pk_bf16(float lo, float hi) { f32x2 v = {lo, hi}; bf16x2_t b = __builtin_convertvector(v, bf16x2_t); return __builtin_bit_cast(unsigned, b); }
__device__ __forceinline__ float wave_sum(float v) {
#pragma unroll
    for (int o = 1; o < 64; o <<= 1) v += __shfl_xor(v, o);
    return v;
}
__device__ __forceinline__ float sigmoidf_(float x) { return __builtin_amdgcn_rcpf(1.0f + __expf(-x)); }
#define LDS_WAIT() asm volatile("s_waitcnt lgkmcnt(0)" ::: "memory")
__device__ __forceinline__ int opaque_s(int v) { asm volatile("" : "+s"(v)); return v; }

#define XB_TMO      128
#define XB_XCNT(j)  (256  + 64 * (j))
#define XB_XSUB(j)  (1280 + 64 * (j))
#define XB_XGEN(j)  (2304 + 64 * (j))
#define XB_TOP      3328
#define XB_TOPGEN   3392
#define XCD_BAR_WORDS 3456
#define XB_SPIN_CAP (1u << 22)
__device__ __forceinline__ unsigned xb_ld(unsigned* p)              { return __hip_atomic_load(p, __ATOMIC_RELAXED, __HIP_MEMORY_SCOPE_AGENT); }
__device__ __forceinline__ unsigned xb_add(unsigned* p, unsigned v) { return __hip_atomic_fetch_add(p, v, __ATOMIC_RELAXED, __HIP_MEMORY_SCOPE_AGENT); }
__device__ __forceinline__ unsigned xb_xcc_id() { return (unsigned)__builtin_amdgcn_s_getreg((3 << 11) | 20) & 0xFu; }
#define XB_SPIN(cond, bar) do { unsigned _sp = 0; while (cond) { __builtin_amdgcn_s_sleep(1); \
    if ((++_sp & 255u) == 0u) { if (xb_ld(&(bar)[XB_TMO])) break; if (_sp > XB_SPIN_CAP) { atomicAdd(&(bar)[XB_TMO], 1u); break; } } } } while (0)
struct XcdBarrier { unsigned* bar; unsigned x; volatile LAS unsigned* st; };
__device__ __forceinline__ XcdBarrier xcd_barrier_post(unsigned* bar, volatile LAS unsigned* st) {
    XcdBarrier b; b.bar = bar; b.x = xb_xcc_id(); b.st = st;
    if (threadIdx.x == 0) (void)xb_add(&bar[XB_XCNT(b.x)], 1u);
    return b;
}
__device__ __forceinline__ void xcd_barrier_complete(unsigned* bar, unsigned x, unsigned& nloc, unsigned& nx) {
    const unsigned G = gridDim.x * gridDim.y * gridDim.z;
    unsigned sum, cnt, mine, sp = 0u;
    for (;;) {
        sum = 0u; cnt = 0u; mine = 0u;
#pragma unroll
        for (unsigned j = 0; j < 16; ++j) { const unsigned c = xb_ld(&bar[XB_XCNT(j)]); sum += c; cnt += (c > 0u) ? 1u : 0u; mine = (j == x) ? c : mine; }
        if (sum == G) break;
        __builtin_amdgcn_s_sleep(1);
        if ((++sp & 255u) == 0u) { if (xb_ld(&bar[XB_TMO])) break; if (sp > XB_SPIN_CAP) { atomicAdd(&bar[XB_TMO], 1u); break; } }
    }
    nloc = mine > 0u ? mine : 1u; nx = cnt > 0u ? cnt : 1u;
}
__device__ __forceinline__ void xcd_barrier(const XcdBarrier& b) {
    asm volatile("s_waitcnt vmcnt(0)" ::: "memory");
    __syncthreads();
    if (threadIdx.x == 0) {
        unsigned* bar = b.bar;
        __builtin_amdgcn_s_waitcnt(0);
        unsigned nloc = b.st[0], nx = b.st[1];
        if (nloc == 0u) { xcd_barrier_complete(bar, b.x, nloc, nx); b.st[0] = nloc; b.st[1] = nx; }
        const unsigned old = xb_add(&bar[XB_XSUB(b.x)], 1u);
        const unsigned gen = old / nloc;
        if (old + 1u == (gen + 1u) * nloc) {
            __builtin_amdgcn_fence(__ATOMIC_RELEASE, "agent");
            asm volatile("s_waitcnt vmcnt(0)" ::: "memory");
            const unsigned og = xb_add(&bar[XB_TOP], 1u);
            const unsigned tg = og / nx;
            if (og + 1u == (tg + 1u) * nx) xb_add(&bar[XB_TOPGEN], 1u);
            else XB_SPIN(xb_ld(&bar[XB_TOPGEN]) == tg, bar);
            __builtin_amdgcn_fence(__ATOMIC_ACQUIRE, "agent");
            xb_add(&bar[XB_XGEN(b.x)], 1u);
            asm volatile("s_waitcnt vmcnt(0)" ::: "memory");
        } else {
            XB_SPIN(xb_ld(&bar[XB_XGEN(b.x)]) == gen, bar);
            __builtin_amdgcn_fence(__ATOMIC_ACQUIRE, "agent");
            asm volatile("s_waitcnt vmcnt(0)" ::: "memory");
        }
    }
    __syncthreads();
}

namespace pg8 {
constexpr int BM = 256, BK = 64, HALF = 128, HTB = HALF * BK * 2, STAGE_BYTES = 8 * HTB, NXCD = 8, WGM = 8;
__host__ __device__ __forceinline__ int lds_byte(int r, int c) { const int st = (r >> 4) * 2 + (c >> 5), rr = r & 15, cc = c & 31, ob = rr * 64 + cc * 2; return st * 1024 + (ob ^ (((ob >> 9) & 1) << 5)); }
__host__ __device__ __forceinline__ void stage_rc(int b, int& R, int& C) { const int st = b / 1024, sb = b % 1024, swz = sb ^ (((sb >> 9) & 1) << 5); R = (st >> 1) * 16 + swz / 64; C = (st & 1) * 32 + (swz % 64) / 2; }
__host__ __device__ __forceinline__ int perm32(int rho) { const int n = rho >> 4, i = rho & 15; return 8 * (i >> 2) + 4 * n + (i & 3); }

struct GU { const char* a; const char* b; unsigned lda2, ldb2; int nt, pm, pn, sub; };

__device__ __forceinline__ void tile_of(int L, int nM, int nN, int& pm, int& pn) {
    const int nwg = nM * nN;
    int wgid = L; { const int q = nwg / NXCD, r = nwg % NXCD, xcd = wgid % NXCD, off = wgid / NXCD; wgid = (xcd < r ? xcd * (q + 1) : r * (q + 1) + (xcd - r) * q) + off; }
    const int nig = WGM * nN, gid = wgid / nig, fm = gid * WGM, gsz = (nM - fm) < WGM ? (nM - fm) : WGM;
    pm = fm + ((wgid % nig) % gsz); pn = (wgid % nig) / gsz;
}

template <class Epi, class Sched, bool ALIGN_EPI>
__device__ __forceinline__ void gemm_phase(LAS unsigned char* lds, const Sched& S, const Epi& E) {
    int tid = threadIdx.x; asm volatile("" : "+v"(tid));
    const int wid = __builtin_amdgcn_readfirstlane(tid >> 6), lane = tid & 63, wr = wid >> 2, wc = wid & 3, fr = lane & 15, fq = lane >> 4;
    unsigned Rr, Rb, C2;
    { int R, C; stage_rc(tid * 16, R, C); Rr = (unsigned)R; Rb = (unsigned)(Epi::PERM ? ((R & ~31) + perm32(R & 31)) : R); C2 = (unsigned)C * 2u; }
    const size_t kstep = (size_t)(BK * 2);
    const unsigned ldsw = (unsigned)wid * 1024u;
    const int aoff = lds_byte(wr * 64 + fr, fq * 8), boff = lds_byte(wc * 32 + fr, fq * 8);
#define PG8_SA(b, h) (((b) * 2 + (h)) * HTB)
#define PG8_SB(b, h) ((4 + (b) * 2 + (h)) * HTB)
#define PG8_STAGE(bufoff, gbase, R, ld) do { const unsigned _v0 = (R) * (ld) + C2; \
        __builtin_amdgcn_global_load_lds((const unsigned*)((const char*)(gbase) + _v0), (LAS unsigned*)(lds + (bufoff) + ldsw), 16, 0, 0); \
        __builtin_amdgcn_global_load_lds((const unsigned*)((const char*)(gbase) + _v0 + 64u * (ld)), (LAS unsigned*)(lds + (bufoff) + ldsw + 8192), 16, 0, 0); } while (0)
#define PG8_LDA(dst, b, h) do { _Pragma("unroll") for (int m = 0; m < 4; ++m) _Pragma("unroll") for (int k = 0; k < 2; ++k) dst[m][k] = *(const LAS bf16x8*)(lds + PG8_SA(b, h) + aoff + m * 2048 + k * 1024); } while (0)
#define PG8_LDB(dst, b, h) do { _Pragma("unroll") for (int n = 0; n < 2; ++n) _Pragma("unroll") for (int k = 0; k < 2; ++k) dst[n][k] = *(const LAS bf16x8*)(lds + PG8_SB(b, h) + boff + n * 2048 + k * 1024); } while (0)
#define PG8_MMA(ai, bj, At, Bt) do { __builtin_amdgcn_s_setprio(1); _Pragma("unroll") for (int m = 0; m < 4; ++m) _Pragma("unroll") for (int n = 0; n < 2; ++n) _Pragma("unroll") for (int k = 0; k < 2; ++k) \
        acc[ai][bj][m][n] = __builtin_amdgcn_mfma_f32_16x16x32_bf16(Bt[n][k], At[m][k], acc[ai][bj][m][n], 0, 0, 0); __builtin_amdgcn_s_setprio(0); } while (0)
#define PG8_WAIT_V(n) asm volatile("s_waitcnt vmcnt(" #n ")" ::: "memory")
#define PG8_WAIT_L(n) asm volatile("s_waitcnt lgkmcnt(" #n ")" ::: "memory")
#define PG8_BAR __builtin_amdgcn_s_barrier()
#define PG8_SCHED __builtin_amdgcn_sched_barrier(0)
    GU cur, nxt; int ui = 0;
    if (!S.next(0, cur)) return;
    f32x4 acc[2][2][4][2];
#pragma unroll
    for (int a = 0; a < 2; ++a)
#pragma unroll
        for (int b = 0; b < 2; ++b)
#pragma unroll
            for (int m = 0; m < 4; ++m)
#pragma unroll
                for (int n = 0; n < 2; ++n) acc[a][b][m][n] = (f32x4){0.f, 0.f, 0.f, 0.f};
    bf16x8 At[4][2], B0[2][2], B1[2][2];
    const char* cA = cur.a; const char* cB = cur.b;
    unsigned ldA = cur.lda2, ldB = cur.ldb2;
    PG8_STAGE(PG8_SB(0, 0), cB, Rb, ldB); PG8_STAGE(PG8_SB(0, 1), cB + (size_t)HALF * ldB, Rb, ldB); PG8_STAGE(PG8_SA(0, 0), cA, Rr, ldA); PG8_STAGE(PG8_SA(0, 1), cA + (size_t)HALF * ldA, Rr, ldA);
    if (wr == 1) PG8_BAR;
    PG8_WAIT_V(2); PG8_BAR;
    PG8_STAGE(PG8_SB(1, 0), cB + kstep, Rb, ldB); PG8_STAGE(PG8_SA(1, 0), cA + kstep, Rr, ldA); PG8_STAGE(PG8_SB(1, 1), cB + (size_t)HALF * ldB + kstep, Rb, ldB);
    PG8_WAIT_V(6); PG8_BAR;
    for (;;) {
        const bool has_next = S.next(ui + 1, nxt);
        const char* nA = has_next ? nxt.a : cA; const char* nB = has_next ? nxt.b : cB;
        const unsigned nldA = has_next ? nxt.lda2 : ldA, nldB = has_next ? nxt.ldb2 : ldB;
        const int nt = cur.nt;
        for (int t = 0; t < nt; t += 2) {
            const bool last = (t == nt - 2);
            const char* a1 = cA + (size_t)(t + 1) * kstep;
            const char* a2 = last ? nA : cA + (size_t)(t + 2) * kstep; const char* b2 = last ? nB : cB + (size_t)(t + 2) * kstep;
            const char* a3 = a2 + kstep; const char* b3 = b2 + kstep;
            const unsigned xldA = last ? nldA : ldA, xldB = last ? nldB : ldB;
            PG8_LDB(B0, 0, 0); PG8_LDB(B1, 0, 1); PG8_SCHED; PG8_LDA(At, 0, 0); PG8_STAGE(PG8_SA(1, 1), a1 + (size_t)HALF * ldA, Rr, ldA);
            PG8_WAIT_V(8); PG8_WAIT_L(0); PG8_BAR; PG8_MMA(0, 0, At, B0); PG8_MMA(0, 1, At, B1); PG8_BAR; PG8_SCHED;
            PG8_LDA(At, 0, 1); PG8_STAGE(PG8_SB(0, 0), b2, Rb, xldB); PG8_STAGE(PG8_SB(0, 1), b2 + (size_t)HALF * xldB, Rb, xldB); PG8_STAGE(PG8_SA(0, 0), a2, Rr, xldA);
            PG8_WAIT_V(8); PG8_WAIT_L(0); PG8_BAR; PG8_MMA(1, 0, At, B0); PG8_MMA(1, 1, At, B1); PG8_BAR; PG8_SCHED;
            PG8_LDB(B0, 1, 0); PG8_LDB(B1, 1, 1); PG8_SCHED; PG8_LDA(At, 1, 0); PG8_STAGE(PG8_SA(0, 1), a2 + (size_t)HALF * xldA, Rr, xldA);
            PG8_WAIT_V(8); PG8_WAIT_L(0); PG8_BAR; PG8_MMA(0, 0, At, B0); PG8_MMA(0, 1, At, B1); PG8_BAR; PG8_SCHED;
            PG8_LDA(At, 1, 1); PG8_STAGE(PG8_SB(1, 0), b3, Rb, xldB); PG8_STAGE(PG8_SB(1, 1), b3 + (size_t)HALF * xldB, Rb, xldB); PG8_STAGE(PG8_SA(1, 0), a3, Rr, xldA);
            PG8_WAIT_V(8); PG8_WAIT_L(0); PG8_BAR; PG8_MMA(1, 0, At, B0); PG8_MMA(1, 1, At, B1); PG8_BAR; PG8_SCHED;
        }
        if constexpr (ALIGN_EPI) { if (wr == 0) PG8_BAR; }
        E(acc, cur, wr, wc, fr, fq);
        if (!has_next) break;
#pragma unroll
        for (int a = 0; a < 2; ++a)
#pragma unroll
            for (int b = 0; b < 2; ++b)
#pragma unroll
                for (int m = 0; m < 4; ++m)
#pragma unroll
                    for (int n = 0; n < 2; ++n) acc[a][b][m][n] = (f32x4){0.f, 0.f, 0.f, 0.f};
        cur = nxt; cA = nA; cB = nB; ldA = nldA; ldB = nldB; ++ui;
        if constexpr (ALIGN_EPI) { if (wr == 1) PG8_BAR; }
    }
    PG8_WAIT_V(0);
    if constexpr (!ALIGN_EPI) { if (wr == 0) PG8_BAR; }
    PG8_BAR;
#undef PG8_SA
#undef PG8_SB
#undef PG8_STAGE
#undef PG8_LDA
#undef PG8_LDB
#undef PG8_MMA
#undef PG8_WAIT_V
#undef PG8_WAIT_L
#undef PG8_BAR
#undef PG8_SCHED
}

struct PlainOrder {
    const char* A; const char* B; unsigned lda2, ldb2; int nt, nM, nN, G, c;
    __device__ __forceinline__ bool next(int i, GU& u) const {
        const int L = i * G + c; if (L >= nM * nN) return false;
        int pm, pn; tile_of(L, nM, nN, pm, pn);
        u.pm = pm; u.pn = pn; u.sub = 0; u.nt = nt; u.lda2 = lda2; u.ldb2 = ldb2;
        u.a = A + (size_t)pm * 256 * lda2; u.b = B + (size_t)pn * 256 * ldb2; return true;
    }
};
struct LoraOrder {
    const char* A; const char* Bl; const char* Bv; int nN, G, c;
    __device__ __forceinline__ bool next(int i, GU& u) const {
        const int L = i * G + c; if (L >= 128 * nN) return false;
        int pm, pn; tile_of(L, 128, nN, pm, pn);
        u.pm = pm; u.pn = pn; u.sub = 0; u.nt = 4; u.lda2 = 1024; u.ldb2 = 512;
        u.a = A + (size_t)pm * 256 * 1024 + (pn == 3 ? 512 : 0); u.b = (pn == 3) ? Bv : Bl + (size_t)pn * 256 * 512; return true;
    }
};
struct MergeOrder {
    const char* Hh; const char* Yy; const char* Wg; const char* Wb; int G, c;
    __device__ __forceinline__ bool next(int i, GU& u) const {
        const int ti = i >> 3, sub = i & 7, n = sub >> 1;
        const int L = ti * G + c; if (L >= 512) return false;
        int pm, pn; tile_of(L, 128, 4, pm, pn);
        u.pm = pm; u.pn = pn; u.sub = sub; u.lda2 = 2048;
        if ((sub & 1) == 0) { u.a = Hh + (size_t)pm * 256 * 2048; u.b = Wg + (size_t)(n * 1024 + pn * 256) * 2048; u.ldb2 = 2048; u.nt = 16; }
        else { u.a = Yy + (size_t)pm * 256 * 2048 + n * 512; u.b = Wb + (size_t)(n * 1024 + pn * 256) * 512; u.ldb2 = 512; u.nt = 4; }
        return true;
    }
};

struct EpiBf16 {
    static constexpr bool PERM = true;
    bf16* O; int ldc;
    __device__ __forceinline__ void operator()(const f32x4 (&acc)[2][2][4][2], const GU& u, int wr, int wc, int fr, int fq) const {
        const int row0 = u.pm * BM + wr * 64 + fr, col0 = u.pn * BM + wc * 32 + 8 * fq;
#pragma unroll
        for (int ai = 0; ai < 2; ++ai)
#pragma unroll
            for (int m = 0; m < 4; ++m) { bf16* rowp = O + (size_t)(row0 + ai * HALF + m * 16) * ldc + col0;
#pragma unroll
                for (int bj = 0; bj < 2; ++bj) { const f32x4 v0 = acc[ai][bj][m][0], v1 = acc[ai][bj][m][1];
                    u32x4 w; w.x = cvt_pk_bf16(v0[0], v0[1]); w.y = cvt_pk_bf16(v0[2], v0[3]); w.z = cvt_pk_bf16(v1[0], v1[1]); w.w = cvt_pk_bf16(v1[2], v1[3]);
                    *(u32x4*)(rowp + bj * HALF) = w; } }
    }
};
struct EpiSwiGLU {
    static constexpr bool PERM = true;
    bf16* O;
    __device__ __forceinline__ void operator()(const f32x4 (&acc)[2][2][4][2], const GU& u, int wr, int wc, int fr, int fq) const {
        const int row0 = u.pm * BM + wr * 64 + fr, col0 = u.pn * HALF + wc * 32 + 8 * fq;
#pragma unroll
        for (int ai = 0; ai < 2; ++ai)
#pragma unroll
            for (int m = 0; m < 4; ++m) { bf16* rowp = O + (size_t)(row0 + ai * HALF + m * 16) * DFF + col0;
                float r[8];
#pragma unroll
                for (int n = 0; n < 2; ++n)
#pragma unroll
                    for (int j = 0; j < 4; ++j) { const float g = acc[ai][0][m][n][j], up = acc[ai][1][m][n][j]; r[n * 4 + j] = g * sigmoidf_(g) * up; }
                u32x4 w; w.x = cvt_pk_bf16(r[0], r[1]); w.y = cvt_pk_bf16(r[2], r[3]); w.z = cvt_pk_bf16(r[4], r[5]); w.w = cvt_pk_bf16(r[6], r[7]);
                *(u32x4*)rowp = w; }
    }
};
struct EpiResF32 {
    static constexpr bool PERM = false;
    const float* base; float* out;
    __device__ __forceinline__ void operator()(const f32x4 (&acc)[2][2][4][2], const GU& u, int wr, int wc, int fr, int fq) const {
        const int row0 = u.pm * BM + wr * 64 + fr, col0 = u.pn * BM + wc * 32 + 4 * fq;
#pragma unroll
        for (int ai = 0; ai < 2; ++ai)
#pragma unroll
            for (int m = 0; m < 4; ++m) { const size_t off = (size_t)(row0 + ai * HALF + m * 16) * D + col0;
#pragma unroll
                for (int bj = 0; bj < 2; ++bj)
#pragma unroll
                    for (int n = 0; n < 2; ++n) { const f32x4 bs = *(const f32x4*)(base + off + bj * HALF + n * 16); *(f32x4*)(out + off + bj * HALF + n * 16) = bs + acc[ai][bj][m][n]; } }
    }
};
struct EpiMerge {
    static constexpr bool PERM = true;
    u32x4* scr; bf16* O;
    __device__ __forceinline__ void operator()(const f32x4 (&acc)[2][2][4][2], const GU& u, int wr, int wc, int fr, int fq) const {
        int tid = threadIdx.x; asm volatile("" : "+v"(tid));
        if ((u.sub & 1) == 0) {
#pragma unroll
            for (int ai = 0; ai < 2; ++ai)
#pragma unroll
                for (int m = 0; m < 4; ++m)
#pragma unroll
                    for (int bj = 0; bj < 2; ++bj) { const f32x4 v0 = acc[ai][bj][m][0], v1 = acc[ai][bj][m][1];
                        u32x4 w; w.x = cvt_pk_bf16(sigmoidf_(v0[0]), sigmoidf_(v0[1])); w.y = cvt_pk_bf16(sigmoidf_(v0[2]), sigmoidf_(v0[3]));
                        w.z = cvt_pk_bf16(sigmoidf_(v1[0]), sigmoidf_(v1[1])); w.w = cvt_pk_bf16(sigmoidf_(v1[2]), sigmoidf_(v1[3]));
                        scr[((ai * 4 + m) * 2 + bj) * 512 + tid] = w; }
        } else {
            const bool first = (u.sub == 1);
            const int row0 = u.pm * BM + wr * 64 + fr, col0 = u.pn * BM + wc * 32 + 8 * fq;
#pragma unroll
            for (int ai = 0; ai < 2; ++ai)
#pragma unroll
                for (int m = 0; m < 4; ++m) { bf16* rowp = O + (size_t)(row0 + ai * HALF + m * 16) * D + col0;
#pragma unroll
                    for (int bj = 0; bj < 2; ++bj) { const f32x4 v0 = acc[ai][bj][m][0], v1 = acc[ai][bj][m][1];
                        const u32x4 s = scr[((ai * 4 + m) * 2 + bj) * 512 + tid];
                        float r[8];
                        r[0] = bflo(s.x) * v0[0]; r[1] = bfhi(s.x) * v0[1]; r[2] = bflo(s.y) * v0[2]; r[3] = bfhi(s.y) * v0[3];
                        r[4] = bflo(s.z) * v1[0]; r[5] = bfhi(s.z) * v1[1]; r[6] = bflo(s.w) * v1[2]; r[7] = bfhi(s.w) * v1[3];
                        if (!first) { const u32x4 p = *(const u32x4*)(rowp + bj * HALF);
                            r[0] += bflo(p.x); r[1] += bfhi(p.x); r[2] += bflo(p.y); r[3] += bfhi(p.y); r[4] += bflo(p.z); r[5] += bfhi(p.z); r[6] += bflo(p.w); r[7] += bfhi(p.w); }
                        u32x4 w; w.x = cvt_pk_bf16(r[0], r[1]); w.y = cvt_pk_bf16(r[2], r[3]); w.z = cvt_pk_bf16(r[4], r[5]); w.w = cvt_pk_bf16(r[6], r[7]);
                        *(u32x4*)(rowp + bj * HALF) = w; } }
        }
    }
};
}

struct Args { const float* in[26]; float* out; unsigned char* ws; int ph_lo, ph_hi; };
enum { I_X = 0, I_N1G, I_WIN, I_MU, I_W0, I_W2, I_A0, I_A2, I_G2, I_KK, I_KA, I_RK, I_GNW, I_GNB, I_V0, I_V1, I_V2, I_LB, I_HGN, I_WBR, I_WOUT, I_N2G, I_WFG, I_WFU, I_WFD, I_FG };

__device__ __forceinline__ void transpose_item(const float* W, int ldw, int k0, int n0, bf16* WT, size_t drow0, int ldt, int dk0, LAS float* scr, int lane) {
#pragma unroll 8
    for (int i = 0; i < 32; ++i) { const int kk = 2 * i + (lane >> 5); scr[kk * 33 + (lane & 31)] = W[(size_t)(k0 + kk) * ldw + n0 + (lane & 31)]; }
    LDS_WAIT(); asm volatile("" ::: "memory");
    const int c = lane & 7;
#pragma unroll
    for (int j = 0; j < 4; ++j) { const int n = (lane >> 3) + 8 * j; const LAS float* s = scr + (8 * c) * 33 + n;
        u32x4 o; o.x = pk2(s[0 * 33], s[1 * 33]); o.y = pk2(s[2 * 33], s[3 * 33]); o.z = pk2(s[4 * 33], s[5 * 33]); o.w = pk2(s[6 * 33], s[7 * 33]);
        *(u32x4*)(WT + (drow0 + n) * (size_t)ldt + dk0 + 8 * c) = o; }
    LDS_WAIT(); asm volatile("" ::: "memory");
}

__device__ __forceinline__ void rms_row_bf16(const float* xrow, const float* g, bf16* orow, int lane) {
    const f32x4* xr = (const f32x4*)xrow + lane; f32x4 v[4]; float s = 0.f;
#pragma unroll
    for (int j = 0; j < 4; ++j) { v[j] = xr[64 * j]; s += (v[j].x * v[j].x + v[j].y * v[j].y) + (v[j].z * v[j].z + v[j].w * v[j].w); }
    const float rs = 1.0f / sqrtf(wave_sum(s) * (1.f / D) + 1e-6f);
    u32x2* o8 = (u32x2*)orow + lane;
#pragma unroll
    for (int j = 0; j < 4; ++j) { const f32x4 gv = ((const f32x4*)g)[lane + 64 * j]; u32x2 w; w.x = pk2(v[j].x * rs * gv.x, v[j].y * rs * gv.y); w.y = pk2(v[j].z * rs * gv.z, v[j].w * rs * gv.w); o8[64 * j] = w; }
}
__device__ __forceinline__ void rms_row_f32(const float* xrow, const float* g, float* orow, int lane) {
    const f32x4* xr = (const f32x4*)xrow + lane; f32x4 v[4]; float s = 0.f;
#pragma unroll
    for (int j = 0; j < 4; ++j) { v[j] = xr[64 * j]; s += (v[j].x * v[j].x + v[j].y * v[j].y) + (v[j].z * v[j].z + v[j].w * v[j].w); }
    const float rs = 1.0f / sqrtf(wave_sum(s) * (1.f / D) + 1e-6f);
    f32x4* o = (f32x4*)orow + lane;
#pragma unroll
    for (int j = 0; j < 4; ++j) { const f32x4 gv = ((const f32x4*)g)[lane + 64 * j]; o[64 * j] = v[j] * rs * gv; }
}

__device__ __forceinline__ void rope_entry(int t, int i, float& c, float& s) {
    const double invf[8] = {1.0, 0.19392274474868576, 0.03760603093086393, 0.007292664737217109, 0.001414213562373095, 0.0002742481756762073, 5.318295896944988e-05, 1.031338537721246e-05};
    double f = invf[0];
#pragma unroll
    for (int j = 1; j < 8; ++j) f = (i == j) ? invf[j] : f;
    const double ang = (double)t * f;
    const double k = __builtin_rint(ang * 0.63661977236758134308);
    double r = __builtin_fma(-k, 1.5707963267948966, ang); r = __builtin_fma(-k, 6.123233995736766e-17, r);
    const double r2 = r * r;
    double sn = r * (1.0 + r2 * (-1.0 / 6 + r2 * (1.0 / 120 + r2 * (-1.0 / 5040 + r2 * (1.0 / 362880 + r2 * (-1.0 / 39916800 + r2 * (1.0 / 6227020800.0)))))));
    double cs = 1.0 + r2 * (-0.5 + r2 * (1.0 / 24 + r2 * (-1.0 / 720 + r2 * (1.0 / 40320 + r2 * (-1.0 / 3628800 + r2 * (1.0 / 479001600.0 + r2 * (-1.0 / 87178291200.0)))))));
    const int q = ((int)(long long)k) & 3;
    const double s2 = (q == 0) ? sn : (q == 1) ? cs : (q == 2) ? -sn : -cs;
    const double c2 = (q == 0) ? cs : (q == 1) ? -sn : (q == 2) ? -cs : sn;
    c = (float)c2; s = (float)s2;
}

__device__ __forceinline__ void phase_a(const Args& a, int layer, const float* xin, LAS unsigned char* lds, int vb, int G) {
    int tid = threadIdx.x; asm volatile("" : "+v"(tid)); const int lane = tid & 63, wave = tid >> 6;
    unsigned char* ws = a.ws;
    bf16* Wb = (bf16*)(ws + WS_W);
    LAS float* scr = (LAS float*)(lds + wave * 16384);
    const int gw = vb * 8 + wave, NGW = G * 8;
    const float* w_in = a.in[I_WIN] + (size_t)layer * D * 7680;
    const float* w_br = a.in[I_WBR] + (size_t)layer * 4 * MW * D;
    const float* w_out = a.in[I_WOUT] + (size_t)layer * D * D;
    const float* w_fg = a.in[I_WFG] + (size_t)layer * D * DFF;
    const float* w_fu = a.in[I_WFU] + (size_t)layer * D * DFF;
    const float* w_fd = a.in[I_WFD] + (size_t)layer * DFF * D;
    const float* w2 = a.in[I_W2] + (size_t)layer * 64 * MW;
    const float* a2 = a.in[I_A2] + (size_t)layer * 64 * MW;
    const float* g2 = a.in[I_G2] + (size_t)layer * 128 * MW;
    constexpr int N_IN = 16 * 240, N_BR = 4 * 4 * 32, N_OUT = 16 * 32, N_FG = 16 * 88, N_FD = 44 * 32, N_LO = 8 + 8 + 16;
    constexpr int NITEMS = N_IN + N_BR + N_OUT + 2 * N_FG + N_FD + N_LO;
    for (int it = gw; it < NITEMS; it += NGW) {
        int r = it;
        if (r < N_IN) { const int kb = r / 240, nb = r % 240; transpose_item(w_in, 7680, kb * 64, nb * 32, (bf16*)((char*)Wb + W_IN), (size_t)nb * 32, 1024, kb * 64, scr, lane); continue; } r -= N_IN;
        if (r < N_BR) { const int n = r / 128, q = r % 128, kb = q / 32, nb = q % 32; transpose_item(w_br + (size_t)n * MW * D, D, kb * 64, nb * 32, (bf16*)((char*)Wb + W_B), (size_t)n * 1024 + nb * 32, 256, kb * 64, scr, lane); continue; } r -= N_BR;
        if (r < N_OUT) { const int kb = r / 32, nb = r % 32; transpose_item(w_out, D, kb * 64, nb * 32, (bf16*)((char*)Wb + W_O), (size_t)nb * 32, 1024, kb * 64, scr, lane); continue; } r -= N_OUT;
        if (r < 2 * N_FG) { const int up = r / N_FG, q = r % N_FG, kb = q / 88, nb = q % 88, n0 = nb * 32;
            transpose_item(up ? w_fu : w_fg, DFF, kb * 64, n0, (bf16*)((char*)Wb + W_GU), (size_t)(n0 / 128) * 256 + (n0 % 128) + up * 128, 1024, kb * 64, scr, lane); continue; } r -= 2 * N_FG;
        if (r < N_FD) { const int kb = r / 32, nb = r % 32; transpose_item(w_fd, D, kb * 64, nb * 32, (bf16*)((char*)Wb + W_D), (size_t)nb * 32, DFF, kb * 64, scr, lane); continue; } r -= N_FD;
        if (r < 8) { transpose_item(w2, MW, 0, r * 32, (bf16*)((char*)Wb + W_L), (size_t)r * 32, 256, 0, scr, lane); continue; } r -= 8;
        if (r < 8) { transpose_item(a2, MW, 0, r * 32, (bf16*)((char*)Wb + W_L), (size_t)256 + r * 32, 256, 64, scr, lane); continue; } r -= 8;
        { const int kb = r / 8, nb = r % 8; transpose_item(g2, MW, kb * 64, nb * 32, (bf16*)((char*)Wb + W_L), (size_t)512 + nb * 32, 256, 128 + kb * 64, scr, lane); }
    }
    const int gt = vb * 512 + tid, NGT = G * 512;
    for (int i = gt; i < 768 * 32; i += NGT) { const int row = i >> 5, ch = i & 31, blk = row >> 8; const int lo = blk == 0 ? 0 : (blk == 1 ? 64 : 128), hi = blk == 0 ? 64 : (blk == 1 ? 128 : 256);
        if (ch * 8 < lo || ch * 8 >= hi) *(u32x4*)((char*)Wb + W_L + (size_t)row * 512 + ch * 16) = (u32x4){0u, 0u, 0u, 0u}; }
    if (layer == 1) {
        const float* v1 = a.in[I_V1]; const float* v2 = a.in[I_V2];
        for (int i = gt; i < 256 * 256; i += NGT) { const int c = i >> 8, k = i & 255; float s = 0.f;
#pragma unroll 8
            for (int j = 0; j < 32; ++j) s += v1[k * 32 + j] * v2[j * 256 + c];
            ((bf16*)((char*)Wb + W_V))[i] = (bf16)f2bf(s); }
    } else {
        float2* rope = (float2*)(ws + WS_ROPE);
        for (int i = gt; i < SEQ * 8; i += NGT) { float c, s; rope_entry(i >> 3, i & 7, c, s); rope[i] = make_float2(c, s); }
    }
    const float* g = a.in[I_N1G] + layer * D;
    bf16* H = (bf16*)(ws + WS_H);
    for (int m = gw; m < M; m += NGW) rms_row_bf16(xin + (size_t)m * D, g, H + (size_t)m * D, lane);
}

__device__ __forceinline__ void phase_c(const Args& a, int layer, LAS unsigned char* lds, int vb, int G) {
    int tid = threadIdx.x; asm volatile("" : "+v"(tid));
    unsigned char* ws = a.ws;
    bf16* PM = (bf16*)(ws + WS_PM); bf16* LA = (bf16*)(ws + WS_LA);
    const float2* rope = (const float2*)(ws + WS_ROPE);
    float* KMP = (float*)(ws + WS_KMP);
    const float* mu = a.in[I_MU] + layer * 1024;
    LAS float* red = (LAS float*)lds;
    for (int u = vb; u < 256; u += G) {
        const int b = u >> 5, hb = u & 31; const int t0 = hb * 128; const size_t row0 = (size_t)b * SEQ + t0;
#pragma unroll
        for (int rr = 0; rr < 2; ++rr) { const int item = tid + 512 * rr; const int tok = item >> 3, hh = (item >> 1) & 3, qk = item & 1;
            bf16* p = PM + (row0 + tok) * PMW + C_MB + qk * 256 + hh * 64;
            const u32x4 x1 = *(const u32x4*)p, x2 = *(const u32x4*)(p + 8);
            const unsigned a1[4] = {x1.x, x1.y, x1.z, x1.w}, a2[4] = {x2.x, x2.y, x2.z, x2.w}; unsigned o1[4], o2[4];
            const float2* rp = rope + (size_t)(t0 + tok) * 8;
#pragma unroll
            for (int j = 0; j < 4; ++j) { const float2 c0 = rp[2 * j], c1 = rp[2 * j + 1];
                const float u0 = bflo(a1[j]), u1 = bfhi(a1[j]), w0 = bflo(a2[j]), w1 = bfhi(a2[j]);
                o1[j] = pk2(u0 * c0.x - w0 * c0.y, u1 * c1.x - w1 * c1.y); o2[j] = pk2(w0 * c0.x + u0 * c0.y, w1 * c1.x + u1 * c1.y); }
            *(u32x4*)p = (u32x4){o1[0], o1[1], o1[2], o1[3]}; *(u32x4*)(p + 8) = (u32x4){o2[0], o2[1], o2[2], o2[3]}; }
        __threadfence_block(); __syncthreads();
        { const int col = tid & 255, half = tid >> 8; float s = 0.f; const bf16* p = PM + (row0 + half * 64) * PMW + C_MB + 256 + col;
            for (int j = 0; j < 64; ++j) s += bf2f(p[(size_t)j * PMW]);
            red[half * 256 + col] = s; }
        __syncthreads();
        if (tid < 256) KMP[((size_t)(b * 4 + (tid >> 6)) * 32 + hb) * 64 + (tid & 63)] = red[tid] + red[256 + tid];
        const int NC = layer ? 512 : 256;
        for (int idx = tid; idx < 128 * NC; idx += 512) { const int tok = idx / NC, c = idx % NC; const int src = c < 256 ? 768 + c : 512 + (c - 256);
            const bf16* p = PM + (row0 + tok) * PMW + C_RW + src; const float x = bf2f(*p); const float xp = (t0 + tok) > 0 ? bf2f(*(p - PMW)) : 0.f;
            const float xs = x + (xp - x) * mu[src];
            const float v = c < 64 ? tanhf(xs) : (c < 128 ? xs : (c < 256 ? sigmoidf_(xs) : xs));
            LA[(row0 + tok) * 512 + c] = (bf16)f2bf(v); }
        __syncthreads();
    }
}

constexpr int TC = 16;
__device__ __forceinline__ float softplusf_(float x) { return fmaxf(x, 0.f) + __logf(1.0f + __expf(-fabsf(x))); }

__device__ __forceinline__ void rwkv_chain(const Args& a, int layer, int bh, LAS float* L) {
    int tid = threadIdx.x; asm volatile("" : "+v"(tid)); const int lane = tid & 63, w = tid >> 6;
    const int b = bh >> 2, h = bh & 3, c = h * 64 + lane;
    unsigned char* ws = a.ws;
    const bf16* PM = (const bf16*)(ws + WS_PM); const bf16* LO = (const bf16*)(ws + WS_LO); bf16* Y = (bf16*)(ws + WS_Y); bf16* VF = (bf16*)(ws + WS_VF);
    LAS float* Rr = L; LAS float* Ww = L + 1024; LAS float* Kk = L + 2048; LAS float* Aa = L + 3072; LAS float* Bb = L + 4096; LAS float* Vv = L + 5120; LAS float* Gg = L + 6144; LAS float* Yr = L + 7168; LAS float* Bon = L + 8192;
    const float* mu = a.in[I_MU] + layer * 1024;
    const float mu_r = mu[c], mu_k = mu[256 + c], mu_v = mu[512 + c];
    const float w0c = a.in[I_W0][layer * 256 + c], a0c = a.in[I_A0][layer * 256 + c], kkc = a.in[I_KK][layer * 256 + c], kac = a.in[I_KA][layer * 256 + c];
    const float rkc = a.in[I_RK][layer * 256 + c], gnw = a.in[I_GNW][layer * 256 + c], gnb = a.in[I_GNB][layer * 256 + c];
    const float v0c = layer ? a.in[I_V0][c] : 0.f;
    float S[64];
#pragma unroll
    for (int k = 0; k < 64; ++k) S[k] = 0.f;
    const size_t rowb = (size_t)b * SEQ;
    for (int ch = 0; ch < SEQ / TC; ++ch) {
#pragma unroll
        for (int jj = 0; jj < 2; ++jj) { const int j = w + 8 * jj, t = ch * TC + j; const size_t row = rowb + t;
            const bf16* p = PM + row * PMW + C_RW + c;
            float r = bf2f(p[0]), k = bf2f(p[256]), v = bf2f(p[512]);
            float rp = 0.f, kp = 0.f, vp = 0.f;
            if (t > 0) { rp = bf2f(*(p - PMW)); kp = bf2f(*(p - PMW + 256)); vp = bf2f(*(p - PMW + 512)); }
            r += (rp - r) * mu_r; k += (kp - k) * mu_k; v += (vp - v) * mu_v;
            const bf16* lo = LO + row * 1024 + c;
            const float wpre = bf2f(lo[0]), apre = bf2f(lo[256]), g = bf2f(lo[512]);
            const float wlog = -softplusf_(-(w0c + wpre)) - 0.5f;
            const float wdec = __expf(-__expf(wlog));
            const float asig = sigmoidf_(a0c + apre);
            if (layer) { const float vg = bf2f(lo[768]); const float vf = bf2f(VF[row * 256 + c]); v += (vf - v) * sigmoidf_(v0c + vg); }
            else VF[row * 256 + c] = (bf16)f2bf(v);
            float kk = k * kkc; const float n2 = wave_sum(kk * kk); kk = kk / fmaxf(sqrtf(n2), 1e-12f);
            const float kmod = k * (1.0f + (asig - 1.0f) * kac);
            const float bon = wave_sum(r * kmod * rkc);
            Rr[j * 64 + lane] = r; Ww[j * 64 + lane] = wdec; Kk[j * 64 + lane] = kmod; Aa[j * 64 + lane] = -kk; Bb[j * 64 + lane] = kk * asig; Vv[j * 64 + lane] = v; Gg[j * 64 + lane] = g;
            if (lane == 0) Bon[j] = bon; }
        __syncthreads();
        if (w == 0) {
            for (int j = 0; j < TC; ++j) { const float vv = Vv[j * 64 + lane]; float sa = 0.f;
#pragma unroll
                for (int k = 0; k < 64; ++k) sa += S[k] * Aa[j * 64 + k];
                float y = 0.f;
#pragma unroll
                for (int k = 0; k < 64; ++k) { S[k] = S[k] * Ww[j * 64 + k] + sa * Bb[j * 64 + k] + vv * Kk[j * 64 + k]; y += S[k] * Rr[j * 64 + k]; }
                Yr[j * 64 + lane] = y; }
        }
        __syncthreads();
#pragma unroll
        for (int jj = 0; jj < 2; ++jj) { const int j = w + 8 * jj, t = ch * TC + j; const size_t row = rowb + t;
            const float y = Yr[j * 64 + lane]; const float mean = wave_sum(y) * (1.f / 64); const float d = y - mean; const float var = wave_sum(d * d) * (1.f / 64);
            const float yn = d * (1.0f / sqrtf(var + 64e-5f)) * gnw + gnb;
            const float o = (yn + Bon[j] * Vv[j * 64 + lane]) * Gg[j * 64 + lane];
            Y[row * 1024 + 256 + c] = (bf16)f2bf(o); }
        __syncthreads();
    }
}

__device__ __forceinline__ void hgrn_chain(const Args& a, int layer, int bh, LAS float* L) {
    int tid = threadIdx.x; asm volatile("" : "+v"(tid)); const int lane = tid & 63, w = tid >> 6;
    const int b = bh >> 2, h = bh & 3, c = h * 64 + lane;
    unsigned char* ws = a.ws;
    const bf16* PM = (const bf16*)(ws + WS_PM); bf16* Y = (bf16*)(ws + WS_Y);
    LAS float* Ff = L; LAS float* Ke = L + 1024; LAS float* Qq = L + 2048; LAS float* Ii = L + 3072; LAS float* Gg = L + 4096; LAS float* Oo = L + 5120;
    float lb = 0.f;
    if (layer) { const float l0 = a.in[I_LB][c], l1 = a.in[I_LB][256 + c]; lb = 1.0f / (1.0f + expf(l0 - l1)); }
    const float gng = a.in[I_HGN][layer * 256 + c];
    float S[64];
#pragma unroll
    for (int k = 0; k < 64; ++k) S[k] = 0.f;
    const size_t rowb = (size_t)b * SEQ;
    for (int ch = 0; ch < SEQ / TC; ++ch) {
#pragma unroll
        for (int jj = 0; jj < 2; ++jj) { const int j = w + 8 * jj, t = ch * TC + j; const size_t row = rowb + t;
            const bf16* p = PM + row * PMW + C_HG + c;
            const float q = bf2f(p[0]), fl = bf2f(p[256]), iv = bf2f(p[512]), g = bf2f(p[768]);
            const float sig = sigmoidf_(fl);
            Ff[j * 64 + lane] = lb + (1.0f - lb) * sig; Ke[j * 64 + lane] = (1.0f - lb) * sigmoidf_(-fl); Qq[j * 64 + lane] = q; Ii[j * 64 + lane] = iv; Gg[j * 64 + lane] = g; }
        __syncthreads();
        if (w == 0) {
            for (int j = 0; j < TC; ++j) { const float iv = Ii[j * 64 + lane]; float o = 0.f;
#pragma unroll
                for (int k = 0; k < 64; ++k) { S[k] = Ff[j * 64 + k] * S[k] + Ke[j * 64 + k] * iv; o += S[k] * Qq[j * 64 + k]; }
                Oo[j * 64 + lane] = o; }
        }
        __syncthreads();
#pragma unroll
        for (int jj = 0; jj < 2; ++jj) { const int j = w + 8 * jj, t = ch * TC + j; const size_t row = rowb + t;
            const float o = Oo[j * 64 + lane]; const float ms = wave_sum(o * o) * (1.f / 64); const float g = Gg[j * 64 + lane];
            const float y = o * (1.0f / sqrtf(ms + 1e-6f)) * gng * (g * sigmoidf_(g));
            Y[row * 1024 + 768 + c] = (bf16)f2bf(y); }
        __syncthreads();
    }
}

__device__ __forceinline__ void stage_kv(const bf16* Kp, const bf16* Vp, LAS float* Ks, LAS float* Vs, int tid) {
    const int key = tid >> 3, d0 = (tid & 7) * 8;
    const u32x4 kx = *(const u32x4*)(Kp + (size_t)key * PMW + d0), vx = *(const u32x4*)(Vp + (size_t)key * PMW + d0);
    LAS f32x4* kd = (LAS f32x4*)(Ks + key * 64 + d0); LAS f32x4* vd = (LAS f32x4*)(Vs + key * 64 + d0);
    kd[0] = (f32x4){bflo(kx.x), bfhi(kx.x), bflo(kx.y), bfhi(kx.y)}; kd[1] = (f32x4){bflo(kx.z), bfhi(kx.z), bflo(kx.w), bfhi(kx.w)};
    vd[0] = (f32x4){bflo(vx.x), bfhi(vx.x), bflo(vx.y), bfhi(vx.y)}; vd[1] = (f32x4){bflo(vx.z), bfhi(vx.z), bflo(vx.w), bfhi(vx.w)};
}

__device__ __forceinline__ void sb_unit(const Args& a, int bh, int qc, LAS float* L, volatile LAS unsigned* MISC) {
    int tid = threadIdx.x; asm volatile("" : "+v"(tid));
    const int b = bh >> 2, h = bh & 3;
    unsigned char* ws = a.ws;
    const bf16* PM = (const bf16*)(ws + WS_PM); bf16* Y = (bf16*)(ws + WS_Y);
    LAS float* Ks = L; LAS float* Vs = L + 4096;
    const int t = qc * 512 + tid; const size_t rowb = (size_t)b * SEQ;
    float q[64], o[64];
    { const bf16* qp = PM + (rowb + t) * PMW + C_SB + h * 64;
#pragma unroll
        for (int i = 0; i < 8; ++i) { const u32x4 x = *(const u32x4*)(qp + i * 8);
            q[i * 8 + 0] = bflo(x.x) * 0.125f; q[i * 8 + 1] = bfhi(x.x) * 0.125f; q[i * 8 + 2] = bflo(x.y) * 0.125f; q[i * 8 + 3] = bfhi(x.y) * 0.125f;
            q[i * 8 + 4] = bflo(x.z) * 0.125f; q[i * 8 + 5] = bfhi(x.z) * 0.125f; q[i * 8 + 6] = bflo(x.w) * 0.125f; q[i * 8 + 7] = bfhi(x.w) * 0.125f; } }
#pragma unroll
    for (int d = 0; d < 64; ++d) o[d] = 0.f;
    float cum = 0.f;
    const int wave_tmax = qc * 512 + (tid | 63);
    for (int kt = qc * 8 + 7; kt >= 0; --kt) {
        __syncthreads();
        stage_kv(PM + (rowb + kt * 64) * PMW + C_SB + 256 + h * 64, PM + (rowb + kt * 64) * PMW + C_SB + 512 + h * 64, Ks, Vs, tid);
        if (tid == 0) MISC[1] = 0u;
        __syncthreads();
        const int s0 = kt * 64;
        if (s0 < wave_tmax) {
            for (int j = 63; j >= 0; --j) {
                const LAS float* kr = Ks + j * 64; float z = 0.f;
#pragma unroll
                for (int d = 0; d < 64; ++d) z += q[d] * kr[d];
                const bool ok = (s0 + j) < t;
                const float l1p = __logf(1.0f + __expf(-fabsf(z)));
                const float ls = fminf(z, 0.f) - l1p, lsn = fminf(-z, 0.f) - l1p;
                const float att = ok ? __expf(ls + cum) : 0.f;
                cum += ok ? lsn : 0.f;
                const LAS float* vr = Vs + j * 64;
#pragma unroll
                for (int d = 0; d < 64; ++d) o[d] += att * vr[d];
            }
        }
        if (!(cum < -110.f)) MISC[1] = 1u;
        __syncthreads();
        if (MISC[1] == 0u) break;
    }
    bf16* yp = Y + (rowb + t) * 1024 + h * 64;
#pragma unroll
    for (int i = 0; i < 8; ++i) { u32x4 w; w.x = pk2(o[i * 8], o[i * 8 + 1]); w.y = pk2(o[i * 8 + 2], o[i * 8 + 3]); w.z = pk2(o[i * 8 + 4], o[i * 8 + 5]); w.w = pk2(o[i * 8 + 6], o[i * 8 + 7]); *(u32x4*)(yp + i * 8) = w; }
    __syncthreads();
}

__device__ __forceinline__ void moba_unit(const Args& a, int bh, int qc, LAS float* L) {
    int tid = threadIdx.x; asm volatile("" : "+v"(tid));
    const int b = bh >> 2, h = bh & 3;
    unsigned char* ws = a.ws;
    const bf16* PM = (const bf16*)(ws + WS_PM); bf16* Y = (bf16*)(ws + WS_Y);
    const float* KMP = (const float*)(ws + WS_KMP);
    LAS float* Ks = L; LAS float* Vs = L + 4096; LAS float* KM = L + 8192;
    const int t = qc * 512 + tid; const size_t rowb = (size_t)b * SEQ;
    __syncthreads();
#pragma unroll
    for (int r = 0; r < 2; ++r) { const int i = tid + 512 * r, j = i >> 6, d = i & 63; const float* kp = KMP + ((size_t)bh * 32 + 2 * j) * 64 + d; KM[i] = (kp[0] + kp[64]) * (1.f / 256); }
    float q[64], o[64];
    { const bf16* qp = PM + (rowb + t) * PMW + C_MB + h * 64;
#pragma unroll
        for (int i = 0; i < 8; ++i) { const u32x4 x = *(const u32x4*)(qp + i * 8);
            q[i * 8 + 0] = bflo(x.x); q[i * 8 + 1] = bfhi(x.x); q[i * 8 + 2] = bflo(x.y); q[i * 8 + 3] = bfhi(x.y);
            q[i * 8 + 4] = bflo(x.z); q[i * 8 + 5] = bfhi(x.z); q[i * 8 + 6] = bflo(x.w); q[i * 8 + 7] = bfhi(x.w); } }
    __syncthreads();
    const int qblk = t >> 8;
    unsigned sel = 0u;
    { float g[16];
#pragma unroll
        for (int j = 0; j < 16; ++j) { float s = 0.f; const LAS float* kr = KM + j * 64;
#pragma unroll
            for (int d = 0; d < 64; ++d) s += q[d] * kr[d];
            g[j] = s; }
#pragma unroll
        for (int r = 0; r < 3; ++r) { float best = -3.0e38f; int bi = -1;
#pragma unroll
            for (int j = 0; j < 16; ++j) { const bool cnd = (j < qblk) && !((sel >> j) & 1u) && (g[j] > best); best = cnd ? g[j] : best; bi = cnd ? j : bi; }
            if (bi >= 0) sel |= 1u << bi; } }
#pragma unroll
    for (int d = 0; d < 64; ++d) o[d] = 0.f;
    float mx = -1.0e30f, l = 0.f;
    const int wave_tmax = qc * 512 + (tid | 63);
    for (int kt = 0; kt <= qc * 8 + 7; ++kt) {
        __syncthreads();
        stage_kv(PM + (rowb + kt * 64) * PMW + C_MB + 256 + h * 64, PM + (rowb + kt * 64) * PMW + C_MB + 512 + h * 64, Ks, Vs, tid);
        __syncthreads();
        const int s0 = kt * 64, sblk = kt >> 2;
        if (s0 <= wave_tmax) {
            const bool past = sblk < qblk;
            const bool blk_ok = past ? (((sel >> sblk) & 1u) != 0u) : (sblk == qblk);
            if (__any(blk_ok)) {
                for (int j = 0; j < 64; ++j) {
                    const LAS float* kr = Ks + j * 64; float z = 0.f;
#pragma unroll
                    for (int d = 0; d < 64; ++d) z += q[d] * kr[d];
                    z *= 0.125f;
                    const bool ok = blk_ok && (past || (s0 + j) <= t);
                    if (ok && z > mx + 8.f) { const float f = __expf(mx - z); l *= f;
#pragma unroll
                        for (int d = 0; d < 64; ++d) o[d] *= f;
                        mx = z; }
                    const float p = ok ? __expf(z - mx) : 0.f;
                    l += p;
                    const LAS float* vr = Vs + j * 64;
#pragma unroll
                    for (int d = 0; d < 64; ++d) o[d] += p * vr[d];
                }
            }
        }
    }
    const float rl = 1.0f / l;
    bf16* yp = Y + (rowb + t) * 1024 + 512 + h * 64;
#pragma unroll
    for (int i = 0; i < 8; ++i) { u32x4 w; w.x = pk2(o[i * 8] * rl, o[i * 8 + 1] * rl); w.y = pk2(o[i * 8 + 2] * rl, o[i * 8 + 3] * rl); w.z = pk2(o[i * 8 + 4] * rl, o[i * 8 + 5] * rl); w.w = pk2(o[i * 8 + 6] * rl, o[i * 8 + 7] * rl); *(u32x4*)(yp + i * 8) = w; }
    __syncthreads();
}

__device__ __forceinline__ void phase_e(const Args& a, int layer, LAS unsigned char* lds, volatile LAS unsigned* MISC, int vb) {
    LAS float* L = (LAS float*)lds;
    unsigned* work = (unsigned*)(a.ws + WS_CTL) + CW_WORK + 64 * layer;
    for (int c = vb; c < 64; c += (int)gridDim.x) { if (c < 32) rwkv_chain(a, layer, c, L); else hgrn_chain(a, layer, c - 32, L); }
    for (;;) {
        __syncthreads();
        if (threadIdx.x == 0) MISC[0] = __hip_atomic_fetch_add(work, 1u, __ATOMIC_RELAXED, __HIP_MEMORY_SCOPE_AGENT);
        __syncthreads();
        const unsigned u = MISC[0];
        if (u >= 512u) break;
        if (u < 256u) moba_unit(a, (int)(u & 31u), 7 - (int)(u >> 5), L);
        else sb_unit(a, (int)((u - 256u) & 31u), 7 - (int)((u - 256u) >> 5), L, MISC);
    }
}

#if MK_ONE_LAUNCH
#define SEAM() xcd_barrier(bar)
#else
#define SEAM() do {} while (0)
#endif
#define IN(k) (lo <= (k) && (k) < hi)
#define BOTH(k) (IN(k) && IN((k) + 1))
template <int LAYER>
__device__ __forceinline__ void layer_phases(const Args& args, LAS unsigned char* lds, volatile LAS unsigned* MISC, const XcdBarrier& bar, int lo, int hi, int vb0, int G0) {
    constexpr int layer = LAYER;
    unsigned char* ws = args.ws;
    float* xres = args.out;
        const int pb = layer * 10;
        const float* xin = layer ? (const float*)args.out : args.in[I_X];
        const char* Wb = (const char*)(ws + WS_W);
        if (IN(pb + 0)) { const int vb = opaque_s(vb0), G = opaque_s(G0); phase_a(args, layer, xin, lds, vb, G); if (BOTH(pb + 0)) SEAM(); }
        if (IN(pb + 1)) { const int vb = opaque_s(vb0), G = opaque_s(G0);
            pg8::PlainOrder S{(const char*)(ws + WS_H), Wb + W_IN, 2048u, 2048u, 16, 128, 14, G, vb};
            pg8::EpiBf16 E{(bf16*)(ws + WS_PM), PMW};
            pg8::gemm_phase<pg8::EpiBf16, pg8::PlainOrder, true>(lds, S, E);
            if (BOTH(pb + 1)) SEAM();
        }
        if (IN(pb + 2)) { const int vb = opaque_s(vb0), G = opaque_s(G0); phase_c(args, layer, lds, vb, G); if (BOTH(pb + 2)) SEAM(); }
        if (IN(pb + 3)) { const int vb = opaque_s(vb0), G = opaque_s(G0);
            pg8::LoraOrder S{(const char*)(ws + WS_LA), Wb + W_L, Wb + W_V, layer ? 4 : 3, G, vb};
            pg8::EpiBf16 E{(bf16*)(ws + WS_LO), 1024};
            pg8::gemm_phase<pg8::EpiBf16, pg8::LoraOrder, true>(lds, S, E);
            if (BOTH(pb + 3)) SEAM();
        }
        if (IN(pb + 4)) { const int vb = opaque_s(vb0); phase_e(args, layer, lds, MISC, vb); if (BOTH(pb + 4)) SEAM(); }
        if (IN(pb + 5)) { const int vb = opaque_s(vb0), G = opaque_s(G0);
            pg8::MergeOrder S{(const char*)(ws + WS_H), (const char*)(ws + WS_Y), Wb + W_IN + (size_t)PMW * 2048, Wb + W_B, G, vb};
            pg8::EpiMerge E{(u32x4*)(ws + WS_LA) + (size_t)vb * 8192, (bf16*)(ws + WS_PM)};
            pg8::gemm_phase<pg8::EpiMerge, pg8::MergeOrder, true>(lds, S, E);
            if (BOTH(pb + 5)) SEAM();
        }
        if (IN(pb + 6)) { const int vb = opaque_s(vb0), G = opaque_s(G0);
            pg8::PlainOrder S{(const char*)(ws + WS_PM), Wb + W_O, 2048u, 2048u, 16, 128, 4, G, vb};
            pg8::EpiResF32 E{xin, xres};
            pg8::gemm_phase<pg8::EpiResF32, pg8::PlainOrder, true>(lds, S, E);
            if (BOTH(pb + 6)) SEAM();
        }
        if (IN(pb + 7)) { const int vb = opaque_s(vb0), G = opaque_s(G0); int tl = threadIdx.x; asm volatile("" : "+v"(tl)); const int lane = tl & 63, wave = tl >> 6;
            const float* g = args.in[I_N2G] + layer * D; bf16* H = (bf16*)(ws + WS_H);
            for (int m = vb * 8 + wave; m < M; m += G * 8) rms_row_bf16(xres + (size_t)m * D, g, H + (size_t)m * D, lane);
            if (BOTH(pb + 7)) SEAM();
        }
        if (IN(pb + 8)) { const int vb = opaque_s(vb0), G = opaque_s(G0);
            pg8::PlainOrder S{(const char*)(ws + WS_H), Wb + W_GU, 2048u, 2048u, 16, 128, 22, G, vb};
            pg8::EpiSwiGLU E{(bf16*)(ws + WS_PM)};
            pg8::gemm_phase<pg8::EpiSwiGLU, pg8::PlainOrder, true>(lds, S, E);
            if (BOTH(pb + 8)) SEAM();
        }
        if (IN(pb + 9)) { const int vb = opaque_s(vb0), G = opaque_s(G0);
            pg8::PlainOrder S{(const char*)(ws + WS_PM), Wb + W_D, (unsigned)(DFF * 2), (unsigned)(DFF * 2), DFF / 64, 128, 4, G, vb};
            pg8::EpiResF32 E{xres, xres};
            pg8::gemm_phase<pg8::EpiResF32, pg8::PlainOrder, true>(lds, S, E);
            if (BOTH(pb + 9)) SEAM();
        }
}

__global__ void __launch_bounds__(512, 2) skel_fwd(Args args) {
    extern __shared__ __attribute__((aligned(16))) unsigned char lds_raw[];
    LAS unsigned char* lds = (LAS unsigned char*)lds_raw;
    volatile LAS unsigned* MISC = (volatile LAS unsigned*)(lds + MISC_OFF);
    const int tid = threadIdx.x;
    const int G0 = gridDim.x, vb0 = blockIdx.x;
    unsigned char* ws = args.ws;
    unsigned* ctl = (unsigned*)(ws + WS_CTL);
    for (int u = tid; u < (LDS_BYTES - LDSCTL_OFF) / 4; u += 512) ((LAS unsigned*)(lds + LDSCTL_OFF))[u] = 0u;
    __syncthreads();
#if MK_ONE_LAUNCH
    XcdBarrier bar = xcd_barrier_post(ctl + CW_BAR, MISC + 8);
#else
    XcdBarrier bar; bar.bar = ctl + CW_BAR; bar.x = 0; bar.st = MISC + 8;
#endif
    const int lo = args.ph_lo, hi = args.ph_hi;
    float* xres = args.out;
    layer_phases<0>(args, lds, MISC, bar, lo, hi, vb0, G0);
    layer_phases<1>(args, lds, MISC, bar, lo, hi, vb0, G0);
    if (IN(20)) { const int vb = opaque_s(vb0), G = opaque_s(G0); int tl = threadIdx.x; asm volatile("" : "+v"(tl)); const int lane = tl & 63, wave = tl >> 6;
        const float* g = args.in[I_FG];
        for (int m = vb * 8 + wave; m < M; m += G * 8) rms_row_f32(xres + (size_t)m * D, g, xres + (size_t)m * D, lane);
    }
#undef IN
#undef BOTH
#undef SEAM
}

extern "C" void kernel_launch(void* const* d_in, const int* in_sizes, int n_in, void* d_out, int out_size, void* d_ws, size_t ws_size, hipStream_t stream) {
    static int grid = 0;
    if (grid == 0) {
        if (n_in != 26 || in_sizes[0] != M * D || out_size != M * D || ws_size < WS_END) { fprintf(stderr, "kernel_launch: unexpected shapes (n_in %d, in0 %d, out %d, ws %zu); nothing launched\n", n_in, n_in > 0 ? in_sizes[0] : -1, out_size, ws_size); grid = -1; return; }
        int dev = 0, cus = 0, per_cu = 0;
        if (hipGetDevice(&dev) != hipSuccess || hipDeviceGetAttribute(&cus, hipDeviceAttributeMultiprocessorCount, dev) != hipSuccess) { grid = -1; return; }
        if (hipFuncSetAttribute((const void*)skel_fwd, hipFuncAttributeMaxDynamicSharedMemorySize, LDS_BYTES) != hipSuccess) { fprintf(stderr, "kernel_launch: hipFuncSetAttribute failed\n"); grid = -1; return; }
        if (hipOccupancyMaxActiveBlocksPerMultiprocessor(&per_cu, (const void*)skel_fwd, 512, LDS_BYTES) != hipSuccess || per_cu < 1) fprintf(stderr, "kernel_launch: occupancy query reports %d\n", per_cu);
        (void)hipGetLastError();
        grid = cus;
    }
    if (grid < 0) return;
    if (hipMemsetAsync((char*)d_ws + WS_CTL, 0, CTL_ZERO_BYTES, stream) != hipSuccess) return;
    Args a{};
    for (int i = 0; i < 26; ++i) a.in[i] = (const float*)d_in[i];
    a.out = (float*)d_out; a.ws = (unsigned char*)d_ws;
#if MK_ONE_LAUNCH
    a.ph_lo = 0; a.ph_hi = NPH;
    hipLaunchKernelGGL(skel_fwd, dim3(grid), dim3(512), LDS_BYTES, stream, a);
#else
    for (int p = 0; p < NPH; ++p) { a.ph_lo = p; a.ph_hi = p + 1; hipLaunchKernelGGL(skel_fwd, dim3(grid), dim3(512), LDS_BYTES, stream, a); }
#endif
}
```

```cpp
#include <hip/hip_runtime.h>
#include <cstdio>
#include <cstdint>

#ifndef REPEAT_PH
#define REPEAT_PH -1
#endif
#ifndef MK_ONE_LAUNCH
#define MK_ONE_LAUNCH 1
#endif

#define LAS __attribute__((address_space(3)))
#define GAS __attribute__((address_space(1)))
typedef unsigned short bf16;
typedef short bf16x8 __attribute__((ext_vector_type(8)));
typedef float f32x4 __attribute__((ext_vector_type(4)));
typedef float f32x2 __attribute__((ext_vector_type(2)));
typedef unsigned u32x4 __attribute__((ext_vector_type(4)));
typedef unsigned u32x2 __attribute__((ext_vector_type(2)));

constexpr int D = 1024, NBATCH = 8, SEQ = 4096, M = NBATCH * SEQ, DFF = 2816, NH = 4, HD = 64, MW = 256;
constexpr int PMW = 3584;
constexpr int C_SB = 0, C_RW = 768, C_MB = 1792, C_HG = 2560;
constexpr int PPL = 12, NPH = 2 * PPL + 1;

constexpr size_t MiB = 1u << 20;
constexpr size_t WS_CTL = 0, CTL_ZERO_BYTES = 1 * MiB;
constexpr size_t WS_ROPE = 1 * MiB;
constexpr size_t WS_KMP = 1 * MiB + 512 * 1024;
constexpr size_t WS_BON = 2 * MiB;
constexpr size_t WS_RSQ1 = 2 * MiB + 512 * 1024;
constexpr size_t WS_RSQ2 = 3 * MiB;
constexpr size_t WS_W = 4 * MiB;
constexpr size_t W_IN = 0, W_B = 15728640, W_O = W_B + 2097152, W_GU = W_O + 2097152, W_D = W_GU + 11534336, W_L = W_D + 5767168, W_V = W_L + 393216, W_END = W_V + 131072;
static_assert(W_END == 36 * MiB, "weights");
constexpr size_t WS_H = 40 * MiB;
constexpr size_t WS_PM = 104 * MiB;
constexpr size_t WS_LA = 328 * MiB;
constexpr size_t RS_ENTRY = 13056;
constexpr size_t WS_RS = 328 * MiB;
constexpr size_t WS_XF = 328 * MiB;
constexpr size_t WS_LO = 432 * MiB;
constexpr size_t WS_VF = 496 * MiB;
constexpr size_t WS_END = 512 * MiB;
static_assert(WS_RS + 8192 * RS_ENTRY <= WS_LO, "rwkv chunk stream");
constexpr int CW_TMO = 0;
constexpr int CW_BAR = 4096;
constexpr int CW_WORK = 16384;

constexpr int RING_BYTES = 131072;
constexpr int LDSCTL_OFF = RING_BYTES, MISC_OFF = LDSCTL_OFF + 320;
constexpr int LDS_XP = RING_BYTES + 1024, LDS_RSL = LDS_XP + 4096;
constexpr int LDS_BYTES = 147456;

__device__ __forceinline__ unsigned f2bf(float f) { unsigned u = __builtin_bit_cast(unsigned, f); return (u + 0x7fffu + ((u >> 16) & 1u)) >> 16; }
__device__ __forceinline__ unsigned pk2(float lo, float hi) { return f2bf(lo) | (f2bf(hi) << 16); }
__device__ __forceinline__ float bf2f(unsigned short b) { return __builtin_bit_cast(float, ((unsigned)b) << 16); }
__device__ __forceinline__ float bflo(unsigned w) { return __builtin_bit_cast(float, w << 16); }
__device__ __forceinline__ float bfhi(unsigned w) { return __builtin_bit_cast(float, w & 0xffff0000u); }
typedef __bf16 bf16x2_t __attribute__((ext_vector_type(2)));
__device__ __forceinline__ unsigned cvt_pk_bf16(float lo, float hi) { f32x2 v = {lo, hi}; bf16x2_t b = __builtin_convertvector(v, bf16x2_t); return __builtin_bit_cast(unsigned, b); }
__device__ __forceinline__ float wave_sum(float v) {
#pragma unroll
    for (int o = 1; o < 64; o <<= 1) v += __shfl_xor(v, o);
    return v;
}
__device__ __forceinline__ float sigmoidf_(float x) { return __builtin_amdgcn_rcpf(1.0f + __expf(-x)); }
#define LDS_WAIT() asm volatile("s_waitcnt lgkmcnt(0)" ::: "memory")
#define LBAR() do { asm volatile("s_waitcnt lgkmcnt(0)" ::: "memory"); __builtin_amdgcn_s_barrier(); asm volatile("" ::: "memory"); } while (0)
__device__ __forceinline__ f32x4 ld4bf(const bf16* p) { const u32x2 w = *(const u32x2*)p; return (f32x4){bflo(w.x), bfhi(w.x), bflo(w.y), bfhi(w.y)}; }
__device__ __forceinline__ float dpp_sum16(float x);
__device__ __forceinline__ int opaque_s(int v) { asm volatile("" : "+s"(v)); return v; }

__device__ __forceinline__ void st4bf(bf16* p, f32x4 v) { u32x2 w; w.x = cvt_pk_bf16(v.x, v.y); w.y = cvt_pk_bf16(v.z, v.w); *(u32x2*)p = w; }
__device__ __forceinline__ float dpp_sum16(float x) {
    x += __builtin_bit_cast(float, __builtin_amdgcn_update_dpp(0, __builtin_bit_cast(int, x), 0xB1, 0xF, 0xF, true));
    x += __builtin_bit_cast(float, __builtin_amdgcn_update_dpp(0, __builtin_bit_cast(int, x), 0x4E, 0xF, 0xF, true));
    x += __builtin_bit_cast(float, __builtin_amdgcn_update_dpp(0, __builtin_bit_cast(int, x), 0x141, 0xF, 0xF, true));
    x += __builtin_bit_cast(float, __builtin_amdgcn_update_dpp(0, __builtin_bit_cast(int, x), 0x140, 0xF, 0xF, true));
    return x;
}
__device__ __forceinline__ float dpp_xor2(float x) { int r; asm volatile("s_nop 1\n\tv_mov_b32_dpp %0, %1 quad_perm:[2,3,0,1] row_mask:0xf bank_mask:0xf\n\ts_nop 0" : "=&v"(r) : "v"(__builtin_bit_cast(int, x))); return __builtin_bit_cast(float, r); }
__device__ __forceinline__ float softplusf_(float x) { return fmaxf(x, 0.f) + __logf(1.0f + __expf(-fabsf(x))); }
#define XB_TMO      128
#define XB_XCNT(j)  (256  + 64 * (j))
#define XB_XSUB(j)  (1280 + 64 * (j))
#define XB_XGEN(j)  (2304 + 64 * (j))
#define XB_TOP      3328
#define XB_TOPGEN   3392
#define XCD_BAR_WORDS 3456
#define XB_SPIN_CAP (1u << 22)
__device__ __forceinline__ unsigned xb_ld(unsigned* p)              { return __hip_atomic_load(p, __ATOMIC_RELAXED, __HIP_MEMORY_SCOPE_AGENT); }
__device__ __forceinline__ unsigned xb_add(unsigned* p, unsigned v) { return __hip_atomic_fetch_add(p, v, __ATOMIC_RELAXED, __HIP_MEMORY_SCOPE_AGENT); }
__device__ __forceinline__ unsigned xb_xcc_id() { return (unsigned)__builtin_amdgcn_s_getreg((3 << 11) | 20) & 0xFu; }
#define XB_SPIN(cond, bar) do { unsigned _sp = 0; while (cond) { __builtin_amdgcn_s_sleep(1); \
    if ((++_sp & 255u) == 0u) { if (xb_ld(&(bar)[XB_TMO])) break; if (_sp > XB_SPIN_CAP) { atomicAdd(&(bar)[XB_TMO], 1u); break; } } } } while (0)
struct XcdBarrier { unsigned* bar; unsigned x; volatile LAS unsigned* st; };
__device__ __forceinline__ XcdBarrier xcd_barrier_post(unsigned* bar, volatile LAS unsigned* st) {
    XcdBarrier b; b.bar = bar; b.x = xb_xcc_id(); b.st = st;
    if (threadIdx.x == 0) (void)xb_add(&bar[XB_XCNT(b.x)], 1u);
    return b;
}
__device__ __forceinline__ void xcd_barrier_complete(unsigned* bar, unsigned x, unsigned& nloc, unsigned& nx) {
    const unsigned G = gridDim.x * gridDim.y * gridDim.z;
    unsigned sum, cnt, mine, sp = 0u;
    for (;;) {
        sum = 0u; cnt = 0u; mine = 0u;
#pragma unroll
        for (unsigned j = 0; j < 16; ++j) { const unsigned c = xb_ld(&bar[XB_XCNT(j)]); sum += c; cnt += (c > 0u) ? 1u : 0u; mine = (j == x) ? c : mine; }
        if (sum == G) break;
        __builtin_amdgcn_s_sleep(1);
        if ((++sp & 255u) == 0u) { if (xb_ld(&bar[XB_TMO])) break; if (sp > XB_SPIN_CAP) { atomicAdd(&bar[XB_TMO], 1u); break; } }
    }
    nloc = mine > 0u ? mine : 1u; nx = cnt > 0u ? cnt : 1u;
}
__device__ __forceinline__ void xcd_barrier(const XcdBarrier& b) {
    asm volatile("s_waitcnt vmcnt(0)" ::: "memory");
    __syncthreads();
    if (threadIdx.x == 0) {
        unsigned* bar = b.bar;
        __builtin_amdgcn_s_waitcnt(0);
        unsigned nloc = b.st[0], nx = b.st[1];
        if (nloc == 0u) { xcd_barrier_complete(bar, b.x, nloc, nx); b.st[0] = nloc; b.st[1] = nx; }
        const unsigned old = xb_add(&bar[XB_XSUB(b.x)], 1u);
        const unsigned gen = old / nloc;
        if (old + 1u == (gen + 1u) * nloc) {
            __builtin_amdgcn_fence(__ATOMIC_RELEASE, "agent");
            asm volatile("s_waitcnt vmcnt(0)" ::: "memory");
            const unsigned og = xb_add(&bar[XB_TOP], 1u);
            const unsigned tg = og / nx;
            if (og + 1u == (tg + 1u) * nx) xb_add(&bar[XB_TOPGEN], 1u);
            else XB_SPIN(xb_ld(&bar[XB_TOPGEN]) == tg, bar);
            __builtin_amdgcn_fence(__ATOMIC_ACQUIRE, "agent");
            xb_add(&bar[XB_XGEN(b.x)], 1u);
            asm volatile("s_waitcnt vmcnt(0)" ::: "memory");
        } else {
            XB_SPIN(xb_ld(&bar[XB_XGEN(b.x)]) == gen, bar);
            __builtin_amdgcn_fence(__ATOMIC_ACQUIRE, "agent");
            asm volatile("s_waitcnt vmcnt(0)" ::: "memory");
        }
    }
    __syncthreads();
}

namespace pg8 {
constexpr int BM = 256, BK = 64, HALF = 128, HTB = HALF * BK * 2, STAGE_BYTES = 8 * HTB, NXCD = 8, WGM = 8;
__host__ __device__ __forceinline__ int lds_byte(int r, int c) { const int st = (r >> 4) * 2 + (c >> 5), rr = r & 15, cc = c & 31, ob = rr * 64 + cc * 2; return st * 1024 + (ob ^ (((ob >> 9) & 1) << 5)); }
__host__ __device__ __forceinline__ void stage_rc(int b, int& R, int& C) { const int st = b / 1024, sb = b % 1024, swz = sb ^ (((sb >> 9) & 1) << 5); R = (st >> 1) * 16 + swz / 64; C = (st & 1) * 32 + (swz % 64) / 2; }
__host__ __device__ __forceinline__ int perm32(int rho) { const int n = rho >> 4, i = rho & 15; return 8 * (i >> 2) + 4 * n + (i & 3); }

struct GU { const char* a; const char* b; unsigned lda2, ldb2; int nt, pm, pn, sub; };

__device__ __forceinline__ void tile_of(int L, int nM, int nN, int& pm, int& pn) {
    const int nwg = nM * nN;
    int wgid = L; { const int q = nwg / NXCD, r = nwg % NXCD, xcd = wgid % NXCD, off = wgid / NXCD; wgid = (xcd < r ? xcd * (q + 1) : r * (q + 1) + (xcd - r) * q) + off; }
    const int nig = WGM * nN, gid = wgid / nig, fm = gid * WGM, gsz = (nM - fm) < WGM ? (nM - fm) : WGM;
    pm = fm + ((wgid % nig) % gsz); pn = (wgid % nig) / gsz;
}

template <class Epi, class Sched, bool ALIGN_EPI>
__device__ __forceinline__ void gemm_phase(LAS unsigned char* lds, const Sched& S, const Epi& E) {
    int tid = threadIdx.x; asm volatile("" : "+v"(tid));
    const int wid = __builtin_amdgcn_readfirstlane(tid >> 6), lane = tid & 63, wr = wid >> 2, wc = wid & 3, fr = lane & 15, fq = lane >> 4;
    unsigned Rr, Rb, C2;
    { int R, C; stage_rc(tid * 16, R, C); Rr = (unsigned)R; Rb = (unsigned)(Epi::PERM ? ((R & ~31) + perm32(R & 31)) : R); C2 = (unsigned)C * 2u; }
    const size_t kstep = (size_t)(BK * 2);
    const unsigned ldsw = (unsigned)wid * 1024u;
    const int aoff = lds_byte(wr * 64 + fr, fq * 8), boff = lds_byte(wc * 32 + fr, fq * 8);
#define PG8_SA(b, h) (((b) * 2 + (h)) * HTB)
#define PG8_SB(b, h) ((4 + (b) * 2 + (h)) * HTB)
#define PG8_STAGE(bufoff, gbase, R, ld) do { const unsigned _v0 = (R) * (ld) + C2; \
        __builtin_amdgcn_global_load_lds((const unsigned*)((const char*)(gbase) + _v0), (LAS unsigned*)(lds + (bufoff) + ldsw), 16, 0, 0); \
        __builtin_amdgcn_global_load_lds((const unsigned*)((const char*)(gbase) + _v0 + 64u * (ld)), (LAS unsigned*)(lds + (bufoff) + ldsw + 8192), 16, 0, 0); } while (0)
#define PG8_LDA(dst, b, h) do { _Pragma("unroll") for (int m = 0; m < 4; ++m) _Pragma("unroll") for (int k = 0; k < 2; ++k) dst[m][k] = *(const LAS bf16x8*)(lds + PG8_SA(b, h) + aoff + m * 2048 + k * 1024); } while (0)
#define PG8_LDB(dst, b, h) do { _Pragma("unroll") for (int n = 0; n < 2; ++n) _Pragma("unroll") for (int k = 0; k < 2; ++k) dst[n][k] = *(const LAS bf16x8*)(lds + PG8_SB(b, h) + boff + n * 2048 + k * 1024); } while (0)
#define PG8_MMA(ai, bj, At, Bt) do { __builtin_amdgcn_s_setprio(1); _Pragma("unroll") for (int m = 0; m < 4; ++m) _Pragma("unroll") for (int n = 0; n < 2; ++n) _Pragma("unroll") for (int k = 0; k < 2; ++k) \
        acc[ai][bj][m][n] = __builtin_amdgcn_mfma_f32_16x16x32_bf16(Bt[n][k], At[m][k], acc[ai][bj][m][n], 0, 0, 0); __builtin_amdgcn_s_setprio(0); } while (0)
#define PG8_WAIT_V(n) asm volatile("s_waitcnt vmcnt(" #n ")" ::: "memory")
#define PG8_WAIT_L(n) asm volatile("s_waitcnt lgkmcnt(" #n ")" ::: "memory")
#define PG8_BAR __builtin_amdgcn_s_barrier()
#define PG8_SCHED __builtin_amdgcn_sched_barrier(0)
    GU cur, nxt; int ui = 0;
    if (!S.next(0, cur)) return;
    f32x4 acc[2][2][4][2];
#pragma unroll
    for (int a = 0; a < 2; ++a)
#pragma unroll
        for (int b = 0; b < 2; ++b)
#pragma unroll
            for (int m = 0; m < 4; ++m)
#pragma unroll
                for (int n = 0; n < 2; ++n) acc[a][b][m][n] = (f32x4){0.f, 0.f, 0.f, 0.f};
    bf16x8 At[4][2], B0[2][2], B1[2][2];
    const char* cA = cur.a; const char* cB = cur.b;
    unsigned ldA = cur.lda2, ldB = cur.ldb2;
    PG8_STAGE(PG8_SB(0, 0), cB, Rb, ldB); PG8_STAGE(PG8_SB(0, 1), cB + (size_t)HALF * ldB, Rb, ldB); PG8_STAGE(PG8_SA(0, 0), cA, Rr, ldA); PG8_STAGE(PG8_SA(0, 1), cA + (size_t)HALF * ldA, Rr, ldA);
    if (wr == 1) PG8_BAR;
    PG8_WAIT_V(2); PG8_BAR;
    PG8_STAGE(PG8_SB(1, 0), cB + kstep, Rb, ldB); PG8_STAGE(PG8_SA(1, 0), cA + kstep, Rr, ldA); PG8_STAGE(PG8_SB(1, 1), cB + (size_t)HALF * ldB + kstep, Rb, ldB);
    PG8_WAIT_V(6); PG8_BAR;
    for (;;) {
        const bool has_next = S.next(ui + 1, nxt);
        const char* nA = has_next ? nxt.a : cA; const char* nB = has_next ? nxt.b : cB;
        const unsigned nldA = has_next ? nxt.lda2 : ldA, nldB = has_next ? nxt.ldb2 : ldB;
        const int nt = cur.nt;
        for (int t = 0; t < nt; t += 2) {
            const bool last = (t == nt - 2);
            const char* a1 = cA + (size_t)(t + 1) * kstep;
            const char* a2 = last ? nA : cA + (size_t)(t + 2) * kstep; const char* b2 = last ? nB : cB + (size_t)(t + 2) * kstep;
            const char* a3 = a2 + kstep; const char* b3 = b2 + kstep;
            const unsigned xldA = last ? nldA : ldA, xldB = last ? nldB : ldB;
            PG8_LDB(B0, 0, 0); PG8_LDB(B1, 0, 1); PG8_SCHED; PG8_LDA(At, 0, 0); PG8_STAGE(PG8_SA(1, 1), a1 + (size_t)HALF * ldA, Rr, ldA);
            PG8_WAIT_V(8); PG8_WAIT_L(0); PG8_BAR; PG8_MMA(0, 0, At, B0); PG8_MMA(0, 1, At, B1); PG8_BAR; PG8_SCHED;
            PG8_LDA(At, 0, 1); PG8_STAGE(PG8_SB(0, 0), b2, Rb, xldB); PG8_STAGE(PG8_SB(0, 1), b2 + (size_t)HALF * xldB, Rb, xldB); PG8_STAGE(PG8_SA(0, 0), a2, Rr, xldA);
            PG8_WAIT_V(8); PG8_WAIT_L(0); PG8_BAR; PG8_MMA(1, 0, At, B0); PG8_MMA(1, 1, At, B1); PG8_BAR; PG8_SCHED;
            PG8_LDB(B0, 1, 0); PG8_LDB(B1, 1, 1); PG8_SCHED; PG8_LDA(At, 1, 0); PG8_STAGE(PG8_SA(0, 1), a2 + (size_t)HALF * xldA, Rr, xldA);
            PG8_WAIT_V(8); PG8_WAIT_L(0); PG8_BAR; PG8_MMA(0, 0, At, B0); PG8_MMA(0, 1, At, B1); PG8_BAR; PG8_SCHED;
            PG8_LDA(At, 1, 1); PG8_STAGE(PG8_SB(1, 0), b3, Rb, xldB); PG8_STAGE(PG8_SB(1, 1), b3 + (size_t)HALF * xldB, Rb, xldB); PG8_STAGE(PG8_SA(1, 0), a3, Rr, xldA);
            PG8_WAIT_V(8); PG8_WAIT_L(0); PG8_BAR; PG8_MMA(1, 0, At, B0); PG8_MMA(1, 1, At, B1); PG8_BAR; PG8_SCHED;
        }
        if constexpr (ALIGN_EPI) { if (wr == 0) PG8_BAR; }
        E(acc, cur, wr, wc, fr, fq);
        if (!has_next) break;
#pragma unroll
        for (int a = 0; a < 2; ++a)
#pragma unroll
            for (int b = 0; b < 2; ++b)
#pragma unroll
                for (int m = 0; m < 4; ++m)
#pragma unroll
                    for (int n = 0; n < 2; ++n) acc[a][b][m][n] = (f32x4){0.f, 0.f, 0.f, 0.f};
        cur = nxt; cA = nA; cB = nB; ldA = nldA; ldB = nldB; ++ui;
        if constexpr (ALIGN_EPI) { if (wr == 1) PG8_BAR; }
    }
    PG8_WAIT_V(0);
    if constexpr (!ALIGN_EPI) { if (wr == 0) PG8_BAR; }
    PG8_BAR;
#undef PG8_SA
#undef PG8_SB
#undef PG8_STAGE
#undef PG8_LDA
#undef PG8_LDB
#undef PG8_MMA
#undef PG8_WAIT_V
#undef PG8_WAIT_L
#undef PG8_BAR
#undef PG8_SCHED
}

struct PlainOrder {
    const char* A; const char* B; unsigned lda2, ldb2; int nt, nM, nN, G, c;
    __device__ __forceinline__ bool next(int i, GU& u) const {
        const int L = i * G + c; if (L >= nM * nN) return false;
        int pm, pn; tile_of(L, nM, nN, pm, pn);
        u.pm = pm; u.pn = pn; u.sub = 0; u.nt = nt; u.lda2 = lda2; u.ldb2 = ldb2;
        u.a = A + (size_t)pm * 256 * lda2; u.b = B + (size_t)pn * 256 * ldb2; return true;
    }
};
struct LoraOrder {
    const char* A; const char* Bl; const char* Bv; int nN, G, c;
    __device__ __forceinline__ bool next(int i, GU& u) const {
        const int L = i * G + c; if (L >= 128 * nN) return false;
        int pm, pn; tile_of(L, 128, nN, pm, pn);
        u.pm = pm; u.pn = pn; u.sub = 0; u.nt = 4; u.lda2 = 1024; u.ldb2 = 512;
        u.a = A + (size_t)pm * 256 * 1024 + (pn == 3 ? 512 : 0); u.b = (pn == 3) ? Bv : Bl + (size_t)pn * 256 * 512; return true;
    }
};
struct MergeOrder {
    const char* Hh; const char* Yy; const char* Wg; const char* Wb; int G, c;
    __device__ __forceinline__ bool next(int i, GU& u) const {
        const int ti = i >> 3, sub = i & 7, n = sub >> 1;
        const int L = ti * G + c; if (L >= 512) return false;
        int pm, pn; tile_of(L, 128, 4, pm, pn);
        u.pm = pm; u.pn = pn; u.sub = sub; u.lda2 = 2048;
        if ((sub & 1) == 0) { u.a = Hh + (size_t)pm * 256 * 2048; u.b = Wg + (size_t)(n * 1024 + pn * 256) * 2048; u.ldb2 = 2048; u.nt = 16; }
        else { const int co = n == 0 ? C_SB : (n == 1 ? C_RW : (n == 2 ? C_MB : C_HG)); u.a = Yy + (size_t)pm * 256 * (PMW * 2) + co * 2; u.lda2 = PMW * 2; u.b = Wb + (size_t)(n * 1024 + pn * 256) * 512; u.ldb2 = 512; u.nt = 4; }
        return true;
    }
};

__device__ __forceinline__ void unit_row_scales(const float* rsq, int pm, LAS unsigned char* ldsx, int tid, int wr, int fr, float (&rs)[2][4]) {
    LAS float* RSL = (LAS float*)(ldsx + LDS_RSL);
    if (tid < 256) { const f32x4 q = *(const f32x4*)(rsq + (size_t)(pm * 256 + tid) * 4); RSL[tid] = 1.0f / sqrtf(((q.x + q.y) + (q.z + q.w)) * (1.f / D) + 1e-6f); }
    LBAR();
#pragma unroll
    for (int ai = 0; ai < 2; ++ai)
#pragma unroll
        for (int m = 0; m < 4; ++m) rs[ai][m] = RSL[ai * HALF + wr * 64 + m * 16 + fr];
}
struct EpiBf16S {
    static constexpr bool PERM = true;
    bf16* O; int ldc; const float* rsq; LAS unsigned char* ldsx;
    __device__ __forceinline__ void operator()(const f32x4 (&acc)[2][2][4][2], const GU& u, int wr, int wc, int fr, int fq) const {
        int tid = threadIdx.x; asm volatile("" : "+v"(tid));
        float rs[2][4]; unit_row_scales(rsq, u.pm, ldsx, tid, wr, fr, rs);
        const int row0 = u.pm * BM + wr * 64 + fr, col0 = u.pn * BM + wc * 32 + 8 * fq;
#pragma unroll
        for (int ai = 0; ai < 2; ++ai)
#pragma unroll
            for (int m = 0; m < 4; ++m) { bf16* rowp = O + (size_t)(row0 + ai * HALF + m * 16) * ldc + col0; const float r_ = rs[ai][m];
#pragma unroll
                for (int bj = 0; bj < 2; ++bj) { const f32x4 v0 = acc[ai][bj][m][0] * r_, v1 = acc[ai][bj][m][1] * r_;
                    u32x4 w; w.x = cvt_pk_bf16(v0[0], v0[1]); w.y = cvt_pk_bf16(v0[2], v0[3]); w.z = cvt_pk_bf16(v1[0], v1[1]); w.w = cvt_pk_bf16(v1[2], v1[3]);
                    *(u32x4*)(rowp + bj * HALF) = w; } }
    }
};
struct EpiBf16 {
    static constexpr bool PERM = true;
    bf16* O; int ldc;
    __device__ __forceinline__ void operator()(const f32x4 (&acc)[2][2][4][2], const GU& u, int wr, int wc, int fr, int fq) const {
        const int row0 = u.pm * BM + wr * 64 + fr, col0 = u.pn * BM + wc * 32 + 8 * fq;
#pragma unroll
        for (int ai = 0; ai < 2; ++ai)
#pragma unroll
            for (int m = 0; m < 4; ++m) { bf16* rowp = O + (size_t)(row0 + ai * HALF + m * 16) * ldc + col0;
#pragma unroll
                for (int bj = 0; bj < 2; ++bj) { const f32x4 v0 = acc[ai][bj][m][0], v1 = acc[ai][bj][m][1];
                    u32x4 w; w.x = cvt_pk_bf16(v0[0], v0[1]); w.y = cvt_pk_bf16(v0[2], v0[3]); w.z = cvt_pk_bf16(v1[0], v1[1]); w.w = cvt_pk_bf16(v1[2], v1[3]);
                    *(u32x4*)(rowp + bj * HALF) = w; } }
    }
};
struct EpiSwiGLU {
    static constexpr bool PERM = true;
    bf16* O; const float* rsq; LAS unsigned char* ldsx;
    __device__ __forceinline__ void operator()(const f32x4 (&acc)[2][2][4][2], const GU& u, int wr, int wc, int fr, int fq) const {
        int tid = threadIdx.x; asm volatile("" : "+v"(tid));
        float rs[2][4]; unit_row_scales(rsq, u.pm, ldsx, tid, wr, fr, rs);
        const int row0 = u.pm * BM + wr * 64 + fr, col0 = u.pn * HALF + wc * 32 + 8 * fq;
#pragma unroll
        for (int ai = 0; ai < 2; ++ai)
#pragma unroll
            for (int m = 0; m < 4; ++m) { bf16* rowp = O + (size_t)(row0 + ai * HALF + m * 16) * DFF + col0;
                float r[8];
#pragma unroll
                for (int n = 0; n < 2; ++n)
#pragma unroll
                    for (int j = 0; j < 4; ++j) { const float g = acc[ai][0][m][n][j] * rs[ai][m], up = acc[ai][1][m][n][j] * rs[ai][m]; r[n * 4 + j] = g * sigmoidf_(g) * up; }
                u32x4 w; w.x = cvt_pk_bf16(r[0], r[1]); w.y = cvt_pk_bf16(r[2], r[3]); w.z = cvt_pk_bf16(r[4], r[5]); w.w = cvt_pk_bf16(r[6], r[7]);
                *(u32x4*)rowp = w; }
    }
};
template <bool EMIT, bool IN16, bool OUT16>
struct EpiResNorm {
    static constexpr bool PERM = false;
    const void* base; void* out; const float* g; bf16* hn; float* rsq; LAS unsigned char* ldsx;
    __device__ __forceinline__ void operator()(const f32x4 (&acc)[2][2][4][2], const GU& u, int wr, int wc, int fr, int fq) const {
        int tid = threadIdx.x; asm volatile("" : "+v"(tid));
        const int row0 = u.pm * BM + wr * 64 + fr, col0 = u.pn * BM + wc * 32 + 4 * fq;
        f32x4 gv[2][2];
        if constexpr (EMIT) {
#pragma unroll
            for (int bj = 0; bj < 2; ++bj)
#pragma unroll
                for (int n = 0; n < 2; ++n) gv[bj][n] = *(const f32x4*)(g + col0 + bj * HALF + n * 16); }
        LAS float* P = (LAS float*)(ldsx + LDS_XP);
#pragma unroll
        for (int ai = 0; ai < 2; ++ai)
#pragma unroll
            for (int m = 0; m < 4; ++m) { const size_t off = (size_t)(row0 + ai * HALF + m * 16) * D + col0; float sq = 0.f;
                f32x4 bs[2][2];
#pragma unroll
                for (int bj = 0; bj < 2; ++bj)
#pragma unroll
                    for (int n = 0; n < 2; ++n) { if constexpr (IN16) bs[bj][n] = ld4bf((const bf16*)base + off + bj * HALF + n * 16); else bs[bj][n] = *(const f32x4*)((const float*)base + off + bj * HALF + n * 16); }
#pragma unroll
                for (int bj = 0; bj < 2; ++bj)
#pragma unroll
                    for (int n = 0; n < 2; ++n) { const f32x4 x = bs[bj][n] + acc[ai][bj][m][n];
                        if constexpr (OUT16) st4bf((bf16*)out + off + bj * HALF + n * 16, x); else *(f32x4*)((float*)out + off + bj * HALF + n * 16) = x;
                        if constexpr (EMIT) { sq += (x.x * x.x + x.y * x.y) + (x.z * x.z + x.w * x.w); st4bf(hn + off + bj * HALF + n * 16, x * gv[bj][n]); } }
                if constexpr (EMIT) { sq += __shfl_xor(sq, 16); sq += __shfl_xor(sq, 32); if (fq == 0) P[(ai * HALF + wr * 64 + m * 16 + fr) * 4 + wc] = sq; } }
        if constexpr (EMIT) { LBAR();
            if (tid < 256) { const f32x4 p = *(const LAS f32x4*)(P + tid * 4); rsq[(size_t)(u.pm * BM + tid) * 4 + u.pn] = (p.x + p.y) + (p.z + p.w); }
            LBAR(); }
    }
};
struct EpiMerge {
    static constexpr bool PERM = true;
    u32x4* scr; bf16* O; const float* rsq; LAS unsigned char* ldsx;
    __device__ __forceinline__ void operator()(const f32x4 (&acc)[2][2][4][2], const GU& u, int wr, int wc, int fr, int fq) const {
        int tid = threadIdx.x; asm volatile("" : "+v"(tid));
        if ((u.sub & 1) == 0) {
            float rs[2][4];
            if (u.sub == 0) unit_row_scales(rsq, u.pm, ldsx, tid, wr, fr, rs);
            else { const LAS float* RSL = (const LAS float*)(ldsx + LDS_RSL);
#pragma unroll
                for (int ai = 0; ai < 2; ++ai)
#pragma unroll
                    for (int m = 0; m < 4; ++m) rs[ai][m] = RSL[ai * HALF + wr * 64 + m * 16 + fr]; }
#pragma unroll
            for (int ai = 0; ai < 2; ++ai)
#pragma unroll
                for (int m = 0; m < 4; ++m)
#pragma unroll
                    for (int bj = 0; bj < 2; ++bj) { const f32x4 v0 = acc[ai][bj][m][0] * rs[ai][m], v1 = acc[ai][bj][m][1] * rs[ai][m];
                        u32x4 w; w.x = cvt_pk_bf16(sigmoidf_(v0[0]), sigmoidf_(v0[1])); w.y = cvt_pk_bf16(sigmoidf_(v0[2]), sigmoidf_(v0[3]));
                        w.z = cvt_pk_bf16(sigmoidf_(v1[0]), sigmoidf_(v1[1])); w.w = cvt_pk_bf16(sigmoidf_(v1[2]), sigmoidf_(v1[3]));
                        scr[((ai * 4 + m) * 2 + bj) * 512 + tid] = w; }
        } else {
            const bool first = (u.sub == 1);
            const int row0 = u.pm * BM + wr * 64 + fr, col0 = u.pn * BM + wc * 32 + 8 * fq;
#pragma unroll
            for (int ai = 0; ai < 2; ++ai) {
                u32x4 sg[4][2], pv[4][2];
#pragma unroll
                for (int m = 0; m < 4; ++m)
#pragma unroll
                    for (int bj = 0; bj < 2; ++bj) { sg[m][bj] = scr[((ai * 4 + m) * 2 + bj) * 512 + tid];
                        pv[m][bj] = first ? (u32x4){0u, 0u, 0u, 0u} : *(const u32x4*)(O + (size_t)(row0 + ai * HALF + m * 16) * D + col0 + bj * HALF); }
#pragma unroll
                for (int m = 0; m < 4; ++m) { bf16* rowp = O + (size_t)(row0 + ai * HALF + m * 16) * D + col0;
#pragma unroll
                    for (int bj = 0; bj < 2; ++bj) { const f32x4 v0 = acc[ai][bj][m][0], v1 = acc[ai][bj][m][1];
                        const u32x4 s = sg[m][bj], p = pv[m][bj];
                        float r[8];
                        r[0] = bflo(s.x) * v0[0] + bflo(p.x); r[1] = bfhi(s.x) * v0[1] + bfhi(p.x); r[2] = bflo(s.y) * v0[2] + bflo(p.y); r[3] = bfhi(s.y) * v0[3] + bfhi(p.y);
                        r[4] = bflo(s.z) * v1[0] + bflo(p.z); r[5] = bfhi(s.z) * v1[1] + bfhi(p.z); r[6] = bflo(s.w) * v1[2] + bflo(p.w); r[7] = bfhi(s.w) * v1[3] + bfhi(p.w);
                        u32x4 w; w.x = cvt_pk_bf16(r[0], r[1]); w.y = cvt_pk_bf16(r[2], r[3]); w.z = cvt_pk_bf16(r[4], r[5]); w.w = cvt_pk_bf16(r[6], r[7]);
                        *(u32x4*)(rowp + bj * HALF) = w; } }
            }
        }
    }
};
}

struct Args { const float* in[26]; float* out; unsigned char* ws; int ph_lo, ph_hi; };
enum { I_X = 0, I_N1G, I_WIN, I_MU, I_W0, I_W2, I_A0, I_A2, I_G2, I_KK, I_KA, I_RK, I_GNW, I_GNB, I_V0, I_V1, I_V2, I_LB, I_HGN, I_WBR, I_WOUT, I_N2G, I_WFG, I_WFU, I_WFD, I_FG };

__device__ __forceinline__ void transpose_item(const float* W, int ldw, int k0, int n0, bf16* WT, size_t drow0, int ldt, int dk0, LAS float* scr, int lane) {
#pragma unroll 8
    for (int i = 0; i < 32; ++i) { const int kk = 2 * i + (lane >> 5); scr[kk * 33 + (lane & 31)] = W[(size_t)(k0 + kk) * ldw + n0 + (lane & 31)]; }
    LDS_WAIT(); asm volatile("" ::: "memory");
    const int c = lane & 7;
#pragma unroll
    for (int j = 0; j < 4; ++j) { const int n = (lane >> 3) + 8 * j; const LAS float* s = scr + (8 * c) * 33 + n;
        u32x4 o; o.x = pk2(s[0 * 33], s[1 * 33]); o.y = pk2(s[2 * 33], s[3 * 33]); o.z = pk2(s[4 * 33], s[5 * 33]); o.w = pk2(s[6 * 33], s[7 * 33]);
        *(u32x4*)(WT + (drow0 + n) * (size_t)ldt + dk0 + 8 * c) = o; }
    LDS_WAIT(); asm volatile("" ::: "memory");
}

__device__ __forceinline__ void rms_row_bf16(const float* xrow, const float* g, bf16* orow, int lane) {
    const f32x4* xr = (const f32x4*)xrow + lane; f32x4 v[4]; float s = 0.f;
#pragma unroll
    for (int j = 0; j < 4; ++j) { v[j] = xr[64 * j]; s += (v[j].x * v[j].x + v[j].y * v[j].y) + (v[j].z * v[j].z + v[j].w * v[j].w); }
    const float rs = 1.0f / sqrtf(wave_sum(s) * (1.f / D) + 1e-6f);
    u32x2* o8 = (u32x2*)orow + lane;
#pragma unroll
    for (int j = 0; j < 4; ++j) { const f32x4 gv = ((const f32x4*)g)[lane + 64 * j]; u32x2 w; w.x = pk2(v[j].x * rs * gv.x, v[j].y * rs * gv.y); w.y = pk2(v[j].z * rs * gv.z, v[j].w * rs * gv.w); o8[64 * j] = w; }
}
__device__ __forceinline__ void rms_row_f32(const float* xrow, const float* g, float* orow, int lane) {
    const f32x4* xr = (const f32x4*)xrow + lane; f32x4 v[4]; float s = 0.f;
#pragma unroll
    for (int j = 0; j < 4; ++j) { v[j] = xr[64 * j]; s += (v[j].x * v[j].x + v[j].y * v[j].y) + (v[j].z * v[j].z + v[j].w * v[j].w); }
    const float rs = 1.0f / sqrtf(wave_sum(s) * (1.f / D) + 1e-6f);
    f32x4* o = (f32x4*)orow + lane;
#pragma unroll
    for (int j = 0; j < 4; ++j) { const f32x4 gv = ((const f32x4*)g)[lane + 64 * j]; o[64 * j] = v[j] * rs * gv; }
}

__device__ __forceinline__ void rope_entry(int t, int i, float& c, float& s) {
    const double invf[8] = {1.0, 0.19392274474868576, 0.03760603093086393, 0.007292664737217109, 0.001414213562373095, 0.0002742481756762073, 5.318295896944988e-05, 1.031338537721246e-05};
    double f = invf[0];
#pragma unroll
    for (int j = 1; j < 8; ++j) f = (i == j) ? invf[j] : f;
    const double ang = (double)t * f;
    const double k = __builtin_rint(ang * 0.63661977236758134308);
    double r = __builtin_fma(-k, 1.5707963267948966, ang); r = __builtin_fma(-k, 6.123233995736766e-17, r);
    const double r2 = r * r;
    double sn = r * (1.0 + r2 * (-1.0 / 6 + r2 * (1.0 / 120 + r2 * (-1.0 / 5040 + r2 * (1.0 / 362880 + r2 * (-1.0 / 39916800 + r2 * (1.0 / 6227020800.0)))))));
    double cs = 1.0 + r2 * (-0.5 + r2 * (1.0 / 24 + r2 * (-1.0 / 720 + r2 * (1.0 / 40320 + r2 * (-1.0 / 3628800 + r2 * (1.0 / 479001600.0 + r2 * (-1.0 / 87178291200.0)))))));
    const int q = ((int)(long long)k) & 3;
    const double s2 = (q == 0) ? sn : (q == 1) ? cs : (q == 2) ? -sn : -cs;
    const double c2 = (q == 0) ? cs : (q == 1) ? -sn : (q == 2) ? -cs : sn;
    c = (float)c2; s = (float)s2;
}

constexpr int N_LATE = 16 * 128 + 4 * 4 * 32 + 16 * 32 + 2 * 16 * 88 + 44 * 32;
static_assert(N_LATE == 7296 && N_LATE % 32 == 0, "late weight items");
constexpr unsigned NWU = N_LATE / 32;
__device__ __forceinline__ void late_weight_item(const Args& a, int layer, int r, LAS float* scr, int lane) {
    bf16* Wb = (bf16*)(a.ws + WS_W);
    constexpr int N_ING = 16 * 128, N_BR = 4 * 4 * 32, N_OUT = 16 * 32, N_FG = 16 * 88;
    if (r < N_ING) { const int kb = r / 128, nb = 112 + r % 128; transpose_item(a.in[I_WIN] + (size_t)layer * D * 7680, 7680, kb * 64, nb * 32, (bf16*)((char*)Wb + W_IN), (size_t)nb * 32, 1024, kb * 64, scr, lane); return; } r -= N_ING;
    if (r < N_BR) { const int n = r / 128, q = r % 128, kb = q / 32, nb = q % 32; transpose_item(a.in[I_WBR] + (size_t)layer * 4 * MW * D + (size_t)n * MW * D, D, kb * 64, nb * 32, (bf16*)((char*)Wb + W_B), (size_t)n * 1024 + nb * 32, 256, kb * 64, scr, lane); return; } r -= N_BR;
    if (r < N_OUT) { const int kb = r / 32, nb = r % 32; transpose_item(a.in[I_WOUT] + (size_t)layer * D * D, D, kb * 64, nb * 32, (bf16*)((char*)Wb + W_O), (size_t)nb * 32, 1024, kb * 64, scr, lane); return; } r -= N_OUT;
    if (r < 2 * N_FG) { const int up = r / N_FG, q = r % N_FG, kb = q / 88, nb = q % 88, n0 = nb * 32;
        transpose_item((up ? a.in[I_WFU] : a.in[I_WFG]) + (size_t)layer * D * DFF, DFF, kb * 64, n0, (bf16*)((char*)Wb + W_GU), (size_t)(n0 / 128) * 256 + (n0 % 128) + up * 128, 1024, kb * 64, scr, lane); return; } r -= 2 * N_FG;
    { const int kb = r / 32, nb = r % 32; transpose_item(a.in[I_WFD] + (size_t)layer * DFF * D, D, kb * 64, nb * 32, (bf16*)((char*)Wb + W_D), (size_t)nb * 32, DFF, kb * 64, scr, lane); }
}

__device__ __forceinline__ void phase_a(const Args& a, int layer, const float* xin, LAS unsigned char* lds, int vb, int G) {
    int tid = threadIdx.x; asm volatile("" : "+v"(tid)); const int lane = tid & 63, wave = tid >> 6;
    unsigned char* ws = a.ws;
    bf16* Wb = (bf16*)(ws + WS_W);
    LAS float* scr = (LAS float*)(lds + wave * 16384);
    const int gw = vb * 8 + wave, NGW = G * 8;
    const float* w_in = a.in[I_WIN] + (size_t)layer * D * 7680;
    const float* w_br = a.in[I_WBR] + (size_t)layer * 4 * MW * D;
    const float* w_out = a.in[I_WOUT] + (size_t)layer * D * D;
    const float* w_fg = a.in[I_WFG] + (size_t)layer * D * DFF;
    const float* w_fu = a.in[I_WFU] + (size_t)layer * D * DFF;
    const float* w_fd = a.in[I_WFD] + (size_t)layer * DFF * D;
    const float* w2 = a.in[I_W2] + (size_t)layer * 64 * MW;
    const float* a2 = a.in[I_A2] + (size_t)layer * 64 * MW;
    const float* g2 = a.in[I_G2] + (size_t)layer * 128 * MW;
    constexpr int N_INE = 16 * 112, N_LO = 8 + 8 + 16;
    for (int it = gw; it < N_INE + N_LO; it += NGW) {
        int r = it;
        if (r < N_INE) { const int kb = r / 112, nb = r % 112; transpose_item(w_in, 7680, kb * 64, nb * 32, (bf16*)((char*)Wb + W_IN), (size_t)nb * 32, 1024, kb * 64, scr, lane); continue; } r -= N_INE;
        if (r < 8) { transpose_item(w2, MW, 0, r * 32, (bf16*)((char*)Wb + W_L), (size_t)r * 32, 256, 0, scr, lane); continue; } r -= 8;
        if (r < 8) { transpose_item(a2, MW, 0, r * 32, (bf16*)((char*)Wb + W_L), (size_t)256 + r * 32, 256, 64, scr, lane); continue; } r -= 8;
        { const int kb = r / 8, nb = r % 8; transpose_item(g2, MW, kb * 64, nb * 32, (bf16*)((char*)Wb + W_L), (size_t)512 + nb * 32, 256, 128 + kb * 64, scr, lane); }
    }
    const int gt = vb * 512 + tid, NGT = G * 512;
    for (int i = gt; i < 768 * 32; i += NGT) { const int row = i >> 5, ch = i & 31, blk = row >> 8; const int lo = blk == 0 ? 0 : (blk == 1 ? 64 : 128), hi = blk == 0 ? 64 : (blk == 1 ? 128 : 256);
        if (ch * 8 < lo || ch * 8 >= hi) *(u32x4*)((char*)Wb + W_L + (size_t)row * 512 + ch * 16) = (u32x4){0u, 0u, 0u, 0u}; }
    if (layer == 1) {
        const float* v1 = a.in[I_V1]; const float* v2 = a.in[I_V2];
        for (int i = gt; i < 256 * 256; i += NGT) { const int c = i >> 8, k = i & 255; float s = 0.f;
#pragma unroll 8
            for (int j = 0; j < 32; ++j) s += v1[k * 32 + j] * v2[j * 256 + c];
            ((bf16*)((char*)Wb + W_V))[i] = (bf16)f2bf(s); }
    } else {
        float2* rope = (float2*)(ws + WS_ROPE);
        for (int i = gt; i < SEQ * 8; i += NGT) { float c, s; rope_entry(i >> 3, i & 7, c, s); rope[i] = make_float2(c, s); }
    }
    if (layer == 0) { const float* g = a.in[I_N1G]; bf16* H = (bf16*)(ws + WS_H); float* RQ = (float*)(ws + WS_RSQ1);
        for (int m = gw; m < M; m += NGW) { const f32x4* xr = (const f32x4*)(xin + (size_t)m * D) + lane; u32x2* o8 = (u32x2*)(H + (size_t)m * D) + lane; float sq = 0.f;
#pragma unroll
            for (int j = 0; j < 4; ++j) { const f32x4 v = xr[64 * j], gv = ((const f32x4*)g)[lane + 64 * j]; sq += (v.x * v.x + v.y * v.y) + (v.z * v.z + v.w * v.w); u32x2 w; w.x = cvt_pk_bf16(v.x * gv.x, v.y * gv.y); w.y = cvt_pk_bf16(v.z * gv.z, v.w * gv.w); o8[64 * j] = w; }
            sq = wave_sum(sq); if (lane == 0) *(f32x4*)(RQ + (size_t)m * 4) = (f32x4){sq, 0.f, 0.f, 0.f}; } }
}

__device__ __forceinline__ void phase_c(const Args& a, int layer, LAS unsigned char* lds, int vb, int G) {
    int tid = threadIdx.x; asm volatile("" : "+v"(tid)); const int lane = tid & 63, wave = tid >> 6;
    unsigned char* ws = a.ws;
    bf16* PM = (bf16*)(ws + WS_PM); bf16* LA = (bf16*)(ws + WS_LA);
    const float2* rope = (const float2*)(ws + WS_ROPE);
    float* KMP = (float*)(ws + WS_KMP);
    const float* mu = a.in[I_MU] + layer * 1024;
    LAS float* red = (LAS float*)lds;
    const int c4 = 4 * lane, l15 = lane & 15; const bool rot = l15 < 4, lower = l15 < 2;
    const f32x4 mu_l = *(const f32x4*)(mu + 768 + c4), mu_v = *(const f32x4*)(mu + 512 + c4);
    for (int u = vb; u < 256; u += G) {
        const int b = u >> 5, hb = u & 31; const int t0 = hb * 128 + wave * 16; const size_t row0 = (size_t)b * SEQ + t0;
        f32x4 ksum = {0.f, 0.f, 0.f, 0.f};
        f32x4 xp = {0.f, 0.f, 0.f, 0.f}, vp = xp;
        if (t0 > 0) { xp = ld4bf(PM + (row0 - 1) * PMW + C_RW + 768 + c4); if (layer) vp = ld4bf(PM + (row0 - 1) * PMW + C_RW + 512 + c4); }
        for (int i = 0; i < 16; ++i) {
            const size_t row = row0 + i; const int t = t0 + i;
            bf16* pq = PM + row * PMW + C_MB + c4;
            const f32x4 x = ld4bf(PM + row * PMW + C_RW + 768 + c4);
            f32x4 v4 = {0.f, 0.f, 0.f, 0.f}; if (layer) v4 = ld4bf(PM + row * PMW + C_RW + 512 + c4);
            f32x4 q4 = ld4bf(pq), k4 = ld4bf(pq + 256);
            { float qa[4] = {q4.x, q4.y, q4.z, q4.w}, ka[4] = {k4.x, k4.y, k4.z, k4.w}, qo[4], ko[4];
#pragma unroll
                for (int j = 0; j < 4; ++j) { qo[j] = dpp_xor2(qa[j]); ko[j] = dpp_xor2(ka[j]); }
                if (rot) { const float2* rp = rope + (size_t)t * 8 + (l15 & 1) * 4;
#pragma unroll
                    for (int j = 0; j < 4; ++j) { const float2 cs = rp[j]; const float sg = lower ? -cs.y : cs.y; qa[j] = qa[j] * cs.x + qo[j] * sg; ka[j] = ka[j] * cs.x + ko[j] * sg; }
                    q4 = (f32x4){qa[0], qa[1], qa[2], qa[3]}; k4 = (f32x4){ka[0], ka[1], ka[2], ka[3]};
                    st4bf(pq, q4); st4bf(pq + 256, k4); } }
            { u32x2 w; w.x = cvt_pk_bf16(k4.x, k4.y); w.y = cvt_pk_bf16(k4.z, k4.w); ksum += (f32x4){bflo(w.x), bfhi(w.x), bflo(w.y), bfhi(w.y)}; }
            { const f32x4 xs = x + (xp - x) * mu_l; f32x4 o;
#pragma unroll
                for (int j = 0; j < 4; ++j) { const float e = __expf(2.0f * xs[j]); const float th = 1.0f - 2.0f * __builtin_amdgcn_rcpf(1.0f + e); o[j] = lane < 16 ? th : (lane < 32 ? xs[j] : sigmoidf_(xs[j])); }
                st4bf(LA + row * 512 + c4, o); xp = x;
                if (layer) { st4bf(LA + row * 512 + 256 + c4, v4 + (vp - v4) * mu_v); vp = v4; } }
        }
        *(LAS f32x4*)(red + wave * 256 + c4) = ksum;
        __syncthreads();
        if (tid < 256) { float sacc = 0.f;
#pragma unroll
            for (int w8 = 0; w8 < 8; ++w8) sacc += red[w8 * 256 + tid];
            KMP[((size_t)(b * 4 + (tid >> 6)) * 32 + hb) * 64 + (tid & 63)] = sacc; }
        __syncthreads();
    }
}

constexpr int TC = 16;
#define DPP_SHR(x, n) __builtin_bit_cast(float, __builtin_amdgcn_update_dpp(0, __builtin_bit_cast(int, (x)), 0x110 + (n), 0xF, 0xF, true))
#define DPP_BC15(x) __builtin_bit_cast(float, __builtin_amdgcn_update_dpp(0, __builtin_bit_cast(int, (x)), 0x15F, 0xF, 0xF, true))
typedef short bf16x4v __attribute__((ext_vector_type(4)));
__device__ __forceinline__ bf16x4v frag4(f32x4 z) { return __builtin_bit_cast(bf16x4v, (u32x2){cvt_pk_bf16(z[0], z[1]), cvt_pk_bf16(z[2], z[3])}); }
#define MM16(xt, y) __builtin_amdgcn_mfma_f32_16x16x16bf16_1k(frag4(xt), frag4(y), (f32x4){0.f, 0.f, 0.f, 0.f}, 0, 0, 0)
__device__ __forceinline__ void phase_d2(const Args& a, int layer, int vb, int G) {
    int tid = threadIdx.x; asm volatile("" : "+v"(tid)); const int lane = tid & 63, wave = tid >> 6;
    unsigned char* ws = a.ws;
    bf16* PM = (bf16*)(ws + WS_PM); bf16* LO = (bf16*)(ws + WS_LO); bf16* VF = (bf16*)(ws + WS_VF); float* BON = (float*)(ws + WS_BON);
    const int s = lane & 15, g = lane >> 4;
    const float* mu = a.in[I_MU] + layer * 1024;
#define LDB16(dst, p) do { const u32x4 a_ = *(const u32x4*)((p) + 8 * g), b_ = *(const u32x4*)((p) + 32 + 8 * g); \
        dst[0] = bflo(a_.x); dst[1] = bfhi(a_.x); dst[2] = bflo(a_.y); dst[3] = bfhi(a_.y); dst[4] = bflo(a_.z); dst[5] = bfhi(a_.z); dst[6] = bflo(a_.w); dst[7] = bfhi(a_.w); \
        dst[8] = bflo(b_.x); dst[9] = bfhi(b_.x); dst[10] = bflo(b_.y); dst[11] = bfhi(b_.y); dst[12] = bflo(b_.z); dst[13] = bfhi(b_.z); dst[14] = bflo(b_.w); dst[15] = bfhi(b_.w); } while (0)
#define LDC16(dst, p) do { const f32x4 a_ = *(const f32x4*)((p) + 8 * g), b_ = *(const f32x4*)((p) + 8 * g + 4), c_ = *(const f32x4*)((p) + 32 + 8 * g), d_ = *(const f32x4*)((p) + 36 + 8 * g); \
        dst[0] = a_.x; dst[1] = a_.y; dst[2] = a_.z; dst[3] = a_.w; dst[4] = b_.x; dst[5] = b_.y; dst[6] = b_.z; dst[7] = b_.w; dst[8] = c_.x; dst[9] = c_.y; dst[10] = c_.z; dst[11] = c_.w; dst[12] = d_.x; dst[13] = d_.y; dst[14] = d_.z; dst[15] = d_.w; } while (0)
#define STB16(p, src) do { u32x4 a_, b_; a_.x = cvt_pk_bf16(src[0], src[1]); a_.y = cvt_pk_bf16(src[2], src[3]); a_.z = cvt_pk_bf16(src[4], src[5]); a_.w = cvt_pk_bf16(src[6], src[7]); \
        b_.x = cvt_pk_bf16(src[8], src[9]); b_.y = cvt_pk_bf16(src[10], src[11]); b_.z = cvt_pk_bf16(src[12], src[13]); b_.w = cvt_pk_bf16(src[14], src[15]); \
        *(u32x4*)((p) + 8 * g) = a_; *(u32x4*)((p) + 32 + 8 * g) = b_; } while (0)
#define PK8(src, o) __builtin_bit_cast(bf16x8, (u32x4){cvt_pk_bf16(src[(o)], src[(o) + 1]), cvt_pk_bf16(src[(o) + 2], src[(o) + 3]), cvt_pk_bf16(src[(o) + 4], src[(o) + 5]), cvt_pk_bf16(src[(o) + 6], src[(o) + 7])})
#define SUM64(x) do { x += __shfl_xor(x, 16); x += __shfl_xor(x, 32); } while (0)
    const int gw = vb * 8 + wave, NGW = G * 8;
    for (int task = gw; task < 8192; task += NGW) {
        const int chain = task >> 8, ch = task & 255, b = chain >> 2, h = chain & 3;
        const int t = ch * 16 + s; const size_t row = (size_t)b * SEQ + t;
        const bf16* pr = PM + row * PMW + C_RW + h * 64; const bf16* pp = (t > 0) ? pr - PMW : pr; const float pz = (t > 0) ? 1.f : 0.f;
        bf16* lo = LO + row * 1024 + h * 64;
        float lw[16], kk[16], bv[16], km[16], rr[16], vv[16];
        { float x0[16], xp[16], c0[16], c1[16], asg[16];
            LDB16(x0, pr); LDB16(xp, pp); LDC16(c0, mu + h * 64);
#pragma unroll
            for (int j = 0; j < 16; ++j) rr[j] = x0[j] + (xp[j] * pz - x0[j]) * c0[j];
            LDB16(x0, pr + 256); LDB16(xp, pp + 256); LDC16(c0, mu + 256 + h * 64);
            float ks[16];
#pragma unroll
            for (int j = 0; j < 16; ++j) ks[j] = x0[j] + (xp[j] * pz - x0[j]) * c0[j];
            LDB16(x0, pr + 512); LDB16(xp, pp + 512); LDC16(c0, mu + 512 + h * 64);
#pragma unroll
            for (int j = 0; j < 16; ++j) vv[j] = x0[j] + (xp[j] * pz - x0[j]) * c0[j];
            LDB16(x0, lo); LDC16(c0, a.in[I_W0] + layer * 256 + h * 64);
#pragma unroll
            for (int j = 0; j < 16; ++j) { const float wlog = -softplusf_(-(c0[j] + x0[j])) - 0.5f; lw[j] = -__expf(wlog); }
            LDB16(x0, lo + 256); LDC16(c0, a.in[I_A0] + layer * 256 + h * 64);
#pragma unroll
            for (int j = 0; j < 16; ++j) asg[j] = sigmoidf_(c0[j] + x0[j]);
            if (layer) { LDB16(x0, lo + 768); LDB16(xp, VF + row * 256 + h * 64); LDC16(c0, a.in[I_V0] + h * 64);
#pragma unroll
                for (int j = 0; j < 16; ++j) vv[j] += (xp[j] - vv[j]) * sigmoidf_(c0[j] + x0[j]); }
            else STB16(VF + row * 256 + h * 64, vv);
            STB16(lo + 768, vv);
            LDC16(c0, a.in[I_KK] + layer * 256 + h * 64); LDC16(c1, a.in[I_KA] + layer * 256 + h * 64);
            float n2 = 0.f;
#pragma unroll
            for (int j = 0; j < 16; ++j) { kk[j] = ks[j] * c0[j]; n2 += kk[j] * kk[j]; km[j] = ks[j] * (1.0f + (asg[j] - 1.0f) * c1[j]); }
            SUM64(n2); const float rn = 1.0f / fmaxf(sqrtf(n2), 1e-12f);
            LDC16(c0, a.in[I_RK] + layer * 256 + h * 64);
            float bon = 0.f;
#pragma unroll
            for (int j = 0; j < 16; ++j) { kk[j] *= rn; bv[j] = kk[j] * asg[j]; bon += rr[j] * km[j] * c0[j]; }
            SUM64(bon); if (g == 0) BON[row * 4 + h] = bon; }
        unsigned char* se = ws + WS_RS + (size_t)task * RS_ENTRY;
        float al[16], bh[16], kh[16], rh[16];
#pragma unroll
        for (int j = 0; j < 16; ++j) { float cs = lw[j]; cs += DPP_SHR(cs, 1); cs += DPP_SHR(cs, 2); cs += DPP_SHR(cs, 4); cs += DPP_SHR(cs, 8);
            const float Gt = __expf(cs), Gi = __expf(-cs), Gp = __expf(cs - lw[j]);
            al[j] = Gp * kk[j]; bh[j] = bv[j] * Gi; kh[j] = km[j] * Gi; rh[j] = Gt * rr[j];
            if (s == 15) ((float*)(se + 12800))[(j < 8 ? 8 * g + j : 24 + 8 * g + j)] = Gt; }
        { bf16* at = (bf16*)se + s * 72; STB16(at, al); bf16* rt = (bf16*)(se + 2304) + s * 72; STB16(rt, rh);
            bf16* bt = (bf16*)(se + 4608); bf16* kt = (bf16*)(se + 6656); bf16* vt = (bf16*)(se + 8704);
#pragma unroll
            for (int j = 0; j < 16; ++j) { const int k = (j < 8 ? 8 * g + j : 24 + 8 * g + j); bt[k * 16 + s] = (bf16)f2bf(-bh[j]); kt[k * 16 + s] = (bf16)f2bf(kh[j]); vt[k * 16 + s] = (bf16)f2bf(vv[j]); } }
        const bf16x8 al0 = PK8(al, 0), al1 = PK8(al, 8), bh0 = PK8(bh, 0), bh1 = PK8(bh, 8), kh0 = PK8(kh, 0), kh1 = PK8(kh, 8), rh0 = PK8(rh, 0), rh1 = PK8(rh, 8);
#define GRAM(x0_, x1_, y0_, y1_) __builtin_amdgcn_mfma_f32_16x16x32_bf16(x1_, y1_, __builtin_amdgcn_mfma_f32_16x16x32_bf16(x0_, y0_, (f32x4){0.f, 0.f, 0.f, 0.f}, 0, 0, 0), 0, 0, 0)
        f32x4 N = GRAM(bh0, bh1, al0, al1), NT = GRAM(al0, al1, bh0, bh1), QT = GRAM(al0, al1, kh0, kh1), BR = GRAM(bh0, bh1, rh0, rh1), KR = GRAM(kh0, kh1, rh0, rh1);
        f32x4 ID;
#pragma unroll
        for (int r = 0; r < 4; ++r) { const int rw = 4 * g + r; N[r] = rw < s ? N[r] : 0.f; NT[r] = s < rw ? NT[r] : 0.f; QT[r] = s < rw ? QT[r] : 0.f; BR[r] = rw <= s ? -BR[r] : 0.f; KR[r] = rw <= s ? KR[r] : 0.f; ID[r] = rw == s ? 1.f : 0.f; }
        const f32x4 N2 = MM16(NT, N), N2T = MM16(N, NT); const f32x4 N4 = MM16(N2T, N2), N4T = MM16(N2, N2T); const f32x4 N8 = MM16(N4T, N4);
        f32x4 X = MM16(ID + N4T, ID + N8); X = MM16(ID + N2T, X); const f32x4 T = MM16(ID - NT, X);
        const f32x4 QTm = MM16(QT, T);
        { u32x2* sm = (u32x2*)(se + 10752) + lane;
            sm[0] = (u32x2){cvt_pk_bf16(T[0], T[1]), cvt_pk_bf16(T[2], T[3])}; sm[64] = (u32x2){cvt_pk_bf16(QTm[0], QTm[1]), cvt_pk_bf16(QTm[2], QTm[3])};
            sm[128] = (u32x2){cvt_pk_bf16(BR[0], BR[1]), cvt_pk_bf16(BR[2], BR[3])}; sm[192] = (u32x2){cvt_pk_bf16(KR[0], KR[1]), cvt_pk_bf16(KR[2], KR[3])}; }
    }
#undef GRAM
#undef LDB16
#undef LDC16
#undef STB16
#undef PK8
#undef SUM64
}

constexpr int RWS = (int)RS_ENTRY;
__device__ __forceinline__ void rwkv_chain(const Args& a, int layer, int chain, LAS unsigned char* L) {
    int tid = threadIdx.x; asm volatile("" : "+v"(tid)); const int lane = tid & 63, w = __builtin_amdgcn_readfirstlane(tid >> 6);
    const int b = chain >> 2, h = chain & 3;
    unsigned char* ws = a.ws;
    const unsigned char* RS = ws + WS_RS + (size_t)chain * 256 * RS_ENTRY;
    constexpr int NCH = 256;
    if (w >= 4) {
        const int lw = w - 4;
#define RW_DMA(cn) do { const int cn_ = (cn) < NCH ? (cn) : NCH - 1; const unsigned char* src_ = RS + (size_t)cn_ * RS_ENTRY + lane * 16; LAS unsigned char* dst_ = L + ((cn) & 7) * RWS; \
            __builtin_amdgcn_global_load_lds((const unsigned*)(src_ + lw * 1024), (LAS unsigned*)(dst_ + lw * 1024), 16, 0, 0); \
            __builtin_amdgcn_global_load_lds((const unsigned*)(src_ + (lw + 4) * 1024), (LAS unsigned*)(dst_ + (lw + 4) * 1024), 16, 0, 0); \
            __builtin_amdgcn_global_load_lds((const unsigned*)(src_ + (lw + 8) * 1024), (LAS unsigned*)(dst_ + (lw + 8) * 1024), 16, 0, 0); \
            if (lw == 0 && lane < 48) __builtin_amdgcn_global_load_lds((const unsigned*)(src_ + 12 * 1024), (LAS unsigned*)(dst_ + 12 * 1024), 16, 0, 0); } while (0)
#define RW_WAIT() do { if (lw == 0) asm volatile("s_waitcnt vmcnt(24)" ::: "memory"); else asm volatile("s_waitcnt vmcnt(18)" ::: "memory"); } while (0)
        RW_DMA(0); RW_DMA(1); RW_DMA(2); RW_DMA(3); RW_DMA(4); RW_DMA(5); RW_DMA(6);
        RW_WAIT(); LBAR();
        for (int c = 0; c < NCH; ++c) { RW_DMA(c + 7); RW_WAIT(); LBAR(); }
        asm volatile("s_waitcnt vmcnt(0)" ::: "memory");
        LBAR();
#undef RW_DMA
#undef RW_WAIT
    } else {
        const int s16 = lane & 15, cg = lane >> 4;
        bf16* PMo = (bf16*)(ws + WS_PM) + (size_t)b * SEQ * PMW + C_RW + h * 64 + 16 * w + s16;
        f32x4 S0 = {0.f, 0.f, 0.f, 0.f}, S1 = S0, S2 = S0, S3 = S0;
        LBAR();
        for (int c = 0; c < NCH; ++c) {
            const LAS unsigned char* E = L + (c & 7) * RWS;
            const LAS bf16* AT = (const LAS bf16*)E + s16 * 72 + 4 * cg; const LAS bf16* RT = (const LAS bf16*)(E + 2304) + s16 * 72 + 4 * cg;
            const LAS bf16* BT = (const LAS bf16*)(E + 4608) + s16 * 16 + 4 * cg; const LAS bf16* KT = (const LAS bf16*)(E + 6656) + s16 * 16 + 4 * cg;
            const bf16x4v vt = *(const LAS bf16x4v*)((const LAS bf16*)(E + 8704) + (16 * w + s16) * 16 + 4 * cg);
            const LAS bf16x4v* SM = (const LAS bf16x4v*)(E + 10752) + lane; const bf16x4v tc = SM[0], qc = SM[64], brc = SM[128], krc = SM[192];
            const LAS float* GC = (const LAS float*)(E + 12800) + 4 * cg;
            const bf16x4v s0b = frag4(S0), s1b = frag4(S1), s2b = frag4(S2), s3b = frag4(S3);
            const f32x4 Z = {0.f, 0.f, 0.f, 0.f};
            f32x4 p1 = __builtin_amdgcn_mfma_f32_16x16x16bf16_1k(*(const LAS bf16x4v*)(AT), s0b, Z, 0, 0, 0);
            p1 = __builtin_amdgcn_mfma_f32_16x16x16bf16_1k(*(const LAS bf16x4v*)(AT + 16), s1b, p1, 0, 0, 0);
            p1 = __builtin_amdgcn_mfma_f32_16x16x16bf16_1k(*(const LAS bf16x4v*)(AT + 32), s2b, p1, 0, 0, 0);
            p1 = __builtin_amdgcn_mfma_f32_16x16x16bf16_1k(*(const LAS bf16x4v*)(AT + 48), s3b, p1, 0, 0, 0);
            f32x4 y = __builtin_amdgcn_mfma_f32_16x16x16bf16_1k(krc, vt, Z, 0, 0, 0);
            y = __builtin_amdgcn_mfma_f32_16x16x16bf16_1k(*(const LAS bf16x4v*)(RT), s0b, y, 0, 0, 0);
            y = __builtin_amdgcn_mfma_f32_16x16x16bf16_1k(*(const LAS bf16x4v*)(RT + 16), s1b, y, 0, 0, 0);
            y = __builtin_amdgcn_mfma_f32_16x16x16bf16_1k(*(const LAS bf16x4v*)(RT + 32), s2b, y, 0, 0, 0);
            y = __builtin_amdgcn_mfma_f32_16x16x16bf16_1k(*(const LAS bf16x4v*)(RT + 48), s3b, y, 0, 0, 0);
            f32x4 u = __builtin_amdgcn_mfma_f32_16x16x16bf16_1k(qc, vt, Z, 0, 0, 0);
            u = __builtin_amdgcn_mfma_f32_16x16x16bf16_1k(tc, frag4(p1), u, 0, 0, 0);
            const bf16x4v ub = frag4(u);
            y = __builtin_amdgcn_mfma_f32_16x16x16bf16_1k(brc, ub, y, 0, 0, 0);
#define RW_UPD(Sx, kt) do { f32x4 n_ = __builtin_amdgcn_mfma_f32_16x16x16bf16_1k(*(const LAS bf16x4v*)(KT + (kt) * 256), vt, Sx, 0, 0, 0); \
                n_ = __builtin_amdgcn_mfma_f32_16x16x16bf16_1k(*(const LAS bf16x4v*)(BT + (kt) * 256), ub, n_, 0, 0, 0); Sx = n_ * *(const LAS f32x4*)(GC + 16 * (kt)); } while (0)
            RW_UPD(S0, 0); RW_UPD(S1, 1); RW_UPD(S2, 2); RW_UPD(S3, 3);
#undef RW_UPD
            bf16* yo = PMo + (size_t)(c * 16 + 4 * cg) * PMW;
#pragma unroll
            for (int r = 0; r < 4; ++r) yo[(size_t)r * PMW] = (bf16)f2bf(y[r]);
            LBAR();
        }
        LBAR();
    }
}

__device__ __forceinline__ void phase_e2(const Args& a, int layer, int vb, int G) {
    int tid = threadIdx.x; asm volatile("" : "+v"(tid)); const int lane = tid & 63, wave = tid >> 6;
    unsigned char* ws = a.ws;
    const bf16* LO = (const bf16*)(ws + WS_LO); const float* BON = (const float*)(ws + WS_BON); bf16* PM = (bf16*)(ws + WS_PM);
    const int c4 = 4 * lane, head = lane >> 4;
    const f32x4 gnw = *(const f32x4*)(a.in[I_GNW] + layer * 256 + c4), gnb = *(const f32x4*)(a.in[I_GNB] + layer * 256 + c4);
    for (int tok = vb * 8 + wave; tok < M; tok += G * 8) {
        const size_t row = (size_t)tok;
        bf16* yp = PM + row * PMW + C_RW + c4; const f32x4 y = ld4bf(yp); const f32x4 vf = ld4bf(LO + row * 1024 + 768 + c4), g = ld4bf(LO + row * 1024 + 512 + c4); const float bon = BON[row * 4 + head];
        const float mean = dpp_sum16((y.x + y.y) + (y.z + y.w)) * (1.f / 64); const f32x4 d = y - mean;
        const float var = dpp_sum16((d.x * d.x + d.y * d.y) + (d.z * d.z + d.w * d.w)) * (1.f / 64);
        const f32x4 yn = d * (1.0f / sqrtf(var + 64e-5f)) * gnw + gnb;
        st4bf(yp, (yn + bon * vf) * g);
    }
}

typedef short bf16x4 __attribute__((ext_vector_type(4)));
constexpr int HQS = 72, HES = 20;
constexpr int HG_QT = 0, HG_KT = HG_QT + 16 * HQS * 2, HG_KE = HG_KT + 16 * HQS * 2, HG_IT = HG_KE + 64 * HES * 2, HG_DEC = HG_IT + 64 * HES * 2, HG_O = HG_DEC + 256, HG_BUF = HG_O + 4096;
__device__ __forceinline__ void hgrn_chain(const Args& a, int layer, int bh, LAS unsigned char* L) {
    int tid = threadIdx.x; asm volatile("" : "+v"(tid)); const int lane = tid & 63, w = __builtin_amdgcn_readfirstlane(tid >> 6);
    const int b = bh >> 2, h = bh & 3;
    unsigned char* ws = a.ws;
    const bf16* PM = (const bf16*)(ws + WS_PM); bf16* PMo = (bf16*)(ws + WS_PM);
    const size_t rowb = (size_t)b * SEQ;
    constexpr int NCH = SEQ / 16;
    const int s16 = lane & 15, cg = lane >> 4;
    constexpr int RAWS = 528, RAWSZ = 16 * RAWS, HG_RAW = 2 * HG_BUF;
    const int ld_tok = tid >> 5, ld_arr = (tid & 31) >> 3, ld_c8 = tid & 7;
    const bf16* ld_src = PM + (rowb + ld_tok) * PMW + C_HG + h * 64 + ld_arr * 256 + ld_c8 * 8;
    const int ld_dst = ld_tok * RAWS + ld_arr * 128 + ld_c8 * 16;
    float lb[2], oml[2];
#pragma unroll
    for (int r = 0; r < 2; ++r) { const int k = (2 * w + r) * 4 + cg; float v = 0.f; if (layer) { const float l0 = a.in[I_LB][h * 64 + k], l1 = a.in[I_LB][256 + h * 64 + k]; v = 1.0f / (1.0f + expf(l0 - l1)); } lb[r] = v; oml[r] = 1.0f - v; }
    const f32x4 gng4 = *(const f32x4*)(a.in[I_HGN] + layer * 256 + h * 64 + 4 * s16);
    const f32x2 lb2 = {lb[0], lb[1]}, oml2 = {oml[0], oml[1]};
    u32x4 pf[8];
#define HG_LOAD(set, cn) do { const int cn_ = (cn) < NCH ? (cn) : NCH - 1; pf[set] = *(const u32x4*)(ld_src + (size_t)cn_ * 16 * PMW); } while (0)
#define HG_STAGE(set, cn) do { *(LAS u32x4*)(L + HG_RAW + ((cn) & 3) * RAWSZ + ld_dst) = pf[set]; } while (0)
#define HG_PROD(cn) do { { LAS unsigned char* B_ = L + ((cn) & 1) * HG_BUF; const int k0_ = (2 * w) * 4 + cg, k1_ = k0_ + 4; \
        const LAS bf16* R_ = (const LAS bf16*)(L + HG_RAW + ((cn) & 3) * RAWSZ + s16 * RAWS); const unsigned rq0_ = R_[k0_], rq1_ = R_[k1_], rf0_ = R_[64 + k0_], rf1_ = R_[64 + k1_], ri0_ = R_[128 + k0_], ri1_ = R_[128 + k1_]; \
        const f32x2 fl_ = {bflo(rf0_), bflo(rf1_)}; \
        f32x2 e_, inv_, lf_; e_.x = __expf(-fabsf(fl_.x)); e_.y = __expf(-fabsf(fl_.y)); inv_.x = __builtin_amdgcn_rcpf(1.0f + e_.x); inv_.y = __builtin_amdgcn_rcpf(1.0f + e_.y); \
        const f32x2 ei_ = e_ * inv_; f32x2 sg_, ns_; sg_.x = fl_.x >= 0.f ? inv_.x : ei_.x; sg_.y = fl_.y >= 0.f ? inv_.y : ei_.y; ns_.x = fl_.x >= 0.f ? ei_.x : inv_.x; ns_.y = fl_.y >= 0.f ? ei_.y : inv_.y; \
        const f32x2 f_ = lb2 + oml2 * sg_, key_ = oml2 * ns_; lf_.x = __logf(f_.x); lf_.y = __logf(f_.y); \
        float b0_ = lf_.x, b1_ = lf_.y; b0_ += DPP_SHR(b0_, 1); b1_ += DPP_SHR(b1_, 1); b0_ += DPP_SHR(b0_, 2); b1_ += DPP_SHR(b1_, 2); b0_ += DPP_SHR(b0_, 4); b1_ += DPP_SHR(b1_, 4); b0_ += DPP_SHR(b0_, 8); b1_ += DPP_SHR(b1_, 8); \
        const float be0_ = DPP_BC15(b0_), be1_ = DPP_BC15(b1_);                         \
        f32x2 eb_, en_, de_; eb_.x = __expf(b0_); eb_.y = __expf(b1_); en_.x = __expf(fminf(-b0_, 80.f)); en_.y = __expf(fminf(-b1_, 80.f)); de_.x = __expf(be0_); de_.y = __expf(be1_); \
        const f32x2 qt_ = (f32x2){bflo(rq0_), bflo(rq1_)} * eb_, kt_ = key_ * en_, ke_ = kt_ * de_; \
        const unsigned wq_ = cvt_pk_bf16(qt_.x, qt_.y), wk_ = cvt_pk_bf16(kt_.x, kt_.y), we_ = cvt_pk_bf16(ke_.x, ke_.y); \
        LAS bf16* QT_ = (LAS bf16*)(B_ + HG_QT) + s16 * HQS; LAS bf16* KT_ = (LAS bf16*)(B_ + HG_KT) + s16 * HQS; LAS bf16* KE_ = (LAS bf16*)(B_ + HG_KE) + s16; LAS bf16* IT_ = (LAS bf16*)(B_ + HG_IT) + s16; \
        QT_[k0_] = (bf16)(wq_ & 0xffffu); QT_[k1_] = (bf16)(wq_ >> 16); KT_[k0_] = (bf16)(wk_ & 0xffffu); KT_[k1_] = (bf16)(wk_ >> 16); \
        KE_[k0_ * HES] = (bf16)(we_ & 0xffffu); KE_[k1_ * HES] = (bf16)(we_ >> 16); IT_[k0_ * HES] = (bf16)ri0_; IT_[k1_ * HES] = (bf16)ri1_; \
        if (s16 == 0) { ((LAS float*)(B_ + HG_DEC))[k0_] = de_.x; ((LAS float*)(B_ + HG_DEC))[k1_] = de_.y; } } } while (0)
#define HG_POST(cn) do { if (w >= 4) { const LAS float* O_ = (const LAS float*)(L + ((cn) & 1) * HG_BUF + HG_O); const int c_ = 4 * (w - 4) + cg; \
        const f32x4 o_ = *(const LAS f32x4*)(O_ + c_ * 64 + 4 * s16); const float ms_ = dpp_sum16((o_.x * o_.x + o_.y * o_.y) + (o_.z * o_.z + o_.w * o_.w)) * (1.f / 64); \
        const u32x2 gw_ = *(const LAS u32x2*)(L + HG_RAW + ((cn) & 3) * RAWSZ + c_ * RAWS + 384 + 8 * s16); const f32x4 g_ = {bflo(gw_.x), bfhi(gw_.x), bflo(gw_.y), bfhi(gw_.y)}; f32x4 sg_; \
        _Pragma("unroll") for (int j_ = 0; j_ < 4; ++j_) sg_[j_] = g_[j_] * sigmoidf_(g_[j_]); \
        st4bf(PMo + (rowb + (cn) * 16 + c_) * PMW + C_HG + h * 64 + 4 * s16, o_ * __builtin_amdgcn_rsqf(ms_ + 1e-6f) * gng4 * sg_); } } while (0)
    f32x4 S0 = {0.f, 0.f, 0.f, 0.f}, S1 = S0, S2 = S0, S3 = S0;
    HG_LOAD(0, 0); HG_LOAD(1, 1); HG_LOAD(2, 2); HG_LOAD(3, 3); HG_LOAD(4, 4); HG_LOAD(5, 5); HG_LOAD(6, 6); HG_LOAD(7, 7);
    HG_STAGE(0, 0); HG_STAGE(1, 1); HG_LOAD(0, 8); HG_LOAD(1, 9);
    LBAR();
    HG_PROD(0);
    LBAR();
#define HG_ITER(i) do { const int n = g0 + (i); HG_STAGE(((i) + 2) & 7, n + 2); HG_LOAD(((i) + 2) & 7, n + 10); if (n + 1 < NCH) HG_PROD(n + 1); hg_mfma(n); if (n > 0) HG_POST(n - 1); LBAR(); } while (0)
    auto hg_mfma = [&](int n) __attribute__((always_inline)) {
        if (w < 4) {
            LAS unsigned char* B = L + (n & 1) * HG_BUF;
            const LAS bf16* QT = (const LAS bf16*)(B + HG_QT); const LAS bf16* KT = (const LAS bf16*)(B + HG_KT); const LAS bf16* KE = (const LAS bf16*)(B + HG_KE); const LAS bf16* IT = (const LAS bf16*)(B + HG_IT);
            const LAS float* DEC = (const LAS float*)(B + HG_DEC); LAS float* O = (LAS float*)(B + HG_O);
            f32x4 sc = {0.f, 0.f, 0.f, 0.f};
#pragma unroll
            for (int ks = 0; ks < 2; ++ks) { const bf16x8 af = *(const LAS bf16x8*)(KT + s16 * HQS + ks * 32 + cg * 8), bfr = *(const LAS bf16x8*)(QT + s16 * HQS + ks * 32 + cg * 8);
                sc = __builtin_amdgcn_mfma_f32_16x16x32_bf16(af, bfr, sc, 0, 0, 0); }
            bf16x4 pf; { float m0 = (4 * cg + 0 <= s16) ? sc[0] : 0.f, m1 = (4 * cg + 1 <= s16) ? sc[1] : 0.f, m2 = (4 * cg + 2 <= s16) ? sc[2] : 0.f, m3 = (4 * cg + 3 <= s16) ? sc[3] : 0.f;
                const unsigned u0 = cvt_pk_bf16(m0, m1), u1 = cvt_pk_bf16(m2, m3); pf = __builtin_bit_cast(bf16x4, (u32x2){u0, u1}); }
            const bf16x4 ifr = *(const LAS bf16x4*)(IT + (16 * w + s16) * HES + 4 * cg);
            f32x4 oacc = {0.f, 0.f, 0.f, 0.f};
            oacc = __builtin_amdgcn_mfma_f32_16x16x16bf16_1k(pf, ifr, oacc, 0, 0, 0);
#define HG_KT_STEP(Sx, kt) do { const bf16x4 qa_ = *(const LAS bf16x4*)(QT + s16 * HQS + 16 * (kt) + 4 * cg); \
                const bf16x4 sb_ = __builtin_bit_cast(bf16x4, (u32x2){cvt_pk_bf16(Sx[0], Sx[1]), cvt_pk_bf16(Sx[2], Sx[3])}); \
                oacc = __builtin_amdgcn_mfma_f32_16x16x16bf16_1k(qa_, sb_, oacc, 0, 0, 0); \
                const bf16x4 ka_ = *(const LAS bf16x4*)(KE + (16 * (kt) + s16) * HES + 4 * cg); const f32x4 dc_ = *(const LAS f32x4*)(DEC + 16 * (kt) + 4 * cg); \
                Sx = __builtin_amdgcn_mfma_f32_16x16x16bf16_1k(ka_, ifr, Sx * dc_, 0, 0, 0); } while (0)
            HG_KT_STEP(S0, 0); HG_KT_STEP(S1, 1); HG_KT_STEP(S2, 2); HG_KT_STEP(S3, 3);
#undef HG_KT_STEP
#pragma unroll
            for (int r = 0; r < 4; ++r) O[(4 * cg + r) * 64 + 16 * w + s16] = oacc[r];
        }
    };
    for (int g0 = 0; g0 < NCH; g0 += 8) { HG_ITER(0); HG_ITER(1); HG_ITER(2); HG_ITER(3); HG_ITER(4); HG_ITER(5); HG_ITER(6); HG_ITER(7); }
    HG_POST(NCH - 1);
    LBAR();
#undef HG_ITER
#undef HG_STAGE
#undef HG_LOAD
#undef HG_PROD
#undef HG_POST
}

#include <hip/hip_bf16.h>
namespace moba_body {
using bf16=__hip_bfloat16;
using bf16x8=__attribute__((ext_vector_type(8)))short;
using s16x4=__attribute__((ext_vector_type(4)))short;
using f32x16=__attribute__((ext_vector_type(16)))float;
using u32x4=__attribute__((ext_vector_type(4)))unsigned;
constexpr int SEQ=4096,D=64,PIN=3584,POUT=3584;
constexpr int NW=8,QBLK=32,QB=QBLK*NW,KVBLK=64,NQB=SEQ/QB;
__device__ __forceinline__ int crow(int r,int hi){return (r&3)+8*(r>>2)+4*hi;}
#define SBAR() __builtin_amdgcn_sched_barrier(0)
__device__ __forceinline__ void cmask(f32x16&p0,f32x16&p1,int jb,int qrel,int hi){
  const float NEG=-INFINITY; int kb=64*jb+4*hi;
  #pragma unroll
  for(int r=0;r<16;++r){int kv=kb+(r&3)+8*(r>>2); if(kv>qrel)p0[r]=NEG; if(kv+32>qrel)p1[r]=NEG;}
}

constexpr int NSLOT=3, SLOTB=8192;
constexpr int LDS_K=0, LDS_V=NSLOT*SLOTB, LDS_WS=2*NSLOT*SLOTB, LDS_OST=LDS_WS+NW*64*4, LDS_BYTES=LDS_OST+NW*4096;
constexpr float C2=0.125f*1.4426950408889634f;
__device__ __forceinline__ void glds16(const void*gbase,unsigned voff,unsigned lds_dst){unsigned keep;
  asm volatile("s_mov_b32 %0, m0\n\ts_mov_b32 m0, %2\n\ts_nop 0\n\tglobal_load_lds_dwordx4 %1, %3\n\ts_mov_b32 m0, %0":"=&s"(keep):"v"(voff),"s"(lds_dst),"s"(gbase):"memory");}
__device__ __forceinline__ float max3f(float a,float b,float c){float r;asm("v_max3_f32 %0, %1, %2, %3":"=v"(r):"v"(a),"v"(b),"v"(c));return r;}
__device__ __forceinline__ float max2f(float a,float b){float r;asm("v_max_f32_e32 %0, %1, %2":"=v"(r):"v"(a),"v"(b));return r;}
__device__ __forceinline__ float fadd_s(float a,float b){float r;asm("v_add_f32_e32 %0, %1, %2":"=v"(r):"v"(a),"v"(b));return r;}
__device__ __forceinline__ float fsub_s(float a,float b){float r;asm("v_sub_f32_e32 %0, %1, %2":"=v"(r):"v"(a),"v"(b));return r;}
typedef float f32x2_t __attribute__((ext_vector_type(2))); typedef __bf16 bf16x2_t __attribute__((ext_vector_type(2)));
__device__ __forceinline__ unsigned cvtpk_s(float lo,float hi){f32x2_t v={lo,hi};bf16x2_t b=__builtin_convertvector(v,bf16x2_t);return __builtin_bit_cast(unsigned,b);}
#define WAIT_BAR(N) asm volatile("s_waitcnt vmcnt(" #N ") lgkmcnt(0)\n\ts_barrier":::"memory")

__device__ __forceinline__ void qkt(f32x16&p0,f32x16&p1,const char*Kslot,const bf16x8*qr,const f32x16&negm,int r32,int hi){
  const char*kb=Kslot+hi*1024+r32*16;
  #pragma unroll
  for(int d0=0;d0<4;++d0){
    const bf16x8 b0=*reinterpret_cast<const bf16x8*>(kb+d0*2048);
    const bf16x8 b1=*reinterpret_cast<const bf16x8*>(kb+d0*2048+512);
    if(d0==0){p0=__builtin_amdgcn_mfma_f32_32x32x16_bf16(b0,qr[0],negm,0,0,0);p1=__builtin_amdgcn_mfma_f32_32x32x16_bf16(b1,qr[0],negm,0,0,0);}
    else{p0=__builtin_amdgcn_mfma_f32_32x32x16_bf16(b0,qr[d0],p0,0,0,0);p1=__builtin_amdgcn_mfma_f32_32x32x16_bf16(b1,qr[d0],p1,0,0,0);}}
}
typedef __attribute__((address_space(3))) const char* lds_cptr;
typedef short v4i16_t __attribute__((ext_vector_type(4)));
__device__ __forceinline__ void kload8(bf16x8*kf,lds_cptr kp){
  kf[0]=*(const __attribute__((address_space(3))) bf16x8*)(kp);      kf[1]=*(const __attribute__((address_space(3))) bf16x8*)(kp+512);
  kf[2]=*(const __attribute__((address_space(3))) bf16x8*)(kp+2048); kf[3]=*(const __attribute__((address_space(3))) bf16x8*)(kp+2560);
  kf[4]=*(const __attribute__((address_space(3))) bf16x8*)(kp+4096); kf[5]=*(const __attribute__((address_space(3))) bf16x8*)(kp+4608);
  kf[6]=*(const __attribute__((address_space(3))) bf16x8*)(kp+6144); kf[7]=*(const __attribute__((address_space(3))) bf16x8*)(kp+6656);
}
__device__ __forceinline__ void kload2(bf16x8*kf,lds_cptr kp,int j){ kf[2*j]=*(const __attribute__((address_space(3))) bf16x8*)(kp+j*2048); kf[2*j+1]=*(const __attribute__((address_space(3))) bf16x8*)(kp+j*2048+512); }
__device__ __forceinline__ s16x4 vtr(lds_cptr p){ return __builtin_bit_cast(s16x4,__builtin_amdgcn_ds_read_tr16_b64_v4i16((__attribute__((address_space(3))) v4i16_t*)p)); }
__device__ __forceinline__ float rowmax(const f32x16&p0,const f32x16&p1){
  float a=max3f(p0[0],p0[1],p1[0]),b=max3f(p0[2],p0[3],p1[1]);a=max3f(a,p1[2],p1[3]);
  #pragma unroll
  for(int r=4;r<16;r+=4){a=max3f(a,p0[r],p0[r+1]);b=max3f(b,p0[r+2],p0[r+3]);a=max3f(a,p1[r],p1[r+1]);b=max3f(b,p1[r+2],p1[r+3]);}
  const float m=max2f(a,b);
  auto rr=__builtin_amdgcn_permlane32_swap(__float_as_uint(m),__float_as_uint(m),false,false);
  return max2f(__uint_as_float(rr[0]),__uint_as_float(rr[1]));
}
__device__ __forceinline__ void pv(f32x16*o,int vb,bf16x8 pa0,bf16x8 pa1,bf16x8 pa2,bf16x8 pa3){
  #pragma unroll
  for(int d0=0;d0<2;++d0){s16x4 lo[4],hi[4];
    #pragma unroll
    for(int ks=0;ks<4;++ks){
      asm volatile("ds_read_b64_tr_b16 %0,%1 offset:%c2":"=&v"(lo[ks]):"v"(vb),"i"(d0*4096+ks*1024):"memory");
      asm volatile("ds_read_b64_tr_b16 %0,%1 offset:%c2":"=&v"(hi[ks]):"v"(vb),"i"(d0*4096+ks*1024+512):"memory");}
    asm volatile("s_waitcnt lgkmcnt(0)":::"memory");SBAR();
    #define PK(k) (bf16x8){lo[k][0],lo[k][1],lo[k][2],lo[k][3],hi[k][0],hi[k][1],hi[k][2],hi[k][3]}
    o[d0]=__builtin_amdgcn_mfma_f32_32x32x16_bf16(pa0,PK(0),o[d0],0,0,0);
    o[d0]=__builtin_amdgcn_mfma_f32_32x32x16_bf16(pa1,PK(1),o[d0],0,0,0);
    o[d0]=__builtin_amdgcn_mfma_f32_32x32x16_bf16(pa2,PK(2),o[d0],0,0,0);
    o[d0]=__builtin_amdgcn_mfma_f32_32x32x16_bf16(pa3,PK(3),o[d0],0,0,0);
    #undef PK
  }
}

#ifndef ATTN_STORE16
#define ATTN_STORE16(p,v) (*(u32x4*)(p)=(v))
#endif
template<int THRL> __device__ __forceinline__ void attn_unit(int b,int h,int qb,const bf16*Q,const bf16*__restrict__ K,const bf16*__restrict__ V,bf16*O,const float*__restrict__ KMP,char*shm){
  int tid=threadIdx.x; asm volatile("":"+v"(tid));
  const int lane=tid&63,r32=lane&31,hi=lane>>5; const int wid=__builtin_amdgcn_readfirstlane(tid>>6);
  const long rowbase=(long)b*SEQ; const int q0=qb*QB;
  const bf16*Qw=Q+(rowbase+q0+wid*QBLK)*PIN+h*D;
  const bf16*Kh=K+rowbase*PIN+h*D,*Vh=V+rowbase*PIN+h*D;
  const unsigned lds0=(unsigned)(uintptr_t)shm;
  float*wsf=(float*)(shm+LDS_WS)+wid*64;
  const unsigned koff=(unsigned)(lane*PIN+wid*8)*2u;
  const unsigned voff=(unsigned)((16*(wid&3)+(lane>>2))*PIN+(wid>>2)*32+(lane&3)*8)*2u;
  const unsigned kdst=lds0+LDS_K+wid*1024, vdst=lds0+LDS_V+wid*1024;
  #define DMA_K(t,slot) glds16(Kh,koff+(unsigned)(t)*(unsigned)(KVBLK*PIN*2),(unsigned)__builtin_amdgcn_readfirstlane(kdst+(slot)))
  #define DMA_V(t,slot) glds16(Vh,voff+(unsigned)(t)*(unsigned)(KVBLK*PIN*2),(unsigned)__builtin_amdgcn_readfirstlane(vdst+(slot)))
  const int vb0=(int)(lds0+LDS_V)+((lane>>4)&1)*32+(lane&3)*8+(4*hi+((lane&15)>>2))*64;
  const char*Kbase=shm+LDS_K; bf16x8 kf[8];
  const lds_cptr shm3=(lds_cptr)shm; const lds_cptr kp0=shm3+LDS_K+hi*1024+r32*16; const lds_cptr vp0=shm3+LDS_V+((lane>>4)&1)*32+(lane&3)*8+(4*hi+((lane&15)>>2))*64;
  const int NT=(q0+QB)/KVBLK;
  DMA_K(0,0);DMA_V(0,0);DMA_K(1,SLOTB);
  bf16x8 qr[4];
  #pragma unroll
  for(int d0=0;d0<4;++d0)qr[d0]=*reinterpret_cast<const bf16x8*>(&Qw[(long)r32*PIN+d0*16+hi*8]);
  unsigned sel=0u;
  { float qf[32];
    #pragma unroll
    for(int d0=0;d0<4;++d0){
      #pragma unroll
      for(int e=0;e<8;++e)qf[d0*8+e]=__uint_as_float(((unsigned)(unsigned short)qr[d0][e])<<16);}
    float b0=-INFINITY,b1=-INFINITY,b2=-INFINITY; int i0=-1,i1=-1,i2=-1;
    for(int j=0;j<qb;++j){
      const float*kp=KMP+((long)(b*4+h)*32+2*j)*64+8*hi; float g=0.f;
      #pragma unroll
      for(int d0=0;d0<4;++d0){ const float4 a0=*reinterpret_cast<const float4*>(kp+16*d0),a1=*reinterpret_cast<const float4*>(kp+16*d0+4),c0=*reinterpret_cast<const float4*>(kp+64+16*d0),c1=*reinterpret_cast<const float4*>(kp+64+16*d0+4);
        g+=qf[d0*8+0]*(a0.x+c0.x);g+=qf[d0*8+1]*(a0.y+c0.y);g+=qf[d0*8+2]*(a0.z+c0.z);g+=qf[d0*8+3]*(a0.w+c0.w);
        g+=qf[d0*8+4]*(a1.x+c1.x);g+=qf[d0*8+5]*(a1.y+c1.y);g+=qf[d0*8+6]*(a1.z+c1.z);g+=qf[d0*8+7]*(a1.w+c1.w);}
      { auto rr=__builtin_amdgcn_permlane32_swap(__float_as_uint(g),__float_as_uint(g),false,false); g=__uint_as_float(rr[0])+__uint_as_float(rr[1]); }
      if(g>b0){b2=b1;i2=i1;b1=b0;i1=i0;b0=g;i0=j;} else if(g>b1){b2=b1;i2=i1;b1=g;i1=j;} else if(g>b2){b2=g;i2=j;}
    }
    if(i0>=0)sel|=1u<<i0; if(i1>=0)sel|=1u<<i1; if(i2>=0)sel|=1u<<i2;
    #pragma unroll
    for(int d0=0;d0<4;++d0){ u32x4 w;
      w[0]=cvtpk_s(qf[d0*8+0]*C2,qf[d0*8+1]*C2);w[1]=cvtpk_s(qf[d0*8+2]*C2,qf[d0*8+3]*C2);w[2]=cvtpk_s(qf[d0*8+4]*C2,qf[d0*8+5]*C2);w[3]=cvtpk_s(qf[d0*8+6]*C2,qf[d0*8+7]*C2);
      qr[d0]=__builtin_bit_cast(bf16x8,w);} }
  float mhat=0.f,l_reg=0.f;f32x16 o[2];o[0]=f32x16{};o[1]=f32x16{};f32x16 negm=f32x16{};asm volatile("":"+v"(negm));
  const int qrel=wid*QBLK+r32;
  #define PMASK(P0,P1,t) do{ if(!((sel>>((t)>>2))&1u)){ _Pragma("unroll") for(int r_=0;r_<16;++r_){P0[r_]=-INFINITY;P1[r_]=-INFINITY;} } }while(0)
  #define CMASK(P0,P1,t) do{int jb_=(t)-(NT-4); if(jb_>=0)cmask(P0,P1,jb_,qrel,hi); else PMASK(P0,P1,t);}while(0)
  bool resc=false;
  #define START(P0,P1) do{ const float rm=rowmax(P0,P1); resc=false; \
    { const float dl=__builtin_fmaxf(rm,-64.f); mhat=fadd_s(mhat,dl); \
      _Pragma("unroll") for(int r=0;r<16;++r){P0[r]=fsub_s(P0[r],dl);P1[r]=fsub_s(P1[r],dl);} \
      _Pragma("unroll") for(int r=0;r<16;++r)negm[r]=-mhat; asm volatile("":"+v"(negm)); } \
    _Pragma("unroll") for(int r=0;r<16;++r)P0[r]=__builtin_amdgcn_exp2f(P0[r]); }while(0)
  #define RESC() do{ if(resc){ asm volatile("s_waitcnt lgkmcnt(0)":::"memory"); \
      _Pragma("unroll") for(int d_=0;d_<2;++d_) _Pragma("unroll") for(int r=0;r<16;++r)o[d_][r]*=wsf[crow(r,hi)]; } }while(0)
  f32x16 pA0,pA1,pB0,pB1;
  int sl_prev=0,sl_cur=0,sl_next=SLOTB;
  #define ROT() do{sl_prev=sl_cur;sl_cur=sl_next;sl_next=(sl_next==(NSLOT-1)*SLOTB)?0:sl_next+SLOTB;}while(0)
  DMA_K(2,2*SLOTB);
  WAIT_BAR(3);
  qkt(pA0,pA1,Kbase,qr,negm,r32,hi);asm volatile("s_nop 15\n\ts_nop 7":"+v"(pA0),"+v"(pA1));CMASK(pA0,pA1,0);
  START(pA0,pA1);
  _Pragma("unroll") for(int r=0;r<16;++r)pA1[r]=__builtin_amdgcn_exp2f(pA1[r]);
  WAIT_BAR(0);
  DMA_K(3,0);DMA_V(1,SLOTB);
  ROT();
  kload8(kf,kp0+sl_cur);
  WAIT_BAR(2);
  s16x4 vlo[8],vhi[8]; u32x4 pw0,pw1,pw2,pw3;
  #define PKW(P,B) cvtpk_s(P[B],P[B+1])
  #define PAF(k) __builtin_bit_cast(bf16x8,pw##k)
  #define VFR(i) (bf16x8){vlo[i][0],vlo[i][1],vlo[i][2],vlo[i][3],vhi[i][0],vhi[i][1],vhi[i][2],vhi[i][3]}
  #define PIN(x) asm volatile("":"+v"(x))
  #define MX3(a,b,c) __builtin_fmaxf(__builtin_fmaxf((a),(b)),(c))
  #define GAPA(MF,A0,A1,A2,A3,W0,W1,PW) do{ MF; sacc+=A0; sacc+=A1; sacc+=A2; sacc+=A3; PIN(sacc); W0; W1; PIN(PW); SBAR(); }while(0)
  #define EX(v) __builtin_amdgcn_exp2f(v)
  #define GAPB(MF,X,B) do{ MF; X[B]=EX(X[B]); X[B+1]=EX(X[B+1]); X[B+2]=EX(X[B+2]); X[B+3]=EX(X[B+3]); PIN(X); SBAR(); }while(0)
  #define VRD(i) do{ vlo[i]=vtr(vp_+(((i)>>2)*4096+((i)&3)*1024)); vhi[i]=vtr(vp_+(((i)>>2)*4096+((i)&3)*1024+512)); }while(0)
  #define KRD(G,j) do{ if(G){ kload2(kf,kp0+sl_next,j); SBAR(); } }while(0)
  #define STEP(C0,C1,P0,P1,t,GK,GV,GL) do{ SBAR(); \
    const lds_cptr vp_=vp0+sl_prev; \
    VRD(0); SBAR(); float sacc=(P0[0]+P0[1]); \
    GAPA(C0=__builtin_amdgcn_mfma_f32_32x32x16_bf16(kf[0],qr[0],negm,0,0,0), P0[2],P0[3],P0[4],P0[5],     pw0[0]=PKW(P0,0), pw0[1]=PKW(P0,2), pw0); \
    VRD(4); SBAR(); GAPA(C1=__builtin_amdgcn_mfma_f32_32x32x16_bf16(kf[1],qr[0],negm,0,0,0), P0[6],P0[7],P0[8],P0[9],     pw0[2]=PKW(P0,4), pw0[3]=PKW(P0,6), pw0); \
    VRD(1); SBAR(); GAPA(C0=__builtin_amdgcn_mfma_f32_32x32x16_bf16(kf[2],qr[1],C0,0,0,0),   P0[10],P0[11],P0[12],P0[13], pw1[0]=PKW(P0,8), pw1[1]=PKW(P0,10), pw1); \
    VRD(5); SBAR(); GAPA(C1=__builtin_amdgcn_mfma_f32_32x32x16_bf16(kf[3],qr[1],C1,0,0,0),   P0[14],P0[15],P1[0],P1[1],   pw1[2]=PKW(P0,12),pw1[3]=PKW(P0,14), pw1); \
    VRD(2); SBAR(); GAPA(C0=__builtin_amdgcn_mfma_f32_32x32x16_bf16(kf[4],qr[2],C0,0,0,0),   P1[2],P1[3],P1[4],P1[5],     pw2[0]=PKW(P1,0), pw2[1]=PKW(P1,2), pw2); \
    VRD(6); SBAR(); GAPA(C1=__builtin_amdgcn_mfma_f32_32x32x16_bf16(kf[5],qr[2],C1,0,0,0),   P1[6],P1[7],P1[8],P1[9],     pw2[2]=PKW(P1,4), pw2[3]=PKW(P1,6), pw2); \
    VRD(3); SBAR(); GAPA(C0=__builtin_amdgcn_mfma_f32_32x32x16_bf16(kf[6],qr[3],C0,0,0,0),   P1[10],P1[11],P1[12],P1[13], pw3[0]=PKW(P1,8), pw3[1]=PKW(P1,10), pw3); \
    VRD(7); SBAR(); GAPA(C1=__builtin_amdgcn_mfma_f32_32x32x16_bf16(kf[7],qr[3],C1,0,0,0),   P1[14],P1[15],0.f,0.f,       pw3[2]=PKW(P1,12),pw3[3]=PKW(P1,14), pw3); \
    l_reg+=sacc; \
    if(GK){DMA_K((t)+3,sl_cur);} if(GV){DMA_V((t)+1,sl_next);} \
    CMASK(C0,C1,t); \
    { float a=MX3(C0[0],C0[1],C1[0]),b=MX3(C0[2],C0[3],C1[1]); a=MX3(a,C1[2],C1[3]); \
      _Pragma("unroll") for(int r=4;r<16;r+=4){a=MX3(a,C0[r],C0[r+1]);b=MX3(b,C0[r+2],C0[r+3]);a=MX3(a,C1[r],C1[r+1]);b=MX3(b,C1[r+2],C1[r+3]);} \
      float rm=__builtin_fmaxf(a,b); { auto rr=__builtin_amdgcn_permlane32_swap(__float_as_uint(rm),__float_as_uint(rm),false,false); rm=__builtin_fmaxf(__uint_as_float(rr[0]),__uint_as_float(rr[1])); } \
      resc=false; \
      if(__builtin_expect(__any(rm>(float)THRL),0)){ const float dl=__builtin_fmaxf(rm,0.f); mhat+=dl; \
        _Pragma("unroll") for(int r=0;r<16;++r){C0[r]-=dl;C1[r]-=dl;} \
        _Pragma("unroll") for(int r=0;r<16;++r)negm[r]=-mhat; asm volatile("":"+v"(negm)); \
        const float f=__builtin_amdgcn_exp2f(-dl); l_reg*=f; if(hi==0)wsf[r32]=f; resc=true; } } \
    SBAR(); \
    GAPB(o[0]=__builtin_amdgcn_mfma_f32_32x32x16_bf16(PAF(0),VFR(0),o[0],0,0,0), C0,0); \
    GAPB(o[1]=__builtin_amdgcn_mfma_f32_32x32x16_bf16(PAF(0),VFR(4),o[1],0,0,0), C0,4); \
    KRD(GL,0); GAPB(o[0]=__builtin_amdgcn_mfma_f32_32x32x16_bf16(PAF(1),VFR(1),o[0],0,0,0), C0,8); \
    KRD(GL,1); GAPB(o[1]=__builtin_amdgcn_mfma_f32_32x32x16_bf16(PAF(1),VFR(5),o[1],0,0,0), C0,12); \
    KRD(GL,2); GAPB(o[0]=__builtin_amdgcn_mfma_f32_32x32x16_bf16(PAF(2),VFR(2),o[0],0,0,0), C1,0); \
    KRD(GL,3); GAPB(o[1]=__builtin_amdgcn_mfma_f32_32x32x16_bf16(PAF(2),VFR(6),o[1],0,0,0), C1,4); \
    GAPB(o[0]=__builtin_amdgcn_mfma_f32_32x32x16_bf16(PAF(3),VFR(3),o[0],0,0,0), C1,8); \
    GAPB(o[1]=__builtin_amdgcn_mfma_f32_32x32x16_bf16(PAF(3),VFR(7),o[1],0,0,0), C1,12); \
    }while(0)
  int t=1;
  #undef CMASK
  #define CMASK(P0,P1,t) PMASK(P0,P1,t)
  for(;t+5<NT;t+=2){
    STEP(pB0,pB1,pA0,pA1,t,true,true,true);     WAIT_BAR(2); RESC(); ROT();
    STEP(pA0,pA1,pB0,pB1,t+1,true,true,true);   WAIT_BAR(2); RESC(); ROT();
  }
  #undef CMASK
  #define CMASK(P0,P1,t) do{int jb_=(t)-(NT-4); if(jb_>=0)cmask(P0,P1,jb_,qrel,hi); else PMASK(P0,P1,t);}while(0)
  #define ENDW(tt) do{ if((tt)+3<NT){WAIT_BAR(2);} else if((tt)+2<NT){WAIT_BAR(1);} else {WAIT_BAR(0);} }while(0)
  for(;t+1<NT;t+=2){
    STEP(pB0,pB1,pA0,pA1,t,(t+3<NT),(t+1<NT),(t+1<NT));       ENDW(t);   RESC(); ROT();
    STEP(pA0,pA1,pB0,pB1,t+1,(t+4<NT),(t+2<NT),(t+2<NT));     ENDW(t+1); RESC(); ROT();
  }
  STEP(pB0,pB1,pA0,pA1,NT-1,false,false,false); RESC();
  { float sacc=pB0[0]+pB0[1]; _Pragma("unroll") for(int r=2;r<16;++r)sacc+=pB0[r]; _Pragma("unroll") for(int r=0;r<16;++r)sacc+=pB1[r]; l_reg+=sacc;
    pw0=(u32x4){PKW(pB0,0),PKW(pB0,2),PKW(pB0,4),PKW(pB0,6)};pw1=(u32x4){PKW(pB0,8),PKW(pB0,10),PKW(pB0,12),PKW(pB0,14)};pw2=(u32x4){PKW(pB1,0),PKW(pB1,2),PKW(pB1,4),PKW(pB1,6)};pw3=(u32x4){PKW(pB1,8),PKW(pB1,10),PKW(pB1,12),PKW(pB1,14)};
    SBAR(); pv(o,vb0+sl_cur,PAF(0),PAF(1),PAF(2),PAF(3)); }
  #undef PKW
  #undef PAF
  #undef VFR
  #undef PIN
  #undef MX3
  #undef GAPA
  #undef GAPB
  #undef EX
  #undef VRD
  #undef KRD
  #undef STEP
  #undef ENDW
  {auto rr=__builtin_amdgcn_permlane32_swap(__float_as_uint(l_reg),__float_as_uint(l_reg),false,false);l_reg=__uint_as_float(rr[0])+__uint_as_float(rr[1]);}
  if(hi==0)wsf[32+r32]=l_reg;asm volatile("s_waitcnt lgkmcnt(0)":::"memory");
  float rli[16];
  #pragma unroll
  for(int r=0;r<16;++r)rli[r]=__builtin_amdgcn_rcpf(wsf[32+crow(r,hi)]);
  bf16*Ow=O+(rowbase+q0+wid*QBLK)*POUT+h*D;
  { bf16*stg=(bf16*)(shm+LDS_OST)+wid*2048;
    #pragma unroll
    for(int r=0;r<16;++r){const int orow=crow(r,hi);
      #pragma unroll
      for(int d0=0;d0<2;++d0)stg[orow*64+d0*32+r32]=__float2bfloat16(o[d0][r]*rli[r]);}
    asm volatile("s_waitcnt lgkmcnt(0)":::"memory");
    #pragma unroll
    for(int i=0;i<4;++i){const int row=i*8+(lane>>3),ch=lane&7; const u32x4 v=*(const u32x4*)(stg+row*64+ch*8); ATTN_STORE16(Ow+(long)row*POUT+ch*8,v);} }
  asm volatile("s_waitcnt lgkmcnt(0)\n\ts_barrier":::"memory");
  #undef DMA_K
  #undef DMA_V
  #undef CMASK
  #undef PMASK
  #undef START
  #undef RESC
  #undef ROT
}
constexpr int ATTN_LDS_BYTES=LDS_BYTES;
#undef SBAR
#undef WAIT_BAR
}

typedef float f32x16 __attribute__((ext_vector_type(16)));
__device__ __forceinline__ void sb_unit(const Args& a, int bh, int qb) {
    int tid = threadIdx.x; asm volatile("" : "+v"(tid));
    const int lane = tid & 63, wid = tid >> 6, r32 = lane & 31, hh = lane >> 5;
    const int b = bh >> 2, h = bh & 3;
    unsigned char* ws = a.ws;
    const bf16* PM = (const bf16*)(ws + WS_PM); bf16* PMo = (bf16*)(ws + WS_PM);
    const size_t rowb = (size_t)b * SEQ;
    const int t0 = qb * 256 + wid * 32, t = t0 + r32;
    const bf16* Kb = PM + rowb * PMW + C_SB + 256 + h * 64; const bf16* Vb = PM + rowb * PMW + C_SB + 512 + h * 64;
    bf16x8 qf[4];
    { const bf16* qp = PM + (rowb + t) * PMW + C_SB + h * 64 + 8 * hh;
#pragma unroll
        for (int ks = 0; ks < 4; ++ks) { const u32x4 x = *(const u32x4*)(qp + 16 * ks); u32x4 y;
            y.x = cvt_pk_bf16(bflo(x.x) * 0.125f, bfhi(x.x) * 0.125f); y.y = cvt_pk_bf16(bflo(x.y) * 0.125f, bfhi(x.y) * 0.125f);
            y.z = cvt_pk_bf16(bflo(x.z) * 0.125f, bfhi(x.z) * 0.125f); y.w = cvt_pk_bf16(bflo(x.w) * 0.125f, bfhi(x.w) * 0.125f); qf[ks] = __builtin_bit_cast(bf16x8, y); } }
    f32x16 o0, o1;
#pragma unroll
    for (int i = 0; i < 16; ++i) { o0[i] = 0.f; o1[i] = 0.f; }
    float carry = 0.f;
    bf16x8 kn[4]; unsigned vn[2][2][8];
#define SB_LOAD(kt_) do { const int s0_ = (kt_) * 32; const bf16* kp_ = Kb + (size_t)(s0_ + r32) * PMW + 8 * hh; \
        _Pragma("unroll") for (int ks_ = 0; ks_ < 4; ++ks_) kn[ks_] = *(const bf16x8*)(kp_ + 16 * ks_); \
        const bf16* vp_ = Vb + (size_t)(s0_ + 4 * hh) * PMW + r32; \
        _Pragma("unroll") for (int s_ = 0; s_ < 2; ++s_) _Pragma("unroll") for (int j_ = 0; j_ < 8; ++j_) { const int k0_ = 16 * s_ + 8 * (j_ >> 2) + (j_ & 3); vn[0][s_][j_] = vp_[(size_t)k0_ * PMW]; vn[1][s_][j_] = vp_[(size_t)k0_ * PMW + 32]; } } while (0)
    SB_LOAD(t0 >> 5);
    for (int kt = t0 >> 5; kt >= 0; --kt) {
        const int s0 = kt * 32;
        f32x16 z;
#pragma unroll
        for (int i = 0; i < 16; ++i) z[i] = 0.f;
        bf16x8 kf[4];
#pragma unroll
        for (int ks = 0; ks < 4; ++ks) kf[ks] = kn[ks];
        unsigned vw[2][2][4];
#pragma unroll
        for (int nt = 0; nt < 2; ++nt)
#pragma unroll
            for (int s_ = 0; s_ < 2; ++s_)
#pragma unroll
                for (int jp = 0; jp < 4; ++jp) vw[nt][s_][jp] = vn[nt][s_][2 * jp] | (vn[nt][s_][2 * jp + 1] << 16);
        if (kt > 0) SB_LOAD(kt - 1);
#pragma unroll
        for (int ks = 0; ks < 4; ++ks) z = __builtin_amdgcn_mfma_f32_32x32x16_bf16(kf[ks], qf[ks], z, 0, 0, 0);
        float ls[16], ln[16];
#pragma unroll
        for (int i = 0; i < 16; ++i) { const int key = s0 + (i & 3) + 8 * (i >> 2) + 4 * hh; const bool ok = key < t; const float zz = z[i];
            const float l1p = __logf(1.0f + __expf(-fabsf(zz)));
            ls[i] = ok ? (fminf(zz, 0.f) - l1p) : -INFINITY; ln[i] = ok ? (fminf(-zz, 0.f) - l1p) : 0.f; }
        float gs[4], pg[4];
#pragma unroll
        for (int m = 0; m < 4; ++m) { gs[m] = (ln[4 * m] + ln[4 * m + 1]) + (ln[4 * m + 2] + ln[4 * m + 3]); pg[m] = __shfl_xor(gs[m], 32); }
        float T[4]; T[3] = 0.f; T[2] = gs[3] + pg[3]; T[1] = T[2] + (gs[2] + pg[2]); T[0] = T[1] + (gs[1] + pg[1]);
        const float total = T[0] + (gs[0] + pg[0]);
        float att[16];
#pragma unroll
        for (int m = 0; m < 4; ++m) { float cb = carry + T[m] + (hh == 0 ? pg[m] : 0.f);
#pragma unroll
            for (int e = 3; e >= 0; --e) { att[4 * m + e] = __expf(ls[4 * m + e] + cb); cb += ln[4 * m + e]; } }
        carry += total;
#pragma unroll
        for (int s_ = 0; s_ < 2; ++s_) { u32x4 aw; aw.x = cvt_pk_bf16(att[8 * s_], att[8 * s_ + 1]); aw.y = cvt_pk_bf16(att[8 * s_ + 2], att[8 * s_ + 3]); aw.z = cvt_pk_bf16(att[8 * s_ + 4], att[8 * s_ + 5]); aw.w = cvt_pk_bf16(att[8 * s_ + 6], att[8 * s_ + 7]);
            const bf16x8 af = __builtin_bit_cast(bf16x8, aw);
            o0 = __builtin_amdgcn_mfma_f32_32x32x16_bf16(af, __builtin_bit_cast(bf16x8, (u32x4){vw[0][s_][0], vw[0][s_][1], vw[0][s_][2], vw[0][s_][3]}), o0, 0, 0, 0);
            o1 = __builtin_amdgcn_mfma_f32_32x32x16_bf16(af, __builtin_bit_cast(bf16x8, (u32x4){vw[1][s_][0], vw[1][s_][1], vw[1][s_][2], vw[1][s_][3]}), o1, 0, 0, 0); }
        if (__all(carry < -110.f)) break;
    }
#undef SB_LOAD
    bf16* yp = PMo + (rowb + t0 + 4 * hh) * PMW + C_SB + h * 64 + r32;
#pragma unroll
    for (int i = 0; i < 16; ++i) { const size_t ro = (size_t)((i & 3) + 8 * (i >> 2)) * PMW; yp[ro] = (bf16)f2bf(o0[i]); yp[ro + 32] = (bf16)f2bf(o1[i]); }
}

__device__ __forceinline__ void phase_e(const Args& a, int layer_rep, LAS unsigned char* lds, volatile LAS unsigned* MISC, int vb) {
    const int layer = layer_rep & 1;
    LAS float* L = (LAS float*)lds;
    unsigned* work = (unsigned*)(a.ws + WS_CTL) + CW_WORK + 64 * layer_rep;
    for (int c = vb; c < 64; c += (int)gridDim.x) { if (c < 32) rwkv_chain(a, layer, c, lds); else hgrn_chain(a, layer, c - 32, (LAS unsigned char*)L); }
    for (;;) {
        __syncthreads();
        if (threadIdx.x == 0) MISC[0] = __hip_atomic_fetch_add(work, 1u, __ATOMIC_RELAXED, __HIP_MEMORY_SCOPE_AGENT);
        __syncthreads();
        const unsigned u = (unsigned)__builtin_amdgcn_readfirstlane((int)MISC[0]);
        if (u >= 1024u + NWU) break;
        if (u < NWU) { int tl = threadIdx.x; asm volatile("" : "+v"(tl)); const int wv = tl >> 6, ln = tl & 63; LAS float* scr = (LAS float*)(lds + wv * 16384);
#pragma unroll 1
            for (int it = (int)u * 32 + wv; it < (int)(u + 1u) * 32; it += 8) late_weight_item(a, layer, it, scr, ln); }
        else if (u < NWU + 512u) { const unsigned v = u - NWU; const int bh = (int)(v & 31u), qb = 15 - (int)(v >> 5); const moba_body::bf16* pm = (const moba_body::bf16*)(a.ws + WS_PM);
            moba_body::attn_unit<8>(bh >> 2, bh & 3, qb, pm + C_MB, pm + C_MB + 256, pm + C_MB + 512, (moba_body::bf16*)(a.ws + WS_PM) + C_MB, (const float*)(a.ws + WS_KMP), (char*)lds); }
        else { const unsigned v = u - NWU - 512u; sb_unit(a, (int)(v & 31u), 15 - (int)(v >> 5)); }
    }
}

#if MK_ONE_LAUNCH
#define SEAM() xcd_barrier(bar)
#else
#define SEAM() do {} while (0)
#endif
#define IN(k) (lo <= (k) && (k) < hi)
#define BOTH(k) (IN(k) && IN((k) + 1))
template <int LAYER>
__device__ __forceinline__ void layer_phases(const Args& args, LAS unsigned char* lds, volatile LAS unsigned* MISC, const XcdBarrier& bar, int lo, int hi, int vb0, int G0) {
    constexpr int layer = LAYER;
    unsigned char* ws = args.ws;
    float* xres = args.out;
        const int pb = layer * PPL;
        const float* xin = layer ? (const float*)args.out : args.in[I_X];
        const char* Wb = (const char*)(ws + WS_W);
        if (IN(pb + 0)) { const int vb = opaque_s(vb0), G = opaque_s(G0); for (int rep = 0; rep < (REPEAT_PH == 0 ? 2 : 1); ++rep) { phase_a(args, layer, xin, lds, vb, G); if (rep == 0 && REPEAT_PH == 0) SEAM(); } if (BOTH(pb + 0)) SEAM(); }
        if (IN(pb + 1)) { const int vb = opaque_s(vb0), G = opaque_s(G0);
            pg8::PlainOrder S{(const char*)(ws + WS_H), Wb + W_IN, 2048u, 2048u, 16, 128, 14, G, vb};
            pg8::EpiBf16S E{(bf16*)(ws + WS_PM), PMW, (const float*)(ws + WS_RSQ1), lds};
            for (int rep = 0; rep < (REPEAT_PH == 1 ? 2 : 1); ++rep) { pg8::gemm_phase<pg8::EpiBf16S, pg8::PlainOrder, true>(lds, S, E); if (rep == 0 && REPEAT_PH == 1) SEAM(); }
            if (BOTH(pb + 1)) SEAM();
        }
        if (IN(pb + 2)) { const int vb = opaque_s(vb0), G = opaque_s(G0); for (int rep = 0; rep < (REPEAT_PH == 2 ? 2 : 1); ++rep) { phase_c(args, layer, lds, vb, G); if (rep == 0 && REPEAT_PH == 2) SEAM(); } if (BOTH(pb + 2)) SEAM(); }
        if (IN(pb + 3)) { const int vb = opaque_s(vb0), G = opaque_s(G0);
            pg8::LoraOrder S{(const char*)(ws + WS_LA), Wb + W_L, Wb + W_V, layer ? 4 : 3, G, vb};
            pg8::EpiBf16 E{(bf16*)(ws + WS_LO), 1024};
            for (int rep = 0; rep < (REPEAT_PH == 3 ? 2 : 1); ++rep) { pg8::gemm_phase<pg8::EpiBf16, pg8::LoraOrder, true>(lds, S, E); if (rep == 0 && REPEAT_PH == 3) SEAM(); }
            if (BOTH(pb + 3)) SEAM();
        }
        if (IN(pb + 4)) { const int vb = opaque_s(vb0), G = opaque_s(G0); for (int rep = 0; rep < (REPEAT_PH == 4 ? 2 : 1); ++rep) { phase_d2(args, layer, vb, G); if (rep == 0 && REPEAT_PH == 4) SEAM(); } if (BOTH(pb + 4)) SEAM(); }
        if (IN(pb + 5)) { const int vb = opaque_s(vb0); for (int rep = 0; rep < (REPEAT_PH == 5 ? 2 : 1); ++rep) { phase_e(args, layer + 2 * rep, lds, MISC, vb); if (rep == 0 && REPEAT_PH == 5) SEAM(); } if (BOTH(pb + 5)) SEAM(); }
        if (IN(pb + 6)) { const int vb = opaque_s(vb0), G = opaque_s(G0); for (int rep = 0; rep < (REPEAT_PH == 6 ? 2 : 1); ++rep) { phase_e2(args, layer, vb, G); if (rep == 0 && REPEAT_PH == 6) SEAM(); } if (BOTH(pb + 6)) SEAM(); }
        if (IN(pb + 7)) { const int vb = opaque_s(vb0), G = opaque_s(G0);
            pg8::MergeOrder S{(const char*)(ws + WS_H), (const char*)(ws + WS_PM), Wb + W_IN + (size_t)PMW * 2048, Wb + W_B, G, vb};
            pg8::EpiMerge E{(u32x4*)(ws + WS_LA) + (size_t)vb * 8192, (bf16*)(ws + WS_LO), (const float*)(ws + WS_RSQ1), lds};
            for (int rep = 0; rep < (REPEAT_PH == 7 ? 2 : 1); ++rep) { pg8::gemm_phase<pg8::EpiMerge, pg8::MergeOrder, true>(lds, S, E); if (rep == 0 && REPEAT_PH == 7) SEAM(); }
            if (BOTH(pb + 7)) SEAM();
        }
        if (IN(pb + 8)) { const int vb = opaque_s(vb0), G = opaque_s(G0);
            pg8::PlainOrder S{(const char*)(ws + WS_LO), Wb + W_O, 2048u, 2048u, 16, 128, 4, G, vb};
            pg8::EpiResNorm<true, LAYER != 0, true> E{(const void*)xin, (void*)xres, args.in[I_N2G] + layer * D, (bf16*)(ws + WS_H), (float*)(ws + WS_RSQ2), lds};
            pg8::gemm_phase<pg8::EpiResNorm<true, LAYER != 0, true>, pg8::PlainOrder, true>(lds, S, E);
            if (BOTH(pb + 8)) SEAM();
        }
        if (IN(pb + 10)) { const int vb = opaque_s(vb0), G = opaque_s(G0);
            pg8::PlainOrder S{(const char*)(ws + WS_H), Wb + W_GU, 2048u, 2048u, 16, 128, 22, G, vb};
            pg8::EpiSwiGLU E{(bf16*)(ws + WS_PM), (const float*)(ws + WS_RSQ2), lds};
            for (int rep = 0; rep < (REPEAT_PH == 10 ? 2 : 1); ++rep) { pg8::gemm_phase<pg8::EpiSwiGLU, pg8::PlainOrder, true>(lds, S, E); if (rep == 0 && REPEAT_PH == 10) SEAM(); }
            if (BOTH(pb + 10)) SEAM();
        }
        if (IN(pb + 11)) { const int vb = opaque_s(vb0), G = opaque_s(G0);
            pg8::PlainOrder S{(const char*)(ws + WS_PM), Wb + W_D, (unsigned)(DFF * 2), (unsigned)(DFF * 2), DFF / 64, 128, 4, G, vb};
            if constexpr (LAYER == 0) { pg8::EpiResNorm<true, true, true> E{(const void*)xres, (void*)xres, args.in[I_N1G] + D, (bf16*)(ws + WS_H), (float*)(ws + WS_RSQ1), lds};
                pg8::gemm_phase<pg8::EpiResNorm<true, true, true>, pg8::PlainOrder, true>(lds, S, E); }
            else { pg8::EpiResNorm<false, true, false> E{(const void*)xres, (void*)(ws + WS_XF), nullptr, nullptr, nullptr, lds};
                pg8::gemm_phase<pg8::EpiResNorm<false, true, false>, pg8::PlainOrder, true>(lds, S, E); }
            if (BOTH(pb + 11)) SEAM();
        }
}

__global__ void __launch_bounds__(512, 2) skel_fwd(Args args) {
    extern __shared__ __attribute__((aligned(16))) unsigned char lds_raw[];
    LAS unsigned char* lds = (LAS unsigned char*)lds_raw;
    volatile LAS unsigned* MISC = (volatile LAS unsigned*)(lds + MISC_OFF);
    const int tid = threadIdx.x;
    const int G0 = gridDim.x, vb0 = blockIdx.x;
    unsigned char* ws = args.ws;
    unsigned* ctl = (unsigned*)(ws + WS_CTL);
    for (int u = tid; u < (LDS_BYTES - LDSCTL_OFF) / 4; u += 512) ((LAS unsigned*)(lds + LDSCTL_OFF))[u] = 0u;
    __syncthreads();
#if MK_ONE_LAUNCH
    XcdBarrier bar = xcd_barrier_post(ctl + CW_BAR, MISC + 8);
#else
    XcdBarrier bar; bar.bar = ctl + CW_BAR; bar.x = 0; bar.st = MISC + 8;
#endif
    const int lo = args.ph_lo, hi = args.ph_hi;
    float* xres = args.out;
    layer_phases<0>(args, lds, MISC, bar, lo, hi, vb0, G0);
    layer_phases<1>(args, lds, MISC, bar, lo, hi, vb0, G0);
    if (IN(2 * PPL)) { const int vb = opaque_s(vb0), G = opaque_s(G0); int tl = threadIdx.x; asm volatile("" : "+v"(tl)); const int lane = tl & 63, wave = tl >> 6;
        const float* g = args.in[I_FG];
        const float* xf = (const float*)(ws + WS_XF);
        for (int m = vb * 8 + wave; m < M; m += G * 8) rms_row_f32(xf + (size_t)m * D, g, xres + (size_t)m * D, lane);
    }
#undef IN
#undef BOTH
#undef SEAM
}

extern "C" void kernel_launch(void* const* d_in, const int* in_sizes, int n_in, void* d_out, int out_size, void* d_ws, size_t ws_size, hipStream_t stream) {
    static int grid = 0;
    if (grid == 0) {
        if (n_in != 26 || in_sizes[0] != M * D || out_size != M * D || ws_size < WS_END) { fprintf(stderr, "kernel_launch: unexpected shapes (n_in %d, in0 %d, out %d, ws %zu); nothing launched\n", n_in, n_in > 0 ? in_sizes[0] : -1, out_size, ws_size); grid = -1; return; }
        int dev = 0, cus = 0, per_cu = 0;
        if (hipGetDevice(&dev) != hipSuccess || hipDeviceGetAttribute(&cus, hipDeviceAttributeMultiprocessorCount, dev) != hipSuccess) { grid = -1; return; }
        if (hipFuncSetAttribute((const void*)skel_fwd, hipFuncAttributeMaxDynamicSharedMemorySize, LDS_BYTES) != hipSuccess) { fprintf(stderr, "kernel_launch: hipFuncSetAttribute failed\n"); grid = -1; return; }
        if (hipOccupancyMaxActiveBlocksPerMultiprocessor(&per_cu, (const void*)skel_fwd, 512, LDS_BYTES) != hipSuccess || per_cu < 1) fprintf(stderr, "kernel_launch: occupancy query reports %d\n", per_cu);
        (void)hipGetLastError();
        grid = cus;
    }
    if (grid < 0) return;
    if (hipMemsetAsync((char*)d_ws + WS_CTL, 0, CTL_ZERO_BYTES, stream) != hipSuccess) return;
    Args a{};
    for (int i = 0; i < 26; ++i) a.in[i] = (const float*)d_in[i];
    a.out = (float*)d_out; a.ws = (unsigned char*)d_ws;
#if MK_ONE_LAUNCH
    a.ph_lo = 0; a.ph_hi = NPH;
    hipLaunchKernelGGL(skel_fwd, dim3(grid), dim3(512), LDS_BYTES, stream, a);
#else
    for (int p = 0; p < NPH; ++p) { a.ph_lo = p; a.ph_hi = p + 1; hipLaunchKernelGGL(skel_fwd, dim3(grid), dim3(512), LDS_BYTES, stream, a); }
#endif
}
```

```cpp
#include <hip/hip_runtime.h>
#include <cstdio>
#include <cstdint>

#ifndef REPEAT_PH
#define REPEAT_PH -1
#endif
#ifndef MK_ONE_LAUNCH
#define MK_ONE_LAUNCH 1
#endif

#define LAS __attribute__((address_space(3)))
#define GAS __attribute__((address_space(1)))
typedef unsigned short bf16;
typedef short bf16x8 __attribute__((ext_vector_type(8)));
typedef float f32x4 __attribute__((ext_vector_type(4)));
typedef float f32x2 __attribute__((ext_vector_type(2)));
typedef unsigned u32x4 __attribute__((ext_vector_type(4)));
typedef unsigned u32x2 __attribute__((ext_vector_type(2)));

constexpr int D = 1024, NBATCH = 8, SEQ = 4096, M = NBATCH * SEQ, DFF = 2816, NH = 4, HD = 64, MW = 256;
constexpr int PMW = 3584;
constexpr int C_SB = 0, C_RW = 768, C_MB = 1792, C_HG = 2560;
constexpr int PPL = 12, NPH = 2 * PPL;

constexpr size_t MiB = 1u << 20;
constexpr size_t WS_CTL = 0, CTL_ZERO_BYTES = 1 * MiB;
constexpr size_t WS_ROPE = 1 * MiB;
constexpr size_t WS_KMP = 1 * MiB + 512 * 1024;
constexpr size_t WS_BON = 2 * MiB;
constexpr size_t WS_RSQ1 = 2 * MiB + 512 * 1024;
constexpr size_t WS_RSQ2 = 3 * MiB;
constexpr size_t WS_W = 4 * MiB;
constexpr size_t W_IN = 0, W_B = 15728640, W_O = W_B + 2097152, W_GU = W_O + 2097152, W_D = W_GU + 11534336, W_L = W_D + 5767168, W_V = W_L + 393216, W_END = W_V + 131072;
static_assert(W_END == 36 * MiB, "weights");
constexpr size_t WS_H = 40 * MiB;
constexpr size_t WS_PM = 104 * MiB;
constexpr size_t WS_LA = 328 * MiB;
constexpr size_t RS_ENTRY = 13056;
constexpr size_t WS_RS = 328 * MiB;
constexpr size_t WS_XF = 328 * MiB;
constexpr size_t WS_LO = 432 * MiB;
constexpr size_t WS_VF = 496 * MiB;
constexpr size_t WS_END = 512 * MiB;
static_assert(WS_RS + 8192 * RS_ENTRY <= WS_LO, "rwkv chunk stream");
constexpr int CW_TMO = 0;
constexpr int CW_BAR = 4096;
constexpr int CW_XCH = 32768;
constexpr int CW_WORK = 16384;

constexpr int RING_BYTES = 131072;
constexpr int LDSCTL_OFF = RING_BYTES, MISC_OFF = LDSCTL_OFF + 320;
constexpr int LDS_XP = RING_BYTES + 1024, LDS_RSL = LDS_XP + 4096;
constexpr int LDS_BYTES = 147456;

__device__ __forceinline__ unsigned f2bf(float f) { unsigned u = __builtin_bit_cast(unsigned, f); return (u + 0x7fffu + ((u >> 16) & 1u)) >> 16; }
__device__ __forceinline__ unsigned pk2(float lo, float hi) { return f2bf(lo) | (f2bf(hi) << 16); }
__device__ __forceinline__ float bf2f(unsigned short b) { return __builtin_bit_cast(float, ((unsigned)b) << 16); }
__device__ __forceinline__ float bflo(unsigned w) { return __builtin_bit_cast(float, w << 16); }
__device__ __forceinline__ float bfhi(unsigned w) { return __builtin_bit_cast(float, w & 0xffff0000u); }
typedef __bf16 bf16x2_t __attribute__((ext_vector_type(2)));
__device__ __forceinline__ unsigned cvt_pk_bf16(float lo, float hi) { f32x2 v = {lo, hi}; bf16x2_t b = __builtin_convertvector(v, bf16x2_t); return __builtin_bit_cast(unsigned, b); }
__device__ __forceinline__ float wave_sum(float v) {
#pragma unroll
    for (int o = 1; o < 64; o <<= 1) v += __shfl_xor(v, o);
    return v;
}
__device__ __forceinline__ float sigmoidf_(float x) { return __builtin_amdgcn_rcpf(1.0f + __expf(-x)); }
#define LDS_WAIT() asm volatile("s_waitcnt lgkmcnt(0)" ::: "memory")
#define LBAR() do { asm volatile("s_waitcnt lgkmcnt(0)" ::: "memory"); __builtin_amdgcn_s_barrier(); asm volatile("" ::: "memory"); } while (0)
__device__ __forceinline__ f32x4 ld4bf(const bf16* p) { const u32x2 w = *(const u32x2*)p; return (f32x4){bflo(w.x), bfhi(w.x), bflo(w.y), bfhi(w.y)}; }
__device__ __forceinline__ float dpp_sum16(float x);
__device__ __forceinline__ int opaque_s(int v) { asm volatile("" : "+s"(v)); return v; }

__device__ __forceinline__ void st4bf(bf16* p, f32x4 v) { u32x2 w; w.x = cvt_pk_bf16(v.x, v.y); w.y = cvt_pk_bf16(v.z, v.w); *(u32x2*)p = w; }
__device__ __forceinline__ float dpp_sum16(float x) {
    x += __builtin_bit_cast(float, __builtin_amdgcn_update_dpp(0, __builtin_bit_cast(int, x), 0xB1, 0xF, 0xF, true));
    x += __builtin_bit_cast(float, __builtin_amdgcn_update_dpp(0, __builtin_bit_cast(int, x), 0x4E, 0xF, 0xF, true));
    x += __builtin_bit_cast(float, __builtin_amdgcn_update_dpp(0, __builtin_bit_cast(int, x), 0x141, 0xF, 0xF, true));
    x += __builtin_bit_cast(float, __builtin_amdgcn_update_dpp(0, __builtin_bit_cast(int, x), 0x140, 0xF, 0xF, true));
    return x;
}
__device__ __forceinline__ float dpp_xor2(float x) { int r; asm volatile("s_nop 1\n\tv_mov_b32_dpp %0, %1 quad_perm:[2,3,0,1] row_mask:0xf bank_mask:0xf\n\ts_nop 0" : "=&v"(r) : "v"(__builtin_bit_cast(int, x))); return __builtin_bit_cast(float, r); }
__device__ __forceinline__ float softplusf_(float x) { return fmaxf(x, 0.f) + __logf(1.0f + __expf(-fabsf(x))); }
#define XB_TMO      128
#define XB_XCNT(j)  (256  + 64 * (j))
#define XB_XSUB(j)  (1280 + 64 * (j))
#define XB_XGEN(j)  (2304 + 64 * (j))
#define XB_TOP      3328
#define XB_TOPGEN   3392
#define XCD_BAR_WORDS 3456
#define XB_SPIN_CAP (1u << 22)
__device__ __forceinline__ unsigned xb_ld(unsigned* p)              { return __hip_atomic_load(p, __ATOMIC_RELAXED, __HIP_MEMORY_SCOPE_AGENT); }
__device__ __forceinline__ unsigned xb_add(unsigned* p, unsigned v) { return __hip_atomic_fetch_add(p, v, __ATOMIC_RELAXED, __HIP_MEMORY_SCOPE_AGENT); }
__device__ __forceinline__ unsigned xb_xcc_id() { return (unsigned)__builtin_amdgcn_s_getreg((3 << 11) | 20) & 0xFu; }
#define XB_SPIN(cond, bar) do { unsigned _sp = 0; while (cond) { __builtin_amdgcn_s_sleep(1); \
    if ((++_sp & 255u) == 0u) { if (xb_ld(&(bar)[XB_TMO])) break; if (_sp > XB_SPIN_CAP) { atomicAdd(&(bar)[XB_TMO], 1u); break; } } } } while (0)
struct XcdBarrier { unsigned* bar; unsigned x; volatile LAS unsigned* st; };
__device__ __forceinline__ XcdBarrier xcd_barrier_post(unsigned* bar, volatile LAS unsigned* st) {
    XcdBarrier b; b.bar = bar; b.x = xb_xcc_id(); b.st = st;
    if (threadIdx.x == 0) (void)xb_add(&bar[XB_XCNT(b.x)], 1u);
    return b;
}
__device__ __forceinline__ void xcd_barrier_complete(unsigned* bar, unsigned x, unsigned& nloc, unsigned& nx) {
    const unsigned G = gridDim.x * gridDim.y * gridDim.z;
    unsigned sum, cnt, mine, sp = 0u;
    for (;;) {
        sum = 0u; cnt = 0u; mine = 0u;
#pragma unroll
        for (unsigned j = 0; j < 16; ++j) { const unsigned c = xb_ld(&bar[XB_XCNT(j)]); sum += c; cnt += (c > 0u) ? 1u : 0u; mine = (j == x) ? c : mine; }
        if (sum == G) break;
        __builtin_amdgcn_s_sleep(1);
        if ((++sp & 255u) == 0u) { if (xb_ld(&bar[XB_TMO])) break; if (sp > XB_SPIN_CAP) { atomicAdd(&bar[XB_TMO], 1u); break; } }
    }
    nloc = mine > 0u ? mine : 1u; nx = cnt > 0u ? cnt : 1u;
}
__device__ __forceinline__ void xcd_barrier(const XcdBarrier& b) {
    asm volatile("s_waitcnt vmcnt(0)" ::: "memory");
    __syncthreads();
    if (threadIdx.x == 0) {
        unsigned* bar = b.bar;
        __builtin_amdgcn_s_waitcnt(0);
        unsigned nloc = b.st[0], nx = b.st[1];
        if (nloc == 0u) { xcd_barrier_complete(bar, b.x, nloc, nx); b.st[0] = nloc; b.st[1] = nx; }
        const unsigned old = xb_add(&bar[XB_XSUB(b.x)], 1u);
        const unsigned gen = old / nloc;
        if (old + 1u == (gen + 1u) * nloc) {
            __builtin_amdgcn_fence(__ATOMIC_RELEASE, "agent");
            asm volatile("s_waitcnt vmcnt(0)" ::: "memory");
            const unsigned og = xb_add(&bar[XB_TOP], 1u);
            const unsigned tg = og / nx;
            if (og + 1u == (tg + 1u) * nx) xb_add(&bar[XB_TOPGEN], 1u);
            else XB_SPIN(xb_ld(&bar[XB_TOPGEN]) == tg, bar);
            __builtin_amdgcn_fence(__ATOMIC_ACQUIRE, "agent");
            xb_add(&bar[XB_XGEN(b.x)], 1u);
            asm volatile("s_waitcnt vmcnt(0)" ::: "memory");
        } else {
            XB_SPIN(xb_ld(&bar[XB_XGEN(b.x)]) == gen, bar);
            __builtin_amdgcn_fence(__ATOMIC_ACQUIRE, "agent");
            asm volatile("s_waitcnt vmcnt(0)" ::: "memory");
        }
    }
    __syncthreads();
}

namespace pg8 {
constexpr int BM = 256, BK = 64, HALF = 128, HTB = HALF * BK * 2, STAGE_BYTES = 8 * HTB, NXCD = 8, WGM = 8;
__host__ __device__ __forceinline__ int lds_byte(int r, int c) { const int st = (r >> 4) * 2 + (c >> 5), rr = r & 15, cc = c & 31, ob = rr * 64 + cc * 2; return st * 1024 + (ob ^ (((ob >> 9) & 1) << 5)); }
__host__ __device__ __forceinline__ void stage_rc(int b, int& R, int& C) { const int st = b / 1024, sb = b % 1024, swz = sb ^ (((sb >> 9) & 1) << 5); R = (st >> 1) * 16 + swz / 64; C = (st & 1) * 32 + (swz % 64) / 2; }
__host__ __device__ __forceinline__ int perm32(int rho) { const int n = rho >> 4, i = rho & 15; return 8 * (i >> 2) + 4 * n + (i & 3); }

struct GU { const char* a; const char* b; unsigned lda2, ldb2; int nt, pm, pn, sub; };

__device__ __forceinline__ void tile_of(int L, int nM, int nN, int& pm, int& pn) {
    const int nwg = nM * nN;
    int wgid = L; { const int q = nwg / NXCD, r = nwg % NXCD, xcd = wgid % NXCD, off = wgid / NXCD; wgid = (xcd < r ? xcd * (q + 1) : r * (q + 1) + (xcd - r) * q) + off; }
    const int nig = WGM * nN, gid = wgid / nig, fm = gid * WGM, gsz = (nM - fm) < WGM ? (nM - fm) : WGM;
    pm = fm + ((wgid % nig) % gsz); pn = (wgid % nig) / gsz;
}

template <class Epi, class Sched, bool ALIGN_EPI>
__device__ __forceinline__ void gemm_phase(LAS unsigned char* lds, const Sched& S, const Epi& E) {
    int tid = threadIdx.x; asm volatile("" : "+v"(tid));
    const int wid = __builtin_amdgcn_readfirstlane(tid >> 6), lane = tid & 63, wr = wid >> 2, wc = wid & 3, fr = lane & 15, fq = lane >> 4;
    unsigned Rr, Rb, C2;
    { int R, C; stage_rc(tid * 16, R, C); Rr = (unsigned)R; Rb = (unsigned)(Epi::PERM ? ((R & ~31) + perm32(R & 31)) : R); C2 = (unsigned)C * 2u; }
    const size_t kstep = (size_t)(BK * 2);
    const unsigned ldsw = (unsigned)wid * 1024u;
    const int aoff = lds_byte(wr * 64 + fr, fq * 8), boff = lds_byte(wc * 32 + fr, fq * 8);
#define PG8_SA(b, h) (((b) * 2 + (h)) * HTB)
#define PG8_SB(b, h) ((4 + (b) * 2 + (h)) * HTB)
#define PG8_STAGE(bufoff, gbase, R, ld) do { const unsigned _v0 = (R) * (ld) + C2; \
        __builtin_amdgcn_global_load_lds((const unsigned*)((const char*)(gbase) + _v0), (LAS unsigned*)(lds + (bufoff) + ldsw), 16, 0, 0); \
        __builtin_amdgcn_global_load_lds((const unsigned*)((const char*)(gbase) + _v0 + 64u * (ld)), (LAS unsigned*)(lds + (bufoff) + ldsw + 8192), 16, 0, 0); } while (0)
#define PG8_LDA(dst, b, h) do { _Pragma("unroll") for (int m = 0; m < 4; ++m) _Pragma("unroll") for (int k = 0; k < 2; ++k) dst[m][k] = *(const LAS bf16x8*)(lds + PG8_SA(b, h) + aoff + m * 2048 + k * 1024); } while (0)
#define PG8_LDB(dst, b, h) do { _Pragma("unroll") for (int n = 0; n < 2; ++n) _Pragma("unroll") for (int k = 0; k < 2; ++k) dst[n][k] = *(const LAS bf16x8*)(lds + PG8_SB(b, h) + boff + n * 2048 + k * 1024); } while (0)
#define PG8_MMA(ai, bj, At, Bt) do { __builtin_amdgcn_s_setprio(1); _Pragma("unroll") for (int m = 0; m < 4; ++m) _Pragma("unroll") for (int n = 0; n < 2; ++n) _Pragma("unroll") for (int k = 0; k < 2; ++k) \
        acc[ai][bj][m][n] = __builtin_amdgcn_mfma_f32_16x16x32_bf16(Bt[n][k], At[m][k], acc[ai][bj][m][n], 0, 0, 0); __builtin_amdgcn_s_setprio(0); } while (0)
#define PG8_WAIT_V(n) asm volatile("s_waitcnt vmcnt(" #n ")" ::: "memory")
#define PG8_WAIT_L(n) asm volatile("s_waitcnt lgkmcnt(" #n ")" ::: "memory")
#define PG8_BAR __builtin_amdgcn_s_barrier()
#define PG8_SCHED __builtin_amdgcn_sched_barrier(0)
    GU cur, nxt; int ui = 0;
    if (!S.next(0, cur)) return;
    f32x4 acc[2][2][4][2];
#pragma unroll
    for (int a = 0; a < 2; ++a)
#pragma unroll
        for (int b = 0; b < 2; ++b)
#pragma unroll
            for (int m = 0; m < 4; ++m)
#pragma unroll
                for (int n = 0; n < 2; ++n) acc[a][b][m][n] = (f32x4){0.f, 0.f, 0.f, 0.f};
    bf16x8 At[4][2], B0[2][2], B1[2][2];
    const char* cA = cur.a; const char* cB = cur.b;
    unsigned ldA = cur.lda2, ldB = cur.ldb2;
    PG8_STAGE(PG8_SB(0, 0), cB, Rb, ldB); PG8_STAGE(PG8_SB(0, 1), cB + (size_t)HALF * ldB, Rb, ldB); PG8_STAGE(PG8_SA(0, 0), cA, Rr, ldA); PG8_STAGE(PG8_SA(0, 1), cA + (size_t)HALF * ldA, Rr, ldA);
    if (wr == 1) PG8_BAR;
    PG8_WAIT_V(2); PG8_BAR;
    PG8_STAGE(PG8_SB(1, 0), cB + kstep, Rb, ldB); PG8_STAGE(PG8_SA(1, 0), cA + kstep, Rr, ldA); PG8_STAGE(PG8_SB(1, 1), cB + (size_t)HALF * ldB + kstep, Rb, ldB);
    PG8_WAIT_V(6); PG8_BAR;
    for (;;) {
        const bool has_next = S.next(ui + 1, nxt);
        const char* nA = has_next ? nxt.a : cA; const char* nB = has_next ? nxt.b : cB;
        const unsigned nldA = has_next ? nxt.lda2 : ldA, nldB = has_next ? nxt.ldb2 : ldB;
        const int nt = cur.nt;
        for (int t = 0; t < nt; t += 2) {
            const bool last = (t == nt - 2);
            const char* a1 = cA + (size_t)(t + 1) * kstep;
            const char* a2 = last ? nA : cA + (size_t)(t + 2) * kstep; const char* b2 = last ? nB : cB + (size_t)(t + 2) * kstep;
            const char* a3 = a2 + kstep; const char* b3 = b2 + kstep;
            const unsigned xldA = last ? nldA : ldA, xldB = last ? nldB : ldB;
            PG8_LDB(B0, 0, 0); PG8_LDB(B1, 0, 1); PG8_SCHED; PG8_LDA(At, 0, 0); PG8_STAGE(PG8_SA(1, 1), a1 + (size_t)HALF * ldA, Rr, ldA);
            PG8_WAIT_V(8); PG8_WAIT_L(0); PG8_BAR; PG8_MMA(0, 0, At, B0); PG8_MMA(0, 1, At, B1); PG8_BAR; PG8_SCHED;
            PG8_LDA(At, 0, 1); PG8_STAGE(PG8_SB(0, 0), b2, Rb, xldB); PG8_STAGE(PG8_SB(0, 1), b2 + (size_t)HALF * xldB, Rb, xldB); PG8_STAGE(PG8_SA(0, 0), a2, Rr, xldA);
            PG8_WAIT_V(8); PG8_WAIT_L(0); PG8_BAR; PG8_MMA(1, 0, At, B0); PG8_MMA(1, 1, At, B1); PG8_BAR; PG8_SCHED;
            PG8_LDB(B0, 1, 0); PG8_LDB(B1, 1, 1); PG8_SCHED; PG8_LDA(At, 1, 0); PG8_STAGE(PG8_SA(0, 1), a2 + (size_t)HALF * xldA, Rr, xldA);
            PG8_WAIT_V(8); PG8_WAIT_L(0); PG8_BAR; PG8_MMA(0, 0, At, B0); PG8_MMA(0, 1, At, B1); PG8_BAR; PG8_SCHED;
            PG8_LDA(At, 1, 1); PG8_STAGE(PG8_SB(1, 0), b3, Rb, xldB); PG8_STAGE(PG8_SB(1, 1), b3 + (size_t)HALF * xldB, Rb, xldB); PG8_STAGE(PG8_SA(1, 0), a3, Rr, xldA);
            PG8_WAIT_V(8); PG8_WAIT_L(0); PG8_BAR; PG8_MMA(1, 0, At, B0); PG8_MMA(1, 1, At, B1); PG8_BAR; PG8_SCHED;
        }
        if constexpr (ALIGN_EPI) { if (wr == 0) PG8_BAR; }
        E(acc, cur, wr, wc, fr, fq);
        if (!has_next) break;
#pragma unroll
        for (int a = 0; a < 2; ++a)
#pragma unroll
            for (int b = 0; b < 2; ++b)
#pragma unroll
                for (int m = 0; m < 4; ++m)
#pragma unroll
                    for (int n = 0; n < 2; ++n) acc[a][b][m][n] = (f32x4){0.f, 0.f, 0.f, 0.f};
        cur = nxt; cA = nA; cB = nB; ldA = nldA; ldB = nldB; ++ui;
        if constexpr (ALIGN_EPI) { if (wr == 1) PG8_BAR; }
    }
    PG8_WAIT_V(0);
    if constexpr (!ALIGN_EPI) { if (wr == 0) PG8_BAR; }
    PG8_BAR;
#undef PG8_SA
#undef PG8_SB
#undef PG8_STAGE
#undef PG8_LDA
#undef PG8_LDB
#undef PG8_MMA
#undef PG8_WAIT_V
#undef PG8_WAIT_L
#undef PG8_BAR
#undef PG8_SCHED
}

struct PlainOrder {
    const char* A; const char* B; unsigned lda2, ldb2; int nt, nM, nN, G, c;
    __device__ __forceinline__ bool next(int i, GU& u) const {
        const int L = i * G + c; if (L >= nM * nN) return false;
        int pm, pn; tile_of(L, nM, nN, pm, pn);
        u.pm = pm; u.pn = pn; u.sub = 0; u.nt = nt; u.lda2 = lda2; u.ldb2 = ldb2;
        u.a = A + (size_t)pm * 256 * lda2; u.b = B + (size_t)pn * 256 * ldb2; return true;
    }
};
struct LoraOrder {
    const char* A; const char* Bl; const char* Bv; int nN, G, c;
    __device__ __forceinline__ bool next(int i, GU& u) const {
        const int L = i * G + c; if (L >= 128 * nN) return false;
        int pm, pn; tile_of(L, 128, nN, pm, pn);
        u.pm = pm; u.pn = pn; u.sub = 0; u.nt = 4; u.lda2 = 1024; u.ldb2 = 512;
        u.a = A + (size_t)pm * 256 * 1024 + (pn == 3 ? 512 : 0); u.b = (pn == 3) ? Bv : Bl + (size_t)pn * 256 * 512; return true;
    }
};
struct MergeOrder {
    const char* Hh; const char* Yy; const char* Wg; const char* Wb; int G, c;
    __device__ __forceinline__ bool next(int i, GU& u) const {
        const int ti = i >> 3, sub = i & 7, n = sub >> 1;
        const int L = ti * G + c; if (L >= 512) return false;
        int pm, pn; tile_of(L, 128, 4, pm, pn);
        u.pm = pm; u.pn = pn; u.sub = sub; u.lda2 = 2048;
        if ((sub & 1) == 0) { u.a = Hh + (size_t)pm * 256 * 2048; u.b = Wg + (size_t)(n * 1024 + pn * 256) * 2048; u.ldb2 = 2048; u.nt = 16; }
        else { const int co = n == 0 ? C_SB : (n == 1 ? C_RW : (n == 2 ? C_MB : C_HG)); u.a = Yy + (size_t)pm * 256 * (PMW * 2) + co * 2; u.lda2 = PMW * 2; u.b = Wb + (size_t)(n * 1024 + pn * 256) * 512; u.ldb2 = 512; u.nt = 4; }
        return true;
    }
};

__device__ __forceinline__ void unit_row_scales(const float* rsq, int pm, LAS unsigned char* ldsx, int tid, int wr, int fr, float (&rs)[2][4]) {
    LAS float* RSL = (LAS float*)(ldsx + LDS_RSL);
    if (tid < 256) { const f32x4 q = *(const f32x4*)(rsq + (size_t)(pm * 256 + tid) * 4); RSL[tid] = 1.0f / sqrtf(((q.x + q.y) + (q.z + q.w)) * (1.f / D) + 1e-6f); }
    LBAR();
#pragma unroll
    for (int ai = 0; ai < 2; ++ai)
#pragma unroll
        for (int m = 0; m < 4; ++m) rs[ai][m] = RSL[ai * HALF + wr * 64 + m * 16 + fr];
}
struct EpiBf16S {
    static constexpr bool PERM = true;
    bf16* O; int ldc; const float* rsq; LAS unsigned char* ldsx;
    __device__ __forceinline__ void operator()(const f32x4 (&acc)[2][2][4][2], const GU& u, int wr, int wc, int fr, int fq) const {
        int tid = threadIdx.x; asm volatile("" : "+v"(tid));
        float rs[2][4]; unit_row_scales(rsq, u.pm, ldsx, tid, wr, fr, rs);
        const int row0 = u.pm * BM + wr * 64 + fr, col0 = u.pn * BM + wc * 32 + 8 * fq;
#pragma unroll
        for (int ai = 0; ai < 2; ++ai)
#pragma unroll
            for (int m = 0; m < 4; ++m) { bf16* rowp = O + (size_t)(row0 + ai * HALF + m * 16) * ldc + col0; const float r_ = rs[ai][m];
#pragma unroll
                for (int bj = 0; bj < 2; ++bj) { const f32x4 v0 = acc[ai][bj][m][0] * r_, v1 = acc[ai][bj][m][1] * r_;
                    u32x4 w; w.x = cvt_pk_bf16(v0[0], v0[1]); w.y = cvt_pk_bf16(v0[2], v0[3]); w.z = cvt_pk_bf16(v1[0], v1[1]); w.w = cvt_pk_bf16(v1[2], v1[3]);
                    *(u32x4*)(rowp + bj * HALF) = w; } }
    }
};
struct EpiBf16 {
    static constexpr bool PERM = true;
    bf16* O; int ldc;
    __device__ __forceinline__ void operator()(const f32x4 (&acc)[2][2][4][2], const GU& u, int wr, int wc, int fr, int fq) const {
        const int row0 = u.pm * BM + wr * 64 + fr, col0 = u.pn * BM + wc * 32 + 8 * fq;
#pragma unroll
        for (int ai = 0; ai < 2; ++ai)
#pragma unroll
            for (int m = 0; m < 4; ++m) { bf16* rowp = O + (size_t)(row0 + ai * HALF + m * 16) * ldc + col0;
#pragma unroll
                for (int bj = 0; bj < 2; ++bj) { const f32x4 v0 = acc[ai][bj][m][0], v1 = acc[ai][bj][m][1];
                    u32x4 w; w.x = cvt_pk_bf16(v0[0], v0[1]); w.y = cvt_pk_bf16(v0[2], v0[3]); w.z = cvt_pk_bf16(v1[0], v1[1]); w.w = cvt_pk_bf16(v1[2], v1[3]);
                    *(u32x4*)(rowp + bj * HALF) = w; } }
    }
};
struct EpiSwiGLU {
    static constexpr bool PERM = true;
    bf16* O; const float* rsq; LAS unsigned char* ldsx;
    __device__ __forceinline__ void operator()(const f32x4 (&acc)[2][2][4][2], const GU& u, int wr, int wc, int fr, int fq) const {
        int tid = threadIdx.x; asm volatile("" : "+v"(tid));
        float rs[2][4]; unit_row_scales(rsq, u.pm, ldsx, tid, wr, fr, rs);
        const int row0 = u.pm * BM + wr * 64 + fr, col0 = u.pn * HALF + wc * 32 + 8 * fq;
#pragma unroll
        for (int ai = 0; ai < 2; ++ai)
#pragma unroll
            for (int m = 0; m < 4; ++m) { bf16* rowp = O + (size_t)(row0 + ai * HALF + m * 16) * DFF + col0;
                float r[8];
#pragma unroll
                for (int n = 0; n < 2; ++n)
#pragma unroll
                    for (int j = 0; j < 4; ++j) { const float g = acc[ai][0][m][n][j] * rs[ai][m], up = acc[ai][1][m][n][j] * rs[ai][m]; r[n * 4 + j] = g * sigmoidf_(g) * up; }
                u32x4 w; w.x = cvt_pk_bf16(r[0], r[1]); w.y = cvt_pk_bf16(r[2], r[3]); w.z = cvt_pk_bf16(r[4], r[5]); w.w = cvt_pk_bf16(r[6], r[7]);
                *(u32x4*)rowp = w; }
    }
};
template <bool EMIT, bool IN16, bool OUT16>
struct EpiResNorm {
    static constexpr bool PERM = true;
    const void* base; void* out; float* rsq; LAS unsigned char* ldsx;
    __device__ __forceinline__ void operator()(const f32x4 (&acc)[2][2][4][2], const GU& u, int wr, int wc, int fr, int fq) const {
        int tid = threadIdx.x; asm volatile("" : "+v"(tid));
        const int row0 = u.pm * BM + wr * 64 + fr, col0 = u.pn * BM + wc * 32 + 8 * fq;
        LAS float* P = (LAS float*)(ldsx + LDS_XP);
#pragma unroll
        for (int ai = 0; ai < 2; ++ai)
#pragma unroll
            for (int m = 0; m < 4; ++m) { const size_t off = (size_t)(row0 + ai * HALF + m * 16) * D + col0; float sq = 0.f;
                f32x4 bs[2][2];
#pragma unroll
                for (int bj = 0; bj < 2; ++bj) {
                    if constexpr (IN16) { const u32x4 w = *(const u32x4*)((const bf16*)base + off + bj * HALF);
                        bs[bj][0] = (f32x4){bflo(w.x), bfhi(w.x), bflo(w.y), bfhi(w.y)}; bs[bj][1] = (f32x4){bflo(w.z), bfhi(w.z), bflo(w.w), bfhi(w.w)}; }
                    else { bs[bj][0] = *(const f32x4*)((const float*)base + off + bj * HALF); bs[bj][1] = *(const f32x4*)((const float*)base + off + bj * HALF + 4); } }
#pragma unroll
                for (int bj = 0; bj < 2; ++bj) { const f32x4 x0 = bs[bj][0] + acc[ai][bj][m][0], x1 = bs[bj][1] + acc[ai][bj][m][1];
                    if constexpr (OUT16) { u32x4 w; w.x = cvt_pk_bf16(x0.x, x0.y); w.y = cvt_pk_bf16(x0.z, x0.w); w.z = cvt_pk_bf16(x1.x, x1.y); w.w = cvt_pk_bf16(x1.z, x1.w); *(u32x4*)((bf16*)out + off + bj * HALF) = w; }
                    else { *(f32x4*)((float*)out + off + bj * HALF) = x0; *(f32x4*)((float*)out + off + bj * HALF + 4) = x1; }
                    if constexpr (EMIT) sq += ((x0.x * x0.x + x0.y * x0.y) + (x0.z * x0.z + x0.w * x0.w)) + ((x1.x * x1.x + x1.y * x1.y) + (x1.z * x1.z + x1.w * x1.w)); }
                if constexpr (EMIT) { sq += __shfl_xor(sq, 16); sq += __shfl_xor(sq, 32); if (fq == 0) P[(ai * HALF + wr * 64 + m * 16 + fr) * 4 + wc] = sq; } }
        if constexpr (EMIT) { LBAR();
            if (tid < 256) { const f32x4 p = *(const LAS f32x4*)(P + tid * 4); rsq[(size_t)(u.pm * BM + tid) * 4 + u.pn] = (p.x + p.y) + (p.z + p.w); }
            LBAR(); }
    }
};
struct EpiResFinal {
    static constexpr bool PERM = true;
    const bf16* base; float* out; const float* g; float* rsq; unsigned* cnt; LAS unsigned char* ldsx;
    __device__ __forceinline__ void operator()(f32x4 (&acc)[2][2][4][2], const GU& u, int wr, int wc, int fr, int fq) const {
        int tid = threadIdx.x; asm volatile("" : "+v"(tid));
        const int row0 = u.pm * BM + wr * 64 + fr, col0 = u.pn * BM + wc * 32 + 8 * fq;
        LAS float* P = (LAS float*)(ldsx + LDS_XP);
        LAS float* RSL = (LAS float*)(ldsx + LDS_RSL);
#pragma unroll
        for (int ai = 0; ai < 2; ++ai)
#pragma unroll
            for (int m = 0; m < 4; ++m) { const size_t off = (size_t)(row0 + ai * HALF + m * 16) * D + col0; float sq = 0.f;
                u32x4 w[2];
#pragma unroll
                for (int bj = 0; bj < 2; ++bj) w[bj] = *(const u32x4*)(base + off + bj * HALF);
#pragma unroll
                for (int bj = 0; bj < 2; ++bj) { const f32x4 x0 = (f32x4){bflo(w[bj].x), bfhi(w[bj].x), bflo(w[bj].y), bfhi(w[bj].y)} + acc[ai][bj][m][0], x1 = (f32x4){bflo(w[bj].z), bfhi(w[bj].z), bflo(w[bj].w), bfhi(w[bj].w)} + acc[ai][bj][m][1];
                    acc[ai][bj][m][0] = x0; acc[ai][bj][m][1] = x1;
                    sq += ((x0.x * x0.x + x0.y * x0.y) + (x0.z * x0.z + x0.w * x0.w)) + ((x1.x * x1.x + x1.y * x1.y) + (x1.z * x1.z + x1.w * x1.w)); }
                sq += __shfl_xor(sq, 16); sq += __shfl_xor(sq, 32); if (fq == 0) P[(ai * HALF + wr * 64 + m * 16 + fr) * 4 + wc] = sq; }
        LBAR();
        if (tid < 256) { const f32x4 p = *(const LAS f32x4*)(P + tid * 4); rsq[(size_t)(u.pm * BM + tid) * 4 + u.pn] = (p.x + p.y) + (p.z + p.w); }
        asm volatile("s_waitcnt vmcnt(0)" ::: "memory");
        LBAR();
        if (tid == 0) { unsigned* c = cnt + u.pm * 16;
            __builtin_amdgcn_fence(__ATOMIC_RELEASE, "agent");
            asm volatile("s_waitcnt vmcnt(0)" ::: "memory");
            (void)xb_add(c, 1u);
            unsigned sp = 0u; while (xb_ld(c) < 4u) { __builtin_amdgcn_s_sleep(1); if (++sp > XB_SPIN_CAP) break; }
            __builtin_amdgcn_fence(__ATOMIC_ACQUIRE, "agent");
            asm volatile("s_waitcnt vmcnt(0)" ::: "memory"); }
        LBAR();
        if (tid < 256) { const f32x4 q = *(const f32x4*)(rsq + (size_t)(u.pm * BM + tid) * 4); RSL[tid] = 1.0f / sqrtf(((q.x + q.y) + (q.z + q.w)) * (1.f / D) + 1e-6f); }
        LBAR();
        f32x4 gv[2][2];
#pragma unroll
        for (int bj = 0; bj < 2; ++bj)
#pragma unroll
            for (int n = 0; n < 2; ++n) gv[bj][n] = *(const f32x4*)(g + col0 + bj * HALF + n * 4);
#pragma unroll
        for (int ai = 0; ai < 2; ++ai)
#pragma unroll
            for (int m = 0; m < 4; ++m) { const size_t off = (size_t)(row0 + ai * HALF + m * 16) * D + col0; const float r_ = RSL[ai * HALF + wr * 64 + m * 16 + fr];
#pragma unroll
                for (int bj = 0; bj < 2; ++bj) { *(f32x4*)(out + off + bj * HALF) = acc[ai][bj][m][0] * r_ * gv[bj][0]; *(f32x4*)(out + off + bj * HALF + 4) = acc[ai][bj][m][1] * r_ * gv[bj][1]; } }
    }
};
struct EpiMerge {
    static constexpr bool PERM = true;
    u32x4* scr; bf16* O; const float* rsq; LAS unsigned char* ldsx;
    __device__ __forceinline__ void operator()(const f32x4 (&acc)[2][2][4][2], const GU& u, int wr, int wc, int fr, int fq) const {
        int tid = threadIdx.x; asm volatile("" : "+v"(tid));
        if ((u.sub & 1) == 0) {
            float rs[2][4];
            if (u.sub == 0) unit_row_scales(rsq, u.pm, ldsx, tid, wr, fr, rs);
            else { const LAS float* RSL = (const LAS float*)(ldsx + LDS_RSL);
#pragma unroll
                for (int ai = 0; ai < 2; ++ai)
#pragma unroll
                    for (int m = 0; m < 4; ++m) rs[ai][m] = RSL[ai * HALF + wr * 64 + m * 16 + fr]; }
#pragma unroll
            for (int ai = 0; ai < 2; ++ai)
#pragma unroll
                for (int m = 0; m < 4; ++m)
#pragma unroll
                    for (int bj = 0; bj < 2; ++bj) { const f32x4 v0 = acc[ai][bj][m][0] * rs[ai][m], v1 = acc[ai][bj][m][1] * rs[ai][m];
                        u32x4 w; w.x = cvt_pk_bf16(sigmoidf_(v0[0]), sigmoidf_(v0[1])); w.y = cvt_pk_bf16(sigmoidf_(v0[2]), sigmoidf_(v0[3]));
                        w.z = cvt_pk_bf16(sigmoidf_(v1[0]), sigmoidf_(v1[1])); w.w = cvt_pk_bf16(sigmoidf_(v1[2]), sigmoidf_(v1[3]));
                        scr[((ai * 4 + m) * 2 + bj) * 512 + tid] = w; }
        } else {
            const bool first = (u.sub == 1);
            const int row0 = u.pm * BM + wr * 64 + fr, col0 = u.pn * BM + wc * 32 + 8 * fq;
#pragma unroll
            for (int ai = 0; ai < 2; ++ai) {
                u32x4 sg[4][2], pv[4][2];
#pragma unroll
                for (int m = 0; m < 4; ++m)
#pragma unroll
                    for (int bj = 0; bj < 2; ++bj) { sg[m][bj] = scr[((ai * 4 + m) * 2 + bj) * 512 + tid];
                        pv[m][bj] = first ? (u32x4){0u, 0u, 0u, 0u} : *(const u32x4*)(O + (size_t)(row0 + ai * HALF + m * 16) * D + col0 + bj * HALF); }
#pragma unroll
                for (int m = 0; m < 4; ++m) { bf16* rowp = O + (size_t)(row0 + ai * HALF + m * 16) * D + col0;
#pragma unroll
                    for (int bj = 0; bj < 2; ++bj) { const f32x4 v0 = acc[ai][bj][m][0], v1 = acc[ai][bj][m][1];
                        const u32x4 s = sg[m][bj], p = pv[m][bj];
                        float r[8];
                        r[0] = bflo(s.x) * v0[0] + bflo(p.x); r[1] = bfhi(s.x) * v0[1] + bfhi(p.x); r[2] = bflo(s.y) * v0[2] + bflo(p.y); r[3] = bfhi(s.y) * v0[3] + bfhi(p.y);
                        r[4] = bflo(s.z) * v1[0] + bflo(p.z); r[5] = bfhi(s.z) * v1[1] + bfhi(p.z); r[6] = bflo(s.w) * v1[2] + bflo(p.w); r[7] = bfhi(s.w) * v1[3] + bfhi(p.w);
                        u32x4 w; w.x = cvt_pk_bf16(r[0], r[1]); w.y = cvt_pk_bf16(r[2], r[3]); w.z = cvt_pk_bf16(r[4], r[5]); w.w = cvt_pk_bf16(r[6], r[7]);
                        *(u32x4*)(rowp + bj * HALF) = w; } }
            }
        }
    }
};
}

struct Args { const float* in[26]; float* out; unsigned char* ws; int ph_lo, ph_hi; };
enum { I_X = 0, I_N1G, I_WIN, I_MU, I_W0, I_W2, I_A0, I_A2, I_G2, I_KK, I_KA, I_RK, I_GNW, I_GNB, I_V0, I_V1, I_V2, I_LB, I_HGN, I_WBR, I_WOUT, I_N2G, I_WFG, I_WFU, I_WFD, I_FG };

__device__ __forceinline__ void transpose_item(const float* W, int ldw, int k0, int n0, bf16* WT, size_t drow0, int ldt, int dk0, LAS float* scr, int lane, const float* gk = nullptr) {
#pragma unroll 8
    for (int i = 0; i < 32; ++i) { const int kk = 2 * i + (lane >> 5); float w = W[(size_t)(k0 + kk) * ldw + n0 + (lane & 31)]; if (gk) w *= gk[k0 + kk]; scr[kk * 33 + (lane & 31)] = w; }
    LDS_WAIT(); asm volatile("" ::: "memory");
    const int c = lane & 7;
#pragma unroll
    for (int j = 0; j < 4; ++j) { const int n = (lane >> 3) + 8 * j; const LAS float* s = scr + (8 * c) * 33 + n;
        u32x4 o; o.x = pk2(s[0 * 33], s[1 * 33]); o.y = pk2(s[2 * 33], s[3 * 33]); o.z = pk2(s[4 * 33], s[5 * 33]); o.w = pk2(s[6 * 33], s[7 * 33]);
        *(u32x4*)(WT + (drow0 + n) * (size_t)ldt + dk0 + 8 * c) = o; }
    LDS_WAIT(); asm volatile("" ::: "memory");
}

__device__ __forceinline__ void rms_row_bf16(const float* xrow, const float* g, bf16* orow, int lane) {
    const f32x4* xr = (const f32x4*)xrow + lane; f32x4 v[4]; float s = 0.f;
#pragma unroll
    for (int j = 0; j < 4; ++j) { v[j] = xr[64 * j]; s += (v[j].x * v[j].x + v[j].y * v[j].y) + (v[j].z * v[j].z + v[j].w * v[j].w); }
    const float rs = 1.0f / sqrtf(wave_sum(s) * (1.f / D) + 1e-6f);
    u32x2* o8 = (u32x2*)orow + lane;
#pragma unroll
    for (int j = 0; j < 4; ++j) { const f32x4 gv = ((const f32x4*)g)[lane + 64 * j]; u32x2 w; w.x = pk2(v[j].x * rs * gv.x, v[j].y * rs * gv.y); w.y = pk2(v[j].z * rs * gv.z, v[j].w * rs * gv.w); o8[64 * j] = w; }
}
__device__ __forceinline__ void rms_row_f32(const float* xrow, const float* g, float* orow, int lane) {
    const f32x4* xr = (const f32x4*)xrow + lane; f32x4 v[4]; float s = 0.f;
#pragma unroll
    for (int j = 0; j < 4; ++j) { v[j] = xr[64 * j]; s += (v[j].x * v[j].x + v[j].y * v[j].y) + (v[j].z * v[j].z + v[j].w * v[j].w); }
    const float rs = 1.0f / sqrtf(wave_sum(s) * (1.f / D) + 1e-6f);
    f32x4* o = (f32x4*)orow + lane;
#pragma unroll
    for (int j = 0; j < 4; ++j) { const f32x4 gv = ((const f32x4*)g)[lane + 64 * j]; o[64 * j] = v[j] * rs * gv; }
}

__device__ __forceinline__ void rope_entry(int t, int i, float& c, float& s) {
    const double invf[8] = {1.0, 0.19392274474868576, 0.03760603093086393, 0.007292664737217109, 0.001414213562373095, 0.0002742481756762073, 5.318295896944988e-05, 1.031338537721246e-05};
    double f = invf[0];
#pragma unroll
    for (int j = 1; j < 8; ++j) f = (i == j) ? invf[j] : f;
    const double ang = (double)t * f;
    const double k = __builtin_rint(ang * 0.63661977236758134308);
    double r = __builtin_fma(-k, 1.5707963267948966, ang); r = __builtin_fma(-k, 6.123233995736766e-17, r);
    const double r2 = r * r;
    double sn = r * (1.0 + r2 * (-1.0 / 6 + r2 * (1.0 / 120 + r2 * (-1.0 / 5040 + r2 * (1.0 / 362880 + r2 * (-1.0 / 39916800 + r2 * (1.0 / 6227020800.0)))))));
    double cs = 1.0 + r2 * (-0.5 + r2 * (1.0 / 24 + r2 * (-1.0 / 720 + r2 * (1.0 / 40320 + r2 * (-1.0 / 3628800 + r2 * (1.0 / 479001600.0 + r2 * (-1.0 / 87178291200.0)))))));
    const int q = ((int)(long long)k) & 3;
    const double s2 = (q == 0) ? sn : (q == 1) ? cs : (q == 2) ? -sn : -cs;
    const double c2 = (q == 0) ? cs : (q == 1) ? -sn : (q == 2) ? -cs : sn;
    c = (float)c2; s = (float)s2;
}

constexpr int N_LATE = 16 * 128 + 4 * 4 * 32 + 16 * 32 + 2 * 16 * 88 + 44 * 32;
static_assert(N_LATE == 7296 && N_LATE % 32 == 0, "late weight items");
constexpr unsigned NWU = N_LATE / 32;
__device__ __forceinline__ void late_weight_item(const Args& a, int layer, int r, LAS float* scr, int lane) {
    bf16* Wb = (bf16*)(a.ws + WS_W);
    constexpr int N_ING = 16 * 128, N_BR = 4 * 4 * 32, N_OUT = 16 * 32, N_FG = 16 * 88;
    if (r < N_ING) { const int kb = r / 128, nb = 112 + r % 128; transpose_item(a.in[I_WIN] + (size_t)layer * D * 7680, 7680, kb * 64, nb * 32, (bf16*)((char*)Wb + W_IN), (size_t)nb * 32, 1024, kb * 64, scr, lane, a.in[I_N1G] + layer * D); return; } r -= N_ING;
    if (r < N_BR) { const int n = r / 128, q = r % 128, kb = q / 32, nb = q % 32; transpose_item(a.in[I_WBR] + (size_t)layer * 4 * MW * D + (size_t)n * MW * D, D, kb * 64, nb * 32, (bf16*)((char*)Wb + W_B), (size_t)n * 1024 + nb * 32, 256, kb * 64, scr, lane); return; } r -= N_BR;
    if (r < N_OUT) { const int kb = r / 32, nb = r % 32; transpose_item(a.in[I_WOUT] + (size_t)layer * D * D, D, kb * 64, nb * 32, (bf16*)((char*)Wb + W_O), (size_t)nb * 32, 1024, kb * 64, scr, lane); return; } r -= N_OUT;
    if (r < 2 * N_FG) { const int up = r / N_FG, q = r % N_FG, kb = q / 88, nb = q % 88, n0 = nb * 32;
        transpose_item((up ? a.in[I_WFU] : a.in[I_WFG]) + (size_t)layer * D * DFF, DFF, kb * 64, n0, (bf16*)((char*)Wb + W_GU), (size_t)(n0 / 128) * 256 + (n0 % 128) + up * 128, 1024, kb * 64, scr, lane, a.in[I_N2G] + layer * D); return; } r -= 2 * N_FG;
    { const int kb = r / 32, nb = r % 32; transpose_item(a.in[I_WFD] + (size_t)layer * DFF * D, D, kb * 64, nb * 32, (bf16*)((char*)Wb + W_D), (size_t)nb * 32, DFF, kb * 64, scr, lane); }
}

__device__ __forceinline__ void phase_a(const Args& a, int layer, const float* xin, LAS unsigned char* lds, int vb, int G) {
    int tid = threadIdx.x; asm volatile("" : "+v"(tid)); const int lane = tid & 63, wave = tid >> 6;
    unsigned char* ws = a.ws;
    bf16* Wb = (bf16*)(ws + WS_W);
    LAS float* scr = (LAS float*)(lds + wave * 16384);
    const int gw = vb * 8 + wave, NGW = G * 8;
    const float* w_in = a.in[I_WIN] + (size_t)layer * D * 7680;
    const float* w_br = a.in[I_WBR] + (size_t)layer * 4 * MW * D;
    const float* w_out = a.in[I_WOUT] + (size_t)layer * D * D;
    const float* w_fg = a.in[I_WFG] + (size_t)layer * D * DFF;
    const float* w_fu = a.in[I_WFU] + (size_t)layer * D * DFF;
    const float* w_fd = a.in[I_WFD] + (size_t)layer * DFF * D;
    const float* w2 = a.in[I_W2] + (size_t)layer * 64 * MW;
    const float* a2 = a.in[I_A2] + (size_t)layer * 64 * MW;
    const float* g2 = a.in[I_G2] + (size_t)layer * 128 * MW;
    constexpr int N_INE = 16 * 112, N_LO = 8 + 8 + 16;
    for (int it = gw; it < N_INE + N_LO; it += NGW) {
        int r = it;
        if (r < N_INE) { const int kb = r / 112, nb = r % 112; transpose_item(w_in, 7680, kb * 64, nb * 32, (bf16*)((char*)Wb + W_IN), (size_t)nb * 32, 1024, kb * 64, scr, lane, a.in[I_N1G] + layer * D); continue; } r -= N_INE;
        if (r < 8) { transpose_item(w2, MW, 0, r * 32, (bf16*)((char*)Wb + W_L), (size_t)r * 32, 256, 0, scr, lane); continue; } r -= 8;
        if (r < 8) { transpose_item(a2, MW, 0, r * 32, (bf16*)((char*)Wb + W_L), (size_t)256 + r * 32, 256, 64, scr, lane); continue; } r -= 8;
        { const int kb = r / 8, nb = r % 8; transpose_item(g2, MW, kb * 64, nb * 32, (bf16*)((char*)Wb + W_L), (size_t)512 + nb * 32, 256, 128 + kb * 64, scr, lane); }
    }
    const int gt = vb * 512 + tid, NGT = G * 512;
    for (int i = gt; i < 768 * 32; i += NGT) { const int row = i >> 5, ch = i & 31, blk = row >> 8; const int lo = blk == 0 ? 0 : (blk == 1 ? 64 : 128), hi = blk == 0 ? 64 : (blk == 1 ? 128 : 256);
        if (ch * 8 < lo || ch * 8 >= hi) *(u32x4*)((char*)Wb + W_L + (size_t)row * 512 + ch * 16) = (u32x4){0u, 0u, 0u, 0u}; }
    if (layer == 1) {
        const float* v1 = a.in[I_V1]; const float* v2 = a.in[I_V2];
        for (int i = gt; i < 256 * 256; i += NGT) { const int c = i >> 8, k = i & 255; float s = 0.f;
#pragma unroll 8
            for (int j = 0; j < 32; ++j) s += v1[k * 32 + j] * v2[j * 256 + c];
            ((bf16*)((char*)Wb + W_V))[i] = (bf16)f2bf(s); }
    } else {
        float2* rope = (float2*)(ws + WS_ROPE);
        for (int i = gt; i < SEQ * 8; i += NGT) { float c, s; rope_entry(i >> 3, i & 7, c, s); rope[i] = make_float2(c, s); }
    }
    if (layer == 0) { bf16* H = (bf16*)(ws + WS_H); float* RQ = (float*)(ws + WS_RSQ1);
        for (int m = gw; m < M; m += NGW) { const f32x4* xr = (const f32x4*)(xin + (size_t)m * D) + lane; u32x2* o8 = (u32x2*)(H + (size_t)m * D) + lane; float sq = 0.f;
#pragma unroll
            for (int j = 0; j < 4; ++j) { const f32x4 v = xr[64 * j]; sq += (v.x * v.x + v.y * v.y) + (v.z * v.z + v.w * v.w); u32x2 w; w.x = cvt_pk_bf16(v.x, v.y); w.y = cvt_pk_bf16(v.z, v.w); o8[64 * j] = w; }
            sq = wave_sum(sq); if (lane == 0) *(f32x4*)(RQ + (size_t)m * 4) = (f32x4){sq, 0.f, 0.f, 0.f}; } }
}

__device__ __forceinline__ void phase_c(const Args& a, int layer, LAS unsigned char* lds, int vb, int G) {
    int tid = threadIdx.x; asm volatile("" : "+v"(tid)); const int lane = tid & 63, wave = tid >> 6;
    unsigned char* ws = a.ws;
    bf16* PM = (bf16*)(ws + WS_PM); bf16* LA = (bf16*)(ws + WS_LA);
    const float2* rope = (const float2*)(ws + WS_ROPE);
    float* KMP = (float*)(ws + WS_KMP);
    const float* mu = a.in[I_MU] + layer * 1024;
    LAS float* red = (LAS float*)lds;
    const int c4 = 4 * lane, l15 = lane & 15; const bool rot = l15 < 4, lower = l15 < 2;
    const f32x4 mu_l = *(const f32x4*)(mu + 768 + c4), mu_v = *(const f32x4*)(mu + 512 + c4);
    for (int u = vb; u < 256; u += G) {
        const int b = u >> 5, hb = u & 31; const int t0 = hb * 128 + wave * 16; const size_t row0 = (size_t)b * SEQ + t0;
        f32x4 ksum = {0.f, 0.f, 0.f, 0.f};
        f32x4 xp = {0.f, 0.f, 0.f, 0.f}, vp = xp;
        if (t0 > 0) { xp = ld4bf(PM + (row0 - 1) * PMW + C_RW + 768 + c4); if (layer) vp = ld4bf(PM + (row0 - 1) * PMW + C_RW + 512 + c4); }
        for (int i = 0; i < 16; ++i) {
            const size_t row = row0 + i; const int t = t0 + i;
            bf16* pq = PM + row * PMW + C_MB + c4;
            const f32x4 x = ld4bf(PM + row * PMW + C_RW + 768 + c4);
            f32x4 v4 = {0.f, 0.f, 0.f, 0.f}; if (layer) v4 = ld4bf(PM + row * PMW + C_RW + 512 + c4);
            f32x4 q4 = ld4bf(pq), k4 = ld4bf(pq + 256);
            { float qa[4] = {q4.x, q4.y, q4.z, q4.w}, ka[4] = {k4.x, k4.y, k4.z, k4.w}, qo[4], ko[4];
#pragma unroll
                for (int j = 0; j < 4; ++j) { qo[j] = dpp_xor2(qa[j]); ko[j] = dpp_xor2(ka[j]); }
                if (rot) { const float2* rp = rope + (size_t)t * 8 + (l15 & 1) * 4;
#pragma unroll
                    for (int j = 0; j < 4; ++j) { const float2 cs = rp[j]; const float sg = lower ? -cs.y : cs.y; qa[j] = qa[j] * cs.x + qo[j] * sg; ka[j] = ka[j] * cs.x + ko[j] * sg; }
                    q4 = (f32x4){qa[0], qa[1], qa[2], qa[3]}; k4 = (f32x4){ka[0], ka[1], ka[2], ka[3]};
                    st4bf(pq, q4); st4bf(pq + 256, k4); } }
            { u32x2 w; w.x = cvt_pk_bf16(k4.x, k4.y); w.y = cvt_pk_bf16(k4.z, k4.w); ksum += (f32x4){bflo(w.x), bfhi(w.x), bflo(w.y), bfhi(w.y)}; }
            { const f32x4 xs = x + (xp - x) * mu_l; f32x4 o;
#pragma unroll
                for (int j = 0; j < 4; ++j) { const float e = __expf(2.0f * xs[j]); const float th = 1.0f - 2.0f * __builtin_amdgcn_rcpf(1.0f + e); o[j] = lane < 16 ? th : (lane < 32 ? xs[j] : sigmoidf_(xs[j])); }
                st4bf(LA + row * 512 + c4, o); xp = x;
                if (layer) { st4bf(LA + row * 512 + 256 + c4, v4 + (vp - v4) * mu_v); vp = v4; } }
        }
        *(LAS f32x4*)(red + wave * 256 + c4) = ksum;
        __syncthreads();
        if (tid < 256) { float sacc = 0.f;
#pragma unroll
            for (int w8 = 0; w8 < 8; ++w8) sacc += red[w8 * 256 + tid];
            KMP[((size_t)(b * 4 + (tid >> 6)) * 32 + hb) * 64 + (tid & 63)] = sacc; }
        __syncthreads();
    }
}

constexpr int TC = 16;
#define DPP_SHR(x, n) __builtin_bit_cast(float, __builtin_amdgcn_update_dpp(0, __builtin_bit_cast(int, (x)), 0x110 + (n), 0xF, 0xF, true))
#define DPP_BC15(x) __builtin_bit_cast(float, __builtin_amdgcn_update_dpp(0, __builtin_bit_cast(int, (x)), 0x15F, 0xF, 0xF, true))
typedef short bf16x4v __attribute__((ext_vector_type(4)));
__device__ __forceinline__ bf16x4v frag4(f32x4 z) { return __builtin_bit_cast(bf16x4v, (u32x2){cvt_pk_bf16(z[0], z[1]), cvt_pk_bf16(z[2], z[3])}); }
#define MM16(xt, y) __builtin_amdgcn_mfma_f32_16x16x16bf16_1k(frag4(xt), frag4(y), (f32x4){0.f, 0.f, 0.f, 0.f}, 0, 0, 0)
__device__ __forceinline__ void phase_d2(const Args& a, int layer, int vb, int G) {
    int tid = threadIdx.x; asm volatile("" : "+v"(tid)); const int lane = tid & 63, wave = tid >> 6;
    unsigned char* ws = a.ws;
    bf16* PM = (bf16*)(ws + WS_PM); bf16* LO = (bf16*)(ws + WS_LO); bf16* VF = (bf16*)(ws + WS_VF); float* BON = (float*)(ws + WS_BON);
    const int s = lane & 15, g = lane >> 4;
    const float* mu = a.in[I_MU] + layer * 1024;
#define LDB16(dst, p) do { const u32x4 a_ = *(const u32x4*)((p) + 8 * g), b_ = *(const u32x4*)((p) + 32 + 8 * g); \
        dst[0] = bflo(a_.x); dst[1] = bfhi(a_.x); dst[2] = bflo(a_.y); dst[3] = bfhi(a_.y); dst[4] = bflo(a_.z); dst[5] = bfhi(a_.z); dst[6] = bflo(a_.w); dst[7] = bfhi(a_.w); \
        dst[8] = bflo(b_.x); dst[9] = bfhi(b_.x); dst[10] = bflo(b_.y); dst[11] = bfhi(b_.y); dst[12] = bflo(b_.z); dst[13] = bfhi(b_.z); dst[14] = bflo(b_.w); dst[15] = bfhi(b_.w); } while (0)
#define LDC16(dst, p) do { const f32x4 a_ = *(const f32x4*)((p) + 8 * g), b_ = *(const f32x4*)((p) + 8 * g + 4), c_ = *(const f32x4*)((p) + 32 + 8 * g), d_ = *(const f32x4*)((p) + 36 + 8 * g); \
        dst[0] = a_.x; dst[1] = a_.y; dst[2] = a_.z; dst[3] = a_.w; dst[4] = b_.x; dst[5] = b_.y; dst[6] = b_.z; dst[7] = b_.w; dst[8] = c_.x; dst[9] = c_.y; dst[10] = c_.z; dst[11] = c_.w; dst[12] = d_.x; dst[13] = d_.y; dst[14] = d_.z; dst[15] = d_.w; } while (0)
#define STB16(p, src) do { u32x4 a_, b_; a_.x = cvt_pk_bf16(src[0], src[1]); a_.y = cvt_pk_bf16(src[2], src[3]); a_.z = cvt_pk_bf16(src[4], src[5]); a_.w = cvt_pk_bf16(src[6], src[7]); \
        b_.x = cvt_pk_bf16(src[8], src[9]); b_.y = cvt_pk_bf16(src[10], src[11]); b_.z = cvt_pk_bf16(src[12], src[13]); b_.w = cvt_pk_bf16(src[14], src[15]); \
        *(u32x4*)((p) + 8 * g) = a_; *(u32x4*)((p) + 32 + 8 * g) = b_; } while (0)
#define PK8(src, o) __builtin_bit_cast(bf16x8, (u32x4){cvt_pk_bf16(src[(o)], src[(o) + 1]), cvt_pk_bf16(src[(o) + 2], src[(o) + 3]), cvt_pk_bf16(src[(o) + 4], src[(o) + 5]), cvt_pk_bf16(src[(o) + 6], src[(o) + 7])})
#define SUM64(x) do { x += __shfl_xor(x, 16); x += __shfl_xor(x, 32); } while (0)
    const int gw = vb * 8 + wave, NGW = G * 8;
    for (int task = gw; task < 8192; task += NGW) {
        const int chain = task >> 8, ch = task & 255, b = chain >> 2, h = chain & 3;
        const int t = ch * 16 + s; const size_t row = (size_t)b * SEQ + t;
        const bf16* pr = PM + row * PMW + C_RW + h * 64; const bf16* pp = (t > 0) ? pr - PMW : pr; const float pz = (t > 0) ? 1.f : 0.f;
        bf16* lo = LO + row * 1024 + h * 64;
        float lw[16], kk[16], bv[16], km[16], rr[16], vv[16];
        { float x0[16], xp[16], c0[16], c1[16], asg[16];
            LDB16(x0, pr); LDB16(xp, pp); LDC16(c0, mu + h * 64);
#pragma unroll
            for (int j = 0; j < 16; ++j) rr[j] = x0[j] + (xp[j] * pz - x0[j]) * c0[j];
            LDB16(x0, pr + 256); LDB16(xp, pp + 256); LDC16(c0, mu + 256 + h * 64);
            float ks[16];
#pragma unroll
            for (int j = 0; j < 16; ++j) ks[j] = x0[j] + (xp[j] * pz - x0[j]) * c0[j];
            LDB16(x0, pr + 512); LDB16(xp, pp + 512); LDC16(c0, mu + 512 + h * 64);
#pragma unroll
            for (int j = 0; j < 16; ++j) vv[j] = x0[j] + (xp[j] * pz - x0[j]) * c0[j];
            LDB16(x0, lo); LDC16(c0, a.in[I_W0] + layer * 256 + h * 64);
#pragma unroll
            for (int j = 0; j < 16; ++j) { const float wlog = -softplusf_(-(c0[j] + x0[j])) - 0.5f; lw[j] = -__expf(wlog); }
            LDB16(x0, lo + 256); LDC16(c0, a.in[I_A0] + layer * 256 + h * 64);
#pragma unroll
            for (int j = 0; j < 16; ++j) asg[j] = sigmoidf_(c0[j] + x0[j]);
            if (layer) { LDB16(x0, lo + 768); LDB16(xp, VF + row * 256 + h * 64); LDC16(c0, a.in[I_V0] + h * 64);
#pragma unroll
                for (int j = 0; j < 16; ++j) vv[j] += (xp[j] - vv[j]) * sigmoidf_(c0[j] + x0[j]); }
            else STB16(VF + row * 256 + h * 64, vv);
            STB16(lo + 768, vv);
            LDC16(c0, a.in[I_KK] + layer * 256 + h * 64); LDC16(c1, a.in[I_KA] + layer * 256 + h * 64);
            float n2 = 0.f;
#pragma unroll
            for (int j = 0; j < 16; ++j) { kk[j] = ks[j] * c0[j]; n2 += kk[j] * kk[j]; km[j] = ks[j] * (1.0f + (asg[j] - 1.0f) * c1[j]); }
            SUM64(n2); const float rn = 1.0f / fmaxf(sqrtf(n2), 1e-12f);
            LDC16(c0, a.in[I_RK] + layer * 256 + h * 64);
            float bon = 0.f;
#pragma unroll
            for (int j = 0; j < 16; ++j) { kk[j] *= rn; bv[j] = kk[j] * asg[j]; bon += rr[j] * km[j] * c0[j]; }
            SUM64(bon); if (g == 0) BON[row * 4 + h] = bon; }
        unsigned char* se = ws + WS_RS + (size_t)task * RS_ENTRY;
        float al[16], bh[16], kh[16], rh[16];
#pragma unroll
        for (int j = 0; j < 16; ++j) { float cs = lw[j]; cs += DPP_SHR(cs, 1); cs += DPP_SHR(cs, 2); cs += DPP_SHR(cs, 4); cs += DPP_SHR(cs, 8);
            const float Gt = __expf(cs), Gi = __expf(-cs), Gp = __expf(cs - lw[j]);
            al[j] = Gp * kk[j]; bh[j] = bv[j] * Gi; kh[j] = km[j] * Gi; rh[j] = Gt * rr[j];
            if (s == 15) ((float*)(se + 12800))[(j < 8 ? 8 * g + j : 24 + 8 * g + j)] = Gt; }
        { bf16* at = (bf16*)se + s * 72; STB16(at, al); bf16* rt = (bf16*)(se + 2304) + s * 72; STB16(rt, rh);
            bf16* bt = (bf16*)(se + 4608); bf16* kt = (bf16*)(se + 6656); bf16* vt = (bf16*)(se + 8704);
#pragma unroll
            for (int j = 0; j < 16; ++j) { const int k = (j < 8 ? 8 * g + j : 24 + 8 * g + j); bt[k * 16 + s] = (bf16)f2bf(-bh[j]); kt[k * 16 + s] = (bf16)f2bf(kh[j]); vt[k * 16 + s] = (bf16)f2bf(vv[j]); } }
        const bf16x8 al0 = PK8(al, 0), al1 = PK8(al, 8), bh0 = PK8(bh, 0), bh1 = PK8(bh, 8), kh0 = PK8(kh, 0), kh1 = PK8(kh, 8), rh0 = PK8(rh, 0), rh1 = PK8(rh, 8);
#define GRAM(x0_, x1_, y0_, y1_) __builtin_amdgcn_mfma_f32_16x16x32_bf16(x1_, y1_, __builtin_amdgcn_mfma_f32_16x16x32_bf16(x0_, y0_, (f32x4){0.f, 0.f, 0.f, 0.f}, 0, 0, 0), 0, 0, 0)
        f32x4 N = GRAM(bh0, bh1, al0, al1), NT = GRAM(al0, al1, bh0, bh1), QT = GRAM(al0, al1, kh0, kh1), BR = GRAM(bh0, bh1, rh0, rh1), KR = GRAM(kh0, kh1, rh0, rh1);
        f32x4 ID;
#pragma unroll
        for (int r = 0; r < 4; ++r) { const int rw = 4 * g + r; N[r] = rw < s ? N[r] : 0.f; NT[r] = s < rw ? NT[r] : 0.f; QT[r] = s < rw ? QT[r] : 0.f; BR[r] = rw <= s ? -BR[r] : 0.f; KR[r] = rw <= s ? KR[r] : 0.f; ID[r] = rw == s ? 1.f : 0.f; }
        const f32x4 N2 = MM16(NT, N), N2T = MM16(N, NT); const f32x4 N4 = MM16(N2T, N2), N4T = MM16(N2, N2T); const f32x4 N8 = MM16(N4T, N4);
        f32x4 X = MM16(ID + N4T, ID + N8); X = MM16(ID + N2T, X); const f32x4 T = MM16(ID - NT, X);
        const f32x4 QTm = MM16(QT, T);
        { u32x2* sm = (u32x2*)(se + 10752) + lane;
            sm[0] = (u32x2){cvt_pk_bf16(T[0], T[1]), cvt_pk_bf16(T[2], T[3])}; sm[64] = (u32x2){cvt_pk_bf16(QTm[0], QTm[1]), cvt_pk_bf16(QTm[2], QTm[3])};
            sm[128] = (u32x2){cvt_pk_bf16(BR[0], BR[1]), cvt_pk_bf16(BR[2], BR[3])}; sm[192] = (u32x2){cvt_pk_bf16(KR[0], KR[1]), cvt_pk_bf16(KR[2], KR[3])}; }
    }
#undef GRAM
#undef LDB16
#undef LDC16
#undef STB16
#undef PK8
#undef SUM64
}

constexpr int RWS = (int)RS_ENTRY;
__device__ __forceinline__ void rwkv_chain(const Args& a, int layer, int chain, LAS unsigned char* L) {
    int tid = threadIdx.x; asm volatile("" : "+v"(tid)); const int lane = tid & 63, w = __builtin_amdgcn_readfirstlane(tid >> 6);
    const int b = chain >> 2, h = chain & 3;
    unsigned char* ws = a.ws;
    const unsigned char* RS = ws + WS_RS + (size_t)chain * 256 * RS_ENTRY;
    constexpr int NCH = 256;
    if (w >= 4) {
        const int lw = w - 4;
#define RW_DMA(cn) do { const int cn_ = (cn) < NCH ? (cn) : NCH - 1; const unsigned char* src_ = RS + (size_t)cn_ * RS_ENTRY + lane * 16; LAS unsigned char* dst_ = L + ((cn) & 7) * RWS; \
            __builtin_amdgcn_global_load_lds((const unsigned*)(src_ + lw * 1024), (LAS unsigned*)(dst_ + lw * 1024), 16, 0, 0); \
            __builtin_amdgcn_global_load_lds((const unsigned*)(src_ + (lw + 4) * 1024), (LAS unsigned*)(dst_ + (lw + 4) * 1024), 16, 0, 0); \
            __builtin_amdgcn_global_load_lds((const unsigned*)(src_ + (lw + 8) * 1024), (LAS unsigned*)(dst_ + (lw + 8) * 1024), 16, 0, 0); \
            if (lw == 0 && lane < 48) __builtin_amdgcn_global_load_lds((const unsigned*)(src_ + 12 * 1024), (LAS unsigned*)(dst_ + 12 * 1024), 16, 0, 0); } while (0)
#define RW_WAIT() do { if (lw == 0) asm volatile("s_waitcnt vmcnt(24)" ::: "memory"); else asm volatile("s_waitcnt vmcnt(18)" ::: "memory"); } while (0)
        RW_DMA(0); RW_DMA(1); RW_DMA(2); RW_DMA(3); RW_DMA(4); RW_DMA(5); RW_DMA(6);
        RW_WAIT(); LBAR();
        for (int c = 0; c < NCH; ++c) { RW_DMA(c + 7); RW_WAIT(); LBAR(); }
        asm volatile("s_waitcnt vmcnt(0)" ::: "memory");
        LBAR();
#undef RW_DMA
#undef RW_WAIT
    } else {
        const int s16 = lane & 15, cg = lane >> 4;
        bf16* PMo = (bf16*)(ws + WS_PM) + (size_t)b * SEQ * PMW + C_RW + h * 64 + 16 * w + s16;
        f32x4 S0 = {0.f, 0.f, 0.f, 0.f}, S1 = S0, S2 = S0, S3 = S0;
        LBAR();
        for (int c = 0; c < NCH; ++c) {
            const LAS unsigned char* E = L + (c & 7) * RWS;
            const LAS bf16* AT = (const LAS bf16*)E + s16 * 72 + 4 * cg; const LAS bf16* RT = (const LAS bf16*)(E + 2304) + s16 * 72 + 4 * cg;
            const LAS bf16* BT = (const LAS bf16*)(E + 4608) + s16 * 16 + 4 * cg; const LAS bf16* KT = (const LAS bf16*)(E + 6656) + s16 * 16 + 4 * cg;
            const bf16x4v vt = *(const LAS bf16x4v*)((const LAS bf16*)(E + 8704) + (16 * w + s16) * 16 + 4 * cg);
            const LAS bf16x4v* SM = (const LAS bf16x4v*)(E + 10752) + lane; const bf16x4v tc = SM[0], qc = SM[64], brc = SM[128], krc = SM[192];
            const LAS float* GC = (const LAS float*)(E + 12800) + 4 * cg;
            const bf16x4v s0b = frag4(S0), s1b = frag4(S1), s2b = frag4(S2), s3b = frag4(S3);
            const f32x4 Z = {0.f, 0.f, 0.f, 0.f};
            f32x4 p1 = __builtin_amdgcn_mfma_f32_16x16x16bf16_1k(*(const LAS bf16x4v*)(AT), s0b, Z, 0, 0, 0);
            p1 = __builtin_amdgcn_mfma_f32_16x16x16bf16_1k(*(const LAS bf16x4v*)(AT + 16), s1b, p1, 0, 0, 0);
            p1 = __builtin_amdgcn_mfma_f32_16x16x16bf16_1k(*(const LAS bf16x4v*)(AT + 32), s2b, p1, 0, 0, 0);
            p1 = __builtin_amdgcn_mfma_f32_16x16x16bf16_1k(*(const LAS bf16x4v*)(AT + 48), s3b, p1, 0, 0, 0);
            f32x4 y = __builtin_amdgcn_mfma_f32_16x16x16bf16_1k(krc, vt, Z, 0, 0, 0);
            y = __builtin_amdgcn_mfma_f32_16x16x16bf16_1k(*(const LAS bf16x4v*)(RT), s0b, y, 0, 0, 0);
            y = __builtin_amdgcn_mfma_f32_16x16x16bf16_1k(*(const LAS bf16x4v*)(RT + 16), s1b, y, 0, 0, 0);
            y = __builtin_amdgcn_mfma_f32_16x16x16bf16_1k(*(const LAS bf16x4v*)(RT + 32), s2b, y, 0, 0, 0);
            y = __builtin_amdgcn_mfma_f32_16x16x16bf16_1k(*(const LAS bf16x4v*)(RT + 48), s3b, y, 0, 0, 0);
            f32x4 u = __builtin_amdgcn_mfma_f32_16x16x16bf16_1k(qc, vt, Z, 0, 0, 0);
            u = __builtin_amdgcn_mfma_f32_16x16x16bf16_1k(tc, frag4(p1), u, 0, 0, 0);
            const bf16x4v ub = frag4(u);
            y = __builtin_amdgcn_mfma_f32_16x16x16bf16_1k(brc, ub, y, 0, 0, 0);
#define RW_UPD(Sx, kt) do { f32x4 n_ = __builtin_amdgcn_mfma_f32_16x16x16bf16_1k(*(const LAS bf16x4v*)(KT + (kt) * 256), vt, Sx, 0, 0, 0); \
                n_ = __builtin_amdgcn_mfma_f32_16x16x16bf16_1k(*(const LAS bf16x4v*)(BT + (kt) * 256), ub, n_, 0, 0, 0); Sx = n_ * *(const LAS f32x4*)(GC + 16 * (kt)); } while (0)
            RW_UPD(S0, 0); RW_UPD(S1, 1); RW_UPD(S2, 2); RW_UPD(S3, 3);
#undef RW_UPD
            bf16* yo = PMo + (size_t)(c * 16 + 4 * cg) * PMW;
#pragma unroll
            for (int r = 0; r < 4; ++r) yo[(size_t)r * PMW] = (bf16)f2bf(y[r]);
            LBAR();
        }
        LBAR();
    }
}

__device__ __forceinline__ void phase_e2(const Args& a, int layer, int vb, int G) {
    int tid = threadIdx.x; asm volatile("" : "+v"(tid)); const int lane = tid & 63, wave = tid >> 6;
    unsigned char* ws = a.ws;
    const bf16* LO = (const bf16*)(ws + WS_LO); const float* BON = (const float*)(ws + WS_BON); bf16* PM = (bf16*)(ws + WS_PM);
    const int c4 = 4 * lane, head = lane >> 4;
    const f32x4 gnw = *(const f32x4*)(a.in[I_GNW] + layer * 256 + c4), gnb = *(const f32x4*)(a.in[I_GNB] + layer * 256 + c4);
    for (int tok = vb * 8 + wave; tok < M; tok += G * 8) {
        const size_t row = (size_t)tok;
        bf16* yp = PM + row * PMW + C_RW + c4; const f32x4 y = ld4bf(yp); const f32x4 vf = ld4bf(LO + row * 1024 + 768 + c4), g = ld4bf(LO + row * 1024 + 512 + c4); const float bon = BON[row * 4 + head];
        const float mean = dpp_sum16((y.x + y.y) + (y.z + y.w)) * (1.f / 64); const f32x4 d = y - mean;
        const float var = dpp_sum16((d.x * d.x + d.y * d.y) + (d.z * d.z + d.w * d.w)) * (1.f / 64);
        const f32x4 yn = d * (1.0f / sqrtf(var + 64e-5f)) * gnw + gnb;
        st4bf(yp, (yn + bon * vf) * g);
    }
}

typedef short bf16x4 __attribute__((ext_vector_type(4)));
constexpr int HQS = 72, HES = 20;
constexpr int HG_QT = 0, HG_KT = HG_QT + 16 * HQS * 2, HG_KE = HG_KT + 16 * HQS * 2, HG_IT = HG_KE + 64 * HES * 2, HG_DEC = HG_IT + 64 * HES * 2, HG_O = HG_DEC + 256, HG_BUF = HG_O + 4096;
__device__ __forceinline__ void hgrn_chain(const Args& a, int layer, int bh, LAS unsigned char* L) {
    int tid = threadIdx.x; asm volatile("" : "+v"(tid)); const int lane = tid & 63, w = __builtin_amdgcn_readfirstlane(tid >> 6);
    const int b = bh >> 2, h = bh & 3;
    unsigned char* ws = a.ws;
    const bf16* PM = (const bf16*)(ws + WS_PM); bf16* PMo = (bf16*)(ws + WS_PM);
    const size_t rowb = (size_t)b * SEQ;
    constexpr int NCH = SEQ / 16;
    const int s16 = lane & 15, cg = lane >> 4;
    constexpr int RAWS = 528, RAWSZ = 16 * RAWS, HG_RAW = 2 * HG_BUF;
    const int ld_tok = tid >> 5, ld_arr = (tid & 31) >> 3, ld_c8 = tid & 7;
    const bf16* ld_src = PM + (rowb + ld_tok) * PMW + C_HG + h * 64 + ld_arr * 256 + ld_c8 * 8;
    const int ld_dst = ld_tok * RAWS + ld_arr * 128 + ld_c8 * 16;
    float lb[2], oml[2];
#pragma unroll
    for (int r = 0; r < 2; ++r) { const int k = (2 * w + r) * 4 + cg; float v = 0.f; if (layer) { const float l0 = a.in[I_LB][h * 64 + k], l1 = a.in[I_LB][256 + h * 64 + k]; v = 1.0f / (1.0f + expf(l0 - l1)); } lb[r] = v; oml[r] = 1.0f - v; }
    const f32x4 gng4 = *(const f32x4*)(a.in[I_HGN] + layer * 256 + h * 64 + 4 * s16);
    const f32x2 lb2 = {lb[0], lb[1]}, oml2 = {oml[0], oml[1]};
    u32x4 pf[8];
#define HG_LOAD(set, cn) do { const int cn_ = (cn) < NCH ? (cn) : NCH - 1; pf[set] = *(const u32x4*)(ld_src + (size_t)cn_ * 16 * PMW); } while (0)
#define HG_STAGE(set, cn) do { *(LAS u32x4*)(L + HG_RAW + ((cn) & 3) * RAWSZ + ld_dst) = pf[set]; } while (0)
#define HG_PROD(cn) do { { LAS unsigned char* B_ = L + ((cn) & 1) * HG_BUF; const int k0_ = (2 * w) * 4 + cg, k1_ = k0_ + 4; \
        const LAS bf16* R_ = (const LAS bf16*)(L + HG_RAW + ((cn) & 3) * RAWSZ + s16 * RAWS); const unsigned rq0_ = R_[k0_], rq1_ = R_[k1_], rf0_ = R_[64 + k0_], rf1_ = R_[64 + k1_], ri0_ = R_[128 + k0_], ri1_ = R_[128 + k1_]; \
        const f32x2 fl_ = {bflo(rf0_), bflo(rf1_)}; \
        f32x2 e_, inv_, lf_; e_.x = __expf(-fabsf(fl_.x)); e_.y = __expf(-fabsf(fl_.y)); inv_.x = __builtin_amdgcn_rcpf(1.0f + e_.x); inv_.y = __builtin_amdgcn_rcpf(1.0f + e_.y); \
        const f32x2 ei_ = e_ * inv_; f32x2 sg_, ns_; sg_.x = fl_.x >= 0.f ? inv_.x : ei_.x; sg_.y = fl_.y >= 0.f ? inv_.y : ei_.y; ns_.x = fl_.x >= 0.f ? ei_.x : inv_.x; ns_.y = fl_.y >= 0.f ? ei_.y : inv_.y; \
        const f32x2 f_ = lb2 + oml2 * sg_, key_ = oml2 * ns_; lf_.x = __logf(f_.x); lf_.y = __logf(f_.y); \
        float b0_ = lf_.x, b1_ = lf_.y; b0_ += DPP_SHR(b0_, 1); b1_ += DPP_SHR(b1_, 1); b0_ += DPP_SHR(b0_, 2); b1_ += DPP_SHR(b1_, 2); b0_ += DPP_SHR(b0_, 4); b1_ += DPP_SHR(b1_, 4); b0_ += DPP_SHR(b0_, 8); b1_ += DPP_SHR(b1_, 8); \
        const float be0_ = DPP_BC15(b0_), be1_ = DPP_BC15(b1_);                         \
        f32x2 eb_, en_, de_; eb_.x = __expf(b0_); eb_.y = __expf(b1_); en_.x = __expf(fminf(-b0_, 80.f)); en_.y = __expf(fminf(-b1_, 80.f)); de_.x = __expf(be0_); de_.y = __expf(be1_); \
        const f32x2 qt_ = (f32x2){bflo(rq0_), bflo(rq1_)} * eb_, kt_ = key_ * en_, ke_ = kt_ * de_; \
        const unsigned wq_ = cvt_pk_bf16(qt_.x, qt_.y), wk_ = cvt_pk_bf16(kt_.x, kt_.y), we_ = cvt_pk_bf16(ke_.x, ke_.y); \
        LAS bf16* QT_ = (LAS bf16*)(B_ + HG_QT) + s16 * HQS; LAS bf16* KT_ = (LAS bf16*)(B_ + HG_KT) + s16 * HQS; LAS bf16* KE_ = (LAS bf16*)(B_ + HG_KE) + s16; LAS bf16* IT_ = (LAS bf16*)(B_ + HG_IT) + s16; \
        QT_[k0_] = (bf16)(wq_ & 0xffffu); QT_[k1_] = (bf16)(wq_ >> 16); KT_[k0_] = (bf16)(wk_ & 0xffffu); KT_[k1_] = (bf16)(wk_ >> 16); \
        KE_[k0_ * HES] = (bf16)(we_ & 0xffffu); KE_[k1_ * HES] = (bf16)(we_ >> 16); IT_[k0_ * HES] = (bf16)ri0_; IT_[k1_ * HES] = (bf16)ri1_; \
        if (s16 == 0) { ((LAS float*)(B_ + HG_DEC))[k0_] = de_.x; ((LAS float*)(B_ + HG_DEC))[k1_] = de_.y; } } } while (0)
#define HG_POST(cn) do { if (w >= 4) { const LAS float* O_ = (const LAS float*)(L + ((cn) & 1) * HG_BUF + HG_O); const int c_ = 4 * (w - 4) + cg; \
        const f32x4 o_ = *(const LAS f32x4*)(O_ + c_ * 64 + 4 * s16); const float ms_ = dpp_sum16((o_.x * o_.x + o_.y * o_.y) + (o_.z * o_.z + o_.w * o_.w)) * (1.f / 64); \
        const u32x2 gw_ = *(const LAS u32x2*)(L + HG_RAW + ((cn) & 3) * RAWSZ + c_ * RAWS + 384 + 8 * s16); const f32x4 g_ = {bflo(gw_.x), bfhi(gw_.x), bflo(gw_.y), bfhi(gw_.y)}; f32x4 sg_; \
        _Pragma("unroll") for (int j_ = 0; j_ < 4; ++j_) sg_[j_] = g_[j_] * sigmoidf_(g_[j_]); \
        st4bf(PMo + (rowb + (cn) * 16 + c_) * PMW + C_HG + h * 64 + 4 * s16, o_ * __builtin_amdgcn_rsqf(ms_ + 1e-6f) * gng4 * sg_); } } while (0)
    f32x4 S0 = {0.f, 0.f, 0.f, 0.f}, S1 = S0, S2 = S0, S3 = S0;
    HG_LOAD(0, 0); HG_LOAD(1, 1); HG_LOAD(2, 2); HG_LOAD(3, 3); HG_LOAD(4, 4); HG_LOAD(5, 5); HG_LOAD(6, 6); HG_LOAD(7, 7);
    HG_STAGE(0, 0); HG_STAGE(1, 1); HG_LOAD(0, 8); HG_LOAD(1, 9);
    LBAR();
    HG_PROD(0);
    LBAR();
#define HG_ITER(i) do { const int n = g0 + (i); HG_STAGE(((i) + 2) & 7, n + 2); HG_LOAD(((i) + 2) & 7, n + 10); if (n + 1 < NCH) HG_PROD(n + 1); hg_mfma(n); if (n > 0) HG_POST(n - 1); LBAR(); } while (0)
    auto hg_mfma = [&](int n) __attribute__((always_inline)) {
        if (w < 4) {
            LAS unsigned char* B = L + (n & 1) * HG_BUF;
            const LAS bf16* QT = (const LAS bf16*)(B + HG_QT); const LAS bf16* KT = (const LAS bf16*)(B + HG_KT); const LAS bf16* KE = (const LAS bf16*)(B + HG_KE); const LAS bf16* IT = (const LAS bf16*)(B + HG_IT);
            const LAS float* DEC = (const LAS float*)(B + HG_DEC); LAS float* O = (LAS float*)(B + HG_O);
            f32x4 sc = {0.f, 0.f, 0.f, 0.f};
#pragma unroll
            for (int ks = 0; ks < 2; ++ks) { const bf16x8 af = *(const LAS bf16x8*)(KT + s16 * HQS + ks * 32 + cg * 8), bfr = *(const LAS bf16x8*)(QT + s16 * HQS + ks * 32 + cg * 8);
                sc = __builtin_amdgcn_mfma_f32_16x16x32_bf16(af, bfr, sc, 0, 0, 0); }
            bf16x4 pf; { float m0 = (4 * cg + 0 <= s16) ? sc[0] : 0.f, m1 = (4 * cg + 1 <= s16) ? sc[1] : 0.f, m2 = (4 * cg + 2 <= s16) ? sc[2] : 0.f, m3 = (4 * cg + 3 <= s16) ? sc[3] : 0.f;
                const unsigned u0 = cvt_pk_bf16(m0, m1), u1 = cvt_pk_bf16(m2, m3); pf = __builtin_bit_cast(bf16x4, (u32x2){u0, u1}); }
            const bf16x4 ifr = *(const LAS bf16x4*)(IT + (16 * w + s16) * HES + 4 * cg);
            f32x4 oacc = {0.f, 0.f, 0.f, 0.f};
            oacc = __builtin_amdgcn_mfma_f32_16x16x16bf16_1k(pf, ifr, oacc, 0, 0, 0);
#define HG_KT_STEP(Sx, kt) do { const bf16x4 qa_ = *(const LAS bf16x4*)(QT + s16 * HQS + 16 * (kt) + 4 * cg); \
                const bf16x4 sb_ = __builtin_bit_cast(bf16x4, (u32x2){cvt_pk_bf16(Sx[0], Sx[1]), cvt_pk_bf16(Sx[2], Sx[3])}); \
                oacc = __builtin_amdgcn_mfma_f32_16x16x16bf16_1k(qa_, sb_, oacc, 0, 0, 0); \
                const bf16x4 ka_ = *(const LAS bf16x4*)(KE + (16 * (kt) + s16) * HES + 4 * cg); const f32x4 dc_ = *(const LAS f32x4*)(DEC + 16 * (kt) + 4 * cg); \
                Sx = __builtin_amdgcn_mfma_f32_16x16x16bf16_1k(ka_, ifr, Sx * dc_, 0, 0, 0); } while (0)
            HG_KT_STEP(S0, 0); HG_KT_STEP(S1, 1); HG_KT_STEP(S2, 2); HG_KT_STEP(S3, 3);
#undef HG_KT_STEP
#pragma unroll
            for (int r = 0; r < 4; ++r) O[(4 * cg + r) * 64 + 16 * w + s16] = oacc[r];
        }
    };
    for (int g0 = 0; g0 < NCH; g0 += 8) { HG_ITER(0); HG_ITER(1); HG_ITER(2); HG_ITER(3); HG_ITER(4); HG_ITER(5); HG_ITER(6); HG_ITER(7); }
    HG_POST(NCH - 1);
    LBAR();
#undef HG_ITER
#undef HG_STAGE
#undef HG_LOAD
#undef HG_PROD
#undef HG_POST
}

#include <hip/hip_bf16.h>
namespace moba_body {
using bf16=__hip_bfloat16;
using bf16x8=__attribute__((ext_vector_type(8)))short;
using s16x4=__attribute__((ext_vector_type(4)))short;
using f32x16=__attribute__((ext_vector_type(16)))float;
using u32x4=__attribute__((ext_vector_type(4)))unsigned;
constexpr int SEQ=4096,D=64,PIN=3584,POUT=3584;
constexpr int NW=8,QBLK=32,QB=QBLK*NW,KVBLK=64,NQB=SEQ/QB;
__device__ __forceinline__ int crow(int r,int hi){return (r&3)+8*(r>>2)+4*hi;}
#define SBAR() __builtin_amdgcn_sched_barrier(0)
__device__ __forceinline__ void cmask(f32x16&p0,f32x16&p1,int jb,int qrel,int hi){
  const float NEG=-INFINITY; int kb=64*jb+4*hi;
  #pragma unroll
  for(int r=0;r<16;++r){int kv=kb+(r&3)+8*(r>>2); if(kv>qrel)p0[r]=NEG; if(kv+32>qrel)p1[r]=NEG;}
}

constexpr int NSLOT=3, SLOTB=8192;
constexpr int LDS_K=0, LDS_V=NSLOT*SLOTB, LDS_WS=2*NSLOT*SLOTB, LDS_OST=LDS_WS+NW*64*4, LDS_BYTES=LDS_OST+NW*4096;
constexpr float C2=0.125f*1.4426950408889634f;
__device__ __forceinline__ void glds16(const void*gbase,unsigned voff,unsigned lds_dst){unsigned keep;
  asm volatile("s_mov_b32 %0, m0\n\ts_mov_b32 m0, %2\n\ts_nop 0\n\tglobal_load_lds_dwordx4 %1, %3\n\ts_mov_b32 m0, %0":"=&s"(keep):"v"(voff),"s"(lds_dst),"s"(gbase):"memory");}
__device__ __forceinline__ float max3f(float a,float b,float c){float r;asm("v_max3_f32 %0, %1, %2, %3":"=v"(r):"v"(a),"v"(b),"v"(c));return r;}
__device__ __forceinline__ float max2f(float a,float b){float r;asm("v_max_f32_e32 %0, %1, %2":"=v"(r):"v"(a),"v"(b));return r;}
__device__ __forceinline__ float fadd_s(float a,float b){float r;asm("v_add_f32_e32 %0, %1, %2":"=v"(r):"v"(a),"v"(b));return r;}
__device__ __forceinline__ float fsub_s(float a,float b){float r;asm("v_sub_f32_e32 %0, %1, %2":"=v"(r):"v"(a),"v"(b));return r;}
typedef float f32x2_t __attribute__((ext_vector_type(2))); typedef __bf16 bf16x2_t __attribute__((ext_vector_type(2)));
__device__ __forceinline__ unsigned cvtpk_s(float lo,float hi){f32x2_t v={lo,hi};bf16x2_t b=__builtin_convertvector(v,bf16x2_t);return __builtin_bit_cast(unsigned,b);}
#define WAIT_BAR(N) asm volatile("s_waitcnt vmcnt(" #N ") lgkmcnt(0)\n\ts_barrier":::"memory")

__device__ __forceinline__ void qkt(f32x16&p0,f32x16&p1,const char*Kslot,const bf16x8*qr,const f32x16&negm,int r32,int hi){
  const char*kb=Kslot+hi*1024+r32*16;
  #pragma unroll
  for(int d0=0;d0<4;++d0){
    const bf16x8 b0=*reinterpret_cast<const bf16x8*>(kb+d0*2048);
    const bf16x8 b1=*reinterpret_cast<const bf16x8*>(kb+d0*2048+512);
    if(d0==0){p0=__builtin_amdgcn_mfma_f32_32x32x16_bf16(b0,qr[0],negm,0,0,0);p1=__builtin_amdgcn_mfma_f32_32x32x16_bf16(b1,qr[0],negm,0,0,0);}
    else{p0=__builtin_amdgcn_mfma_f32_32x32x16_bf16(b0,qr[d0],p0,0,0,0);p1=__builtin_amdgcn_mfma_f32_32x32x16_bf16(b1,qr[d0],p1,0,0,0);}}
}
typedef __attribute__((address_space(3))) const char* lds_cptr;
typedef short v4i16_t __attribute__((ext_vector_type(4)));
__device__ __forceinline__ void kload8(bf16x8*kf,lds_cptr kp){
  kf[0]=*(const __attribute__((address_space(3))) bf16x8*)(kp);      kf[1]=*(const __attribute__((address_space(3))) bf16x8*)(kp+512);
  kf[2]=*(const __attribute__((address_space(3))) bf16x8*)(kp+2048); kf[3]=*(const __attribute__((address_space(3))) bf16x8*)(kp+2560);
  kf[4]=*(const __attribute__((address_space(3))) bf16x8*)(kp+4096); kf[5]=*(const __attribute__((address_space(3))) bf16x8*)(kp+4608);
  kf[6]=*(const __attribute__((address_space(3))) bf16x8*)(kp+6144); kf[7]=*(const __attribute__((address_space(3))) bf16x8*)(kp+6656);
}
__device__ __forceinline__ void kload2(bf16x8*kf,lds_cptr kp,int j){ kf[2*j]=*(const __attribute__((address_space(3))) bf16x8*)(kp+j*2048); kf[2*j+1]=*(const __attribute__((address_space(3))) bf16x8*)(kp+j*2048+512); }
__device__ __forceinline__ s16x4 vtr(lds_cptr p){ return __builtin_bit_cast(s16x4,__builtin_amdgcn_ds_read_tr16_b64_v4i16((__attribute__((address_space(3))) v4i16_t*)p)); }
__device__ __forceinline__ float rowmax(const f32x16&p0,const f32x16&p1){
  float a=max3f(p0[0],p0[1],p1[0]),b=max3f(p0[2],p0[3],p1[1]);a=max3f(a,p1[2],p1[3]);
  #pragma unroll
  for(int r=4;r<16;r+=4){a=max3f(a,p0[r],p0[r+1]);b=max3f(b,p0[r+2],p0[r+3]);a=max3f(a,p1[r],p1[r+1]);b=max3f(b,p1[r+2],p1[r+3]);}
  const float m=max2f(a,b);
  auto rr=__builtin_amdgcn_permlane32_swap(__float_as_uint(m),__float_as_uint(m),false,false);
  return max2f(__uint_as_float(rr[0]),__uint_as_float(rr[1]));
}
__device__ __forceinline__ void pv(f32x16*o,int vb,bf16x8 pa0,bf16x8 pa1,bf16x8 pa2,bf16x8 pa3){
  #pragma unroll
  for(int d0=0;d0<2;++d0){s16x4 lo[4],hi[4];
    #pragma unroll
    for(int ks=0;ks<4;++ks){
      asm volatile("ds_read_b64_tr_b16 %0,%1 offset:%c2":"=&v"(lo[ks]):"v"(vb),"i"(d0*4096+ks*1024):"memory");
      asm volatile("ds_read_b64_tr_b16 %0,%1 offset:%c2":"=&v"(hi[ks]):"v"(vb),"i"(d0*4096+ks*1024+512):"memory");}
    asm volatile("s_waitcnt lgkmcnt(0)":::"memory");SBAR();
    #define PK(k) (bf16x8){lo[k][0],lo[k][1],lo[k][2],lo[k][3],hi[k][0],hi[k][1],hi[k][2],hi[k][3]}
    o[d0]=__builtin_amdgcn_mfma_f32_32x32x16_bf16(pa0,PK(0),o[d0],0,0,0);
    o[d0]=__builtin_amdgcn_mfma_f32_32x32x16_bf16(pa1,PK(1),o[d0],0,0,0);
    o[d0]=__builtin_amdgcn_mfma_f32_32x32x16_bf16(pa2,PK(2),o[d0],0,0,0);
    o[d0]=__builtin_amdgcn_mfma_f32_32x32x16_bf16(pa3,PK(3),o[d0],0,0,0);
    #undef PK
  }
}

#ifndef ATTN_STORE16
#define ATTN_STORE16(p,v) (*(u32x4*)(p)=(v))
#endif
template<int THRL> __device__ __forceinline__ void attn_unit(int b,int h,int qb,const bf16*Q,const bf16*__restrict__ K,const bf16*__restrict__ V,bf16*O,const float*__restrict__ KMP,char*shm){
  int tid=threadIdx.x; asm volatile("":"+v"(tid));
  const int lane=tid&63,r32=lane&31,hi=lane>>5; const int wid=__builtin_amdgcn_readfirstlane(tid>>6);
  const long rowbase=(long)b*SEQ; const int q0=qb*QB;
  const bf16*Qw=Q+(rowbase+q0+wid*QBLK)*PIN+h*D;
  const bf16*Kh=K+rowbase*PIN+h*D,*Vh=V+rowbase*PIN+h*D;
  const unsigned lds0=(unsigned)(uintptr_t)shm;
  float*wsf=(float*)(shm+LDS_WS)+wid*64;
  const unsigned koff=(unsigned)(lane*PIN+wid*8)*2u;
  const unsigned voff=(unsigned)((16*(wid&3)+(lane>>2))*PIN+(wid>>2)*32+(lane&3)*8)*2u;
  const unsigned kdst=lds0+LDS_K+wid*1024, vdst=lds0+LDS_V+wid*1024;
  #define DMA_K(t,slot) glds16(Kh,koff+(unsigned)(t)*(unsigned)(KVBLK*PIN*2),(unsigned)__builtin_amdgcn_readfirstlane(kdst+(slot)))
  #define DMA_V(t,slot) glds16(Vh,voff+(unsigned)(t)*(unsigned)(KVBLK*PIN*2),(unsigned)__builtin_amdgcn_readfirstlane(vdst+(slot)))
  const int vb0=(int)(lds0+LDS_V)+((lane>>4)&1)*32+(lane&3)*8+(4*hi+((lane&15)>>2))*64;
  const char*Kbase=shm+LDS_K; bf16x8 kf[8];
  const lds_cptr shm3=(lds_cptr)shm; const lds_cptr kp0=shm3+LDS_K+hi*1024+r32*16; const lds_cptr vp0=shm3+LDS_V+((lane>>4)&1)*32+(lane&3)*8+(4*hi+((lane&15)>>2))*64;
  const int NT=(q0+QB)/KVBLK;
  DMA_K(0,0);DMA_V(0,0);DMA_K(1,SLOTB);
  bf16x8 qr[4];
  #pragma unroll
  for(int d0=0;d0<4;++d0)qr[d0]=*reinterpret_cast<const bf16x8*>(&Qw[(long)r32*PIN+d0*16+hi*8]);
  unsigned sel=0u;
  { float qf[32];
    #pragma unroll
    for(int d0=0;d0<4;++d0){
      #pragma unroll
      for(int e=0;e<8;++e)qf[d0*8+e]=__uint_as_float(((unsigned)(unsigned short)qr[d0][e])<<16);}
    float b0=-INFINITY,b1=-INFINITY,b2=-INFINITY; int i0=-1,i1=-1,i2=-1;
    for(int j=0;j<qb;++j){
      const float*kp=KMP+((long)(b*4+h)*32+2*j)*64+8*hi; float g=0.f;
      #pragma unroll
      for(int d0=0;d0<4;++d0){ const float4 a0=*reinterpret_cast<const float4*>(kp+16*d0),a1=*reinterpret_cast<const float4*>(kp+16*d0+4),c0=*reinterpret_cast<const float4*>(kp+64+16*d0),c1=*reinterpret_cast<const float4*>(kp+64+16*d0+4);
        g+=qf[d0*8+0]*(a0.x+c0.x);g+=qf[d0*8+1]*(a0.y+c0.y);g+=qf[d0*8+2]*(a0.z+c0.z);g+=qf[d0*8+3]*(a0.w+c0.w);
        g+=qf[d0*8+4]*(a1.x+c1.x);g+=qf[d0*8+5]*(a1.y+c1.y);g+=qf[d0*8+6]*(a1.z+c1.z);g+=qf[d0*8+7]*(a1.w+c1.w);}
      { auto rr=__builtin_amdgcn_permlane32_swap(__float_as_uint(g),__float_as_uint(g),false,false); g=__uint_as_float(rr[0])+__uint_as_float(rr[1]); }
      if(g>b0){b2=b1;i2=i1;b1=b0;i1=i0;b0=g;i0=j;} else if(g>b1){b2=b1;i2=i1;b1=g;i1=j;} else if(g>b2){b2=g;i2=j;}
    }
    if(i0>=0)sel|=1u<<i0; if(i1>=0)sel|=1u<<i1; if(i2>=0)sel|=1u<<i2;
    #pragma unroll
    for(int d0=0;d0<4;++d0){ u32x4 w;
      w[0]=cvtpk_s(qf[d0*8+0]*C2,qf[d0*8+1]*C2);w[1]=cvtpk_s(qf[d0*8+2]*C2,qf[d0*8+3]*C2);w[2]=cvtpk_s(qf[d0*8+4]*C2,qf[d0*8+5]*C2);w[3]=cvtpk_s(qf[d0*8+6]*C2,qf[d0*8+7]*C2);
      qr[d0]=__builtin_bit_cast(bf16x8,w);} }
  float mhat=0.f,l_reg=0.f;f32x16 o[2];o[0]=f32x16{};o[1]=f32x16{};f32x16 negm=f32x16{};asm volatile("":"+v"(negm));
  const int qrel=wid*QBLK+r32;
  #define PMASK(P0,P1,t) do{ if(!((sel>>((t)>>2))&1u)){ _Pragma("unroll") for(int r_=0;r_<16;++r_){P0[r_]=-INFINITY;P1[r_]=-INFINITY;} } }while(0)
  #define CMASK(P0,P1,t) do{int jb_=(t)-(NT-4); if(jb_>=0)cmask(P0,P1,jb_,qrel,hi); else PMASK(P0,P1,t);}while(0)
  bool resc=false;
  #define START(P0,P1) do{ const float rm=rowmax(P0,P1); resc=false; \
    { const float dl=__builtin_fmaxf(rm,-64.f); mhat=fadd_s(mhat,dl); \
      _Pragma("unroll") for(int r=0;r<16;++r){P0[r]=fsub_s(P0[r],dl);P1[r]=fsub_s(P1[r],dl);} \
      _Pragma("unroll") for(int r=0;r<16;++r)negm[r]=-mhat; asm volatile("":"+v"(negm)); } \
    _Pragma("unroll") for(int r=0;r<16;++r)P0[r]=__builtin_amdgcn_exp2f(P0[r]); }while(0)
  #define RESC() do{ if(resc){ asm volatile("s_waitcnt lgkmcnt(0)":::"memory"); \
      _Pragma("unroll") for(int d_=0;d_<2;++d_) _Pragma("unroll") for(int r=0;r<16;++r)o[d_][r]*=wsf[crow(r,hi)]; } }while(0)
  f32x16 pA0,pA1,pB0,pB1;
  int sl_prev=0,sl_cur=0,sl_next=SLOTB;
  #define ROT() do{sl_prev=sl_cur;sl_cur=sl_next;sl_next=(sl_next==(NSLOT-1)*SLOTB)?0:sl_next+SLOTB;}while(0)
  DMA_K(2,2*SLOTB);
  WAIT_BAR(3);
  qkt(pA0,pA1,Kbase,qr,negm,r32,hi);asm volatile("s_nop 15\n\ts_nop 7":"+v"(pA0),"+v"(pA1));CMASK(pA0,pA1,0);
  START(pA0,pA1);
  _Pragma("unroll") for(int r=0;r<16;++r)pA1[r]=__builtin_amdgcn_exp2f(pA1[r]);
  WAIT_BAR(0);
  DMA_K(3,0);DMA_V(1,SLOTB);
  ROT();
  kload8(kf,kp0+sl_cur);
  WAIT_BAR(2);
  s16x4 vlo[8],vhi[8]; u32x4 pw0,pw1,pw2,pw3;
  #define PKW(P,B) cvtpk_s(P[B],P[B+1])
  #define PAF(k) __builtin_bit_cast(bf16x8,pw##k)
  #define VFR(i) (bf16x8){vlo[i][0],vlo[i][1],vlo[i][2],vlo[i][3],vhi[i][0],vhi[i][1],vhi[i][2],vhi[i][3]}
  #define PIN(x) asm volatile("":"+v"(x))
  #define MX3(a,b,c) __builtin_fmaxf(__builtin_fmaxf((a),(b)),(c))
  #define GAPA(MF,A0,A1,A2,A3,W0,W1,PW) do{ MF; sacc+=A0; sacc+=A1; sacc+=A2; sacc+=A3; PIN(sacc); W0; W1; PIN(PW); SBAR(); }while(0)
  #define EX(v) __builtin_amdgcn_exp2f(v)
  #define GAPB(MF,X,B) do{ MF; X[B]=EX(X[B]); X[B+1]=EX(X[B+1]); X[B+2]=EX(X[B+2]); X[B+3]=EX(X[B+3]); PIN(X); SBAR(); }while(0)
  #define VRD(i) do{ vlo[i]=vtr(vp_+(((i)>>2)*4096+((i)&3)*1024)); vhi[i]=vtr(vp_+(((i)>>2)*4096+((i)&3)*1024+512)); }while(0)
  #define KRD(G,j) do{ if(G){ kload2(kf,kp0+sl_next,j); SBAR(); } }while(0)
  #define STEP(C0,C1,P0,P1,t,GK,GV,GL) do{ SBAR(); \
    const lds_cptr vp_=vp0+sl_prev; \
    VRD(0); SBAR(); float sacc=(P0[0]+P0[1]); \
    GAPA(C0=__builtin_amdgcn_mfma_f32_32x32x16_bf16(kf[0],qr[0],negm,0,0,0), P0[2],P0[3],P0[4],P0[5],     pw0[0]=PKW(P0,0), pw0[1]=PKW(P0,2), pw0); \
    VRD(4); SBAR(); GAPA(C1=__builtin_amdgcn_mfma_f32_32x32x16_bf16(kf[1],qr[0],negm,0,0,0), P0[6],P0[7],P0[8],P0[9],     pw0[2]=PKW(P0,4), pw0[3]=PKW(P0,6), pw0); \
    VRD(1); SBAR(); GAPA(C0=__builtin_amdgcn_mfma_f32_32x32x16_bf16(kf[2],qr[1],C0,0,0,0),   P0[10],P0[11],P0[12],P0[13], pw1[0]=PKW(P0,8), pw1[1]=PKW(P0,10), pw1); \
    VRD(5); SBAR(); GAPA(C1=__builtin_amdgcn_mfma_f32_32x32x16_bf16(kf[3],qr[1],C1,0,0,0),   P0[14],P0[15],P1[0],P1[1],   pw1[2]=PKW(P0,12),pw1[3]=PKW(P0,14), pw1); \
    VRD(2); SBAR(); GAPA(C0=__builtin_amdgcn_mfma_f32_32x32x16_bf16(kf[4],qr[2],C0,0,0,0),   P1[2],P1[3],P1[4],P1[5],     pw2[0]=PKW(P1,0), pw2[1]=PKW(P1,2), pw2); \
    VRD(6); SBAR(); GAPA(C1=__builtin_amdgcn_mfma_f32_32x32x16_bf16(kf[5],qr[2],C1,0,0,0),   P1[6],P1[7],P1[8],P1[9],     pw2[2]=PKW(P1,4), pw2[3]=PKW(P1,6), pw2); \
    VRD(3); SBAR(); GAPA(C0=__builtin_amdgcn_mfma_f32_32x32x16_bf16(kf[6],qr[3],C0,0,0,0),   P1[10],P1[11],P1[12],P1[13], pw3[0]=PKW(P1,8), pw3[1]=PKW(P1,10), pw3); \
    VRD(7); SBAR(); GAPA(C1=__builtin_amdgcn_mfma_f32_32x32x16_bf16(kf[7],qr[3],C1,0,0,0),   P1[14],P1[15],0.f,0.f,       pw3[2]=PKW(P1,12),pw3[3]=PKW(P1,14), pw3); \
    l_reg+=sacc; \
    if(GK){DMA_K((t)+3,sl_cur);} if(GV){DMA_V((t)+1,sl_next);} \
    CMASK(C0,C1,t); \
    { float a=MX3(C0[0],C0[1],C1[0]),b=MX3(C0[2],C0[3],C1[1]); a=MX3(a,C1[2],C1[3]); \
      _Pragma("unroll") for(int r=4;r<16;r+=4){a=MX3(a,C0[r],C0[r+1]);b=MX3(b,C0[r+2],C0[r+3]);a=MX3(a,C1[r],C1[r+1]);b=MX3(b,C1[r+2],C1[r+3]);} \
      float rm=__builtin_fmaxf(a,b); { auto rr=__builtin_amdgcn_permlane32_swap(__float_as_uint(rm),__float_as_uint(rm),false,false); rm=__builtin_fmaxf(__uint_as_float(rr[0]),__uint_as_float(rr[1])); } \
      resc=false; \
      if(__builtin_expect(__any(rm>(float)THRL),0)){ const float dl=__builtin_fmaxf(rm,0.f); mhat+=dl; \
        _Pragma("unroll") for(int r=0;r<16;++r){C0[r]-=dl;C1[r]-=dl;} \
        _Pragma("unroll") for(int r=0;r<16;++r)negm[r]=-mhat; asm volatile("":"+v"(negm)); \
        const float f=__builtin_amdgcn_exp2f(-dl); l_reg*=f; if(hi==0)wsf[r32]=f; resc=true; } } \
    SBAR(); \
    GAPB(o[0]=__builtin_amdgcn_mfma_f32_32x32x16_bf16(PAF(0),VFR(0),o[0],0,0,0), C0,0); \
    GAPB(o[1]=__builtin_amdgcn_mfma_f32_32x32x16_bf16(PAF(0),VFR(4),o[1],0,0,0), C0,4); \
    KRD(GL,0); GAPB(o[0]=__builtin_amdgcn_mfma_f32_32x32x16_bf16(PAF(1),VFR(1),o[0],0,0,0), C0,8); \
    KRD(GL,1); GAPB(o[1]=__builtin_amdgcn_mfma_f32_32x32x16_bf16(PAF(1),VFR(5),o[1],0,0,0), C0,12); \
    KRD(GL,2); GAPB(o[0]=__builtin_amdgcn_mfma_f32_32x32x16_bf16(PAF(2),VFR(2),o[0],0,0,0), C1,0); \
    KRD(GL,3); GAPB(o[1]=__builtin_amdgcn_mfma_f32_32x32x16_bf16(PAF(2),VFR(6),o[1],0,0,0), C1,4); \
    GAPB(o[0]=__builtin_amdgcn_mfma_f32_32x32x16_bf16(PAF(3),VFR(3),o[0],0,0,0), C1,8); \
    GAPB(o[1]=__builtin_amdgcn_mfma_f32_32x32x16_bf16(PAF(3),VFR(7),o[1],0,0,0), C1,12); \
    }while(0)
  int t=1;
  #undef CMASK
  #define CMASK(P0,P1,t) PMASK(P0,P1,t)
  for(;t+5<NT;t+=2){
    STEP(pB0,pB1,pA0,pA1,t,true,true,true);     WAIT_BAR(2); RESC(); ROT();
    STEP(pA0,pA1,pB0,pB1,t+1,true,true,true);   WAIT_BAR(2); RESC(); ROT();
  }
  #undef CMASK
  #define CMASK(P0,P1,t) do{int jb_=(t)-(NT-4); if(jb_>=0)cmask(P0,P1,jb_,qrel,hi); else PMASK(P0,P1,t);}while(0)
  #define ENDW(tt) do{ if((tt)+3<NT){WAIT_BAR(2);} else if((tt)+2<NT){WAIT_BAR(1);} else {WAIT_BAR(0);} }while(0)
  for(;t+1<NT;t+=2){
    STEP(pB0,pB1,pA0,pA1,t,(t+3<NT),(t+1<NT),(t+1<NT));       ENDW(t);   RESC(); ROT();
    STEP(pA0,pA1,pB0,pB1,t+1,(t+4<NT),(t+2<NT),(t+2<NT));     ENDW(t+1); RESC(); ROT();
  }
  STEP(pB0,pB1,pA0,pA1,NT-1,false,false,false); RESC();
  { float sacc=pB0[0]+pB0[1]; _Pragma("unroll") for(int r=2;r<16;++r)sacc+=pB0[r]; _Pragma("unroll") for(int r=0;r<16;++r)sacc+=pB1[r]; l_reg+=sacc;
    pw0=(u32x4){PKW(pB0,0),PKW(pB0,2),PKW(pB0,4),PKW(pB0,6)};pw1=(u32x4){PKW(pB0,8),PKW(pB0,10),PKW(pB0,12),PKW(pB0,14)};pw2=(u32x4){PKW(pB1,0),PKW(pB1,2),PKW(pB1,4),PKW(pB1,6)};pw3=(u32x4){PKW(pB1,8),PKW(pB1,10),PKW(pB1,12),PKW(pB1,14)};
    SBAR(); pv(o,vb0+sl_cur,PAF(0),PAF(1),PAF(2),PAF(3)); }
  #undef PKW
  #undef PAF
  #undef VFR
  #undef PIN
  #undef MX3
  #undef GAPA
  #undef GAPB
  #undef EX
  #undef VRD
  #undef KRD
  #undef STEP
  #undef ENDW
  {auto rr=__builtin_amdgcn_permlane32_swap(__float_as_uint(l_reg),__float_as_uint(l_reg),false,false);l_reg=__uint_as_float(rr[0])+__uint_as_float(rr[1]);}
  if(hi==0)wsf[32+r32]=l_reg;asm volatile("s_waitcnt lgkmcnt(0)":::"memory");
  float rli[16];
  #pragma unroll
  for(int r=0;r<16;++r)rli[r]=__builtin_amdgcn_rcpf(wsf[32+crow(r,hi)]);
  bf16*Ow=O+(rowbase+q0+wid*QBLK)*POUT+h*D;
  { bf16*stg=(bf16*)(shm+LDS_OST)+wid*2048;
    #pragma unroll
    for(int r=0;r<16;++r){const int orow=crow(r,hi);
      #pragma unroll
      for(int d0=0;d0<2;++d0)stg[orow*64+d0*32+r32]=__float2bfloat16(o[d0][r]*rli[r]);}
    asm volatile("s_waitcnt lgkmcnt(0)":::"memory");
    #pragma unroll
    for(int i=0;i<4;++i){const int row=i*8+(lane>>3),ch=lane&7; const u32x4 v=*(const u32x4*)(stg+row*64+ch*8); ATTN_STORE16(Ow+(long)row*POUT+ch*8,v);} }
  asm volatile("s_waitcnt lgkmcnt(0)\n\ts_barrier":::"memory");
  #undef DMA_K
  #undef DMA_V
  #undef CMASK
  #undef PMASK
  #undef START
  #undef RESC
  #undef ROT
}
constexpr int ATTN_LDS_BYTES=LDS_BYTES;
#undef SBAR
#undef WAIT_BAR
}

typedef float f32x16 __attribute__((ext_vector_type(16)));
__device__ __forceinline__ void sb_unit(const Args& a, int bh, int qb) {
    int tid = threadIdx.x; asm volatile("" : "+v"(tid));
    const int lane = tid & 63, wid = tid >> 6, r32 = lane & 31, hh = lane >> 5;
    const int b = bh >> 2, h = bh & 3;
    unsigned char* ws = a.ws;
    const bf16* PM = (const bf16*)(ws + WS_PM); bf16* PMo = (bf16*)(ws + WS_PM);
    const size_t rowb = (size_t)b * SEQ;
    const int t0 = qb * 256 + wid * 32, t = t0 + r32;
    const bf16* Kb = PM + rowb * PMW + C_SB + 256 + h * 64; const bf16* Vb = PM + rowb * PMW + C_SB + 512 + h * 64;
    bf16x8 qf[4];
    { const bf16* qp = PM + (rowb + t) * PMW + C_SB + h * 64 + 8 * hh;
#pragma unroll
        for (int ks = 0; ks < 4; ++ks) { const u32x4 x = *(const u32x4*)(qp + 16 * ks); u32x4 y;
            y.x = cvt_pk_bf16(bflo(x.x) * 0.125f, bfhi(x.x) * 0.125f); y.y = cvt_pk_bf16(bflo(x.y) * 0.125f, bfhi(x.y) * 0.125f);
            y.z = cvt_pk_bf16(bflo(x.z) * 0.125f, bfhi(x.z) * 0.125f); y.w = cvt_pk_bf16(bflo(x.w) * 0.125f, bfhi(x.w) * 0.125f); qf[ks] = __builtin_bit_cast(bf16x8, y); } }
    f32x16 o0, o1;
#pragma unroll
    for (int i = 0; i < 16; ++i) { o0[i] = 0.f; o1[i] = 0.f; }
    float carry = 0.f;
    bf16x8 kn[4]; unsigned vn[2][2][8];
#define SB_LOAD(kt_) do { const int s0_ = (kt_) * 32; const bf16* kp_ = Kb + (size_t)(s0_ + r32) * PMW + 8 * hh; \
        _Pragma("unroll") for (int ks_ = 0; ks_ < 4; ++ks_) kn[ks_] = *(const bf16x8*)(kp_ + 16 * ks_); \
        const bf16* vp_ = Vb + (size_t)(s0_ + 4 * hh) * PMW + r32; \
        _Pragma("unroll") for (int s_ = 0; s_ < 2; ++s_) _Pragma("unroll") for (int j_ = 0; j_ < 8; ++j_) { const int k0_ = 16 * s_ + 8 * (j_ >> 2) + (j_ & 3); vn[0][s_][j_] = vp_[(size_t)k0_ * PMW]; vn[1][s_][j_] = vp_[(size_t)k0_ * PMW + 32]; } } while (0)
    SB_LOAD(t0 >> 5);
    for (int kt = t0 >> 5; kt >= 0; --kt) {
        const int s0 = kt * 32;
        f32x16 z;
#pragma unroll
        for (int i = 0; i < 16; ++i) z[i] = 0.f;
        bf16x8 kf[4];
#pragma unroll
        for (int ks = 0; ks < 4; ++ks) kf[ks] = kn[ks];
        unsigned vw[2][2][4];
#pragma unroll
        for (int nt = 0; nt < 2; ++nt)
#pragma unroll
            for (int s_ = 0; s_ < 2; ++s_)
#pragma unroll
                for (int jp = 0; jp < 4; ++jp) vw[nt][s_][jp] = vn[nt][s_][2 * jp] | (vn[nt][s_][2 * jp + 1] << 16);
        if (kt > 0) SB_LOAD(kt - 1);
#pragma unroll
        for (int ks = 0; ks < 4; ++ks) z = __builtin_amdgcn_mfma_f32_32x32x16_bf16(kf[ks], qf[ks], z, 0, 0, 0);
        float ls[16], ln[16];
#pragma unroll
        for (int i = 0; i < 16; ++i) { const int key = s0 + (i & 3) + 8 * (i >> 2) + 4 * hh; const bool ok = key < t; const float zz = z[i];
            const float l1p = __logf(1.0f + __expf(-fabsf(zz)));
            ls[i] = ok ? (fminf(zz, 0.f) - l1p) : -INFINITY; ln[i] = ok ? (fminf(-zz, 0.f) - l1p) : 0.f; }
        float gs[4], pg[4];
#pragma unroll
        for (int m = 0; m < 4; ++m) { gs[m] = (ln[4 * m] + ln[4 * m + 1]) + (ln[4 * m + 2] + ln[4 * m + 3]); pg[m] = __shfl_xor(gs[m], 32); }
        float T[4]; T[3] = 0.f; T[2] = gs[3] + pg[3]; T[1] = T[2] + (gs[2] + pg[2]); T[0] = T[1] + (gs[1] + pg[1]);
        const float total = T[0] + (gs[0] + pg[0]);
        float att[16];
#pragma unroll
        for (int m = 0; m < 4; ++m) { float cb = carry + T[m] + (hh == 0 ? pg[m] : 0.f);
#pragma unroll
            for (int e = 3; e >= 0; --e) { att[4 * m + e] = __expf(ls[4 * m + e] + cb); cb += ln[4 * m + e]; } }
        carry += total;
#pragma unroll
        for (int s_ = 0; s_ < 2; ++s_) { u32x4 aw; aw.x = cvt_pk_bf16(att[8 * s_], att[8 * s_ + 1]); aw.y = cvt_pk_bf16(att[8 * s_ + 2], att[8 * s_ + 3]); aw.z = cvt_pk_bf16(att[8 * s_ + 4], att[8 * s_ + 5]); aw.w = cvt_pk_bf16(att[8 * s_ + 6], att[8 * s_ + 7]);
            const bf16x8 af = __builtin_bit_cast(bf16x8, aw);
            o0 = __builtin_amdgcn_mfma_f32_32x32x16_bf16(af, __builtin_bit_cast(bf16x8, (u32x4){vw[0][s_][0], vw[0][s_][1], vw[0][s_][2], vw[0][s_][3]}), o0, 0, 0, 0);
            o1 = __builtin_amdgcn_mfma_f32_32x32x16_bf16(af, __builtin_bit_cast(bf16x8, (u32x4){vw[1][s_][0], vw[1][s_][1], vw[1][s_][2], vw[1][s_][3]}), o1, 0, 0, 0); }
        if (__all(carry < -110.f)) break;
    }
#undef SB_LOAD
    bf16* yp = PMo + (rowb + t0 + 4 * hh) * PMW + C_SB + h * 64 + r32;
#pragma unroll
    for (int i = 0; i < 16; ++i) { const size_t ro = (size_t)((i & 3) + 8 * (i >> 2)) * PMW; yp[ro] = (bf16)f2bf(o0[i]); yp[ro + 32] = (bf16)f2bf(o1[i]); }
}

__device__ __forceinline__ void phase_e(const Args& a, int layer_rep, LAS unsigned char* lds, volatile LAS unsigned* MISC, int vb) {
    const int layer = layer_rep & 1;
    LAS float* L = (LAS float*)lds;
    unsigned* work = (unsigned*)(a.ws + WS_CTL) + CW_WORK + 64 * layer_rep;
    for (int c = vb; c < 64; c += (int)gridDim.x) { if (c < 32) rwkv_chain(a, layer, c, lds); else hgrn_chain(a, layer, c - 32, (LAS unsigned char*)L); }
    for (;;) {
        __syncthreads();
        if (threadIdx.x == 0) MISC[0] = __hip_atomic_fetch_add(work, 1u, __ATOMIC_RELAXED, __HIP_MEMORY_SCOPE_AGENT);
        __syncthreads();
        const unsigned u = (unsigned)__builtin_amdgcn_readfirstlane((int)MISC[0]);
        if (u >= 1024u + NWU) break;
        if (u < NWU) { int tl = threadIdx.x; asm volatile("" : "+v"(tl)); const int wv = tl >> 6, ln = tl & 63; LAS float* scr = (LAS float*)(lds + wv * 16384);
#pragma unroll 1
            for (int it = (int)u * 32 + wv; it < (int)(u + 1u) * 32; it += 8) late_weight_item(a, layer, it, scr, ln); }
        else if (u < NWU + 512u) { const unsigned v = u - NWU; const int bh = (int)(v & 31u), qb = 15 - (int)(v >> 5); const moba_body::bf16* pm = (const moba_body::bf16*)(a.ws + WS_PM);
            moba_body::attn_unit<8>(bh >> 2, bh & 3, qb, pm + C_MB, pm + C_MB + 256, pm + C_MB + 512, (moba_body::bf16*)(a.ws + WS_PM) + C_MB, (const float*)(a.ws + WS_KMP), (char*)lds); }
        else { const unsigned v = u - NWU - 512u; sb_unit(a, (int)(v & 31u), 15 - (int)(v >> 5)); }
    }
}

#if MK_ONE_LAUNCH
#define SEAM() xcd_barrier(bar)
#else
#define SEAM() do {} while (0)
#endif
#define IN(k) (lo <= (k) && (k) < hi)
#define BOTH(k) (IN(k) && IN((k) + 1))
template <int LAYER>
__device__ __forceinline__ void layer_phases(const Args& args, LAS unsigned char* lds, volatile LAS unsigned* MISC, const XcdBarrier& bar, int lo, int hi, int vb0, int G0) {
    constexpr int layer = LAYER;
    unsigned char* ws = args.ws;
    float* xres = args.out;
        const int pb = layer * PPL;
        const float* xin = layer ? (const float*)args.out : args.in[I_X];
        const char* Wb = (const char*)(ws + WS_W);
        if (IN(pb + 0)) { const int vb = opaque_s(vb0), G = opaque_s(G0); for (int rep = 0; rep < (REPEAT_PH == 0 ? 2 : 1); ++rep) { phase_a(args, layer, xin, lds, vb, G); if (rep == 0 && REPEAT_PH == 0) SEAM(); } if (BOTH(pb + 0)) SEAM(); }
        if (IN(pb + 1)) { const int vb = opaque_s(vb0), G = opaque_s(G0);
            pg8::PlainOrder S{LAYER == 0 ? (const char*)(ws + WS_H) : (const char*)xres, Wb + W_IN, 2048u, 2048u, 16, 128, 14, G, vb};
            pg8::EpiBf16S E{(bf16*)(ws + WS_PM), PMW, (const float*)(ws + WS_RSQ1), lds};
            for (int rep = 0; rep < (REPEAT_PH == 1 ? 2 : 1); ++rep) { pg8::gemm_phase<pg8::EpiBf16S, pg8::PlainOrder, true>(lds, S, E); if (rep == 0 && REPEAT_PH == 1) SEAM(); }
            if (BOTH(pb + 1)) SEAM();
        }
        if (IN(pb + 2)) { const int vb = opaque_s(vb0), G = opaque_s(G0); for (int rep = 0; rep < (REPEAT_PH == 2 ? 2 : 1); ++rep) { phase_c(args, layer, lds, vb, G); if (rep == 0 && REPEAT_PH == 2) SEAM(); } if (BOTH(pb + 2)) SEAM(); }
        if (IN(pb + 3)) { const int vb = opaque_s(vb0), G = opaque_s(G0);
            pg8::LoraOrder S{(const char*)(ws + WS_LA), Wb + W_L, Wb + W_V, layer ? 4 : 3, G, vb};
            pg8::EpiBf16 E{(bf16*)(ws + WS_LO), 1024};
            for (int rep = 0; rep < (REPEAT_PH == 3 ? 2 : 1); ++rep) { pg8::gemm_phase<pg8::EpiBf16, pg8::LoraOrder, true>(lds, S, E); if (rep == 0 && REPEAT_PH == 3) SEAM(); }
            if (BOTH(pb + 3)) SEAM();
        }
        if (IN(pb + 4)) { const int vb = opaque_s(vb0), G = opaque_s(G0); for (int rep = 0; rep < (REPEAT_PH == 4 ? 2 : 1); ++rep) { phase_d2(args, layer, vb, G); if (rep == 0 && REPEAT_PH == 4) SEAM(); } if (BOTH(pb + 4)) SEAM(); }
        if (IN(pb + 5)) { const int vb = opaque_s(vb0); for (int rep = 0; rep < (REPEAT_PH == 5 ? 2 : 1); ++rep) { phase_e(args, layer + 2 * rep, lds, MISC, vb); if (rep == 0 && REPEAT_PH == 5) SEAM(); } if (BOTH(pb + 5)) SEAM(); }
        if (IN(pb + 6)) { const int vb = opaque_s(vb0), G = opaque_s(G0); for (int rep = 0; rep < (REPEAT_PH == 6 ? 2 : 1); ++rep) { phase_e2(args, layer, vb, G); if (rep == 0 && REPEAT_PH == 6) SEAM(); } if (BOTH(pb + 6)) SEAM(); }
        if (IN(pb + 7)) { const int vb = opaque_s(vb0), G = opaque_s(G0);
            pg8::MergeOrder S{LAYER == 0 ? (const char*)(ws + WS_H) : (const char*)xres, (const char*)(ws + WS_PM), Wb + W_IN + (size_t)PMW * 2048, Wb + W_B, G, vb};
            pg8::EpiMerge E{(u32x4*)(ws + WS_LA) + (size_t)vb * 8192, (bf16*)(ws + WS_LO), (const float*)(ws + WS_RSQ1), lds};
            for (int rep = 0; rep < (REPEAT_PH == 7 ? 2 : 1); ++rep) { pg8::gemm_phase<pg8::EpiMerge, pg8::MergeOrder, true>(lds, S, E); if (rep == 0 && REPEAT_PH == 7) SEAM(); }
            if (BOTH(pb + 7)) SEAM();
        }
        if (IN(pb + 8)) { const int vb = opaque_s(vb0), G = opaque_s(G0);
            pg8::PlainOrder S{(const char*)(ws + WS_LO), Wb + W_O, 2048u, 2048u, 16, 128, 4, G, vb};
            pg8::EpiResNorm<true, LAYER != 0, true> E{(const void*)xin, LAYER == 0 ? (void*)xres : (void*)(ws + WS_H), (float*)(ws + WS_RSQ2), lds};
            pg8::gemm_phase<pg8::EpiResNorm<true, LAYER != 0, true>, pg8::PlainOrder, true>(lds, S, E);
            if (BOTH(pb + 8)) SEAM();
        }
        if (IN(pb + 10)) { const int vb = opaque_s(vb0), G = opaque_s(G0);
            pg8::PlainOrder S{LAYER == 0 ? (const char*)xres : (const char*)(ws + WS_H), Wb + W_GU, 2048u, 2048u, 16, 128, 22, G, vb};
            pg8::EpiSwiGLU E{(bf16*)(ws + WS_PM), (const float*)(ws + WS_RSQ2), lds};
            for (int rep = 0; rep < (REPEAT_PH == 10 ? 2 : 1); ++rep) { pg8::gemm_phase<pg8::EpiSwiGLU, pg8::PlainOrder, true>(lds, S, E); if (rep == 0 && REPEAT_PH == 10) SEAM(); }
            if (BOTH(pb + 10)) SEAM();
        }
        if (IN(pb + 11)) { const int vb = opaque_s(vb0), G = opaque_s(G0);
            pg8::PlainOrder S{(const char*)(ws + WS_PM), Wb + W_D, (unsigned)(DFF * 2), (unsigned)(DFF * 2), DFF / 64, 128, 4, G, vb};
            if constexpr (LAYER == 0) { pg8::EpiResNorm<true, true, true> E{(const void*)xres, (void*)xres, (float*)(ws + WS_RSQ1), lds};
                pg8::gemm_phase<pg8::EpiResNorm<true, true, true>, pg8::PlainOrder, true>(lds, S, E); }
            else { pg8::EpiResFinal E{(const bf16*)(ws + WS_H), xres, args.in[I_FG], (float*)(ws + WS_RSQ1), (unsigned*)(ws + WS_CTL) + CW_XCH, lds};
                pg8::gemm_phase<pg8::EpiResFinal, pg8::PlainOrder, true>(lds, S, E); }
            if (BOTH(pb + 11)) SEAM();
        }
}

__global__ void __launch_bounds__(512, 2) skel_fwd(Args args) {
    extern __shared__ __attribute__((aligned(16))) unsigned char lds_raw[];
    LAS unsigned char* lds = (LAS unsigned char*)lds_raw;
    volatile LAS unsigned* MISC = (volatile LAS unsigned*)(lds + MISC_OFF);
    const int tid = threadIdx.x;
    const int G0 = gridDim.x, vb0 = blockIdx.x;
    unsigned char* ws = args.ws;
    unsigned* ctl = (unsigned*)(ws + WS_CTL);
    for (int u = tid; u < (LDS_BYTES - LDSCTL_OFF) / 4; u += 512) ((LAS unsigned*)(lds + LDSCTL_OFF))[u] = 0u;
    __syncthreads();
#if MK_ONE_LAUNCH
    XcdBarrier bar = xcd_barrier_post(ctl + CW_BAR, MISC + 8);
#else
    XcdBarrier bar; bar.bar = ctl + CW_BAR; bar.x = 0; bar.st = MISC + 8;
#endif
    const int lo = args.ph_lo, hi = args.ph_hi;
    float* xres = args.out;
    layer_phases<0>(args, lds, MISC, bar, lo, hi, vb0, G0);
    layer_phases<1>(args, lds, MISC, bar, lo, hi, vb0, G0);
#undef IN
#undef BOTH
#undef SEAM
}

extern "C" void kernel_launch(void* const* d_in, const int* in_sizes, int n_in, void* d_out, int out_size, void* d_ws, size_t ws_size, hipStream_t stream) {
    static int grid = 0;
    if (grid == 0) {
        if (n_in != 26 || in_sizes[0] != M * D || out_size != M * D || ws_size < WS_END) { fprintf(stderr, "kernel_launch: unexpected shapes (n_in %d, in0 %d, out %d, ws %zu); nothing launched\n", n_in, n_in > 0 ? in_sizes[0] : -1, out_size, ws_size); grid = -1; return; }
        int dev = 0, cus = 0, per_cu = 0;
        if (hipGetDevice(&dev) != hipSuccess || hipDeviceGetAttribute(&cus, hipDeviceAttributeMultiprocessorCount, dev) != hipSuccess) { grid = -1; return; }
        if (hipFuncSetAttribute((const void*)skel_fwd, hipFuncAttributeMaxDynamicSharedMemorySize, LDS_BYTES) != hipSuccess) { fprintf(stderr, "kernel_launch: hipFuncSetAttribute failed\n"); grid = -1; return; }
        if (hipOccupancyMaxActiveBlocksPerMultiprocessor(&per_cu, (const void*)skel_fwd, 512, LDS_BYTES) != hipSuccess || per_cu < 1) fprintf(stderr, "kernel_launch: occupancy query reports %d\n", per_cu);
        (void)hipGetLastError();
        grid = cus;
    }
    if (grid < 0) return;
    if (hipMemsetAsync((char*)d_ws + WS_CTL, 0, CTL_ZERO_BYTES, stream) != hipSuccess) return;
    Args a{};
    for (int i = 0; i < 26; ++i) a.in[i] = (const float*)d_in[i];
    a.out = (float*)d_out; a.ws = (unsigned char*)d_ws;
#if MK_ONE_LAUNCH
    a.ph_lo = 0; a.ph_hi = NPH;
    hipLaunchKernelGGL(skel_fwd, dim3(grid), dim3(512), LDS_BYTES, stream, a);
#else
    for (int p = 0; p < NPH; ++p) { a.ph_lo = p; a.ph_hi = p + 1; hipLaunchKernelGGL(skel_fwd, dim3(grid), dim3(512), LDS_BYTES, stream, a); }
#endif
}
```

```cpp
#include <hip/hip_runtime.h>
#include <cstdio>
#include <cstdint>

#ifndef REPEAT_PH
#define REPEAT_PH -1
#endif
#ifndef MK_ONE_LAUNCH
#define MK_ONE_LAUNCH 1
#endif

#define LAS __attribute__((address_space(3)))
#define GAS __attribute__((address_space(1)))
typedef unsigned short bf16;
typedef short bf16x8 __attribute__((ext_vector_type(8)));
typedef float f32x4 __attribute__((ext_vector_type(4)));
typedef float f32x2 __attribute__((ext_vector_type(2)));
typedef unsigned u32x4 __attribute__((ext_vector_type(4)));
typedef unsigned u32x2 __attribute__((ext_vector_type(2)));

constexpr int D = 1024, NBATCH = 8, SEQ = 4096, M = NBATCH * SEQ, DFF = 2816, NH = 4, HD = 64, MW = 256;
constexpr int PMW = 3584;
constexpr int C_SB = 0, C_RW = 768, C_MB = 1792, C_HG = 2560;
constexpr int PPL = 12, NPH = 2 * PPL;

constexpr size_t MiB = 1u << 20;
constexpr size_t WS_CTL = 0, CTL_ZERO_BYTES = 1 * MiB;
constexpr size_t WS_ROPE = 1 * MiB;
constexpr size_t WS_KMP = 1 * MiB + 512 * 1024;
constexpr size_t WS_BON = 2 * MiB;
constexpr size_t WS_RSQ1 = 2 * MiB + 512 * 1024;
constexpr size_t WS_RSQ2 = 3 * MiB;
constexpr size_t WS_W = 4 * MiB;
constexpr size_t W_IN = 0, W_B = 15728640, W_O = W_B + 2097152, W_GU = W_O + 2097152, W_D = W_GU + 11534336, W_L = W_D + 5767168, W_V = W_L + 393216, W_END = W_V + 131072;
static_assert(W_END == 36 * MiB, "weights");
constexpr size_t WS_H = 40 * MiB;
constexpr size_t WS_PM = 104 * MiB;
constexpr size_t WS_LA = 328 * MiB;
constexpr size_t RS_ENTRY = 13056;
constexpr size_t WS_RS = 328 * MiB;
constexpr size_t WS_XF = 328 * MiB;
constexpr size_t WS_LO = 432 * MiB;
constexpr size_t WS_VF = 496 * MiB;
constexpr size_t WS_END = 512 * MiB;
static_assert(WS_RS + 8192 * RS_ENTRY <= WS_LO, "rwkv chunk stream");
constexpr int CW_TMO = 0;
constexpr int CW_BAR = 4096;
constexpr int CW_XCH = 32768;
constexpr int CW_WORK = 16384;

constexpr int RING_BYTES = 131072;
constexpr int LDSCTL_OFF = RING_BYTES, MISC_OFF = LDSCTL_OFF + 320;
constexpr int LDS_XP = RING_BYTES + 1024, LDS_RSL = LDS_XP + 4096;
constexpr int LDS_BYTES = 147456;

__device__ __forceinline__ unsigned f2bf(float f) { unsigned u = __builtin_bit_cast(unsigned, f); return (u + 0x7fffu + ((u >> 16) & 1u)) >> 16; }
__device__ __forceinline__ unsigned pk2(float lo, float hi) { return f2bf(lo) | (f2bf(hi) << 16); }
__device__ __forceinline__ float bf2f(unsigned short b) { return __builtin_bit_cast(float, ((unsigned)b) << 16); }
__device__ __forceinline__ float bflo(unsigned w) { return __builtin_bit_cast(float, w << 16); }
__device__ __forceinline__ float bfhi(unsigned w) { return __builtin_bit_cast(float, w & 0xffff0000u); }
typedef __bf16 bf16x2_t __attribute__((ext_vector_type(2)));
__device__ __forceinline__ unsigned cvt_pk_bf16(float lo, float hi) { f32x2 v = {lo, hi}; bf16x2_t b = __builtin_convertvector(v, bf16x2_t); return __builtin_bit_cast(unsigned, b); }
__device__ __forceinline__ float wave_sum(float v) {
#pragma unroll
    for (int o = 1; o < 64; o <<= 1) v += __shfl_xor(v, o);
    return v;
}
__device__ __forceinline__ float sigmoidf_(float x) { return __builtin_amdgcn_rcpf(1.0f + __expf(-x)); }
#define LDS_WAIT() asm volatile("s_waitcnt lgkmcnt(0)" ::: "memory")
#define LBAR() do { asm volatile("s_waitcnt lgkmcnt(0)" ::: "memory"); __builtin_amdgcn_s_barrier(); asm volatile("" ::: "memory"); } while (0)
__device__ __forceinline__ f32x4 ld4bf(const bf16* p) { const u32x2 w = *(const u32x2*)p; return (f32x4){bflo(w.x), bfhi(w.x), bflo(w.y), bfhi(w.y)}; }
__device__ __forceinline__ float dpp_sum16(float x);
__device__ __forceinline__ int opaque_s(int v) { asm volatile("" : "+s"(v)); return v; }

__device__ __forceinline__ void st4bf(bf16* p, f32x4 v) { u32x2 w; w.x = cvt_pk_bf16(v.x, v.y); w.y = cvt_pk_bf16(v.z, v.w); *(u32x2*)p = w; }
__device__ __forceinline__ float dpp_sum16(float x) {
    x += __builtin_bit_cast(float, __builtin_amdgcn_update_dpp(0, __builtin_bit_cast(int, x), 0xB1, 0xF, 0xF, true));
    x += __builtin_bit_cast(float, __builtin_amdgcn_update_dpp(0, __builtin_bit_cast(int, x), 0x4E, 0xF, 0xF, true));
    x += __builtin_bit_cast(float, __builtin_amdgcn_update_dpp(0, __builtin_bit_cast(int, x), 0x141, 0xF, 0xF, true));
    x += __builtin_bit_cast(float, __builtin_amdgcn_update_dpp(0, __builtin_bit_cast(int, x), 0x140, 0xF, 0xF, true));
    return x;
}
__device__ __forceinline__ float dpp_xor2(float x) { int r; asm volatile("s_nop 1\n\tv_mov_b32_dpp %0, %1 quad_perm:[2,3,0,1] row_mask:0xf bank_mask:0xf\n\ts_nop 0" : "=&v"(r) : "v"(__builtin_bit_cast(int, x))); return __builtin_bit_cast(float, r); }
__device__ __forceinline__ float softplusf_(float x) { return fmaxf(x, 0.f) + __logf(1.0f + __expf(-fabsf(x))); }
#define XB_TMO      128
#define XB_XCNT(j)  (256  + 64 * (j))
#define XB_XSUB(j)  (1280 + 64 * (j))
#define XB_XGEN(j)  (2304 + 64 * (j))
#define XB_TOP      3328
#define XB_TOPGEN   3392
#define XCD_BAR_WORDS 3456
#define XB_SPIN_CAP (1u << 22)
__device__ __forceinline__ unsigned xb_ld(unsigned* p)              { return __hip_atomic_load(p, __ATOMIC_RELAXED, __HIP_MEMORY_SCOPE_AGENT); }
__device__ __forceinline__ unsigned xb_add(unsigned* p, unsigned v) { return __hip_atomic_fetch_add(p, v, __ATOMIC_RELAXED, __HIP_MEMORY_SCOPE_AGENT); }
__device__ __forceinline__ unsigned xb_xcc_id() { return (unsigned)__builtin_amdgcn_s_getreg((3 << 11) | 20) & 0xFu; }
#define XB_SPIN(cond, bar) do { unsigned _sp = 0; while (cond) { __builtin_amdgcn_s_sleep(1); \
    if ((++_sp & 255u) == 0u) { if (xb_ld(&(bar)[XB_TMO])) break; if (_sp > XB_SPIN_CAP) { atomicAdd(&(bar)[XB_TMO], 1u); break; } } } } while (0)
struct XcdBarrier { unsigned* bar; unsigned x; volatile LAS unsigned* st; };
__device__ __forceinline__ XcdBarrier xcd_barrier_post(unsigned* bar, volatile LAS unsigned* st) {
    XcdBarrier b; b.bar = bar; b.x = xb_xcc_id(); b.st = st;
    if (threadIdx.x == 0) (void)xb_add(&bar[XB_XCNT(b.x)], 1u);
    return b;
}
__device__ __forceinline__ void xcd_barrier_complete(unsigned* bar, unsigned x, unsigned& nloc, unsigned& nx) {
    const unsigned G = gridDim.x * gridDim.y * gridDim.z;
    unsigned sum, cnt, mine, sp = 0u;
    for (;;) {
        sum = 0u; cnt = 0u; mine = 0u;
#pragma unroll
        for (unsigned j = 0; j < 16; ++j) { const unsigned c = xb_ld(&bar[XB_XCNT(j)]); sum += c; cnt += (c > 0u) ? 1u : 0u; mine = (j == x) ? c : mine; }
        if (sum == G) break;
        __builtin_amdgcn_s_sleep(1);
        if ((++sp & 255u) == 0u) { if (xb_ld(&bar[XB_TMO])) break; if (sp > XB_SPIN_CAP) { atomicAdd(&bar[XB_TMO], 1u); break; } }
    }
    nloc = mine > 0u ? mine : 1u; nx = cnt > 0u ? cnt : 1u;
}
__device__ __forceinline__ void xcd_barrier(const XcdBarrier& b) {
    asm volatile("s_waitcnt vmcnt(0)" ::: "memory");
    __syncthreads();
    if (threadIdx.x == 0) {
        unsigned* bar = b.bar;
        __builtin_amdgcn_s_waitcnt(0);
        unsigned nloc = b.st[0], nx = b.st[1];
        if (nloc == 0u) { xcd_barrier_complete(bar, b.x, nloc, nx); b.st[0] = nloc; b.st[1] = nx; }
        const unsigned old = xb_add(&bar[XB_XSUB(b.x)], 1u);
        const unsigned gen = old / nloc;
        if (old + 1u == (gen + 1u) * nloc) {
            __builtin_amdgcn_fence(__ATOMIC_RELEASE, "agent");
            asm volatile("s_waitcnt vmcnt(0)" ::: "memory");
            const unsigned og = xb_add(&bar[XB_TOP], 1u);
            const unsigned tg = og / nx;
            if (og + 1u == (tg + 1u) * nx) xb_add(&bar[XB_TOPGEN], 1u);
            else XB_SPIN(xb_ld(&bar[XB_TOPGEN]) == tg, bar);
            __builtin_amdgcn_fence(__ATOMIC_ACQUIRE, "agent");
            xb_add(&bar[XB_XGEN(b.x)], 1u);
            asm volatile("s_waitcnt vmcnt(0)" ::: "memory");
        } else {
            XB_SPIN(xb_ld(&bar[XB_XGEN(b.x)]) == gen, bar);
            __builtin_amdgcn_fence(__ATOMIC_ACQUIRE, "agent");
            asm volatile("s_waitcnt vmcnt(0)" ::: "memory");
        }
    }
    __syncthreads();
}

namespace pg8 {
constexpr int BM = 256, BK = 64, HALF = 128, HTB = HALF * BK * 2, STAGE_BYTES = 8 * HTB, NXCD = 8, WGM = 8;
__host__ __device__ __forceinline__ int lds_byte(int r, int c) { const int st = (r >> 4) * 2 + (c >> 5), rr = r & 15, cc = c & 31, ob = rr * 64 + cc * 2; return st * 1024 + (ob ^ (((ob >> 9) & 1) << 5)); }
__host__ __device__ __forceinline__ void stage_rc(int b, int& R, int& C) { const int st = b / 1024, sb = b % 1024, swz = sb ^ (((sb >> 9) & 1) << 5); R = (st >> 1) * 16 + swz / 64; C = (st & 1) * 32 + (swz % 64) / 2; }
__host__ __device__ __forceinline__ int perm32(int rho) { const int n = rho >> 4, i = rho & 15; return 8 * (i >> 2) + 4 * n + (i & 3); }

struct GU { const char* a; const char* b; unsigned lda2, ldb2; int nt, pm, pn, sub; };

__device__ __forceinline__ void tile_of(int L, int nM, int nN, int& pm, int& pn) {
    const int nwg = nM * nN;
    int wgid = L; { const int q = nwg / NXCD, r = nwg % NXCD, xcd = wgid % NXCD, off = wgid / NXCD; wgid = (xcd < r ? xcd * (q + 1) : r * (q + 1) + (xcd - r) * q) + off; }
    const int nig = WGM * nN, gid = wgid / nig, fm = gid * WGM, gsz = (nM - fm) < WGM ? (nM - fm) : WGM;
    pm = fm + ((wgid % nig) % gsz); pn = (wgid % nig) / gsz;
}

template <class Epi, class Sched, bool ALIGN_EPI>
__device__ __forceinline__ void gemm_phase(LAS unsigned char* lds, const Sched& S, const Epi& E) {
    int tid = threadIdx.x; asm volatile("" : "+v"(tid));
    const int wid = __builtin_amdgcn_readfirstlane(tid >> 6), lane = tid & 63, wr = wid >> 2, wc = wid & 3, fr = lane & 15, fq = lane >> 4;
    unsigned Rr, Rb, C2;
    { int R, C; stage_rc(tid * 16, R, C); Rr = (unsigned)R; Rb = (unsigned)(Epi::PERM ? ((R & ~31) + perm32(R & 31)) : R); C2 = (unsigned)C * 2u; }
    const size_t kstep = (size_t)(BK * 2);
    const unsigned ldsw = (unsigned)wid * 1024u;
    const int aoff = lds_byte(wr * 64 + fr, fq * 8), boff = lds_byte(wc * 32 + fr, fq * 8);
#define PG8_SA(b, h) (((b) * 2 + (h)) * HTB)
#define PG8_SB(b, h) ((4 + (b) * 2 + (h)) * HTB)
#define PG8_STAGE(bufoff, gbase, R, ld) do { const unsigned _v0 = (R) * (ld) + C2; \
        __builtin_amdgcn_global_load_lds((const unsigned*)((const char*)(gbase) + _v0), (LAS unsigned*)(lds + (bufoff) + ldsw), 16, 0, 0); \
        __builtin_amdgcn_global_load_lds((const unsigned*)((const char*)(gbase) + _v0 + 64u * (ld)), (LAS unsigned*)(lds + (bufoff) + ldsw + 8192), 16, 0, 0); } while (0)
#define PG8_LDA(dst, b, h) do { _Pragma("unroll") for (int m = 0; m < 4; ++m) _Pragma("unroll") for (int k = 0; k < 2; ++k) dst[m][k] = *(const LAS bf16x8*)(lds + PG8_SA(b, h) + aoff + m * 2048 + k * 1024); } while (0)
#define PG8_LDB(dst, b, h) do { _Pragma("unroll") for (int n = 0; n < 2; ++n) _Pragma("unroll") for (int k = 0; k < 2; ++k) dst[n][k] = *(const LAS bf16x8*)(lds + PG8_SB(b, h) + boff + n * 2048 + k * 1024); } while (0)
#define PG8_MMA(ai, bj, At, Bt) do { __builtin_amdgcn_s_setprio(1); _Pragma("unroll") for (int m = 0; m < 4; ++m) _Pragma("unroll") for (int n = 0; n < 2; ++n) _Pragma("unroll") for (int k = 0; k < 2; ++k) \
        acc[ai][bj][m][n] = __builtin_amdgcn_mfma_f32_16x16x32_bf16(Bt[n][k], At[m][k], acc[ai][bj][m][n], 0, 0, 0); __builtin_amdgcn_s_setprio(0); } while (0)
#define PG8_WAIT_V(n) asm volatile("s_waitcnt vmcnt(" #n ")" ::: "memory")
#define PG8_WAIT_E() asm volatile("s_waitcnt vmcnt(%0)" :: "n"(8 + Epi::EOPS) : "memory")
#define PG8_PAIR(W1, W2, a1, a2, b2, a3, b3, xldA, xldB) do { \
              \
            PG8_LDB(B0, 0, 0); PG8_LDB(B1, 0, 1); PG8_SCHED; PG8_LDA(At, 0, 0); PG8_STAGE(PG8_SA(1, 1), (a1) + (size_t)HALF * ldA, Rr, ldA); \
            W1; PG8_WAIT_L(0); PG8_BAR; PG8_MMA(0, 0, At, B0); PG8_MMA(0, 1, At, B1); PG8_BAR; PG8_SCHED; \
              \
            PG8_LDA(At, 0, 1); PG8_STAGE(PG8_SB(0, 0), (b2), Rb, (xldB)); PG8_STAGE(PG8_SB(0, 1), (b2) + (size_t)HALF * (xldB), Rb, (xldB)); PG8_STAGE(PG8_SA(0, 0), (a2), Rr, (xldA)); \
            W2; PG8_WAIT_L(0); PG8_BAR; PG8_MMA(1, 0, At, B0); PG8_MMA(1, 1, At, B1); PG8_BAR; PG8_SCHED; \
              \
            PG8_LDB(B0, 1, 0); PG8_LDB(B1, 1, 1); PG8_SCHED; PG8_LDA(At, 1, 0); PG8_STAGE(PG8_SA(0, 1), (a2) + (size_t)HALF * (xldA), Rr, (xldA)); \
            PG8_WAIT_V(8); PG8_WAIT_L(0); PG8_BAR; PG8_MMA(0, 0, At, B0); PG8_MMA(0, 1, At, B1); PG8_BAR; PG8_SCHED; \
              \
            PG8_LDA(At, 1, 1); PG8_STAGE(PG8_SB(1, 0), (b3), Rb, (xldB)); PG8_STAGE(PG8_SB(1, 1), (b3) + (size_t)HALF * (xldB), Rb, (xldB)); PG8_STAGE(PG8_SA(1, 0), (a3), Rr, (xldA)); \
            PG8_WAIT_V(8); PG8_WAIT_L(0); PG8_BAR; PG8_MMA(1, 0, At, B0); PG8_MMA(1, 1, At, B1); PG8_BAR; PG8_SCHED; } while (0)
#define PG8_WAIT_L(n) asm volatile("s_waitcnt lgkmcnt(" #n ")" ::: "memory")
#define PG8_BAR __builtin_amdgcn_s_barrier()
#define PG8_SCHED __builtin_amdgcn_sched_barrier(0)
    GU cur, nxt; int ui = 0;
    if (!S.next(0, cur)) return;
    f32x4 acc[2][2][4][2];
#pragma unroll
    for (int a = 0; a < 2; ++a)
#pragma unroll
        for (int b = 0; b < 2; ++b)
#pragma unroll
            for (int m = 0; m < 4; ++m)
#pragma unroll
                for (int n = 0; n < 2; ++n) acc[a][b][m][n] = (f32x4){0.f, 0.f, 0.f, 0.f};
    bf16x8 At[4][2], B0[2][2], B1[2][2];
    const char* cA = cur.a; const char* cB = cur.b;
    unsigned ldA = cur.lda2, ldB = cur.ldb2;
    PG8_STAGE(PG8_SB(0, 0), cB, Rb, ldB); PG8_STAGE(PG8_SB(0, 1), cB + (size_t)HALF * ldB, Rb, ldB); PG8_STAGE(PG8_SA(0, 0), cA, Rr, ldA); PG8_STAGE(PG8_SA(0, 1), cA + (size_t)HALF * ldA, Rr, ldA);
    if (wr == 1) PG8_BAR;
    PG8_WAIT_V(2); PG8_BAR;
    PG8_STAGE(PG8_SB(1, 0), cB + kstep, Rb, ldB); PG8_STAGE(PG8_SA(1, 0), cA + kstep, Rr, ldA); PG8_STAGE(PG8_SB(1, 1), cB + (size_t)HALF * ldB + kstep, Rb, ldB);
    PG8_WAIT_V(6); PG8_BAR;
    PG8_PAIR(PG8_WAIT_V(8), PG8_WAIT_V(8), cA + kstep, cA + 2 * kstep, cB + 2 * kstep, cA + 3 * kstep, cB + 3 * kstep, ldA, ldB);
    for (;;) {
        const bool has_next = S.next(ui + 1, nxt);
        const char* nA = has_next ? nxt.a : cA; const char* nB = has_next ? nxt.b : cB;
        const unsigned nldA = has_next ? nxt.lda2 : ldA, nldB = has_next ? nxt.ldb2 : ldB;
        const int nt = cur.nt;
        for (int t = 2; t < nt; t += 2) {
            const bool last = (t == nt - 2);
            const char* a1 = cA + (size_t)(t + 1) * kstep;
            const char* a2 = last ? nA : cA + (size_t)(t + 2) * kstep; const char* b2 = last ? nB : cB + (size_t)(t + 2) * kstep;
            const char* a3 = a2 + kstep; const char* b3 = b2 + kstep;
            const unsigned xldA = last ? nldA : ldA, xldB = last ? nldB : ldB;
            PG8_PAIR(PG8_WAIT_V(8), PG8_WAIT_V(8), a1, a2, b2, a3, b3, xldA, xldB);
        }
        if constexpr (ALIGN_EPI) { if (wr == 0) PG8_BAR; }
        E(acc, cur, wr, wc, fr, fq);
        if (!has_next) break;
#pragma unroll
        for (int a = 0; a < 2; ++a)
#pragma unroll
            for (int b = 0; b < 2; ++b)
#pragma unroll
                for (int m = 0; m < 4; ++m)
#pragma unroll
                    for (int n = 0; n < 2; ++n) acc[a][b][m][n] = (f32x4){0.f, 0.f, 0.f, 0.f};
        cur = nxt; cA = nA; cB = nB; ldA = nldA; ldB = nldB; ++ui;
        if constexpr (ALIGN_EPI) { if (wr == 1) PG8_BAR; }
        PG8_PAIR(PG8_WAIT_E(), PG8_WAIT_E(), cA + kstep, cA + 2 * kstep, cB + 2 * kstep, cA + 3 * kstep, cB + 3 * kstep, ldA, ldB);
    }
    PG8_WAIT_V(0);
    if constexpr (!ALIGN_EPI) { if (wr == 0) PG8_BAR; }
    PG8_BAR;
#undef PG8_SA
#undef PG8_SB
#undef PG8_STAGE
#undef PG8_LDA
#undef PG8_LDB
#undef PG8_MMA
#undef PG8_WAIT_V
#undef PG8_WAIT_E
#undef PG8_PAIR
#undef PG8_WAIT_L
#undef PG8_BAR
#undef PG8_SCHED
}

struct PlainOrder {
    const char* A; const char* B; unsigned lda2, ldb2; int nt, nM, nN, G, c;
    __device__ __forceinline__ bool next(int i, GU& u) const {
        const int L = i * G + c; if (L >= nM * nN) return false;
        int pm, pn; tile_of(L, nM, nN, pm, pn);
        u.pm = pm; u.pn = pn; u.sub = 0; u.nt = nt; u.lda2 = lda2; u.ldb2 = ldb2;
        u.a = A + (size_t)pm * 256 * lda2; u.b = B + (size_t)pn * 256 * ldb2; return true;
    }
};
struct LoraOrder {
    const char* A; const char* Bl; const char* Bv; int nN, G, c;
    __device__ __forceinline__ bool next(int i, GU& u) const {
        const int L = i * G + c; if (L >= 128 * nN) return false;
        int pm, pn; tile_of(L, 128, nN, pm, pn);
        u.pm = pm; u.pn = pn; u.sub = 0; u.nt = 4; u.lda2 = 1024; u.ldb2 = 512;
        u.a = A + (size_t)pm * 256 * 1024 + (pn == 3 ? 512 : 0); u.b = (pn == 3) ? Bv : Bl + (size_t)pn * 256 * 512; return true;
    }
};
struct MergeOrder {
    const char* Hh; const char* Yy; const char* Wg; const char* Wb; int G, c;
    __device__ __forceinline__ bool next(int i, GU& u) const {
        const int ti = i >> 3, sub = i & 7, n = sub >> 1;
        const int L = ti * G + c; if (L >= 512) return false;
        int pm, pn; tile_of(L, 128, 4, pm, pn);
        u.pm = pm; u.pn = pn; u.sub = sub; u.lda2 = 2048;
        if ((sub & 1) == 0) { u.a = Hh + (size_t)pm * 256 * 2048; u.b = Wg + (size_t)(n * 1024 + pn * 256) * 2048; u.ldb2 = 2048; u.nt = 16; }
        else { const int co = n == 0 ? C_SB : (n == 1 ? C_RW : (n == 2 ? C_MB : C_HG)); u.a = Yy + (size_t)pm * 256 * (PMW * 2) + co * 2; u.lda2 = PMW * 2; u.b = Wb + (size_t)(n * 1024 + pn * 256) * 512; u.ldb2 = 512; u.nt = 4; }
        return true;
    }
};

__device__ __forceinline__ void unit_row_scales(const float* rsq, int pm, LAS unsigned char* ldsx, int tid, int wr, int fr, float (&rs)[2][4]) {
    LAS float* RSL = (LAS float*)(ldsx + LDS_RSL);
    if (tid < 256) { const f32x4 q = *(const f32x4*)(rsq + (size_t)(pm * 256 + tid) * 4); RSL[tid] = 1.0f / sqrtf(((q.x + q.y) + (q.z + q.w)) * (1.f / D) + 1e-6f); }
    LBAR();
#pragma unroll
    for (int ai = 0; ai < 2; ++ai)
#pragma unroll
        for (int m = 0; m < 4; ++m) rs[ai][m] = RSL[ai * HALF + wr * 64 + m * 16 + fr];
}
struct EpiBf16S {
    static constexpr int EOPS = 16; static constexpr bool PERM = true;
    bf16* O; int ldc; const float* rsq; LAS unsigned char* ldsx;
    __device__ __forceinline__ void operator()(const f32x4 (&acc)[2][2][4][2], const GU& u, int wr, int wc, int fr, int fq) const {
        int tid = threadIdx.x; asm volatile("" : "+v"(tid));
        fr = tid & 15; fq = (tid >> 4) & 3;
        float rs[2][4]; unit_row_scales(rsq, u.pm, ldsx, tid, wr, fr, rs);
        const int row0 = u.pm * BM + wr * 64 + fr, col0 = u.pn * BM + wc * 32 + 8 * fq;
#pragma unroll
        for (int ai = 0; ai < 2; ++ai)
#pragma unroll
            for (int m = 0; m < 4; ++m) { bf16* rowp = O + (size_t)(row0 + ai * HALF + m * 16) * ldc + col0; const float r_ = rs[ai][m];
#pragma unroll
                for (int bj = 0; bj < 2; ++bj) { const f32x4 v0 = acc[ai][bj][m][0] * r_, v1 = acc[ai][bj][m][1] * r_;
                    u32x4 w; w.x = cvt_pk_bf16(v0[0], v0[1]); w.y = cvt_pk_bf16(v0[2], v0[3]); w.z = cvt_pk_bf16(v1[0], v1[1]); w.w = cvt_pk_bf16(v1[2], v1[3]);
                    *(u32x4*)(rowp + bj * HALF) = w; } }
    }
};
struct EpiBf16 {
    static constexpr int EOPS = 16; static constexpr bool PERM = true;
    bf16* O; int ldc;
    __device__ __forceinline__ void operator()(const f32x4 (&acc)[2][2][4][2], const GU& u, int wr, int wc, int fr, int fq) const {
        { int tid = threadIdx.x; asm volatile("" : "+v"(tid)); fr = tid & 15; fq = (tid >> 4) & 3; }
        const int row0 = u.pm * BM + wr * 64 + fr, col0 = u.pn * BM + wc * 32 + 8 * fq;
#pragma unroll
        for (int ai = 0; ai < 2; ++ai)
#pragma unroll
            for (int m = 0; m < 4; ++m) { bf16* rowp = O + (size_t)(row0 + ai * HALF + m * 16) * ldc + col0;
#pragma unroll
                for (int bj = 0; bj < 2; ++bj) { const f32x4 v0 = acc[ai][bj][m][0], v1 = acc[ai][bj][m][1];
                    u32x4 w; w.x = cvt_pk_bf16(v0[0], v0[1]); w.y = cvt_pk_bf16(v0[2], v0[3]); w.z = cvt_pk_bf16(v1[0], v1[1]); w.w = cvt_pk_bf16(v1[2], v1[3]);
                    *(u32x4*)(rowp + bj * HALF) = w; } }
    }
};
struct EpiSwiGLU {
    static constexpr int EOPS = 8; static constexpr bool PERM = true;
    bf16* O; const float* rsq; LAS unsigned char* ldsx;
    __device__ __forceinline__ void operator()(const f32x4 (&acc)[2][2][4][2], const GU& u, int wr, int wc, int fr, int fq) const {
        int tid = threadIdx.x; asm volatile("" : "+v"(tid));
        fr = tid & 15; fq = (tid >> 4) & 3;
        float rs[2][4]; unit_row_scales(rsq, u.pm, ldsx, tid, wr, fr, rs);
        const int row0 = u.pm * BM + wr * 64 + fr, col0 = u.pn * HALF + wc * 32 + 8 * fq;
#pragma unroll
        for (int ai = 0; ai < 2; ++ai)
#pragma unroll
            for (int m = 0; m < 4; ++m) { bf16* rowp = O + (size_t)(row0 + ai * HALF + m * 16) * DFF + col0;
                float r[8];
#pragma unroll
                for (int n = 0; n < 2; ++n)
#pragma unroll
                    for (int j = 0; j < 4; ++j) { const float g = acc[ai][0][m][n][j] * rs[ai][m], up = acc[ai][1][m][n][j] * rs[ai][m]; r[n * 4 + j] = g * sigmoidf_(g) * up; }
                u32x4 w; w.x = cvt_pk_bf16(r[0], r[1]); w.y = cvt_pk_bf16(r[2], r[3]); w.z = cvt_pk_bf16(r[4], r[5]); w.w = cvt_pk_bf16(r[6], r[7]);
                *(u32x4*)rowp = w; }
    }
};
template <bool EMIT, bool IN16, bool OUT16>
struct EpiResNorm {
    static constexpr int EOPS = 16; static constexpr bool PERM = true;
    const void* base; void* out; float* rsq; LAS unsigned char* ldsx;
    __device__ __forceinline__ void operator()(const f32x4 (&acc)[2][2][4][2], const GU& u, int wr, int wc, int fr, int fq) const {
        int tid = threadIdx.x; asm volatile("" : "+v"(tid));
        fr = tid & 15; fq = (tid >> 4) & 3;
        const int row0 = u.pm * BM + wr * 64 + fr, col0 = u.pn * BM + wc * 32 + 8 * fq;
        LAS float* P = (LAS float*)(ldsx + LDS_XP);
#pragma unroll
        for (int ai = 0; ai < 2; ++ai)
#pragma unroll
            for (int m = 0; m < 4; ++m) { const size_t off = (size_t)(row0 + ai * HALF + m * 16) * D + col0; float sq = 0.f;
                f32x4 bs[2][2];
#pragma unroll
                for (int bj = 0; bj < 2; ++bj) {
                    if constexpr (IN16) { const u32x4 w = *(const u32x4*)((const bf16*)base + off + bj * HALF);
                        bs[bj][0] = (f32x4){bflo(w.x), bfhi(w.x), bflo(w.y), bfhi(w.y)}; bs[bj][1] = (f32x4){bflo(w.z), bfhi(w.z), bflo(w.w), bfhi(w.w)}; }
                    else { bs[bj][0] = *(const f32x4*)((const float*)base + off + bj * HALF); bs[bj][1] = *(const f32x4*)((const float*)base + off + bj * HALF + 4); } }
#pragma unroll
                for (int bj = 0; bj < 2; ++bj) { const f32x4 x0 = bs[bj][0] + acc[ai][bj][m][0], x1 = bs[bj][1] + acc[ai][bj][m][1];
                    if constexpr (OUT16) { u32x4 w; w.x = cvt_pk_bf16(x0.x, x0.y); w.y = cvt_pk_bf16(x0.z, x0.w); w.z = cvt_pk_bf16(x1.x, x1.y); w.w = cvt_pk_bf16(x1.z, x1.w); *(u32x4*)((bf16*)out + off + bj * HALF) = w; }
                    else { *(f32x4*)((float*)out + off + bj * HALF) = x0; *(f32x4*)((float*)out + off + bj * HALF + 4) = x1; }
                    if constexpr (EMIT) sq += ((x0.x * x0.x + x0.y * x0.y) + (x0.z * x0.z + x0.w * x0.w)) + ((x1.x * x1.x + x1.y * x1.y) + (x1.z * x1.z + x1.w * x1.w)); }
                if constexpr (EMIT) { sq += __shfl_xor(sq, 16); sq += __shfl_xor(sq, 32); if (fq == 0) P[(ai * HALF + wr * 64 + m * 16 + fr) * 4 + wc] = sq; } }
        if constexpr (EMIT) { LBAR();
            if (tid < 256) { const f32x4 p = *(const LAS f32x4*)(P + tid * 4); rsq[(size_t)(u.pm * BM + tid) * 4 + u.pn] = (p.x + p.y) + (p.z + p.w); }
            LBAR(); }
    }
};
struct EpiResFinal {
    static constexpr int EOPS = 32; static constexpr bool PERM = true;
    const bf16* base; float* out; const float* g; float* rsq; unsigned* cnt; LAS unsigned char* ldsx;
    __device__ __forceinline__ void operator()(f32x4 (&acc)[2][2][4][2], const GU& u, int wr, int wc, int fr, int fq) const {
        int tid = threadIdx.x; asm volatile("" : "+v"(tid));
        fr = tid & 15; fq = (tid >> 4) & 3;
        const int row0 = u.pm * BM + wr * 64 + fr, col0 = u.pn * BM + wc * 32 + 8 * fq;
        LAS float* P = (LAS float*)(ldsx + LDS_XP);
        LAS float* RSL = (LAS float*)(ldsx + LDS_RSL);
#pragma unroll
        for (int ai = 0; ai < 2; ++ai)
#pragma unroll
            for (int m = 0; m < 4; ++m) { const size_t off = (size_t)(row0 + ai * HALF + m * 16) * D + col0; float sq = 0.f;
                u32x4 w[2];
#pragma unroll
                for (int bj = 0; bj < 2; ++bj) w[bj] = *(const u32x4*)(base + off + bj * HALF);
#pragma unroll
                for (int bj = 0; bj < 2; ++bj) { const f32x4 x0 = (f32x4){bflo(w[bj].x), bfhi(w[bj].x), bflo(w[bj].y), bfhi(w[bj].y)} + acc[ai][bj][m][0], x1 = (f32x4){bflo(w[bj].z), bfhi(w[bj].z), bflo(w[bj].w), bfhi(w[bj].w)} + acc[ai][bj][m][1];
                    acc[ai][bj][m][0] = x0; acc[ai][bj][m][1] = x1;
                    sq += ((x0.x * x0.x + x0.y * x0.y) + (x0.z * x0.z + x0.w * x0.w)) + ((x1.x * x1.x + x1.y * x1.y) + (x1.z * x1.z + x1.w * x1.w)); }
                sq += __shfl_xor(sq, 16); sq += __shfl_xor(sq, 32); if (fq == 0) P[(ai * HALF + wr * 64 + m * 16 + fr) * 4 + wc] = sq; }
        LBAR();
        if (tid < 256) { const f32x4 p = *(const LAS f32x4*)(P + tid * 4); rsq[(size_t)(u.pm * BM + tid) * 4 + u.pn] = (p.x + p.y) + (p.z + p.w); }
        asm volatile("s_waitcnt vmcnt(0)" ::: "memory");
        LBAR();
        if (tid == 0) { unsigned* c = cnt + u.pm * 16;
            __builtin_amdgcn_fence(__ATOMIC_RELEASE, "agent");
            asm volatile("s_waitcnt vmcnt(0)" ::: "memory");
            (void)xb_add(c, 1u);
            unsigned sp = 0u; while (xb_ld(c) < 4u) { __builtin_amdgcn_s_sleep(1); if (++sp > XB_SPIN_CAP) break; }
            __builtin_amdgcn_fence(__ATOMIC_ACQUIRE, "agent");
            asm volatile("s_waitcnt vmcnt(0)" ::: "memory"); }
        LBAR();
        if (tid < 256) { const f32x4 q = *(const f32x4*)(rsq + (size_t)(u.pm * BM + tid) * 4); RSL[tid] = 1.0f / sqrtf(((q.x + q.y) + (q.z + q.w)) * (1.f / D) + 1e-6f); }
        LBAR();
        f32x4 gv[2][2];
#pragma unroll
        for (int bj = 0; bj < 2; ++bj)
#pragma unroll
            for (int n = 0; n < 2; ++n) gv[bj][n] = *(const f32x4*)(g + col0 + bj * HALF + n * 4);
#pragma unroll
        for (int ai = 0; ai < 2; ++ai)
#pragma unroll
            for (int m = 0; m < 4; ++m) { const size_t off = (size_t)(row0 + ai * HALF + m * 16) * D + col0; const float r_ = RSL[ai * HALF + wr * 64 + m * 16 + fr];
#pragma unroll
                for (int bj = 0; bj < 2; ++bj) { *(f32x4*)(out + off + bj * HALF) = acc[ai][bj][m][0] * r_ * gv[bj][0]; *(f32x4*)(out + off + bj * HALF + 4) = acc[ai][bj][m][1] * r_ * gv[bj][1]; } }
    }
};
struct EpiMerge {
    static constexpr int EOPS = 16; static constexpr bool PERM = true;
    u32x4* scr; bf16* O; const float* rsq; LAS unsigned char* ldsx;
    __device__ __forceinline__ void operator()(const f32x4 (&acc)[2][2][4][2], const GU& u, int wr, int wc, int fr, int fq) const {
        int tid = threadIdx.x; asm volatile("" : "+v"(tid));
        fr = tid & 15; fq = (tid >> 4) & 3;
        if ((u.sub & 1) == 0) {
            float rs[2][4];
            if (u.sub == 0) unit_row_scales(rsq, u.pm, ldsx, tid, wr, fr, rs);
            else { const LAS float* RSL = (const LAS float*)(ldsx + LDS_RSL);
#pragma unroll
                for (int ai = 0; ai < 2; ++ai)
#pragma unroll
                    for (int m = 0; m < 4; ++m) rs[ai][m] = RSL[ai * HALF + wr * 64 + m * 16 + fr]; }
#pragma unroll
            for (int ai = 0; ai < 2; ++ai)
#pragma unroll
                for (int m = 0; m < 4; ++m)
#pragma unroll
                    for (int bj = 0; bj < 2; ++bj) { const f32x4 v0 = acc[ai][bj][m][0] * rs[ai][m], v1 = acc[ai][bj][m][1] * rs[ai][m];
                        u32x4 w; w.x = cvt_pk_bf16(sigmoidf_(v0[0]), sigmoidf_(v0[1])); w.y = cvt_pk_bf16(sigmoidf_(v0[2]), sigmoidf_(v0[3]));
                        w.z = cvt_pk_bf16(sigmoidf_(v1[0]), sigmoidf_(v1[1])); w.w = cvt_pk_bf16(sigmoidf_(v1[2]), sigmoidf_(v1[3]));
                        scr[((ai * 4 + m) * 2 + bj) * 512 + tid] = w; }
        } else {
            const bool first = (u.sub == 1);
            const int row0 = u.pm * BM + wr * 64 + fr, col0 = u.pn * BM + wc * 32 + 8 * fq;
#pragma unroll
            for (int ai = 0; ai < 2; ++ai) {
                u32x4 sg[4][2], pv[4][2];
#pragma unroll
                for (int m = 0; m < 4; ++m)
#pragma unroll
                    for (int bj = 0; bj < 2; ++bj) { sg[m][bj] = scr[((ai * 4 + m) * 2 + bj) * 512 + tid];
                        pv[m][bj] = first ? (u32x4){0u, 0u, 0u, 0u} : *(const u32x4*)(O + (size_t)(row0 + ai * HALF + m * 16) * D + col0 + bj * HALF); }
#pragma unroll
                for (int m = 0; m < 4; ++m) { bf16* rowp = O + (size_t)(row0 + ai * HALF + m * 16) * D + col0;
#pragma unroll
                    for (int bj = 0; bj < 2; ++bj) { const f32x4 v0 = acc[ai][bj][m][0], v1 = acc[ai][bj][m][1];
                        const u32x4 s = sg[m][bj], p = pv[m][bj];
                        float r[8];
                        r[0] = bflo(s.x) * v0[0] + bflo(p.x); r[1] = bfhi(s.x) * v0[1] + bfhi(p.x); r[2] = bflo(s.y) * v0[2] + bflo(p.y); r[3] = bfhi(s.y) * v0[3] + bfhi(p.y);
                        r[4] = bflo(s.z) * v1[0] + bflo(p.z); r[5] = bfhi(s.z) * v1[1] + bfhi(p.z); r[6] = bflo(s.w) * v1[2] + bflo(p.w); r[7] = bfhi(s.w) * v1[3] + bfhi(p.w);
                        u32x4 w; w.x = cvt_pk_bf16(r[0], r[1]); w.y = cvt_pk_bf16(r[2], r[3]); w.z = cvt_pk_bf16(r[4], r[5]); w.w = cvt_pk_bf16(r[6], r[7]);
                        *(u32x4*)(rowp + bj * HALF) = w; } }
            }
        }
    }
};
}

struct Args { const float* in[26]; float* out; unsigned char* ws; int ph_lo, ph_hi; };
enum { I_X = 0, I_N1G, I_WIN, I_MU, I_W0, I_W2, I_A0, I_A2, I_G2, I_KK, I_KA, I_RK, I_GNW, I_GNB, I_V0, I_V1, I_V2, I_LB, I_HGN, I_WBR, I_WOUT, I_N2G, I_WFG, I_WFU, I_WFD, I_FG };

__device__ __forceinline__ void transpose_item(const float* W, int ldw, int k0, int n0, bf16* WT, size_t drow0, int ldt, int dk0, LAS float* scr, int lane, const float* gk = nullptr) {
#pragma unroll 8
    for (int i = 0; i < 32; ++i) { const int kk = 2 * i + (lane >> 5); float w = W[(size_t)(k0 + kk) * ldw + n0 + (lane & 31)]; if (gk) w *= gk[k0 + kk]; scr[kk * 33 + (lane & 31)] = w; }
    LDS_WAIT(); asm volatile("" ::: "memory");
    const int c = lane & 7;
#pragma unroll
    for (int j = 0; j < 4; ++j) { const int n = (lane >> 3) + 8 * j; const LAS float* s = scr + (8 * c) * 33 + n;
        u32x4 o; o.x = pk2(s[0 * 33], s[1 * 33]); o.y = pk2(s[2 * 33], s[3 * 33]); o.z = pk2(s[4 * 33], s[5 * 33]); o.w = pk2(s[6 * 33], s[7 * 33]);
        *(u32x4*)(WT + (drow0 + n) * (size_t)ldt + dk0 + 8 * c) = o; }
    LDS_WAIT(); asm volatile("" ::: "memory");
}

__device__ __forceinline__ void rms_row_bf16(const float* xrow, const float* g, bf16* orow, int lane) {
    const f32x4* xr = (const f32x4*)xrow + lane; f32x4 v[4]; float s = 0.f;
#pragma unroll
    for (int j = 0; j < 4; ++j) { v[j] = xr[64 * j]; s += (v[j].x * v[j].x + v[j].y * v[j].y) + (v[j].z * v[j].z + v[j].w * v[j].w); }
    const float rs = 1.0f / sqrtf(wave_sum(s) * (1.f / D) + 1e-6f);
    u32x2* o8 = (u32x2*)orow + lane;
#pragma unroll
    for (int j = 0; j < 4; ++j) { const f32x4 gv = ((const f32x4*)g)[lane + 64 * j]; u32x2 w; w.x = pk2(v[j].x * rs * gv.x, v[j].y * rs * gv.y); w.y = pk2(v[j].z * rs * gv.z, v[j].w * rs * gv.w); o8[64 * j] = w; }
}
__device__ __forceinline__ void rms_row_f32(const float* xrow, const float* g, float* orow, int lane) {
    const f32x4* xr = (const f32x4*)xrow + lane; f32x4 v[4]; float s = 0.f;
#pragma unroll
    for (int j = 0; j < 4; ++j) { v[j] = xr[64 * j]; s += (v[j].x * v[j].x + v[j].y * v[j].y) + (v[j].z * v[j].z + v[j].w * v[j].w); }
    const float rs = 1.0f / sqrtf(wave_sum(s) * (1.f / D) + 1e-6f);
    f32x4* o = (f32x4*)orow + lane;
#pragma unroll
    for (int j = 0; j < 4; ++j) { const f32x4 gv = ((const f32x4*)g)[lane + 64 * j]; o[64 * j] = v[j] * rs * gv; }
}

__device__ __forceinline__ void rope_entry(int t, int i, float& c, float& s) {
    const double invf[8] = {1.0, 0.19392274474868576, 0.03760603093086393, 0.007292664737217109, 0.001414213562373095, 0.0002742481756762073, 5.318295896944988e-05, 1.031338537721246e-05};
    double f = invf[0];
#pragma unroll
    for (int j = 1; j < 8; ++j) f = (i == j) ? invf[j] : f;
    const double ang = (double)t * f;
    const double k = __builtin_rint(ang * 0.63661977236758134308);
    double r = __builtin_fma(-k, 1.5707963267948966, ang); r = __builtin_fma(-k, 6.123233995736766e-17, r);
    const double r2 = r * r;
    double sn = r * (1.0 + r2 * (-1.0 / 6 + r2 * (1.0 / 120 + r2 * (-1.0 / 5040 + r2 * (1.0 / 362880 + r2 * (-1.0 / 39916800 + r2 * (1.0 / 6227020800.0)))))));
    double cs = 1.0 + r2 * (-0.5 + r2 * (1.0 / 24 + r2 * (-1.0 / 720 + r2 * (1.0 / 40320 + r2 * (-1.0 / 3628800 + r2 * (1.0 / 479001600.0 + r2 * (-1.0 / 87178291200.0)))))));
    const int q = ((int)(long long)k) & 3;
    const double s2 = (q == 0) ? sn : (q == 1) ? cs : (q == 2) ? -sn : -cs;
    const double c2 = (q == 0) ? cs : (q == 1) ? -sn : (q == 2) ? -cs : sn;
    c = (float)c2; s = (float)s2;
}

constexpr int N_LATE = 16 * 128 + 4 * 4 * 32 + 16 * 32 + 2 * 16 * 88 + 44 * 32;
static_assert(N_LATE == 7296 && N_LATE % 32 == 0, "late weight items");
constexpr unsigned NWU = N_LATE / 32;
__device__ __forceinline__ void late_weight_item(const Args& a, int layer, int r, LAS float* scr, int lane) {
    bf16* Wb = (bf16*)(a.ws + WS_W);
    constexpr int N_ING = 16 * 128, N_BR = 4 * 4 * 32, N_OUT = 16 * 32, N_FG = 16 * 88;
    if (r < N_ING) { const int kb = r / 128, nb = 112 + r % 128; transpose_item(a.in[I_WIN] + (size_t)layer * D * 7680, 7680, kb * 64, nb * 32, (bf16*)((char*)Wb + W_IN), (size_t)nb * 32, 1024, kb * 64, scr, lane, a.in[I_N1G] + layer * D); return; } r -= N_ING;
    if (r < N_BR) { const int n = r / 128, q = r % 128, kb = q / 32, nb = q % 32; transpose_item(a.in[I_WBR] + (size_t)layer * 4 * MW * D + (size_t)n * MW * D, D, kb * 64, nb * 32, (bf16*)((char*)Wb + W_B), (size_t)n * 1024 + nb * 32, 256, kb * 64, scr, lane); return; } r -= N_BR;
    if (r < N_OUT) { const int kb = r / 32, nb = r % 32; transpose_item(a.in[I_WOUT] + (size_t)layer * D * D, D, kb * 64, nb * 32, (bf16*)((char*)Wb + W_O), (size_t)nb * 32, 1024, kb * 64, scr, lane); return; } r -= N_OUT;
    if (r < 2 * N_FG) { const int up = r / N_FG, q = r % N_FG, kb = q / 88, nb = q % 88, n0 = nb * 32;
        transpose_item((up ? a.in[I_WFU] : a.in[I_WFG]) + (size_t)layer * D * DFF, DFF, kb * 64, n0, (bf16*)((char*)Wb + W_GU), (size_t)(n0 / 128) * 256 + (n0 % 128) + up * 128, 1024, kb * 64, scr, lane, a.in[I_N2G] + layer * D); return; } r -= 2 * N_FG;
    { const int kb = r / 32, nb = r % 32; transpose_item(a.in[I_WFD] + (size_t)layer * DFF * D, D, kb * 64, nb * 32, (bf16*)((char*)Wb + W_D), (size_t)nb * 32, DFF, kb * 64, scr, lane); }
}

__device__ __forceinline__ void phase_a(const Args& a, int layer, const float* xin, LAS unsigned char* lds, int vb, int G) {
    int tid = threadIdx.x; asm volatile("" : "+v"(tid)); const int lane = tid & 63, wave = tid >> 6;
    unsigned char* ws = a.ws;
    bf16* Wb = (bf16*)(ws + WS_W);
    LAS float* scr = (LAS float*)(lds + wave * 16384);
    const int gw = vb * 8 + wave, NGW = G * 8;
    const float* w_in = a.in[I_WIN] + (size_t)layer * D * 7680;
    const float* w_br = a.in[I_WBR] + (size_t)layer * 4 * MW * D;
    const float* w_out = a.in[I_WOUT] + (size_t)layer * D * D;
    const float* w_fg = a.in[I_WFG] + (size_t)layer * D * DFF;
    const float* w_fu = a.in[I_WFU] + (size_t)layer * D * DFF;
    const float* w_fd = a.in[I_WFD] + (size_t)layer * DFF * D;
    const float* w2 = a.in[I_W2] + (size_t)layer * 64 * MW;
    const float* a2 = a.in[I_A2] + (size_t)layer * 64 * MW;
    const float* g2 = a.in[I_G2] + (size_t)layer * 128 * MW;
    constexpr int N_INE = 16 * 112, N_LO = 8 + 8 + 16;
    for (int it = gw; it < N_INE + N_LO; it += NGW) {
        int r = it;
        if (r < N_INE) { const int kb = r / 112, nb = r % 112; transpose_item(w_in, 7680, kb * 64, nb * 32, (bf16*)((char*)Wb + W_IN), (size_t)nb * 32, 1024, kb * 64, scr, lane, a.in[I_N1G] + layer * D); continue; } r -= N_INE;
        if (r < 8) { transpose_item(w2, MW, 0, r * 32, (bf16*)((char*)Wb + W_L), (size_t)r * 32, 256, 0, scr, lane); continue; } r -= 8;
        if (r < 8) { transpose_item(a2, MW, 0, r * 32, (bf16*)((char*)Wb + W_L), (size_t)256 + r * 32, 256, 64, scr, lane); continue; } r -= 8;
        { const int kb = r / 8, nb = r % 8; transpose_item(g2, MW, kb * 64, nb * 32, (bf16*)((char*)Wb + W_L), (size_t)512 + nb * 32, 256, 128 + kb * 64, scr, lane); }
    }
    const int gt = vb * 512 + tid, NGT = G * 512;
    for (int i = gt; i < 768 * 32; i += NGT) { const int row = i >> 5, ch = i & 31, blk = row >> 8; const int lo = blk == 0 ? 0 : (blk == 1 ? 64 : 128), hi = blk == 0 ? 64 : (blk == 1 ? 128 : 256);
        if (ch * 8 < lo || ch * 8 >= hi) *(u32x4*)((char*)Wb + W_L + (size_t)row * 512 + ch * 16) = (u32x4){0u, 0u, 0u, 0u}; }
    if (layer == 1) {
        const float* v1 = a.in[I_V1]; const float* v2 = a.in[I_V2];
        for (int i = gt; i < 256 * 256; i += NGT) { const int c = i >> 8, k = i & 255; float s = 0.f;
#pragma unroll 8
            for (int j = 0; j < 32; ++j) s += v1[k * 32 + j] * v2[j * 256 + c];
            ((bf16*)((char*)Wb + W_V))[i] = (bf16)f2bf(s); }
    } else {
        float2* rope = (float2*)(ws + WS_ROPE);
        for (int i = gt; i < SEQ * 8; i += NGT) { float c, s; rope_entry(i >> 3, i & 7, c, s); rope[i] = make_float2(c, s); }
    }
    if (layer == 0) { bf16* H = (bf16*)(ws + WS_H); float* RQ = (float*)(ws + WS_RSQ1);
        for (int m = gw; m < M; m += NGW) { const f32x4* xr = (const f32x4*)(xin + (size_t)m * D) + lane; u32x2* o8 = (u32x2*)(H + (size_t)m * D) + lane; float sq = 0.f;
#pragma unroll
            for (int j = 0; j < 4; ++j) { const f32x4 v = xr[64 * j]; sq += (v.x * v.x + v.y * v.y) + (v.z * v.z + v.w * v.w); u32x2 w; w.x = cvt_pk_bf16(v.x, v.y); w.y = cvt_pk_bf16(v.z, v.w); o8[64 * j] = w; }
            sq = wave_sum(sq); if (lane == 0) *(f32x4*)(RQ + (size_t)m * 4) = (f32x4){sq, 0.f, 0.f, 0.f}; } }
}

__device__ __forceinline__ void phase_c(const Args& a, int layer, LAS unsigned char* lds, int vb, int G) {
    int tid = threadIdx.x; asm volatile("" : "+v"(tid)); const int lane = tid & 63, wave = tid >> 6;
    unsigned char* ws = a.ws;
    bf16* PM = (bf16*)(ws + WS_PM); bf16* LA = (bf16*)(ws + WS_LA);
    const float2* rope = (const float2*)(ws + WS_ROPE);
    float* KMP = (float*)(ws + WS_KMP);
    const float* mu = a.in[I_MU] + layer * 1024;
    LAS float* red = (LAS float*)lds;
    const int c4 = 4 * lane, l15 = lane & 15; const bool rot = l15 < 4, lower = l15 < 2;
    const f32x4 mu_l = *(const f32x4*)(mu + 768 + c4), mu_v = *(const f32x4*)(mu + 512 + c4);
    for (int u = vb; u < 256; u += G) {
        const int b = u >> 5, hb = u & 31; const int t0 = hb * 128 + wave * 16; const size_t row0 = (size_t)b * SEQ + t0;
        f32x4 ksum = {0.f, 0.f, 0.f, 0.f};
        f32x4 xp = {0.f, 0.f, 0.f, 0.f}, vp = xp;
        if (t0 > 0) { xp = ld4bf(PM + (row0 - 1) * PMW + C_RW + 768 + c4); if (layer) vp = ld4bf(PM + (row0 - 1) * PMW + C_RW + 512 + c4); }
        for (int i = 0; i < 16; ++i) {
            const size_t row = row0 + i; const int t = t0 + i;
            bf16* pq = PM + row * PMW + C_MB + c4;
            const f32x4 x = ld4bf(PM + row * PMW + C_RW + 768 + c4);
            f32x4 v4 = {0.f, 0.f, 0.f, 0.f}; if (layer) v4 = ld4bf(PM + row * PMW + C_RW + 512 + c4);
            f32x4 q4 = ld4bf(pq), k4 = ld4bf(pq + 256);
            { float qa[4] = {q4.x, q4.y, q4.z, q4.w}, ka[4] = {k4.x, k4.y, k4.z, k4.w}, qo[4], ko[4];
#pragma unroll
                for (int j = 0; j < 4; ++j) { qo[j] = dpp_xor2(qa[j]); ko[j] = dpp_xor2(ka[j]); }
                if (rot) { const float2* rp = rope + (size_t)t * 8 + (l15 & 1) * 4;
#pragma unroll
                    for (int j = 0; j < 4; ++j) { const float2 cs = rp[j]; const float sg = lower ? -cs.y : cs.y; qa[j] = qa[j] * cs.x + qo[j] * sg; ka[j] = ka[j] * cs.x + ko[j] * sg; }
                    q4 = (f32x4){qa[0], qa[1], qa[2], qa[3]}; k4 = (f32x4){ka[0], ka[1], ka[2], ka[3]};
                    st4bf(pq, q4); st4bf(pq + 256, k4); } }
            { u32x2 w; w.x = cvt_pk_bf16(k4.x, k4.y); w.y = cvt_pk_bf16(k4.z, k4.w); ksum += (f32x4){bflo(w.x), bfhi(w.x), bflo(w.y), bfhi(w.y)}; }
            { const f32x4 xs = x + (xp - x) * mu_l; f32x4 o;
#pragma unroll
                for (int j = 0; j < 4; ++j) { const float e = __expf(2.0f * xs[j]); const float th = 1.0f - 2.0f * __builtin_amdgcn_rcpf(1.0f + e); o[j] = lane < 16 ? th : (lane < 32 ? xs[j] : sigmoidf_(xs[j])); }
                st4bf(LA + row * 512 + c4, o); xp = x;
                if (layer) { st4bf(LA + row * 512 + 256 + c4, v4 + (vp - v4) * mu_v); vp = v4; } }
        }
        *(LAS f32x4*)(red + wave * 256 + c4) = ksum;
        __syncthreads();
        if (tid < 256) { float sacc = 0.f;
#pragma unroll
            for (int w8 = 0; w8 < 8; ++w8) sacc += red[w8 * 256 + tid];
            KMP[((size_t)(b * 4 + (tid >> 6)) * 32 + hb) * 64 + (tid & 63)] = sacc; }
        __syncthreads();
    }
}

constexpr int TC = 16;
#define DPP_SHR(x, n) __builtin_bit_cast(float, __builtin_amdgcn_update_dpp(0, __builtin_bit_cast(int, (x)), 0x110 + (n), 0xF, 0xF, true))
#define DPP_BC15(x) __builtin_bit_cast(float, __builtin_amdgcn_update_dpp(0, __builtin_bit_cast(int, (x)), 0x15F, 0xF, 0xF, true))
typedef short bf16x4v __attribute__((ext_vector_type(4)));
__device__ __forceinline__ bf16x4v frag4(f32x4 z) { return __builtin_bit_cast(bf16x4v, (u32x2){cvt_pk_bf16(z[0], z[1]), cvt_pk_bf16(z[2], z[3])}); }
#define MM16(xt, y) __builtin_amdgcn_mfma_f32_16x16x16bf16_1k(frag4(xt), frag4(y), (f32x4){0.f, 0.f, 0.f, 0.f}, 0, 0, 0)
__device__ __forceinline__ void phase_d2(const Args& a, int layer, int vb, int G) {
    int tid = threadIdx.x; asm volatile("" : "+v"(tid)); const int lane = tid & 63, wave = tid >> 6;
    unsigned char* ws = a.ws;
    bf16* PM = (bf16*)(ws + WS_PM); bf16* LO = (bf16*)(ws + WS_LO); bf16* VF = (bf16*)(ws + WS_VF); float* BON = (float*)(ws + WS_BON);
    const int s = lane & 15, g = lane >> 4;
    const float* mu = a.in[I_MU] + layer * 1024;
#define LDB16(dst, p) do { const u32x4 a_ = *(const u32x4*)((p) + 8 * g), b_ = *(const u32x4*)((p) + 32 + 8 * g); \
        dst[0] = bflo(a_.x); dst[1] = bfhi(a_.x); dst[2] = bflo(a_.y); dst[3] = bfhi(a_.y); dst[4] = bflo(a_.z); dst[5] = bfhi(a_.z); dst[6] = bflo(a_.w); dst[7] = bfhi(a_.w); \
        dst[8] = bflo(b_.x); dst[9] = bfhi(b_.x); dst[10] = bflo(b_.y); dst[11] = bfhi(b_.y); dst[12] = bflo(b_.z); dst[13] = bfhi(b_.z); dst[14] = bflo(b_.w); dst[15] = bfhi(b_.w); } while (0)
#define LDC16(dst, p) do { const f32x4 a_ = *(const f32x4*)((p) + 8 * g), b_ = *(const f32x4*)((p) + 8 * g + 4), c_ = *(const f32x4*)((p) + 32 + 8 * g), d_ = *(const f32x4*)((p) + 36 + 8 * g); \
        dst[0] = a_.x; dst[1] = a_.y; dst[2] = a_.z; dst[3] = a_.w; dst[4] = b_.x; dst[5] = b_.y; dst[6] = b_.z; dst[7] = b_.w; dst[8] = c_.x; dst[9] = c_.y; dst[10] = c_.z; dst[11] = c_.w; dst[12] = d_.x; dst[13] = d_.y; dst[14] = d_.z; dst[15] = d_.w; } while (0)
#define STB16(p, src) do { u32x4 a_, b_; a_.x = cvt_pk_bf16(src[0], src[1]); a_.y = cvt_pk_bf16(src[2], src[3]); a_.z = cvt_pk_bf16(src[4], src[5]); a_.w = cvt_pk_bf16(src[6], src[7]); \
        b_.x = cvt_pk_bf16(src[8], src[9]); b_.y = cvt_pk_bf16(src[10], src[11]); b_.z = cvt_pk_bf16(src[12], src[13]); b_.w = cvt_pk_bf16(src[14], src[15]); \
        *(u32x4*)((p) + 8 * g) = a_; *(u32x4*)((p) + 32 + 8 * g) = b_; } while (0)
#define PK8(src, o) __builtin_bit_cast(bf16x8, (u32x4){cvt_pk_bf16(src[(o)], src[(o) + 1]), cvt_pk_bf16(src[(o) + 2], src[(o) + 3]), cvt_pk_bf16(src[(o) + 4], src[(o) + 5]), cvt_pk_bf16(src[(o) + 6], src[(o) + 7])})
#define SUM64(x) do { x += __shfl_xor(x, 16); x += __shfl_xor(x, 32); } while (0)
    const int gw = vb * 8 + wave, NGW = G * 8;
    for (int task = gw; task < 8192; task += NGW) {
        const int chain = task >> 8, ch = task & 255, b = chain >> 2, h = chain & 3;
        const int t = ch * 16 + s; const size_t row = (size_t)b * SEQ + t;
        const bf16* pr = PM + row * PMW + C_RW + h * 64; const bf16* pp = (t > 0) ? pr - PMW : pr; const float pz = (t > 0) ? 1.f : 0.f;
        bf16* lo = LO + row * 1024 + h * 64;
        float lw[16], kk[16], bv[16], km[16], rr[16], vv[16];
        { float x0[16], xp[16], c0[16], c1[16], asg[16];
            LDB16(x0, pr); LDB16(xp, pp); LDC16(c0, mu + h * 64);
#pragma unroll
            for (int j = 0; j < 16; ++j) rr[j] = x0[j] + (xp[j] * pz - x0[j]) * c0[j];
            LDB16(x0, pr + 256); LDB16(xp, pp + 256); LDC16(c0, mu + 256 + h * 64);
            float ks[16];
#pragma unroll
            for (int j = 0; j < 16; ++j) ks[j] = x0[j] + (xp[j] * pz - x0[j]) * c0[j];
            LDB16(x0, pr + 512); LDB16(xp, pp + 512); LDC16(c0, mu + 512 + h * 64);
#pragma unroll
            for (int j = 0; j < 16; ++j) vv[j] = x0[j] + (xp[j] * pz - x0[j]) * c0[j];
            LDB16(x0, lo); LDC16(c0, a.in[I_W0] + layer * 256 + h * 64);
#pragma unroll
            for (int j = 0; j < 16; ++j) { const float wlog = -softplusf_(-(c0[j] + x0[j])) - 0.5f; lw[j] = -__expf(wlog); }
            LDB16(x0, lo + 256); LDC16(c0, a.in[I_A0] + layer * 256 + h * 64);
#pragma unroll
            for (int j = 0; j < 16; ++j) asg[j] = sigmoidf_(c0[j] + x0[j]);
            if (layer) { LDB16(x0, lo + 768); LDB16(xp, VF + row * 256 + h * 64); LDC16(c0, a.in[I_V0] + h * 64);
#pragma unroll
                for (int j = 0; j < 16; ++j) vv[j] += (xp[j] - vv[j]) * sigmoidf_(c0[j] + x0[j]); }
            else STB16(VF + row * 256 + h * 64, vv);
            STB16(lo + 768, vv);
            LDC16(c0, a.in[I_KK] + layer * 256 + h * 64); LDC16(c1, a.in[I_KA] + layer * 256 + h * 64);
            float n2 = 0.f;
#pragma unroll
            for (int j = 0; j < 16; ++j) { kk[j] = ks[j] * c0[j]; n2 += kk[j] * kk[j]; km[j] = ks[j] * (1.0f + (asg[j] - 1.0f) * c1[j]); }
            SUM64(n2); const float rn = 1.0f / fmaxf(sqrtf(n2), 1e-12f);
            LDC16(c0, a.in[I_RK] + layer * 256 + h * 64);
            float bon = 0.f;
#pragma unroll
            for (int j = 0; j < 16; ++j) { kk[j] *= rn; bv[j] = kk[j] * asg[j]; bon += rr[j] * km[j] * c0[j]; }
            SUM64(bon); if (g == 0) BON[row * 4 + h] = bon; }
        unsigned char* se = ws + WS_RS + (size_t)task * RS_ENTRY;
        float al[16], bh[16], kh[16], rh[16];
#pragma unroll
        for (int j = 0; j < 16; ++j) { float cs = lw[j]; cs += DPP_SHR(cs, 1); cs += DPP_SHR(cs, 2); cs += DPP_SHR(cs, 4); cs += DPP_SHR(cs, 8);
            const float Gt = __expf(cs), Gi = __expf(-cs), Gp = __expf(cs - lw[j]);
            al[j] = Gp * kk[j]; bh[j] = bv[j] * Gi; kh[j] = km[j] * Gi; rh[j] = Gt * rr[j];
            if (s == 15) ((float*)(se + 12800))[(j < 8 ? 8 * g + j : 24 + 8 * g + j)] = Gt; }
        { bf16* at = (bf16*)se + s * 72; STB16(at, al); bf16* rt = (bf16*)(se + 2304) + s * 72; STB16(rt, rh);
            bf16* bt = (bf16*)(se + 4608); bf16* kt = (bf16*)(se + 6656); bf16* vt = (bf16*)(se + 8704);
#pragma unroll
            for (int j = 0; j < 16; ++j) { const int k = (j < 8 ? 8 * g + j : 24 + 8 * g + j); bt[k * 16 + s] = (bf16)f2bf(-bh[j]); kt[k * 16 + s] = (bf16)f2bf(kh[j]); vt[k * 16 + s] = (bf16)f2bf(vv[j]); } }
        const bf16x8 al0 = PK8(al, 0), al1 = PK8(al, 8), bh0 = PK8(bh, 0), bh1 = PK8(bh, 8), kh0 = PK8(kh, 0), kh1 = PK8(kh, 8), rh0 = PK8(rh, 0), rh1 = PK8(rh, 8);
#define GRAM(x0_, x1_, y0_, y1_) __builtin_amdgcn_mfma_f32_16x16x32_bf16(x1_, y1_, __builtin_amdgcn_mfma_f32_16x16x32_bf16(x0_, y0_, (f32x4){0.f, 0.f, 0.f, 0.f}, 0, 0, 0), 0, 0, 0)
        f32x4 N = GRAM(bh0, bh1, al0, al1), NT = GRAM(al0, al1, bh0, bh1), QT = GRAM(al0, al1, kh0, kh1), BR = GRAM(bh0, bh1, rh0, rh1), KR = GRAM(kh0, kh1, rh0, rh1);
        f32x4 ID;
#pragma unroll
        for (int r = 0; r < 4; ++r) { const int rw = 4 * g + r; N[r] = rw < s ? N[r] : 0.f; NT[r] = s < rw ? NT[r] : 0.f; QT[r] = s < rw ? QT[r] : 0.f; BR[r] = rw <= s ? -BR[r] : 0.f; KR[r] = rw <= s ? KR[r] : 0.f; ID[r] = rw == s ? 1.f : 0.f; }
        const f32x4 N2 = MM16(NT, N), N2T = MM16(N, NT); const f32x4 N4 = MM16(N2T, N2), N4T = MM16(N2, N2T); const f32x4 N8 = MM16(N4T, N4);
        f32x4 X = MM16(ID + N4T, ID + N8); X = MM16(ID + N2T, X); const f32x4 T = MM16(ID - NT, X);
        const f32x4 QTm = MM16(QT, T);
        { u32x2* sm = (u32x2*)(se + 10752) + lane;
            sm[0] = (u32x2){cvt_pk_bf16(T[0], T[1]), cvt_pk_bf16(T[2], T[3])}; sm[64] = (u32x2){cvt_pk_bf16(QTm[0], QTm[1]), cvt_pk_bf16(QTm[2], QTm[3])};
            sm[128] = (u32x2){cvt_pk_bf16(BR[0], BR[1]), cvt_pk_bf16(BR[2], BR[3])}; sm[192] = (u32x2){cvt_pk_bf16(KR[0], KR[1]), cvt_pk_bf16(KR[2], KR[3])}; }
    }
#undef GRAM
#undef LDB16
#undef LDC16
#undef STB16
#undef PK8
#undef SUM64
}

constexpr int RWS = (int)RS_ENTRY;
__device__ __forceinline__ void rwkv_chain(const Args& a, int layer, int chain, LAS unsigned char* L) {
    int tid = threadIdx.x; asm volatile("" : "+v"(tid)); const int lane = tid & 63, w = __builtin_amdgcn_readfirstlane(tid >> 6);
    const int b = chain >> 2, h = chain & 3;
    unsigned char* ws = a.ws;
    const unsigned char* RS = ws + WS_RS + (size_t)chain * 256 * RS_ENTRY;
    constexpr int NCH = 256;
    if (w >= 4) {
        const int lw = w - 4;
#define RW_DMA(cn) do { const int cn_ = (cn) < NCH ? (cn) : NCH - 1; const unsigned char* src_ = RS + (size_t)cn_ * RS_ENTRY + lane * 16; LAS unsigned char* dst_ = L + ((cn) & 7) * RWS; \
            __builtin_amdgcn_global_load_lds((const unsigned*)(src_ + lw * 1024), (LAS unsigned*)(dst_ + lw * 1024), 16, 0, 0); \
            __builtin_amdgcn_global_load_lds((const unsigned*)(src_ + (lw + 4) * 1024), (LAS unsigned*)(dst_ + (lw + 4) * 1024), 16, 0, 0); \
            __builtin_amdgcn_global_load_lds((const unsigned*)(src_ + (lw + 8) * 1024), (LAS unsigned*)(dst_ + (lw + 8) * 1024), 16, 0, 0); \
            if (lw == 0 && lane < 48) __builtin_amdgcn_global_load_lds((const unsigned*)(src_ + 12 * 1024), (LAS unsigned*)(dst_ + 12 * 1024), 16, 0, 0); } while (0)
#define RW_WAIT() do { if (lw == 0) asm volatile("s_waitcnt vmcnt(24)" ::: "memory"); else asm volatile("s_waitcnt vmcnt(18)" ::: "memory"); } while (0)
        RW_DMA(0); RW_DMA(1); RW_DMA(2); RW_DMA(3); RW_DMA(4); RW_DMA(5); RW_DMA(6);
        RW_WAIT(); LBAR();
        for (int c = 0; c < NCH; ++c) { RW_DMA(c + 7); RW_WAIT(); LBAR(); }
        asm volatile("s_waitcnt vmcnt(0)" ::: "memory");
        LBAR();
#undef RW_DMA
#undef RW_WAIT
    } else {
        const int s16 = lane & 15, cg = lane >> 4;
        bf16* PMo = (bf16*)(ws + WS_PM) + (size_t)b * SEQ * PMW + C_RW + h * 64 + 16 * w + s16;
        f32x4 S0 = {0.f, 0.f, 0.f, 0.f}, S1 = S0, S2 = S0, S3 = S0;
        LBAR();
        for (int c = 0; c < NCH; ++c) {
            const LAS unsigned char* E = L + (c & 7) * RWS;
            const LAS bf16* AT = (const LAS bf16*)E + s16 * 72 + 4 * cg; const LAS bf16* RT = (const LAS bf16*)(E + 2304) + s16 * 72 + 4 * cg;
            const LAS bf16* BT = (const LAS bf16*)(E + 4608) + s16 * 16 + 4 * cg; const LAS bf16* KT = (const LAS bf16*)(E + 6656) + s16 * 16 + 4 * cg;
            const bf16x4v vt = *(const LAS bf16x4v*)((const LAS bf16*)(E + 8704) + (16 * w + s16) * 16 + 4 * cg);
            const LAS bf16x4v* SM = (const LAS bf16x4v*)(E + 10752) + lane; const bf16x4v tc = SM[0], qc = SM[64], brc = SM[128], krc = SM[192];
            const LAS float* GC = (const LAS float*)(E + 12800) + 4 * cg;
            const bf16x4v s0b = frag4(S0), s1b = frag4(S1), s2b = frag4(S2), s3b = frag4(S3);
            const f32x4 Z = {0.f, 0.f, 0.f, 0.f};
            f32x4 p1 = __builtin_amdgcn_mfma_f32_16x16x16bf16_1k(*(const LAS bf16x4v*)(AT), s0b, Z, 0, 0, 0);
            p1 = __builtin_amdgcn_mfma_f32_16x16x16bf16_1k(*(const LAS bf16x4v*)(AT + 16), s1b, p1, 0, 0, 0);
            p1 = __builtin_amdgcn_mfma_f32_16x16x16bf16_1k(*(const LAS bf16x4v*)(AT + 32), s2b, p1, 0, 0, 0);
            p1 = __builtin_amdgcn_mfma_f32_16x16x16bf16_1k(*(const LAS bf16x4v*)(AT + 48), s3b, p1, 0, 0, 0);
            f32x4 y = __builtin_amdgcn_mfma_f32_16x16x16bf16_1k(krc, vt, Z, 0, 0, 0);
            y = __builtin_amdgcn_mfma_f32_16x16x16bf16_1k(*(const LAS bf16x4v*)(RT), s0b, y, 0, 0, 0);
            y = __builtin_amdgcn_mfma_f32_16x16x16bf16_1k(*(const LAS bf16x4v*)(RT + 16), s1b, y, 0, 0, 0);
            y = __builtin_amdgcn_mfma_f32_16x16x16bf16_1k(*(const LAS bf16x4v*)(RT + 32), s2b, y, 0, 0, 0);
            y = __builtin_amdgcn_mfma_f32_16x16x16bf16_1k(*(const LAS bf16x4v*)(RT + 48), s3b, y, 0, 0, 0);
            f32x4 u = __builtin_amdgcn_mfma_f32_16x16x16bf16_1k(qc, vt, Z, 0, 0, 0);
            u = __builtin_amdgcn_mfma_f32_16x16x16bf16_1k(tc, frag4(p1), u, 0, 0, 0);
            const bf16x4v ub = frag4(u);
            y = __builtin_amdgcn_mfma_f32_16x16x16bf16_1k(brc, ub, y, 0, 0, 0);
#define RW_UPD(Sx, kt) do { f32x4 n_ = __builtin_amdgcn_mfma_f32_16x16x16bf16_1k(*(const LAS bf16x4v*)(KT + (kt) * 256), vt, Sx, 0, 0, 0); \
                n_ = __builtin_amdgcn_mfma_f32_16x16x16bf16_1k(*(const LAS bf16x4v*)(BT + (kt) * 256), ub, n_, 0, 0, 0); Sx = n_ * *(const LAS f32x4*)(GC + 16 * (kt)); } while (0)
            RW_UPD(S0, 0); RW_UPD(S1, 1); RW_UPD(S2, 2); RW_UPD(S3, 3);
#undef RW_UPD
            bf16* yo = PMo + (size_t)(c * 16 + 4 * cg) * PMW;
#pragma unroll
            for (int r = 0; r < 4; ++r) yo[(size_t)r * PMW] = (bf16)f2bf(y[r]);
            LBAR();
        }
        LBAR();
    }
}

__device__ __forceinline__ void phase_e2(const Args& a, int layer, int vb, int G) {
    int tid = threadIdx.x; asm volatile("" : "+v"(tid)); const int lane = tid & 63, wave = tid >> 6;
    unsigned char* ws = a.ws;
    const bf16* LO = (const bf16*)(ws + WS_LO); const float* BON = (const float*)(ws + WS_BON); bf16* PM = (bf16*)(ws + WS_PM);
    const int c4 = 4 * lane, head = lane >> 4;
    const f32x4 gnw = *(const f32x4*)(a.in[I_GNW] + layer * 256 + c4), gnb = *(const f32x4*)(a.in[I_GNB] + layer * 256 + c4);
    for (int tok = vb * 8 + wave; tok < M; tok += G * 8) {
        const size_t row = (size_t)tok;
        bf16* yp = PM + row * PMW + C_RW + c4; const f32x4 y = ld4bf(yp); const f32x4 vf = ld4bf(LO + row * 1024 + 768 + c4), g = ld4bf(LO + row * 1024 + 512 + c4); const float bon = BON[row * 4 + head];
        const float mean = dpp_sum16((y.x + y.y) + (y.z + y.w)) * (1.f / 64); const f32x4 d = y - mean;
        const float var = dpp_sum16((d.x * d.x + d.y * d.y) + (d.z * d.z + d.w * d.w)) * (1.f / 64);
        const f32x4 yn = d * (1.0f / sqrtf(var + 64e-5f)) * gnw + gnb;
        st4bf(yp, (yn + bon * vf) * g);
    }
}

typedef short bf16x4 __attribute__((ext_vector_type(4)));
constexpr int HQS = 72, HES = 20;
constexpr int HG_QT = 0, HG_KT = HG_QT + 16 * HQS * 2, HG_KE = HG_KT + 16 * HQS * 2, HG_IT = HG_KE + 64 * HES * 2, HG_DEC = HG_IT + 64 * HES * 2, HG_O = HG_DEC + 256, HG_BUF = HG_O + 4096;
__device__ __forceinline__ void hgrn_chain(const Args& a, int layer, int bh, LAS unsigned char* L) {
    int tid = threadIdx.x; asm volatile("" : "+v"(tid)); const int lane = tid & 63, w = __builtin_amdgcn_readfirstlane(tid >> 6);
    const int b = bh >> 2, h = bh & 3;
    unsigned char* ws = a.ws;
    const bf16* PM = (const bf16*)(ws + WS_PM); bf16* PMo = (bf16*)(ws + WS_PM);
    const size_t rowb = (size_t)b * SEQ;
    constexpr int NCH = SEQ / 16;
    const int s16 = lane & 15, cg = lane >> 4;
    constexpr int RAWS = 528, RAWSZ = 16 * RAWS, HG_RAW = 2 * HG_BUF;
    const int ld_tok = tid >> 5, ld_arr = (tid & 31) >> 3, ld_c8 = tid & 7;
    const bf16* ld_src = PM + (rowb + ld_tok) * PMW + C_HG + h * 64 + ld_arr * 256 + ld_c8 * 8;
    const int ld_dst = ld_tok * RAWS + ld_arr * 128 + ld_c8 * 16;
    float lb[2], oml[2];
#pragma unroll
    for (int r = 0; r < 2; ++r) { const int k = (2 * w + r) * 4 + cg; float v = 0.f; if (layer) { const float l0 = a.in[I_LB][h * 64 + k], l1 = a.in[I_LB][256 + h * 64 + k]; v = 1.0f / (1.0f + expf(l0 - l1)); } lb[r] = v; oml[r] = 1.0f - v; }
    const f32x4 gng4 = *(const f32x4*)(a.in[I_HGN] + layer * 256 + h * 64 + 4 * s16);
    const f32x2 lb2 = {lb[0], lb[1]}, oml2 = {oml[0], oml[1]};
    u32x4 pf[8];
#define HG_LOAD(set, cn) do { const int cn_ = (cn) < NCH ? (cn) : NCH - 1; pf[set] = *(const u32x4*)(ld_src + (size_t)cn_ * 16 * PMW); } while (0)
#define HG_STAGE(set, cn) do { *(LAS u32x4*)(L + HG_RAW + ((cn) & 3) * RAWSZ + ld_dst) = pf[set]; } while (0)
#define HG_PROD(cn) do { { LAS unsigned char* B_ = L + ((cn) & 1) * HG_BUF; const int k0_ = (2 * w) * 4 + cg, k1_ = k0_ + 4; \
        const LAS bf16* R_ = (const LAS bf16*)(L + HG_RAW + ((cn) & 3) * RAWSZ + s16 * RAWS); const unsigned rq0_ = R_[k0_], rq1_ = R_[k1_], rf0_ = R_[64 + k0_], rf1_ = R_[64 + k1_], ri0_ = R_[128 + k0_], ri1_ = R_[128 + k1_]; \
        const f32x2 fl_ = {bflo(rf0_), bflo(rf1_)}; \
        f32x2 e_, inv_, lf_; e_.x = __expf(-fabsf(fl_.x)); e_.y = __expf(-fabsf(fl_.y)); inv_.x = __builtin_amdgcn_rcpf(1.0f + e_.x); inv_.y = __builtin_amdgcn_rcpf(1.0f + e_.y); \
        const f32x2 ei_ = e_ * inv_; f32x2 sg_, ns_; sg_.x = fl_.x >= 0.f ? inv_.x : ei_.x; sg_.y = fl_.y >= 0.f ? inv_.y : ei_.y; ns_.x = fl_.x >= 0.f ? ei_.x : inv_.x; ns_.y = fl_.y >= 0.f ? ei_.y : inv_.y; \
        const f32x2 f_ = lb2 + oml2 * sg_, key_ = oml2 * ns_; lf_.x = __logf(f_.x); lf_.y = __logf(f_.y); \
        float b0_ = lf_.x, b1_ = lf_.y; b0_ += DPP_SHR(b0_, 1); b1_ += DPP_SHR(b1_, 1); b0_ += DPP_SHR(b0_, 2); b1_ += DPP_SHR(b1_, 2); b0_ += DPP_SHR(b0_, 4); b1_ += DPP_SHR(b1_, 4); b0_ += DPP_SHR(b0_, 8); b1_ += DPP_SHR(b1_, 8); \
        const float be0_ = DPP_BC15(b0_), be1_ = DPP_BC15(b1_);                         \
        f32x2 eb_, en_, de_; eb_.x = __expf(b0_); eb_.y = __expf(b1_); en_.x = __expf(fminf(-b0_, 80.f)); en_.y = __expf(fminf(-b1_, 80.f)); de_.x = __expf(be0_); de_.y = __expf(be1_); \
        const f32x2 qt_ = (f32x2){bflo(rq0_), bflo(rq1_)} * eb_, kt_ = key_ * en_, ke_ = kt_ * de_; \
        const unsigned wq_ = cvt_pk_bf16(qt_.x, qt_.y), wk_ = cvt_pk_bf16(kt_.x, kt_.y), we_ = cvt_pk_bf16(ke_.x, ke_.y); \
        LAS bf16* QT_ = (LAS bf16*)(B_ + HG_QT) + s16 * HQS; LAS bf16* KT_ = (LAS bf16*)(B_ + HG_KT) + s16 * HQS; LAS bf16* KE_ = (LAS bf16*)(B_ + HG_KE) + s16; LAS bf16* IT_ = (LAS bf16*)(B_ + HG_IT) + s16; \
        QT_[k0_] = (bf16)(wq_ & 0xffffu); QT_[k1_] = (bf16)(wq_ >> 16); KT_[k0_] = (bf16)(wk_ & 0xffffu); KT_[k1_] = (bf16)(wk_ >> 16); \
        KE_[k0_ * HES] = (bf16)(we_ & 0xffffu); KE_[k1_ * HES] = (bf16)(we_ >> 16); IT_[k0_ * HES] = (bf16)ri0_; IT_[k1_ * HES] = (bf16)ri1_; \
        if (s16 == 0) { ((LAS float*)(B_ + HG_DEC))[k0_] = de_.x; ((LAS float*)(B_ + HG_DEC))[k1_] = de_.y; } } } while (0)
#define HG_POST(cn) do { if (w >= 4) { const LAS float* O_ = (const LAS float*)(L + ((cn) & 1) * HG_BUF + HG_O); const int c_ = 4 * (w - 4) + cg; \
        const f32x4 o_ = *(const LAS f32x4*)(O_ + c_ * 64 + 4 * s16); const float ms_ = dpp_sum16((o_.x * o_.x + o_.y * o_.y) + (o_.z * o_.z + o_.w * o_.w)) * (1.f / 64); \
        const u32x2 gw_ = *(const LAS u32x2*)(L + HG_RAW + ((cn) & 3) * RAWSZ + c_ * RAWS + 384 + 8 * s16); const f32x4 g_ = {bflo(gw_.x), bfhi(gw_.x), bflo(gw_.y), bfhi(gw_.y)}; f32x4 sg_; \
        _Pragma("unroll") for (int j_ = 0; j_ < 4; ++j_) sg_[j_] = g_[j_] * sigmoidf_(g_[j_]); \
        st4bf(PMo + (rowb + (cn) * 16 + c_) * PMW + C_HG + h * 64 + 4 * s16, o_ * __builtin_amdgcn_rsqf(ms_ + 1e-6f) * gng4 * sg_); } } while (0)
    f32x4 S0 = {0.f, 0.f, 0.f, 0.f}, S1 = S0, S2 = S0, S3 = S0;
    HG_LOAD(0, 0); HG_LOAD(1, 1); HG_LOAD(2, 2); HG_LOAD(3, 3); HG_LOAD(4, 4); HG_LOAD(5, 5); HG_LOAD(6, 6); HG_LOAD(7, 7);
    HG_STAGE(0, 0); HG_STAGE(1, 1); HG_LOAD(0, 8); HG_LOAD(1, 9);
    LBAR();
    HG_PROD(0);
    LBAR();
#define HG_ITER(i) do { const int n = g0 + (i); HG_STAGE(((i) + 2) & 7, n + 2); HG_LOAD(((i) + 2) & 7, n + 10); if (n + 1 < NCH) HG_PROD(n + 1); hg_mfma(n); if (n > 0) HG_POST(n - 1); LBAR(); } while (0)
    auto hg_mfma = [&](int n) __attribute__((always_inline)) {
        if (w < 4) {
            LAS unsigned char* B = L + (n & 1) * HG_BUF;
            const LAS bf16* QT = (const LAS bf16*)(B + HG_QT); const LAS bf16* KT = (const LAS bf16*)(B + HG_KT); const LAS bf16* KE = (const LAS bf16*)(B + HG_KE); const LAS bf16* IT = (const LAS bf16*)(B + HG_IT);
            const LAS float* DEC = (const LAS float*)(B + HG_DEC); LAS float* O = (LAS float*)(B + HG_O);
            f32x4 sc = {0.f, 0.f, 0.f, 0.f};
#pragma unroll
            for (int ks = 0; ks < 2; ++ks) { const bf16x8 af = *(const LAS bf16x8*)(KT + s16 * HQS + ks * 32 + cg * 8), bfr = *(const LAS bf16x8*)(QT + s16 * HQS + ks * 32 + cg * 8);
                sc = __builtin_amdgcn_mfma_f32_16x16x32_bf16(af, bfr, sc, 0, 0, 0); }
            bf16x4 pf; { float m0 = (4 * cg + 0 <= s16) ? sc[0] : 0.f, m1 = (4 * cg + 1 <= s16) ? sc[1] : 0.f, m2 = (4 * cg + 2 <= s16) ? sc[2] : 0.f, m3 = (4 * cg + 3 <= s16) ? sc[3] : 0.f;
                const unsigned u0 = cvt_pk_bf16(m0, m1), u1 = cvt_pk_bf16(m2, m3); pf = __builtin_bit_cast(bf16x4, (u32x2){u0, u1}); }
            const bf16x4 ifr = *(const LAS bf16x4*)(IT + (16 * w + s16) * HES + 4 * cg);
            f32x4 oacc = {0.f, 0.f, 0.f, 0.f};
            oacc = __builtin_amdgcn_mfma_f32_16x16x16bf16_1k(pf, ifr, oacc, 0, 0, 0);
#define HG_KT_STEP(Sx, kt) do { const bf16x4 qa_ = *(const LAS bf16x4*)(QT + s16 * HQS + 16 * (kt) + 4 * cg); \
                const bf16x4 sb_ = __builtin_bit_cast(bf16x4, (u32x2){cvt_pk_bf16(Sx[0], Sx[1]), cvt_pk_bf16(Sx[2], Sx[3])}); \
                oacc = __builtin_amdgcn_mfma_f32_16x16x16bf16_1k(qa_, sb_, oacc, 0, 0, 0); \
                const bf16x4 ka_ = *(const LAS bf16x4*)(KE + (16 * (kt) + s16) * HES + 4 * cg); const f32x4 dc_ = *(const LAS f32x4*)(DEC + 16 * (kt) + 4 * cg); \
                Sx = __builtin_amdgcn_mfma_f32_16x16x16bf16_1k(ka_, ifr, Sx * dc_, 0, 0, 0); } while (0)
            HG_KT_STEP(S0, 0); HG_KT_STEP(S1, 1); HG_KT_STEP(S2, 2); HG_KT_STEP(S3, 3);
#undef HG_KT_STEP
#pragma unroll
            for (int r = 0; r < 4; ++r) O[(4 * cg + r) * 64 + 16 * w + s16] = oacc[r];
        }
    };
    for (int g0 = 0; g0 < NCH; g0 += 8) { HG_ITER(0); HG_ITER(1); HG_ITER(2); HG_ITER(3); HG_ITER(4); HG_ITER(5); HG_ITER(6); HG_ITER(7); }
    HG_POST(NCH - 1);
    LBAR();
#undef HG_ITER
#undef HG_STAGE
#undef HG_LOAD
#undef HG_PROD
#undef HG_POST
}

#include <hip/hip_bf16.h>
namespace moba_body {
using bf16=__hip_bfloat16;
using bf16x8=__attribute__((ext_vector_type(8)))short;
using s16x4=__attribute__((ext_vector_type(4)))short;
using f32x16=__attribute__((ext_vector_type(16)))float;
using u32x4=__attribute__((ext_vector_type(4)))unsigned;
constexpr int SEQ=4096,D=64,PIN=3584,POUT=3584;
constexpr int NW=8,QBLK=32,QB=QBLK*NW,KVBLK=64,NQB=SEQ/QB;
__device__ __forceinline__ int crow(int r,int hi){return (r&3)+8*(r>>2)+4*hi;}
#define SBAR() __builtin_amdgcn_sched_barrier(0)
__device__ __forceinline__ void cmask(f32x16&p0,f32x16&p1,int jb,int qrel,int hi){
  const float NEG=-INFINITY; int kb=64*jb+4*hi;
  #pragma unroll
  for(int r=0;r<16;++r){int kv=kb+(r&3)+8*(r>>2); if(kv>qrel)p0[r]=NEG; if(kv+32>qrel)p1[r]=NEG;}
}

constexpr int NSLOT=3, SLOTB=8192;
constexpr int LDS_K=0, LDS_V=NSLOT*SLOTB, LDS_WS=2*NSLOT*SLOTB, LDS_OST=LDS_WS+NW*64*4, LDS_BYTES=LDS_OST+NW*4096;
constexpr float C2=0.125f*1.4426950408889634f;
__device__ __forceinline__ void glds16(const void*gbase,unsigned voff,unsigned lds_dst){unsigned keep;
  asm volatile("s_mov_b32 %0, m0\n\ts_mov_b32 m0, %2\n\ts_nop 0\n\tglobal_load_lds_dwordx4 %1, %3\n\ts_mov_b32 m0, %0":"=&s"(keep):"v"(voff),"s"(lds_dst),"s"(gbase):"memory");}
__device__ __forceinline__ float max3f(float a,float b,float c){float r;asm("v_max3_f32 %0, %1, %2, %3":"=v"(r):"v"(a),"v"(b),"v"(c));return r;}
__device__ __forceinline__ float max2f(float a,float b){float r;asm("v_max_f32_e32 %0, %1, %2":"=v"(r):"v"(a),"v"(b));return r;}
__device__ __forceinline__ float fadd_s(float a,float b){float r;asm("v_add_f32_e32 %0, %1, %2":"=v"(r):"v"(a),"v"(b));return r;}
__device__ __forceinline__ float fsub_s(float a,float b){float r;asm("v_sub_f32_e32 %0, %1, %2":"=v"(r):"v"(a),"v"(b));return r;}
typedef float f32x2_t __attribute__((ext_vector_type(2))); typedef __bf16 bf16x2_t __attribute__((ext_vector_type(2)));
__device__ __forceinline__ unsigned cvtpk_s(float lo,float hi){f32x2_t v={lo,hi};bf16x2_t b=__builtin_convertvector(v,bf16x2_t);return __builtin_bit_cast(unsigned,b);}
#define WAIT_BAR(N) asm volatile("s_waitcnt vmcnt(" #N ") lgkmcnt(0)\n\ts_barrier":::"memory")

__device__ __forceinline__ void qkt(f32x16&p0,f32x16&p1,const char*Kslot,const bf16x8*qr,const f32x16&negm,int r32,int hi){
  const char*kb=Kslot+hi*1024+r32*16;
  #pragma unroll
  for(int d0=0;d0<4;++d0){
    const bf16x8 b0=*reinterpret_cast<const bf16x8*>(kb+d0*2048);
    const bf16x8 b1=*reinterpret_cast<const bf16x8*>(kb+d0*2048+512);
    if(d0==0){p0=__builtin_amdgcn_mfma_f32_32x32x16_bf16(b0,qr[0],negm,0,0,0);p1=__builtin_amdgcn_mfma_f32_32x32x16_bf16(b1,qr[0],negm,0,0,0);}
    else{p0=__builtin_amdgcn_mfma_f32_32x32x16_bf16(b0,qr[d0],p0,0,0,0);p1=__builtin_amdgcn_mfma_f32_32x32x16_bf16(b1,qr[d0],p1,0,0,0);}}
}
typedef __attribute__((address_space(3))) const char* lds_cptr;
typedef short v4i16_t __attribute__((ext_vector_type(4)));
__device__ __forceinline__ void kload8(bf16x8*kf,lds_cptr kp){
  kf[0]=*(const __attribute__((address_space(3))) bf16x8*)(kp);      kf[1]=*(const __attribute__((address_space(3))) bf16x8*)(kp+512);
  kf[2]=*(const __attribute__((address_space(3))) bf16x8*)(kp+2048); kf[3]=*(const __attribute__((address_space(3))) bf16x8*)(kp+2560);
  kf[4]=*(const __attribute__((address_space(3))) bf16x8*)(kp+4096); kf[5]=*(const __attribute__((address_space(3))) bf16x8*)(kp+4608);
  kf[6]=*(const __attribute__((address_space(3))) bf16x8*)(kp+6144); kf[7]=*(const __attribute__((address_space(3))) bf16x8*)(kp+6656);
}
__device__ __forceinline__ void kload2(bf16x8*kf,lds_cptr kp,int j){ kf[2*j]=*(const __attribute__((address_space(3))) bf16x8*)(kp+j*2048); kf[2*j+1]=*(const __attribute__((address_space(3))) bf16x8*)(kp+j*2048+512); }
__device__ __forceinline__ s16x4 vtr(lds_cptr p){ return __builtin_bit_cast(s16x4,__builtin_amdgcn_ds_read_tr16_b64_v4i16((__attribute__((address_space(3))) v4i16_t*)p)); }
__device__ __forceinline__ float rowmax(const f32x16&p0,const f32x16&p1){
  float a=max3f(p0[0],p0[1],p1[0]),b=max3f(p0[2],p0[3],p1[1]);a=max3f(a,p1[2],p1[3]);
  #pragma unroll
  for(int r=4;r<16;r+=4){a=max3f(a,p0[r],p0[r+1]);b=max3f(b,p0[r+2],p0[r+3]);a=max3f(a,p1[r],p1[r+1]);b=max3f(b,p1[r+2],p1[r+3]);}
  const float m=max2f(a,b);
  auto rr=__builtin_amdgcn_permlane32_swap(__float_as_uint(m),__float_as_uint(m),false,false);
  return max2f(__uint_as_float(rr[0]),__uint_as_float(rr[1]));
}
__device__ __forceinline__ void pv(f32x16*o,int vb,bf16x8 pa0,bf16x8 pa1,bf16x8 pa2,bf16x8 pa3){
  #pragma unroll
  for(int d0=0;d0<2;++d0){s16x4 lo[4],hi[4];
    #pragma unroll
    for(int ks=0;ks<4;++ks){
      asm volatile("ds_read_b64_tr_b16 %0,%1 offset:%c2":"=&v"(lo[ks]):"v"(vb),"i"(d0*4096+ks*1024):"memory");
      asm volatile("ds_read_b64_tr_b16 %0,%1 offset:%c2":"=&v"(hi[ks]):"v"(vb),"i"(d0*4096+ks*1024+512):"memory");}
    asm volatile("s_waitcnt lgkmcnt(0)":::"memory");SBAR();
    #define PK(k) (bf16x8){lo[k][0],lo[k][1],lo[k][2],lo[k][3],hi[k][0],hi[k][1],hi[k][2],hi[k][3]}
    o[d0]=__builtin_amdgcn_mfma_f32_32x32x16_bf16(pa0,PK(0),o[d0],0,0,0);
    o[d0]=__builtin_amdgcn_mfma_f32_32x32x16_bf16(pa1,PK(1),o[d0],0,0,0);
    o[d0]=__builtin_amdgcn_mfma_f32_32x32x16_bf16(pa2,PK(2),o[d0],0,0,0);
    o[d0]=__builtin_amdgcn_mfma_f32_32x32x16_bf16(pa3,PK(3),o[d0],0,0,0);
    #undef PK
  }
}

#ifndef ATTN_STORE16
#define ATTN_STORE16(p,v) (*(u32x4*)(p)=(v))
#endif
template<int THRL> __device__ __forceinline__ void attn_unit(int b,int h,int qb,const bf16*Q,const bf16*__restrict__ K,const bf16*__restrict__ V,bf16*O,const float*__restrict__ KMP,char*shm){
  int tid=threadIdx.x; asm volatile("":"+v"(tid));
  const int lane=tid&63,r32=lane&31,hi=lane>>5; const int wid=__builtin_amdgcn_readfirstlane(tid>>6);
  const long rowbase=(long)b*SEQ; const int q0=qb*QB;
  const bf16*Qw=Q+(rowbase+q0+wid*QBLK)*PIN+h*D;
  const bf16*Kh=K+rowbase*PIN+h*D,*Vh=V+rowbase*PIN+h*D;
  const unsigned lds0=(unsigned)(uintptr_t)shm;
  float*wsf=(float*)(shm+LDS_WS)+wid*64;
  const unsigned koff=(unsigned)(lane*PIN+wid*8)*2u;
  const unsigned voff=(unsigned)((16*(wid&3)+(lane>>2))*PIN+(wid>>2)*32+(lane&3)*8)*2u;
  const unsigned kdst=lds0+LDS_K+wid*1024, vdst=lds0+LDS_V+wid*1024;
  #define DMA_K(t,slot) glds16(Kh,koff+(unsigned)(t)*(unsigned)(KVBLK*PIN*2),(unsigned)__builtin_amdgcn_readfirstlane(kdst+(slot)))
  #define DMA_V(t,slot) glds16(Vh,voff+(unsigned)(t)*(unsigned)(KVBLK*PIN*2),(unsigned)__builtin_amdgcn_readfirstlane(vdst+(slot)))
  const int vb0=(int)(lds0+LDS_V)+((lane>>4)&1)*32+(lane&3)*8+(4*hi+((lane&15)>>2))*64;
  const char*Kbase=shm+LDS_K; bf16x8 kf[8];
  const lds_cptr shm3=(lds_cptr)shm; const lds_cptr kp0=shm3+LDS_K+hi*1024+r32*16; const lds_cptr vp0=shm3+LDS_V+((lane>>4)&1)*32+(lane&3)*8+(4*hi+((lane&15)>>2))*64;
  const int NT=(q0+QB)/KVBLK;
  DMA_K(0,0);DMA_V(0,0);DMA_K(1,SLOTB);
  bf16x8 qr[4];
  #pragma unroll
  for(int d0=0;d0<4;++d0)qr[d0]=*reinterpret_cast<const bf16x8*>(&Qw[(long)r32*PIN+d0*16+hi*8]);
  unsigned sel=0u;
  { float qf[32];
    #pragma unroll
    for(int d0=0;d0<4;++d0){
      #pragma unroll
      for(int e=0;e<8;++e)qf[d0*8+e]=__uint_as_float(((unsigned)(unsigned short)qr[d0][e])<<16);}
    float b0=-INFINITY,b1=-INFINITY,b2=-INFINITY; int i0=-1,i1=-1,i2=-1;
    for(int j=0;j<qb;++j){
      const float*kp=KMP+((long)(b*4+h)*32+2*j)*64+8*hi; float g=0.f;
      #pragma unroll
      for(int d0=0;d0<4;++d0){ const float4 a0=*reinterpret_cast<const float4*>(kp+16*d0),a1=*reinterpret_cast<const float4*>(kp+16*d0+4),c0=*reinterpret_cast<const float4*>(kp+64+16*d0),c1=*reinterpret_cast<const float4*>(kp+64+16*d0+4);
        g+=qf[d0*8+0]*(a0.x+c0.x);g+=qf[d0*8+1]*(a0.y+c0.y);g+=qf[d0*8+2]*(a0.z+c0.z);g+=qf[d0*8+3]*(a0.w+c0.w);
        g+=qf[d0*8+4]*(a1.x+c1.x);g+=qf[d0*8+5]*(a1.y+c1.y);g+=qf[d0*8+6]*(a1.z+c1.z);g+=qf[d0*8+7]*(a1.w+c1.w);}
      { auto rr=__builtin_amdgcn_permlane32_swap(__float_as_uint(g),__float_as_uint(g),false,false); g=__uint_as_float(rr[0])+__uint_as_float(rr[1]); }
      if(g>b0){b2=b1;i2=i1;b1=b0;i1=i0;b0=g;i0=j;} else if(g>b1){b2=b1;i2=i1;b1=g;i1=j;} else if(g>b2){b2=g;i2=j;}
    }
    if(i0>=0)sel|=1u<<i0; if(i1>=0)sel|=1u<<i1; if(i2>=0)sel|=1u<<i2;
    #pragma unroll
    for(int d0=0;d0<4;++d0){ u32x4 w;
      w[0]=cvtpk_s(qf[d0*8+0]*C2,qf[d0*8+1]*C2);w[1]=cvtpk_s(qf[d0*8+2]*C2,qf[d0*8+3]*C2);w[2]=cvtpk_s(qf[d0*8+4]*C2,qf[d0*8+5]*C2);w[3]=cvtpk_s(qf[d0*8+6]*C2,qf[d0*8+7]*C2);
      qr[d0]=__builtin_bit_cast(bf16x8,w);} }
  float mhat=0.f,l_reg=0.f;f32x16 o[2];o[0]=f32x16{};o[1]=f32x16{};f32x16 negm=f32x16{};asm volatile("":"+v"(negm));
  const int qrel=wid*QBLK+r32;
  #define PMASK(P0,P1,t) do{ if(!((sel>>((t)>>2))&1u)){ _Pragma("unroll") for(int r_=0;r_<16;++r_){P0[r_]=-INFINITY;P1[r_]=-INFINITY;} } }while(0)
  #define CMASK(P0,P1,t) do{int jb_=(t)-(NT-4); if(jb_>=0)cmask(P0,P1,jb_,qrel,hi); else PMASK(P0,P1,t);}while(0)
  bool resc=false;
  #define START(P0,P1) do{ const float rm=rowmax(P0,P1); resc=false; \
    { const float dl=__builtin_fmaxf(rm,-64.f); mhat=fadd_s(mhat,dl); \
      _Pragma("unroll") for(int r=0;r<16;++r){P0[r]=fsub_s(P0[r],dl);P1[r]=fsub_s(P1[r],dl);} \
      _Pragma("unroll") for(int r=0;r<16;++r)negm[r]=-mhat; asm volatile("":"+v"(negm)); } \
    _Pragma("unroll") for(int r=0;r<16;++r)P0[r]=__builtin_amdgcn_exp2f(P0[r]); }while(0)
  #define RESC() do{ if(resc){ asm volatile("s_waitcnt lgkmcnt(0)":::"memory"); \
      _Pragma("unroll") for(int d_=0;d_<2;++d_) _Pragma("unroll") for(int r=0;r<16;++r)o[d_][r]*=wsf[crow(r,hi)]; } }while(0)
  f32x16 pA0,pA1,pB0,pB1;
  int sl_prev=0,sl_cur=0,sl_next=SLOTB;
  #define ROT() do{sl_prev=sl_cur;sl_cur=sl_next;sl_next=(sl_next==(NSLOT-1)*SLOTB)?0:sl_next+SLOTB;}while(0)
  DMA_K(2,2*SLOTB);
  WAIT_BAR(3);
  qkt(pA0,pA1,Kbase,qr,negm,r32,hi);asm volatile("s_nop 15\n\ts_nop 7":"+v"(pA0),"+v"(pA1));CMASK(pA0,pA1,0);
  START(pA0,pA1);
  _Pragma("unroll") for(int r=0;r<16;++r)pA1[r]=__builtin_amdgcn_exp2f(pA1[r]);
  WAIT_BAR(0);
  DMA_K(3,0);DMA_V(1,SLOTB);
  ROT();
  kload8(kf,kp0+sl_cur);
  WAIT_BAR(2);
  s16x4 vlo[8],vhi[8]; u32x4 pw0,pw1,pw2,pw3;
  #define PKW(P,B) cvtpk_s(P[B],P[B+1])
  #define PAF(k) __builtin_bit_cast(bf16x8,pw##k)
  #define VFR(i) (bf16x8){vlo[i][0],vlo[i][1],vlo[i][2],vlo[i][3],vhi[i][0],vhi[i][1],vhi[i][2],vhi[i][3]}
  #define PIN(x) asm volatile("":"+v"(x))
  #define MX3(a,b,c) __builtin_fmaxf(__builtin_fmaxf((a),(b)),(c))
  #define GAPA(MF,A0,A1,A2,A3,W0,W1,PW) do{ MF; sacc+=A0; sacc+=A1; sacc+=A2; sacc+=A3; PIN(sacc); W0; W1; PIN(PW); SBAR(); }while(0)
  #define EX(v) __builtin_amdgcn_exp2f(v)
  #define GAPB(MF,X,B) do{ MF; X[B]=EX(X[B]); X[B+1]=EX(X[B+1]); X[B+2]=EX(X[B+2]); X[B+3]=EX(X[B+3]); PIN(X); SBAR(); }while(0)
  #define VRD(i) do{ vlo[i]=vtr(vp_+(((i)>>2)*4096+((i)&3)*1024)); vhi[i]=vtr(vp_+(((i)>>2)*4096+((i)&3)*1024+512)); }while(0)
  #define KRD(G,j) do{ if(G){ kload2(kf,kp0+sl_next,j); SBAR(); } }while(0)
  #define STEP(C0,C1,P0,P1,t,GK,GV,GL) do{ SBAR(); \
    const lds_cptr vp_=vp0+sl_prev; \
    VRD(0); SBAR(); float sacc=(P0[0]+P0[1]); \
    GAPA(C0=__builtin_amdgcn_mfma_f32_32x32x16_bf16(kf[0],qr[0],negm,0,0,0), P0[2],P0[3],P0[4],P0[5],     pw0[0]=PKW(P0,0), pw0[1]=PKW(P0,2), pw0); \
    VRD(4); SBAR(); GAPA(C1=__builtin_amdgcn_mfma_f32_32x32x16_bf16(kf[1],qr[0],negm,0,0,0), P0[6],P0[7],P0[8],P0[9],     pw0[2]=PKW(P0,4), pw0[3]=PKW(P0,6), pw0); \
    VRD(1); SBAR(); GAPA(C0=__builtin_amdgcn_mfma_f32_32x32x16_bf16(kf[2],qr[1],C0,0,0,0),   P0[10],P0[11],P0[12],P0[13], pw1[0]=PKW(P0,8), pw1[1]=PKW(P0,10), pw1); \
    VRD(5); SBAR(); GAPA(C1=__builtin_amdgcn_mfma_f32_32x32x16_bf16(kf[3],qr[1],C1,0,0,0),   P0[14],P0[15],P1[0],P1[1],   pw1[2]=PKW(P0,12),pw1[3]=PKW(P0,14), pw1); \
    VRD(2); SBAR(); GAPA(C0=__builtin_amdgcn_mfma_f32_32x32x16_bf16(kf[4],qr[2],C0,0,0,0),   P1[2],P1[3],P1[4],P1[5],     pw2[0]=PKW(P1,0), pw2[1]=PKW(P1,2), pw2); \
    VRD(6); SBAR(); GAPA(C1=__builtin_amdgcn_mfma_f32_32x32x16_bf16(kf[5],qr[2],C1,0,0,0),   P1[6],P1[7],P1[8],P1[9],     pw2[2]=PKW(P1,4), pw2[3]=PKW(P1,6), pw2); \
    VRD(3); SBAR(); GAPA(C0=__builtin_amdgcn_mfma_f32_32x32x16_bf16(kf[6],qr[3],C0,0,0,0),   P1[10],P1[11],P1[12],P1[13], pw3[0]=PKW(P1,8), pw3[1]=PKW(P1,10), pw3); \
    VRD(7); SBAR(); GAPA(C1=__builtin_amdgcn_mfma_f32_32x32x16_bf16(kf[7],qr[3],C1,0,0,0),   P1[14],P1[15],0.f,0.f,       pw3[2]=PKW(P1,12),pw3[3]=PKW(P1,14), pw3); \
    l_reg+=sacc; \
    if(GK){DMA_K((t)+3,sl_cur);} if(GV){DMA_V((t)+1,sl_next);} \
    CMASK(C0,C1,t); \
    { float a=MX3(C0[0],C0[1],C1[0]),b=MX3(C0[2],C0[3],C1[1]); a=MX3(a,C1[2],C1[3]); \
      _Pragma("unroll") for(int r=4;r<16;r+=4){a=MX3(a,C0[r],C0[r+1]);b=MX3(b,C0[r+2],C0[r+3]);a=MX3(a,C1[r],C1[r+1]);b=MX3(b,C1[r+2],C1[r+3]);} \
      float rm=__builtin_fmaxf(a,b); { auto rr=__builtin_amdgcn_permlane32_swap(__float_as_uint(rm),__float_as_uint(rm),false,false); rm=__builtin_fmaxf(__uint_as_float(rr[0]),__uint_as_float(rr[1])); } \
      resc=false; \
      if(__builtin_expect(__any(rm>(float)THRL),0)){ const float dl=__builtin_fmaxf(rm,0.f); mhat+=dl; \
        _Pragma("unroll") for(int r=0;r<16;++r){C0[r]-=dl;C1[r]-=dl;} \
        _Pragma("unroll") for(int r=0;r<16;++r)negm[r]=-mhat; asm volatile("":"+v"(negm)); \
        const float f=__builtin_amdgcn_exp2f(-dl); l_reg*=f; if(hi==0)wsf[r32]=f; resc=true; } } \
    SBAR(); \
    GAPB(o[0]=__builtin_amdgcn_mfma_f32_32x32x16_bf16(PAF(0),VFR(0),o[0],0,0,0), C0,0); \
    GAPB(o[1]=__builtin_amdgcn_mfma_f32_32x32x16_bf16(PAF(0),VFR(4),o[1],0,0,0), C0,4); \
    KRD(GL,0); GAPB(o[0]=__builtin_amdgcn_mfma_f32_32x32x16_bf16(PAF(1),VFR(1),o[0],0,0,0), C0,8); \
    KRD(GL,1); GAPB(o[1]=__builtin_amdgcn_mfma_f32_32x32x16_bf16(PAF(1),VFR(5),o[1],0,0,0), C0,12); \
    KRD(GL,2); GAPB(o[0]=__builtin_amdgcn_mfma_f32_32x32x16_bf16(PAF(2),VFR(2),o[0],0,0,0), C1,0); \
    KRD(GL,3); GAPB(o[1]=__builtin_amdgcn_mfma_f32_32x32x16_bf16(PAF(2),VFR(6),o[1],0,0,0), C1,4); \
    GAPB(o[0]=__builtin_amdgcn_mfma_f32_32x32x16_bf16(PAF(3),VFR(3),o[0],0,0,0), C1,8); \
    GAPB(o[1]=__builtin_amdgcn_mfma_f32_32x32x16_bf16(PAF(3),VFR(7),o[1],0,0,0), C1,12); \
    }while(0)
  int t=1;
  #undef CMASK
  #define CMASK(P0,P1,t) PMASK(P0,P1,t)
  for(;t+5<NT;t+=2){
    STEP(pB0,pB1,pA0,pA1,t,true,true,true);     WAIT_BAR(2); RESC(); ROT();
    STEP(pA0,pA1,pB0,pB1,t+1,true,true,true);   WAIT_BAR(2); RESC(); ROT();
  }
  #undef CMASK
  #define CMASK(P0,P1,t) do{int jb_=(t)-(NT-4); if(jb_>=0)cmask(P0,P1,jb_,qrel,hi); else PMASK(P0,P1,t);}while(0)
  #define ENDW(tt) do{ if((tt)+3<NT){WAIT_BAR(2);} else if((tt)+2<NT){WAIT_BAR(1);} else {WAIT_BAR(0);} }while(0)
  for(;t+1<NT;t+=2){
    STEP(pB0,pB1,pA0,pA1,t,(t+3<NT),(t+1<NT),(t+1<NT));       ENDW(t);   RESC(); ROT();
    STEP(pA0,pA1,pB0,pB1,t+1,(t+4<NT),(t+2<NT),(t+2<NT));     ENDW(t+1); RESC(); ROT();
  }
  STEP(pB0,pB1,pA0,pA1,NT-1,false,false,false); RESC();
  { float sacc=pB0[0]+pB0[1]; _Pragma("unroll") for(int r=2;r<16;++r)sacc+=pB0[r]; _Pragma("unroll") for(int r=0;r<16;++r)sacc+=pB1[r]; l_reg+=sacc;
    pw0=(u32x4){PKW(pB0,0),PKW(pB0,2),PKW(pB0,4),PKW(pB0,6)};pw1=(u32x4){PKW(pB0,8),PKW(pB0,10),PKW(pB0,12),PKW(pB0,14)};pw2=(u32x4){PKW(pB1,0),PKW(pB1,2),PKW(pB1,4),PKW(pB1,6)};pw3=(u32x4){PKW(pB1,8),PKW(pB1,10),PKW(pB1,12),PKW(pB1,14)};
    SBAR(); pv(o,vb0+sl_cur,PAF(0),PAF(1),PAF(2),PAF(3)); }
  #undef PKW
  #undef PAF
  #undef VFR
  #undef PIN
  #undef MX3
  #undef GAPA
  #undef GAPB
  #undef EX
  #undef VRD
  #undef KRD
  #undef STEP
  #undef ENDW
  {auto rr=__builtin_amdgcn_permlane32_swap(__float_as_uint(l_reg),__float_as_uint(l_reg),false,false);l_reg=__uint_as_float(rr[0])+__uint_as_float(rr[1]);}
  if(hi==0)wsf[32+r32]=l_reg;asm volatile("s_waitcnt lgkmcnt(0)":::"memory");
  float rli[16];
  #pragma unroll
  for(int r=0;r<16;++r)rli[r]=__builtin_amdgcn_rcpf(wsf[32+crow(r,hi)]);
  bf16*Ow=O+(rowbase+q0+wid*QBLK)*POUT+h*D;
  { bf16*stg=(bf16*)(shm+LDS_OST)+wid*2048;
    #pragma unroll
    for(int r=0;r<16;++r){const int orow=crow(r,hi);
      #pragma unroll
      for(int d0=0;d0<2;++d0)stg[orow*64+d0*32+r32]=__float2bfloat16(o[d0][r]*rli[r]);}
    asm volatile("s_waitcnt lgkmcnt(0)":::"memory");
    #pragma unroll
    for(int i=0;i<4;++i){const int row=i*8+(lane>>3),ch=lane&7; const u32x4 v=*(const u32x4*)(stg+row*64+ch*8); ATTN_STORE16(Ow+(long)row*POUT+ch*8,v);} }
  asm volatile("s_waitcnt lgkmcnt(0)\n\ts_barrier":::"memory");
  #undef DMA_K
  #undef DMA_V
  #undef CMASK
  #undef PMASK
  #undef START
  #undef RESC
  #undef ROT
}
constexpr int ATTN_LDS_BYTES=LDS_BYTES;
#undef SBAR
#undef WAIT_BAR
}

typedef float f32x16 __attribute__((ext_vector_type(16)));
__device__ __forceinline__ void sb_unit(const Args& a, int bh, int qb) {
    int tid = threadIdx.x; asm volatile("" : "+v"(tid));
    const int lane = tid & 63, wid = tid >> 6, r32 = lane & 31, hh = lane >> 5;
    const int b = bh >> 2, h = bh & 3;
    unsigned char* ws = a.ws;
    const bf16* PM = (const bf16*)(ws + WS_PM); bf16* PMo = (bf16*)(ws + WS_PM);
    const size_t rowb = (size_t)b * SEQ;
    const int t0 = qb * 256 + wid * 32, t = t0 + r32;
    const bf16* Kb = PM + rowb * PMW + C_SB + 256 + h * 64; const bf16* Vb = PM + rowb * PMW + C_SB + 512 + h * 64;
    bf16x8 qf[4];
    { const bf16* qp = PM + (rowb + t) * PMW + C_SB + h * 64 + 8 * hh;
#pragma unroll
        for (int ks = 0; ks < 4; ++ks) { const u32x4 x = *(const u32x4*)(qp + 16 * ks); u32x4 y;
            y.x = cvt_pk_bf16(bflo(x.x) * 0.125f, bfhi(x.x) * 0.125f); y.y = cvt_pk_bf16(bflo(x.y) * 0.125f, bfhi(x.y) * 0.125f);
            y.z = cvt_pk_bf16(bflo(x.z) * 0.125f, bfhi(x.z) * 0.125f); y.w = cvt_pk_bf16(bflo(x.w) * 0.125f, bfhi(x.w) * 0.125f); qf[ks] = __builtin_bit_cast(bf16x8, y); } }
    f32x16 o0, o1;
#pragma unroll
    for (int i = 0; i < 16; ++i) { o0[i] = 0.f; o1[i] = 0.f; }
    float carry = 0.f;
    bf16x8 kn[4]; unsigned vn[2][2][8];
#define SB_LOAD(kt_) do { const int s0_ = (kt_) * 32; const bf16* kp_ = Kb + (size_t)(s0_ + r32) * PMW + 8 * hh; \
        _Pragma("unroll") for (int ks_ = 0; ks_ < 4; ++ks_) kn[ks_] = *(const bf16x8*)(kp_ + 16 * ks_); \
        const bf16* vp_ = Vb + (size_t)(s0_ + 4 * hh) * PMW + r32; \
        _Pragma("unroll") for (int s_ = 0; s_ < 2; ++s_) _Pragma("unroll") for (int j_ = 0; j_ < 8; ++j_) { const int k0_ = 16 * s_ + 8 * (j_ >> 2) + (j_ & 3); vn[0][s_][j_] = vp_[(size_t)k0_ * PMW]; vn[1][s_][j_] = vp_[(size_t)k0_ * PMW + 32]; } } while (0)
    SB_LOAD(t0 >> 5);
    for (int kt = t0 >> 5; kt >= 0; --kt) {
        const int s0 = kt * 32;
        f32x16 z;
#pragma unroll
        for (int i = 0; i < 16; ++i) z[i] = 0.f;
        bf16x8 kf[4];
#pragma unroll
        for (int ks = 0; ks < 4; ++ks) kf[ks] = kn[ks];
        unsigned vw[2][2][4];
#pragma unroll
        for (int nt = 0; nt < 2; ++nt)
#pragma unroll
            for (int s_ = 0; s_ < 2; ++s_)
#pragma unroll
                for (int jp = 0; jp < 4; ++jp) vw[nt][s_][jp] = vn[nt][s_][2 * jp] | (vn[nt][s_][2 * jp + 1] << 16);
        if (kt > 0) SB_LOAD(kt - 1);
#pragma unroll
        for (int ks = 0; ks < 4; ++ks) z = __builtin_amdgcn_mfma_f32_32x32x16_bf16(kf[ks], qf[ks], z, 0, 0, 0);
        float ls[16], ln[16];
#pragma unroll
        for (int i = 0; i < 16; ++i) { const int key = s0 + (i & 3) + 8 * (i >> 2) + 4 * hh; const bool ok = key < t; const float zz = z[i];
            const float l1p = __logf(1.0f + __expf(-fabsf(zz)));
            ls[i] = ok ? (fminf(zz, 0.f) - l1p) : -INFINITY; ln[i] = ok ? (fminf(-zz, 0.f) - l1p) : 0.f; }
        float gs[4], pg[4];
#pragma unroll
        for (int m = 0; m < 4; ++m) { gs[m] = (ln[4 * m] + ln[4 * m + 1]) + (ln[4 * m + 2] + ln[4 * m + 3]); pg[m] = __shfl_xor(gs[m], 32); }
        float T[4]; T[3] = 0.f; T[2] = gs[3] + pg[3]; T[1] = T[2] + (gs[2] + pg[2]); T[0] = T[1] + (gs[1] + pg[1]);
        const float total = T[0] + (gs[0] + pg[0]);
        float att[16];
#pragma unroll
        for (int m = 0; m < 4; ++m) { float cb = carry + T[m] + (hh == 0 ? pg[m] : 0.f);
#pragma unroll
            for (int e = 3; e >= 0; --e) { att[4 * m + e] = __expf(ls[4 * m + e] + cb); cb += ln[4 * m + e]; } }
        carry += total;
#pragma unroll
        for (int s_ = 0; s_ < 2; ++s_) { u32x4 aw; aw.x = cvt_pk_bf16(att[8 * s_], att[8 * s_ + 1]); aw.y = cvt_pk_bf16(att[8 * s_ + 2], att[8 * s_ + 3]); aw.z = cvt_pk_bf16(att[8 * s_ + 4], att[8 * s_ + 5]); aw.w = cvt_pk_bf16(att[8 * s_ + 6], att[8 * s_ + 7]);
            const bf16x8 af = __builtin_bit_cast(bf16x8, aw);
            o0 = __builtin_amdgcn_mfma_f32_32x32x16_bf16(af, __builtin_bit_cast(bf16x8, (u32x4){vw[0][s_][0], vw[0][s_][1], vw[0][s_][2], vw[0][s_][3]}), o0, 0, 0, 0);
            o1 = __builtin_amdgcn_mfma_f32_32x32x16_bf16(af, __builtin_bit_cast(bf16x8, (u32x4){vw[1][s_][0], vw[1][s_][1], vw[1][s_][2], vw[1][s_][3]}), o1, 0, 0, 0); }
        if (__all(carry < -110.f)) break;
    }
#undef SB_LOAD
    bf16* yp = PMo + (rowb + t0 + 4 * hh) * PMW + C_SB + h * 64 + r32;
#pragma unroll
    for (int i = 0; i < 16; ++i) { const size_t ro = (size_t)((i & 3) + 8 * (i >> 2)) * PMW; yp[ro] = (bf16)f2bf(o0[i]); yp[ro + 32] = (bf16)f2bf(o1[i]); }
}

__device__ __forceinline__ void phase_e(const Args& a, int layer_rep, LAS unsigned char* lds, volatile LAS unsigned* MISC, int vb) {
    const int layer = layer_rep & 1;
    LAS float* L = (LAS float*)lds;
    unsigned* work = (unsigned*)(a.ws + WS_CTL) + CW_WORK + 64 * layer_rep;
    for (int c = vb; c < 64; c += (int)gridDim.x) { if (c < 32) rwkv_chain(a, layer, c, lds); else hgrn_chain(a, layer, c - 32, (LAS unsigned char*)L); }
    for (;;) {
        __syncthreads();
        if (threadIdx.x == 0) MISC[0] = __hip_atomic_fetch_add(work, 1u, __ATOMIC_RELAXED, __HIP_MEMORY_SCOPE_AGENT);
        __syncthreads();
        const unsigned u = (unsigned)__builtin_amdgcn_readfirstlane((int)MISC[0]);
        if (u >= 1024u + NWU) break;
        if (u < NWU) { int tl = threadIdx.x; asm volatile("" : "+v"(tl)); const int wv = tl >> 6, ln = tl & 63; LAS float* scr = (LAS float*)(lds + wv * 16384);
#pragma unroll 1
            for (int it = (int)u * 32 + wv; it < (int)(u + 1u) * 32; it += 8) late_weight_item(a, layer, it, scr, ln); }
        else if (u < NWU + 512u) { const unsigned v = u - NWU; const int bh = (int)(v & 31u), qb = 15 - (int)(v >> 5); const moba_body::bf16* pm = (const moba_body::bf16*)(a.ws + WS_PM);
            moba_body::attn_unit<8>(bh >> 2, bh & 3, qb, pm + C_MB, pm + C_MB + 256, pm + C_MB + 512, (moba_body::bf16*)(a.ws + WS_PM) + C_MB, (const float*)(a.ws + WS_KMP), (char*)lds); }
        else { const unsigned v = u - NWU - 512u; sb_unit(a, (int)(v & 31u), 15 - (int)(v >> 5)); }
    }
}

#if MK_ONE_LAUNCH
#define SEAM() xcd_barrier(bar)
#else
#define SEAM() do {} while (0)
#endif
#define IN(k) (lo <= (k) && (k) < hi)
#define BOTH(k) (IN(k) && IN((k) + 1))
template <int LAYER>
__device__ __forceinline__ void layer_phases(const Args& args, LAS unsigned char* lds, volatile LAS unsigned* MISC, const XcdBarrier& bar, int lo, int hi, int vb0, int G0) {
    constexpr int layer = LAYER;
    unsigned char* ws = args.ws;
    float* xres = args.out;
        const int pb = layer * PPL;
        const float* xin = layer ? (const float*)args.out : args.in[I_X];
        const char* Wb = (const char*)(ws + WS_W);
        if (IN(pb + 0)) { const int vb = opaque_s(vb0), G = opaque_s(G0); for (int rep = 0; rep < (REPEAT_PH == 0 ? 2 : 1); ++rep) { phase_a(args, layer, xin, lds, vb, G); if (rep == 0 && REPEAT_PH == 0) SEAM(); } if (BOTH(pb + 0)) SEAM(); }
        if (IN(pb + 1)) { const int vb = opaque_s(vb0), G = opaque_s(G0);
            pg8::PlainOrder S{LAYER == 0 ? (const char*)(ws + WS_H) : (const char*)xres, Wb + W_IN, 2048u, 2048u, 16, 128, 14, G, vb};
            pg8::EpiBf16S E{(bf16*)(ws + WS_PM), PMW, (const float*)(ws + WS_RSQ1), lds};
            for (int rep = 0; rep < (REPEAT_PH == 1 ? 2 : 1); ++rep) { pg8::gemm_phase<pg8::EpiBf16S, pg8::PlainOrder, true>(lds, S, E); if (rep == 0 && REPEAT_PH == 1) SEAM(); }
            if (BOTH(pb + 1)) SEAM();
        }
        if (IN(pb + 2)) { const int vb = opaque_s(vb0), G = opaque_s(G0); for (int rep = 0; rep < (REPEAT_PH == 2 ? 2 : 1); ++rep) { phase_c(args, layer, lds, vb, G); if (rep == 0 && REPEAT_PH == 2) SEAM(); } if (BOTH(pb + 2)) SEAM(); }
        if (IN(pb + 3)) { const int vb = opaque_s(vb0), G = opaque_s(G0);
            pg8::LoraOrder S{(const char*)(ws + WS_LA), Wb + W_L, Wb + W_V, layer ? 4 : 3, G, vb};
            pg8::EpiBf16 E{(bf16*)(ws + WS_LO), 1024};
            for (int rep = 0; rep < (REPEAT_PH == 3 ? 2 : 1); ++rep) { pg8::gemm_phase<pg8::EpiBf16, pg8::LoraOrder, true>(lds, S, E); if (rep == 0 && REPEAT_PH == 3) SEAM(); }
            if (BOTH(pb + 3)) SEAM();
        }
        if (IN(pb + 4)) { const int vb = opaque_s(vb0), G = opaque_s(G0); for (int rep = 0; rep < (REPEAT_PH == 4 ? 2 : 1); ++rep) { phase_d2(args, layer, vb, G); if (rep == 0 && REPEAT_PH == 4) SEAM(); } if (BOTH(pb + 4)) SEAM(); }
        if (IN(pb + 5)) { const int vb = opaque_s(vb0); for (int rep = 0; rep < (REPEAT_PH == 5 ? 2 : 1); ++rep) { phase_e(args, layer + 2 * rep, lds, MISC, vb); if (rep == 0 && REPEAT_PH == 5) SEAM(); } if (BOTH(pb + 5)) SEAM(); }
        if (IN(pb + 6)) { const int vb = opaque_s(vb0), G = opaque_s(G0); for (int rep = 0; rep < (REPEAT_PH == 6 ? 2 : 1); ++rep) { phase_e2(args, layer, vb, G); if (rep == 0 && REPEAT_PH == 6) SEAM(); } if (BOTH(pb + 6)) SEAM(); }
        if (IN(pb + 7)) { const int vb = opaque_s(vb0), G = opaque_s(G0);
            pg8::MergeOrder S{LAYER == 0 ? (const char*)(ws + WS_H) : (const char*)xres, (const char*)(ws + WS_PM), Wb + W_IN + (size_t)PMW * 2048, Wb + W_B, G, vb};
            pg8::EpiMerge E{(u32x4*)(ws + WS_LA) + (size_t)vb * 8192, (bf16*)(ws + WS_LO), (const float*)(ws + WS_RSQ1), lds};
            for (int rep = 0; rep < (REPEAT_PH == 7 ? 2 : 1); ++rep) { pg8::gemm_phase<pg8::EpiMerge, pg8::MergeOrder, true>(lds, S, E); if (rep == 0 && REPEAT_PH == 7) SEAM(); }
            if (BOTH(pb + 7)) SEAM();
        }
        if (IN(pb + 8)) { const int vb = opaque_s(vb0), G = opaque_s(G0);
            pg8::PlainOrder S{(const char*)(ws + WS_LO), Wb + W_O, 2048u, 2048u, 16, 128, 4, G, vb};
            pg8::EpiResNorm<true, LAYER != 0, true> E{(const void*)xin, LAYER == 0 ? (void*)xres : (void*)(ws + WS_H), (float*)(ws + WS_RSQ2), lds};
            pg8::gemm_phase<pg8::EpiResNorm<true, LAYER != 0, true>, pg8::PlainOrder, true>(lds, S, E);
            if (BOTH(pb + 8)) SEAM();
        }
        if (IN(pb + 10)) { const int vb = opaque_s(vb0), G = opaque_s(G0);
            pg8::PlainOrder S{LAYER == 0 ? (const char*)xres : (const char*)(ws + WS_H), Wb + W_GU, 2048u, 2048u, 16, 128, 22, G, vb};
            pg8::EpiSwiGLU E{(bf16*)(ws + WS_PM), (const float*)(ws + WS_RSQ2), lds};
            for (int rep = 0; rep < (REPEAT_PH == 10 ? 2 : 1); ++rep) { pg8::gemm_phase<pg8::EpiSwiGLU, pg8::PlainOrder, true>(lds, S, E); if (rep == 0 && REPEAT_PH == 10) SEAM(); }
            if (BOTH(pb + 10)) SEAM();
        }
        if (IN(pb + 11)) { const int vb = opaque_s(vb0), G = opaque_s(G0);
            pg8::PlainOrder S{(const char*)(ws + WS_PM), Wb + W_D, (unsigned)(DFF * 2), (unsigned)(DFF * 2), DFF / 64, 128, 4, G, vb};
            if constexpr (LAYER == 0) { pg8::EpiResNorm<true, true, true> E{(const void*)xres, (void*)xres, (float*)(ws + WS_RSQ1), lds};
                pg8::gemm_phase<pg8::EpiResNorm<true, true, true>, pg8::PlainOrder, true>(lds, S, E); }
            else { pg8::EpiResFinal E{(const bf16*)(ws + WS_H), xres, args.in[I_FG], (float*)(ws + WS_RSQ1), (unsigned*)(ws + WS_CTL) + CW_XCH, lds};
                pg8::gemm_phase<pg8::EpiResFinal, pg8::PlainOrder, true>(lds, S, E); }
            if (BOTH(pb + 11)) SEAM();
        }
}

__global__ void __launch_bounds__(512, 2) skel_fwd(Args args) {
    extern __shared__ __attribute__((aligned(16))) unsigned char lds_raw[];
    LAS unsigned char* lds = (LAS unsigned char*)lds_raw;
    volatile LAS unsigned* MISC = (volatile LAS unsigned*)(lds + MISC_OFF);
    const int tid = threadIdx.x;
    const int G0 = gridDim.x, vb0 = blockIdx.x;
    unsigned char* ws = args.ws;
    unsigned* ctl = (unsigned*)(ws + WS_CTL);
    for (int u = tid; u < (LDS_BYTES - LDSCTL_OFF) / 4; u += 512) ((LAS unsigned*)(lds + LDSCTL_OFF))[u] = 0u;
    __syncthreads();
#if MK_ONE_LAUNCH
    XcdBarrier bar = xcd_barrier_post(ctl + CW_BAR, MISC + 8);
#else
    XcdBarrier bar; bar.bar = ctl + CW_BAR; bar.x = 0; bar.st = MISC + 8;
#endif
    const int lo = args.ph_lo, hi = args.ph_hi;
    float* xres = args.out;
    layer_phases<0>(args, lds, MISC, bar, lo, hi, vb0, G0);
    layer_phases<1>(args, lds, MISC, bar, lo, hi, vb0, G0);
#undef IN
#undef BOTH
#undef SEAM
}

extern "C" void kernel_launch(void* const* d_in, const int* in_sizes, int n_in, void* d_out, int out_size, void* d_ws, size_t ws_size, hipStream_t stream) {
    static int grid = 0;
    if (grid == 0) {
        if (n_in != 26 || in_sizes[0] != M * D || out_size != M * D || ws_size < WS_END) { fprintf(stderr, "kernel_launch: unexpected shapes (n_in %d, in0 %d, out %d, ws %zu); nothing launched\n", n_in, n_in > 0 ? in_sizes[0] : -1, out_size, ws_size); grid = -1; return; }
        int dev = 0, cus = 0, per_cu = 0;
        if (hipGetDevice(&dev) != hipSuccess || hipDeviceGetAttribute(&cus, hipDeviceAttributeMultiprocessorCount, dev) != hipSuccess) { grid = -1; return; }
        if (hipFuncSetAttribute((const void*)skel_fwd, hipFuncAttributeMaxDynamicSharedMemorySize, LDS_BYTES) != hipSuccess) { fprintf(stderr, "kernel_launch: hipFuncSetAttribute failed\n"); grid = -1; return; }
        if (hipOccupancyMaxActiveBlocksPerMultiprocessor(&per_cu, (const void*)skel_fwd, 512, LDS_BYTES) != hipSuccess || per_cu < 1) fprintf(stderr, "kernel_launch: occupancy query reports %d\n", per_cu);
        (void)hipGetLastError();
        grid = cus;
    }
    if (grid < 0) return;
    if (hipMemsetAsync((char*)d_ws + WS_CTL, 0, CTL_ZERO_BYTES, stream) != hipSuccess) return;
    Args a{};
    for (int i = 0; i < 26; ++i) a.in[i] = (const float*)d_in[i];
    a.out = (float*)d_out; a.ws = (unsigned char*)d_ws;
#if MK_ONE_LAUNCH
    a.ph_lo = 0; a.ph_hi = NPH;
    hipLaunchKernelGGL(skel_fwd, dim3(grid), dim3(512), LDS_BYTES, stream, a);
#else
    for (int p = 0; p < NPH; ++p) { a.ph_lo = p; a.ph_hi = p + 1; hipLaunchKernelGGL(skel_fwd, dim3(grid), dim3(512), LDS_BYTES, stream, a); }
#endif
}
```

```cpp
#include <hip/hip_runtime.h>
#include <cstdio>
#include <cstdint>

#ifndef REPEAT_PH
#define REPEAT_PH -1
#endif
#ifndef MK_ONE_LAUNCH
#define MK_ONE_LAUNCH 1
#endif

#define LAS __attribute__((address_space(3)))
#define GAS __attribute__((address_space(1)))
typedef unsigned short bf16;
typedef short bf16x8 __attribute__((ext_vector_type(8)));
typedef float f32x4 __attribute__((ext_vector_type(4)));
typedef float f32x2 __attribute__((ext_vector_type(2)));
typedef unsigned u32x4 __attribute__((ext_vector_type(4)));
typedef unsigned u32x2 __attribute__((ext_vector_type(2)));

constexpr int D = 1024, NBATCH = 8, SEQ = 4096, M = NBATCH * SEQ, DFF = 2816, NH = 4, HD = 64, MW = 256;
constexpr int PMW = 3584;
constexpr int C_SB = 0, C_RW = 768, C_MB = 1792, C_HG = 2560;
constexpr int PPL = 12, NPH = 2 * PPL;

constexpr size_t MiB = 1u << 20;
constexpr size_t WS_CTL = 0, CTL_ZERO_BYTES = 1 * MiB;
constexpr size_t WS_ROPE = 1 * MiB;
constexpr size_t WS_KMP = 1 * MiB + 512 * 1024;
constexpr size_t WS_BON = 2 * MiB;
constexpr size_t WS_RSQ1 = 2 * MiB + 512 * 1024;
constexpr size_t WS_RSQ2 = 3 * MiB;
constexpr size_t WS_W = 4 * MiB;
constexpr size_t W_IN = 0, W_B = 15728640, W_O = W_B + 2097152, W_GU = W_O + 2097152, W_D = W_GU + 11534336, W_L = W_D + 5767168, W_V = W_L + 393216, W_END = W_V + 131072;
static_assert(W_END == 36 * MiB, "weights");
constexpr size_t WS_H = 40 * MiB;
constexpr size_t WS_PM = 104 * MiB;
constexpr size_t WS_LA = 328 * MiB;
constexpr size_t RS_ENTRY = 13056;
constexpr size_t WS_RS = 328 * MiB;
constexpr size_t WS_XF = 328 * MiB;
constexpr size_t WS_LO = 432 * MiB;
constexpr size_t WS_VF = 496 * MiB;
constexpr size_t WS_END = 512 * MiB;
static_assert(WS_RS + 8192 * RS_ENTRY <= WS_LO, "rwkv chunk stream");
constexpr int CW_TMO = 0;
constexpr int CW_BAR = 4096;
constexpr int CW_XCH = 32768;
constexpr int CW_WORK = 16384;

constexpr int RING_BYTES = 131072;
constexpr int LDSCTL_OFF = RING_BYTES, MISC_OFF = LDSCTL_OFF + 320;
constexpr int LDS_XP = RING_BYTES + 1024, LDS_RSL = LDS_XP + 4096;
constexpr int LDS_BYTES = 147456;

__device__ __forceinline__ unsigned f2bf(float f) { unsigned u = __builtin_bit_cast(unsigned, f); return (u + 0x7fffu + ((u >> 16) & 1u)) >> 16; }
__device__ __forceinline__ unsigned pk2(float lo, float hi) { return f2bf(lo) | (f2bf(hi) << 16); }
__device__ __forceinline__ float bf2f(unsigned short b) { return __builtin_bit_cast(float, ((unsigned)b) << 16); }
__device__ __forceinline__ float bflo(unsigned w) { return __builtin_bit_cast(float, w << 16); }
__device__ __forceinline__ float bfhi(unsigned w) { return __builtin_bit_cast(float, w & 0xffff0000u); }
typedef __bf16 bf16x2_t __attribute__((ext_vector_type(2)));
__device__ __forceinline__ unsigned cvt_pk_bf16(float lo, float hi) { f32x2 v = {lo, hi}; bf16x2_t b = __builtin_convertvector(v, bf16x2_t); return __builtin_bit_cast(unsigned, b); }
__device__ __forceinline__ float wave_sum(float v) {
#pragma unroll
    for (int o = 1; o < 64; o <<= 1) v += __shfl_xor(v, o);
    return v;
}
__device__ __forceinline__ float sigmoidf_(float x) { return __builtin_amdgcn_rcpf(1.0f + __expf(-x)); }
#define LDS_WAIT() asm volatile("s_waitcnt lgkmcnt(0)" ::: "memory")
#define LBAR() do { asm volatile("s_waitcnt lgkmcnt(0)" ::: "memory"); __builtin_amdgcn_s_barrier(); asm volatile("" ::: "memory"); } while (0)
__device__ __forceinline__ f32x4 ld4bf(const bf16* p) { const u32x2 w = *(const u32x2*)p; return (f32x4){bflo(w.x), bfhi(w.x), bflo(w.y), bfhi(w.y)}; }
__device__ __forceinline__ float dpp_sum16(float x);
__device__ __forceinline__ int opaque_s(int v) { asm volatile("" : "+s"(v)); return v; }

__device__ __forceinline__ void st4bf(bf16* p, f32x4 v) { u32x2 w; w.x = cvt_pk_bf16(v.x, v.y); w.y = cvt_pk_bf16(v.z, v.w); *(u32x2*)p = w; }
__device__ __forceinline__ float dpp_sum16(float x) {
    x += __builtin_bit_cast(float, __builtin_amdgcn_update_dpp(0, __builtin_bit_cast(int, x), 0xB1, 0xF, 0xF, true));
    x += __builtin_bit_cast(float, __builtin_amdgcn_update_dpp(0, __builtin_bit_cast(int, x), 0x4E, 0xF, 0xF, true));
    x += __builtin_bit_cast(float, __builtin_amdgcn_update_dpp(0, __builtin_bit_cast(int, x), 0x141, 0xF, 0xF, true));
    x += __builtin_bit_cast(float, __builtin_amdgcn_update_dpp(0, __builtin_bit_cast(int, x), 0x140, 0xF, 0xF, true));
    return x;
}
__device__ __forceinline__ float dpp_xor2(float x) { int r; asm volatile("s_nop 1\n\tv_mov_b32_dpp %0, %1 quad_perm:[2,3,0,1] row_mask:0xf bank_mask:0xf\n\ts_nop 0" : "=&v"(r) : "v"(__builtin_bit_cast(int, x))); return __builtin_bit_cast(float, r); }
__device__ __forceinline__ float softplusf_(float x) { return fmaxf(x, 0.f) + __logf(1.0f + __expf(-fabsf(x))); }
#define XB_TMO      128
#define XB_XCNT(j)  (256  + 64 * (j))
#define XB_XSUB(j)  (1280 + 64 * (j))
#define XB_XGEN(j)  (2304 + 64 * (j))
#define XB_TOP      3328
#define XB_TOPGEN   3392
#define XCD_BAR_WORDS 3456
#define XB_SPIN_CAP (1u << 22)
__device__ __forceinline__ unsigned xb_ld(unsigned* p)              { return __hip_atomic_load(p, __ATOMIC_RELAXED, __HIP_MEMORY_SCOPE_AGENT); }
__device__ __forceinline__ unsigned xb_add(unsigned* p, unsigned v) { return __hip_atomic_fetch_add(p, v, __ATOMIC_RELAXED, __HIP_MEMORY_SCOPE_AGENT); }
__device__ __forceinline__ unsigned xb_xcc_id() { return (unsigned)__builtin_amdgcn_s_getreg((3 << 11) | 20) & 0xFu; }
#define XB_SPIN(cond, bar) do { unsigned _sp = 0; while (cond) { __builtin_amdgcn_s_sleep(1); \
    if ((++_sp & 255u) == 0u) { if (xb_ld(&(bar)[XB_TMO])) break; if (_sp > XB_SPIN_CAP) { atomicAdd(&(bar)[XB_TMO], 1u); break; } } } } while (0)
struct XcdBarrier { unsigned* bar; unsigned x; volatile LAS unsigned* st; };
__device__ __forceinline__ XcdBarrier xcd_barrier_post(unsigned* bar, volatile LAS unsigned* st) {
    XcdBarrier b; b.bar = bar; b.x = xb_xcc_id(); b.st = st;
    if (threadIdx.x == 0) (void)xb_add(&bar[XB_XCNT(b.x)], 1u);
    return b;
}
__device__ __forceinline__ void xcd_barrier_complete(unsigned* bar, unsigned x, unsigned& nloc, unsigned& nx) {
    const unsigned G = gridDim.x * gridDim.y * gridDim.z;
    unsigned sum, cnt, mine, sp = 0u;
    for (;;) {
        sum = 0u; cnt = 0u; mine = 0u;
#pragma unroll
        for (unsigned j = 0; j < 16; ++j) { const unsigned c = xb_ld(&bar[XB_XCNT(j)]); sum += c; cnt += (c > 0u) ? 1u : 0u; mine = (j == x) ? c : mine; }
        if (sum == G) break;
        __builtin_amdgcn_s_sleep(1);
        if ((++sp & 255u) == 0u) { if (xb_ld(&bar[XB_TMO])) break; if (sp > XB_SPIN_CAP) { atomicAdd(&bar[XB_TMO], 1u); break; } }
    }
    nloc = mine > 0u ? mine : 1u; nx = cnt > 0u ? cnt : 1u;
}
__device__ __forceinline__ void xcd_barrier(const XcdBarrier& b) {
    asm volatile("s_waitcnt vmcnt(0)" ::: "memory");
    __syncthreads();
    if (threadIdx.x == 0) {
        unsigned* bar = b.bar;
        __builtin_amdgcn_s_waitcnt(0);
        unsigned nloc = b.st[0], nx = b.st[1];
        if (nloc == 0u) { xcd_barrier_complete(bar, b.x, nloc, nx); b.st[0] = nloc; b.st[1] = nx; }
        const unsigned old = xb_add(&bar[XB_XSUB(b.x)], 1u);
        const unsigned gen = old / nloc;
        if (old + 1u == (gen + 1u) * nloc) {
            __builtin_amdgcn_fence(__ATOMIC_RELEASE, "agent");
            asm volatile("s_waitcnt vmcnt(0)" ::: "memory");
            const unsigned og = xb_add(&bar[XB_TOP], 1u);
            const unsigned tg = og / nx;
            if (og + 1u == (tg + 1u) * nx) xb_add(&bar[XB_TOPGEN], 1u);
            else XB_SPIN(xb_ld(&bar[XB_TOPGEN]) == tg, bar);
            __builtin_amdgcn_fence(__ATOMIC_ACQUIRE, "agent");
            xb_add(&bar[XB_XGEN(b.x)], 1u);
            asm volatile("s_waitcnt vmcnt(0)" ::: "memory");
        } else {
            XB_SPIN(xb_ld(&bar[XB_XGEN(b.x)]) == gen, bar);
            __builtin_amdgcn_fence(__ATOMIC_ACQUIRE, "agent");
            asm volatile("s_waitcnt vmcnt(0)" ::: "memory");
        }
    }
    __syncthreads();
}

namespace pg8 {
constexpr int BM = 256, BK = 64, HALF = 128, HTB = HALF * BK * 2, STAGE_BYTES = 8 * HTB, NXCD = 8, WGM = 8;
__host__ __device__ __forceinline__ int lds_byte(int r, int c) { const int st = (r >> 4) * 2 + (c >> 5), rr = r & 15, cc = c & 31, ob = rr * 64 + cc * 2; return st * 1024 + (ob ^ (((ob >> 9) & 1) << 5)); }
__host__ __device__ __forceinline__ void stage_rc(int b, int& R, int& C) { const int st = b / 1024, sb = b % 1024, swz = sb ^ (((sb >> 9) & 1) << 5); R = (st >> 1) * 16 + swz / 64; C = (st & 1) * 32 + (swz % 64) / 2; }
__host__ __device__ __forceinline__ int perm32(int rho) { const int n = rho >> 4, i = rho & 15; return 8 * (i >> 2) + 4 * n + (i & 3); }

struct GU { const char* a; const char* b; unsigned lda2, ldb2; int nt, pm, pn, sub; };

__device__ __forceinline__ void tile_of(int L, int nM, int nN, int& pm, int& pn) {
    const int nwg = nM * nN;
    int wgid = L; { const int q = nwg / NXCD, r = nwg % NXCD, xcd = wgid % NXCD, off = wgid / NXCD; wgid = (xcd < r ? xcd * (q + 1) : r * (q + 1) + (xcd - r) * q) + off; }
    const int nig = WGM * nN, gid = wgid / nig, fm = gid * WGM, gsz = (nM - fm) < WGM ? (nM - fm) : WGM;
    pm = fm + ((wgid % nig) % gsz); pn = (wgid % nig) / gsz;
}

template <class Epi, class Sched, bool ALIGN_EPI>
__device__ __forceinline__ void gemm_phase(LAS unsigned char* lds, const Sched& S, const Epi& E) {
    int tid = threadIdx.x; asm volatile("" : "+v"(tid));
    const int wid = __builtin_amdgcn_readfirstlane(tid >> 6), lane = tid & 63, wr = wid >> 2, wc = wid & 3, fr = lane & 15, fq = lane >> 4;
    unsigned Rr, Rb, C2;
    { int R, C; stage_rc(tid * 16, R, C); Rr = (unsigned)R; Rb = (unsigned)(Epi::PERM ? ((R & ~31) + perm32(R & 31)) : R); C2 = (unsigned)C * 2u; }
    const size_t kstep = (size_t)(BK * 2);
    const unsigned ldsw = (unsigned)wid * 1024u;
    const int aoff = lds_byte(wr * 64 + fr, fq * 8), boff = lds_byte(wc * 32 + fr, fq * 8);
#define PG8_SA(b, h) (((b) * 2 + (h)) * HTB)
#define PG8_SB(b, h) ((4 + (b) * 2 + (h)) * HTB)
#define PG8_STAGE(bufoff, gbase, R, ld) do { const unsigned _v0 = (R) * (ld) + C2; \
        __builtin_amdgcn_global_load_lds((const unsigned*)((const char*)(gbase) + _v0), (LAS unsigned*)(lds + (bufoff) + ldsw), 16, 0, 0); \
        __builtin_amdgcn_global_load_lds((const unsigned*)((const char*)(gbase) + _v0 + 64u * (ld)), (LAS unsigned*)(lds + (bufoff) + ldsw + 8192), 16, 0, 0); } while (0)
#define PG8_LDA(dst, b, h) do { _Pragma("unroll") for (int m = 0; m < 4; ++m) _Pragma("unroll") for (int k = 0; k < 2; ++k) dst[m][k] = *(const LAS bf16x8*)(lds + PG8_SA(b, h) + aoff + m * 2048 + k * 1024); } while (0)
#define PG8_LDB(dst, b, h) do { _Pragma("unroll") for (int n = 0; n < 2; ++n) _Pragma("unroll") for (int k = 0; k < 2; ++k) dst[n][k] = *(const LAS bf16x8*)(lds + PG8_SB(b, h) + boff + n * 2048 + k * 1024); } while (0)
#define PG8_MMA(ai, bj, At, Bt) do { __builtin_amdgcn_s_setprio(1); _Pragma("unroll") for (int m = 0; m < 4; ++m) _Pragma("unroll") for (int n = 0; n < 2; ++n) _Pragma("unroll") for (int k = 0; k < 2; ++k) \
        acc[ai][bj][m][n] = __builtin_amdgcn_mfma_f32_16x16x32_bf16(Bt[n][k], At[m][k], acc[ai][bj][m][n], 0, 0, 0); __builtin_amdgcn_s_setprio(0); } while (0)
#define PG8_WAIT_V(n) asm volatile("s_waitcnt vmcnt(" #n ")" ::: "memory")
#define PG8_WAIT_E() asm volatile("s_waitcnt vmcnt(%0)" :: "n"(8 + Epi::EOPS) : "memory")
#define PG8_PAIR(W1, W2, a1, a2, b2, a3, b3, xldA, xldB) do { \
              \
            PG8_LDB(B0, 0, 0); PG8_LDB(B1, 0, 1); PG8_SCHED; PG8_LDA(At, 0, 0); PG8_STAGE(PG8_SA(1, 1), (a1) + (size_t)HALF * ldA, Rr, ldA); \
            W1; PG8_WAIT_L(0); PG8_BAR; PG8_MMA(0, 0, At, B0); PG8_MMA(0, 1, At, B1); PG8_BAR; PG8_SCHED; \
              \
            PG8_LDA(At, 0, 1); PG8_STAGE(PG8_SB(0, 0), (b2), Rb, (xldB)); PG8_STAGE(PG8_SB(0, 1), (b2) + (size_t)HALF * (xldB), Rb, (xldB)); PG8_STAGE(PG8_SA(0, 0), (a2), Rr, (xldA)); \
            W2; PG8_WAIT_L(0); PG8_BAR; PG8_MMA(1, 0, At, B0); PG8_MMA(1, 1, At, B1); PG8_BAR; PG8_SCHED; \
              \
            PG8_LDB(B0, 1, 0); PG8_LDB(B1, 1, 1); PG8_SCHED; PG8_LDA(At, 1, 0); PG8_STAGE(PG8_SA(0, 1), (a2) + (size_t)HALF * (xldA), Rr, (xldA)); \
            PG8_WAIT_V(8); PG8_WAIT_L(0); PG8_BAR; PG8_MMA(0, 0, At, B0); PG8_MMA(0, 1, At, B1); PG8_BAR; PG8_SCHED; \
              \
            PG8_LDA(At, 1, 1); PG8_STAGE(PG8_SB(1, 0), (b3), Rb, (xldB)); PG8_STAGE(PG8_SB(1, 1), (b3) + (size_t)HALF * (xldB), Rb, (xldB)); PG8_STAGE(PG8_SA(1, 0), (a3), Rr, (xldA)); \
            PG8_WAIT_V(8); PG8_WAIT_L(0); PG8_BAR; PG8_MMA(1, 0, At, B0); PG8_MMA(1, 1, At, B1); PG8_BAR; PG8_SCHED; } while (0)
#define PG8_WAIT_L(n) asm volatile("s_waitcnt lgkmcnt(" #n ")" ::: "memory")
#define PG8_BAR __builtin_amdgcn_s_barrier()
#define PG8_SCHED __builtin_amdgcn_sched_barrier(0)
    GU cur, nxt; int ui = 0;
    if (!S.next(0, cur)) return;
    f32x4 acc[2][2][4][2];
#pragma unroll
    for (int a = 0; a < 2; ++a)
#pragma unroll
        for (int b = 0; b < 2; ++b)
#pragma unroll
            for (int m = 0; m < 4; ++m)
#pragma unroll
                for (int n = 0; n < 2; ++n) acc[a][b][m][n] = (f32x4){0.f, 0.f, 0.f, 0.f};
    bf16x8 At[4][2], B0[2][2], B1[2][2];
    const char* cA = cur.a; const char* cB = cur.b;
    unsigned ldA = cur.lda2, ldB = cur.ldb2;
    PG8_STAGE(PG8_SB(0, 0), cB, Rb, ldB); PG8_STAGE(PG8_SB(0, 1), cB + (size_t)HALF * ldB, Rb, ldB); PG8_STAGE(PG8_SA(0, 0), cA, Rr, ldA); PG8_STAGE(PG8_SA(0, 1), cA + (size_t)HALF * ldA, Rr, ldA);
    if (wr == 1) PG8_BAR;
    PG8_WAIT_V(2); PG8_BAR;
    PG8_STAGE(PG8_SB(1, 0), cB + kstep, Rb, ldB); PG8_STAGE(PG8_SA(1, 0), cA + kstep, Rr, ldA); PG8_STAGE(PG8_SB(1, 1), cB + (size_t)HALF * ldB + kstep, Rb, ldB);
    PG8_WAIT_V(6); PG8_BAR;
    PG8_PAIR(PG8_WAIT_V(8), PG8_WAIT_V(8), cA + kstep, cA + 2 * kstep, cB + 2 * kstep, cA + 3 * kstep, cB + 3 * kstep, ldA, ldB);
    for (;;) {
        const bool has_next = S.next(ui + 1, nxt);
        const char* nA = has_next ? nxt.a : cA; const char* nB = has_next ? nxt.b : cB;
        const unsigned nldA = has_next ? nxt.lda2 : ldA, nldB = has_next ? nxt.ldb2 : ldB;
        const int nt = cur.nt;
        for (int t = 2; t < nt; t += 2) {
            const bool last = (t == nt - 2);
            const char* a1 = cA + (size_t)(t + 1) * kstep;
            const char* a2 = last ? nA : cA + (size_t)(t + 2) * kstep; const char* b2 = last ? nB : cB + (size_t)(t + 2) * kstep;
            const char* a3 = a2 + kstep; const char* b3 = b2 + kstep;
            const unsigned xldA = last ? nldA : ldA, xldB = last ? nldB : ldB;
            PG8_PAIR(PG8_WAIT_V(8), PG8_WAIT_V(8), a1, a2, b2, a3, b3, xldA, xldB);
        }
        if constexpr (ALIGN_EPI) { if (wr == 0) PG8_BAR; }
        E(acc, cur, wr, wc, fr, fq);
        if (!has_next) break;
#pragma unroll
        for (int a = 0; a < 2; ++a)
#pragma unroll
            for (int b = 0; b < 2; ++b)
#pragma unroll
                for (int m = 0; m < 4; ++m)
#pragma unroll
                    for (int n = 0; n < 2; ++n) acc[a][b][m][n] = (f32x4){0.f, 0.f, 0.f, 0.f};
        cur = nxt; cA = nA; cB = nB; ldA = nldA; ldB = nldB; ++ui;
        if constexpr (ALIGN_EPI) { if (wr == 1) PG8_BAR; }
        PG8_PAIR(PG8_WAIT_E(), PG8_WAIT_E(), cA + kstep, cA + 2 * kstep, cB + 2 * kstep, cA + 3 * kstep, cB + 3 * kstep, ldA, ldB);
    }
    PG8_WAIT_V(0);
    if constexpr (!ALIGN_EPI) { if (wr == 0) PG8_BAR; }
    PG8_BAR;
#undef PG8_SA
#undef PG8_SB
#undef PG8_STAGE
#undef PG8_LDA
#undef PG8_LDB
#undef PG8_MMA
#undef PG8_WAIT_V
#undef PG8_WAIT_E
#undef PG8_PAIR
#undef PG8_WAIT_L
#undef PG8_BAR
#undef PG8_SCHED
}

struct PlainOrder {
    const char* A; const char* B; unsigned lda2, ldb2; int nt, nM, nN, G, c;
    __device__ __forceinline__ bool next(int i, GU& u) const {
        const int L = i * G + c; if (L >= nM * nN) return false;
        int pm, pn; tile_of(L, nM, nN, pm, pn);
        u.pm = pm; u.pn = pn; u.sub = 0; u.nt = nt; u.lda2 = lda2; u.ldb2 = ldb2;
        u.a = A + (size_t)pm * 256 * lda2; u.b = B + (size_t)pn * 256 * ldb2; return true;
    }
};
struct LoraOrder {
    const char* A; const char* Bl; const char* Bv; int nN, G, c;
    __device__ __forceinline__ bool next(int i, GU& u) const {
        const int L = i * G + c; if (L >= 128 * nN) return false;
        int pm, pn; tile_of(L, 128, nN, pm, pn);
        u.pm = pm; u.pn = pn; u.sub = 0; u.nt = 4; u.lda2 = 1024; u.ldb2 = 512;
        u.a = A + (size_t)pm * 256 * 1024 + (pn == 3 ? 512 : 0); u.b = (pn == 3) ? Bv : Bl + (size_t)pn * 256 * 512; return true;
    }
};
struct MergeOrder {
    const char* Hh; const char* Yy; const char* Wg; const char* Wb; int G, c;
    __device__ __forceinline__ bool next(int i, GU& u) const {
        const int ti = i >> 3, sub = i & 7, n = sub >> 1;
        const int L = ti * G + c; if (L >= 512) return false;
        int pm, pn; tile_of(L, 128, 4, pm, pn);
        u.pm = pm; u.pn = pn; u.sub = sub; u.lda2 = 2048;
        if ((sub & 1) == 0) { u.a = Hh + (size_t)pm * 256 * 2048; u.b = Wg + (size_t)(n * 1024 + pn * 256) * 2048; u.ldb2 = 2048; u.nt = 16; }
        else { const int co = n == 0 ? C_SB : (n == 1 ? C_RW : (n == 2 ? C_MB : C_HG)); u.a = Yy + (size_t)pm * 256 * (PMW * 2) + co * 2; u.lda2 = PMW * 2; u.b = Wb + (size_t)(n * 1024 + pn * 256) * 512; u.ldb2 = 512; u.nt = 4; }
        return true;
    }
};

__device__ __forceinline__ void unit_row_scales(const float* rsq, int pm, LAS unsigned char* ldsx, int tid, int wr, int fr, float (&rs)[2][4]) {
    LAS float* RSL = (LAS float*)(ldsx + LDS_RSL);
    if (tid < 256) { const f32x4 q = *(const f32x4*)(rsq + (size_t)(pm * 256 + tid) * 4); RSL[tid] = 1.0f / sqrtf(((q.x + q.y) + (q.z + q.w)) * (1.f / D) + 1e-6f); }
    LBAR();
#pragma unroll
    for (int ai = 0; ai < 2; ++ai)
#pragma unroll
        for (int m = 0; m < 4; ++m) rs[ai][m] = RSL[ai * HALF + wr * 64 + m * 16 + fr];
}
struct EpiBf16S {
    static constexpr int EOPS = 16; static constexpr bool PERM = true;
    bf16* O; int ldc; const float* rsq; LAS unsigned char* ldsx;
    __device__ __forceinline__ void operator()(const f32x4 (&acc)[2][2][4][2], const GU& u, int wr, int wc, int fr, int fq) const {
        int tid = threadIdx.x; asm volatile("" : "+v"(tid));
        fr = tid & 15; fq = (tid >> 4) & 3;
        float rs[2][4]; unit_row_scales(rsq, u.pm, ldsx, tid, wr, fr, rs);
        const int row0 = u.pm * BM + wr * 64 + fr, col0 = u.pn * BM + wc * 32 + 8 * fq;
#pragma unroll
        for (int ai = 0; ai < 2; ++ai)
#pragma unroll
            for (int m = 0; m < 4; ++m) { bf16* rowp = O + (size_t)(row0 + ai * HALF + m * 16) * ldc + col0; const float r_ = rs[ai][m];
#pragma unroll
                for (int bj = 0; bj < 2; ++bj) { const f32x4 v0 = acc[ai][bj][m][0] * r_, v1 = acc[ai][bj][m][1] * r_;
                    u32x4 w; w.x = cvt_pk_bf16(v0[0], v0[1]); w.y = cvt_pk_bf16(v0[2], v0[3]); w.z = cvt_pk_bf16(v1[0], v1[1]); w.w = cvt_pk_bf16(v1[2], v1[3]);
                    *(u32x4*)(rowp + bj * HALF) = w; } }
    }
};
struct EpiBf16 {
    static constexpr int EOPS = 16; static constexpr bool PERM = true;
    bf16* O; int ldc;
    __device__ __forceinline__ void operator()(const f32x4 (&acc)[2][2][4][2], const GU& u, int wr, int wc, int fr, int fq) const {
        { int tid = threadIdx.x; asm volatile("" : "+v"(tid)); fr = tid & 15; fq = (tid >> 4) & 3; }
        const int row0 = u.pm * BM + wr * 64 + fr, col0 = u.pn * BM + wc * 32 + 8 * fq;
#pragma unroll
        for (int ai = 0; ai < 2; ++ai)
#pragma unroll
            for (int m = 0; m < 4; ++m) { bf16* rowp = O + (size_t)(row0 + ai * HALF + m * 16) * ldc + col0;
#pragma unroll
                for (int bj = 0; bj < 2; ++bj) { const f32x4 v0 = acc[ai][bj][m][0], v1 = acc[ai][bj][m][1];
                    u32x4 w; w.x = cvt_pk_bf16(v0[0], v0[1]); w.y = cvt_pk_bf16(v0[2], v0[3]); w.z = cvt_pk_bf16(v1[0], v1[1]); w.w = cvt_pk_bf16(v1[2], v1[3]);
                    *(u32x4*)(rowp + bj * HALF) = w; } }
    }
};
struct EpiSwiGLU {
    static constexpr int EOPS = 8; static constexpr bool PERM = true;
    bf16* O; const float* rsq; LAS unsigned char* ldsx;
    __device__ __forceinline__ void operator()(const f32x4 (&acc)[2][2][4][2], const GU& u, int wr, int wc, int fr, int fq) const {
        int tid = threadIdx.x; asm volatile("" : "+v"(tid));
        fr = tid & 15; fq = (tid >> 4) & 3;
        float rs[2][4]; unit_row_scales(rsq, u.pm, ldsx, tid, wr, fr, rs);
        const int row0 = u.pm * BM + wr * 64 + fr, col0 = u.pn * HALF + wc * 32 + 8 * fq;
#pragma unroll
        for (int ai = 0; ai < 2; ++ai)
#pragma unroll
            for (int m = 0; m < 4; ++m) { bf16* rowp = O + (size_t)(row0 + ai * HALF + m * 16) * DFF + col0;
                float r[8];
#pragma unroll
                for (int n = 0; n < 2; ++n)
#pragma unroll
                    for (int j = 0; j < 4; ++j) { const float g = acc[ai][0][m][n][j] * rs[ai][m], up = acc[ai][1][m][n][j] * rs[ai][m]; r[n * 4 + j] = g * sigmoidf_(g) * up; }
                u32x4 w; w.x = cvt_pk_bf16(r[0], r[1]); w.y = cvt_pk_bf16(r[2], r[3]); w.z = cvt_pk_bf16(r[4], r[5]); w.w = cvt_pk_bf16(r[6], r[7]);
                *(u32x4*)rowp = w; }
    }
};
template <bool EMIT, bool IN16, bool OUT16>
struct EpiResNorm {
    static constexpr int EOPS = 16; static constexpr bool PERM = true;
    const void* base; void* out; float* rsq; LAS unsigned char* ldsx;
    __device__ __forceinline__ void operator()(const f32x4 (&acc)[2][2][4][2], const GU& u, int wr, int wc, int fr, int fq) const {
        int tid = threadIdx.x; asm volatile("" : "+v"(tid));
        fr = tid & 15; fq = (tid >> 4) & 3;
        const int row0 = u.pm * BM + wr * 64 + fr, col0 = u.pn * BM + wc * 32 + 8 * fq;
        LAS float* P = (LAS float*)(ldsx + LDS_XP);
#pragma unroll
        for (int ai = 0; ai < 2; ++ai)
#pragma unroll
            for (int m = 0; m < 4; ++m) { const size_t off = (size_t)(row0 + ai * HALF + m * 16) * D + col0; float sq = 0.f;
                f32x4 bs[2][2];
#pragma unroll
                for (int bj = 0; bj < 2; ++bj) {
                    if constexpr (IN16) { const u32x4 w = *(const u32x4*)((const bf16*)base + off + bj * HALF);
                        bs[bj][0] = (f32x4){bflo(w.x), bfhi(w.x), bflo(w.y), bfhi(w.y)}; bs[bj][1] = (f32x4){bflo(w.z), bfhi(w.z), bflo(w.w), bfhi(w.w)}; }
                    else { bs[bj][0] = *(const f32x4*)((const float*)base + off + bj * HALF); bs[bj][1] = *(const f32x4*)((const float*)base + off + bj * HALF + 4); } }
#pragma unroll
                for (int bj = 0; bj < 2; ++bj) { const f32x4 x0 = bs[bj][0] + acc[ai][bj][m][0], x1 = bs[bj][1] + acc[ai][bj][m][1];
                    if constexpr (OUT16) { u32x4 w; w.x = cvt_pk_bf16(x0.x, x0.y); w.y = cvt_pk_bf16(x0.z, x0.w); w.z = cvt_pk_bf16(x1.x, x1.y); w.w = cvt_pk_bf16(x1.z, x1.w); *(u32x4*)((bf16*)out + off + bj * HALF) = w; }
                    else { *(f32x4*)((float*)out + off + bj * HALF) = x0; *(f32x4*)((float*)out + off + bj * HALF + 4) = x1; }
                    if constexpr (EMIT) sq += ((x0.x * x0.x + x0.y * x0.y) + (x0.z * x0.z + x0.w * x0.w)) + ((x1.x * x1.x + x1.y * x1.y) + (x1.z * x1.z + x1.w * x1.w)); }
                if constexpr (EMIT) { sq += __shfl_xor(sq, 16); sq += __shfl_xor(sq, 32); if (fq == 0) P[(ai * HALF + wr * 64 + m * 16 + fr) * 4 + wc] = sq; } }
        if constexpr (EMIT) { LBAR();
            if (tid < 256) { const f32x4 p = *(const LAS f32x4*)(P + tid * 4); rsq[(size_t)(u.pm * BM + tid) * 4 + u.pn] = (p.x + p.y) + (p.z + p.w); }
            LBAR(); }
    }
};
struct EpiResFinal {
    static constexpr int EOPS = 32; static constexpr bool PERM = true;
    const bf16* base; float* out; const float* g; float* rsq; unsigned* cnt; LAS unsigned char* ldsx;
    __device__ __forceinline__ void operator()(f32x4 (&acc)[2][2][4][2], const GU& u, int wr, int wc, int fr, int fq) const {
        int tid = threadIdx.x; asm volatile("" : "+v"(tid));
        fr = tid & 15; fq = (tid >> 4) & 3;
        const int row0 = u.pm * BM + wr * 64 + fr, col0 = u.pn * BM + wc * 32 + 8 * fq;
        LAS float* P = (LAS float*)(ldsx + LDS_XP);
        LAS float* RSL = (LAS float*)(ldsx + LDS_RSL);
#pragma unroll
        for (int ai = 0; ai < 2; ++ai)
#pragma unroll
            for (int m = 0; m < 4; ++m) { const size_t off = (size_t)(row0 + ai * HALF + m * 16) * D + col0; float sq = 0.f;
                u32x4 w[2];
#pragma unroll
                for (int bj = 0; bj < 2; ++bj) w[bj] = *(const u32x4*)(base + off + bj * HALF);
#pragma unroll
                for (int bj = 0; bj < 2; ++bj) { const f32x4 x0 = (f32x4){bflo(w[bj].x), bfhi(w[bj].x), bflo(w[bj].y), bfhi(w[bj].y)} + acc[ai][bj][m][0], x1 = (f32x4){bflo(w[bj].z), bfhi(w[bj].z), bflo(w[bj].w), bfhi(w[bj].w)} + acc[ai][bj][m][1];
                    acc[ai][bj][m][0] = x0; acc[ai][bj][m][1] = x1;
                    sq += ((x0.x * x0.x + x0.y * x0.y) + (x0.z * x0.z + x0.w * x0.w)) + ((x1.x * x1.x + x1.y * x1.y) + (x1.z * x1.z + x1.w * x1.w)); }
                sq += __shfl_xor(sq, 16); sq += __shfl_xor(sq, 32); if (fq == 0) P[(ai * HALF + wr * 64 + m * 16 + fr) * 4 + wc] = sq; }
        LBAR();
        if (tid < 256) { const f32x4 p = *(const LAS f32x4*)(P + tid * 4); rsq[(size_t)(u.pm * BM + tid) * 4 + u.pn] = (p.x + p.y) + (p.z + p.w); }
        asm volatile("s_waitcnt vmcnt(0)" ::: "memory");
        LBAR();
        if (tid == 0) { unsigned* c = cnt + u.pm * 16;
            __builtin_amdgcn_fence(__ATOMIC_RELEASE, "agent");
            asm volatile("s_waitcnt vmcnt(0)" ::: "memory");
            (void)xb_add(c, 1u);
            unsigned sp = 0u; while (xb_ld(c) < 4u) { __builtin_amdgcn_s_sleep(1); if (++sp > XB_SPIN_CAP) break; }
            __builtin_amdgcn_fence(__ATOMIC_ACQUIRE, "agent");
            asm volatile("s_waitcnt vmcnt(0)" ::: "memory"); }
        LBAR();
        if (tid < 256) { const f32x4 q = *(const f32x4*)(rsq + (size_t)(u.pm * BM + tid) * 4); RSL[tid] = 1.0f / sqrtf(((q.x + q.y) + (q.z + q.w)) * (1.f / D) + 1e-6f); }
        LBAR();
        f32x4 gv[2][2];
#pragma unroll
        for (int bj = 0; bj < 2; ++bj)
#pragma unroll
            for (int n = 0; n < 2; ++n) gv[bj][n] = *(const f32x4*)(g + col0 + bj * HALF + n * 4);
#pragma unroll
        for (int ai = 0; ai < 2; ++ai)
#pragma unroll
            for (int m = 0; m < 4; ++m) { const size_t off = (size_t)(row0 + ai * HALF + m * 16) * D + col0; const float r_ = RSL[ai * HALF + wr * 64 + m * 16 + fr];
#pragma unroll
                for (int bj = 0; bj < 2; ++bj) { *(f32x4*)(out + off + bj * HALF) = acc[ai][bj][m][0] * r_ * gv[bj][0]; *(f32x4*)(out + off + bj * HALF + 4) = acc[ai][bj][m][1] * r_ * gv[bj][1]; } }
    }
};
struct EpiMerge {
    static constexpr int EOPS = 16; static constexpr bool PERM = true;
    u32x4* scr; bf16* O; const float* rsq; LAS unsigned char* ldsx;
    __device__ __forceinline__ void operator()(const f32x4 (&acc)[2][2][4][2], const GU& u, int wr, int wc, int fr, int fq) const {
        int tid = threadIdx.x; asm volatile("" : "+v"(tid));
        fr = tid & 15; fq = (tid >> 4) & 3;
        if ((u.sub & 1) == 0) {
            float rs[2][4];
            if (u.sub == 0) unit_row_scales(rsq, u.pm, ldsx, tid, wr, fr, rs);
            else { const LAS float* RSL = (const LAS float*)(ldsx + LDS_RSL);
#pragma unroll
                for (int ai = 0; ai < 2; ++ai)
#pragma unroll
                    for (int m = 0; m < 4; ++m) rs[ai][m] = RSL[ai * HALF + wr * 64 + m * 16 + fr]; }
#pragma unroll
            for (int ai = 0; ai < 2; ++ai)
#pragma unroll
                for (int m = 0; m < 4; ++m)
#pragma unroll
                    for (int bj = 0; bj < 2; ++bj) { const f32x4 v0 = acc[ai][bj][m][0] * rs[ai][m], v1 = acc[ai][bj][m][1] * rs[ai][m];
                        u32x4 w; w.x = cvt_pk_bf16(sigmoidf_(v0[0]), sigmoidf_(v0[1])); w.y = cvt_pk_bf16(sigmoidf_(v0[2]), sigmoidf_(v0[3]));
                        w.z = cvt_pk_bf16(sigmoidf_(v1[0]), sigmoidf_(v1[1])); w.w = cvt_pk_bf16(sigmoidf_(v1[2]), sigmoidf_(v1[3]));
                        scr[((ai * 4 + m) * 2 + bj) * 512 + tid] = w; }
        } else {
            const bool first = (u.sub == 1);
            const int row0 = u.pm * BM + wr * 64 + fr, col0 = u.pn * BM + wc * 32 + 8 * fq;
#pragma unroll
            for (int ai = 0; ai < 2; ++ai) {
                u32x4 sg[4][2], pv[4][2];
#pragma unroll
                for (int m = 0; m < 4; ++m)
#pragma unroll
                    for (int bj = 0; bj < 2; ++bj) { sg[m][bj] = scr[((ai * 4 + m) * 2 + bj) * 512 + tid];
                        pv[m][bj] = first ? (u32x4){0u, 0u, 0u, 0u} : *(const u32x4*)(O + (size_t)(row0 + ai * HALF + m * 16) * D + col0 + bj * HALF); }
#pragma unroll
                for (int m = 0; m < 4; ++m) { bf16* rowp = O + (size_t)(row0 + ai * HALF + m * 16) * D + col0;
#pragma unroll
                    for (int bj = 0; bj < 2; ++bj) { const f32x4 v0 = acc[ai][bj][m][0], v1 = acc[ai][bj][m][1];
                        const u32x4 s = sg[m][bj], p = pv[m][bj];
                        float r[8];
                        r[0] = bflo(s.x) * v0[0] + bflo(p.x); r[1] = bfhi(s.x) * v0[1] + bfhi(p.x); r[2] = bflo(s.y) * v0[2] + bflo(p.y); r[3] = bfhi(s.y) * v0[3] + bfhi(p.y);
                        r[4] = bflo(s.z) * v1[0] + bflo(p.z); r[5] = bfhi(s.z) * v1[1] + bfhi(p.z); r[6] = bflo(s.w) * v1[2] + bflo(p.w); r[7] = bfhi(s.w) * v1[3] + bfhi(p.w);
                        u32x4 w; w.x = cvt_pk_bf16(r[0], r[1]); w.y = cvt_pk_bf16(r[2], r[3]); w.z = cvt_pk_bf16(r[4], r[5]); w.w = cvt_pk_bf16(r[6], r[7]);
                        *(u32x4*)(rowp + bj * HALF) = w; } }
            }
        }
    }
};
}

struct Args { const float* in[26]; float* out; unsigned char* ws; int ph_lo, ph_hi; };
enum { I_X = 0, I_N1G, I_WIN, I_MU, I_W0, I_W2, I_A0, I_A2, I_G2, I_KK, I_KA, I_RK, I_GNW, I_GNB, I_V0, I_V1, I_V2, I_LB, I_HGN, I_WBR, I_WOUT, I_N2G, I_WFG, I_WFU, I_WFD, I_FG };

__device__ __forceinline__ void transpose_item(const float* W, int ldw, int k0, int n0, bf16* WT, size_t drow0, int ldt, int dk0, LAS float* scr, int lane, const float* gk = nullptr) {
#pragma unroll 8
    for (int i = 0; i < 32; ++i) { const int kk = 2 * i + (lane >> 5); float w = W[(size_t)(k0 + kk) * ldw + n0 + (lane & 31)]; if (gk) w *= gk[k0 + kk]; scr[kk * 33 + (lane & 31)] = w; }
    LDS_WAIT(); asm volatile("" ::: "memory");
    const int c = lane & 7;
#pragma unroll
    for (int j = 0; j < 4; ++j) { const int n = (lane >> 3) + 8 * j; const LAS float* s = scr + (8 * c) * 33 + n;
        u32x4 o; o.x = pk2(s[0 * 33], s[1 * 33]); o.y = pk2(s[2 * 33], s[3 * 33]); o.z = pk2(s[4 * 33], s[5 * 33]); o.w = pk2(s[6 * 33], s[7 * 33]);
        *(u32x4*)(WT + (drow0 + n) * (size_t)ldt + dk0 + 8 * c) = o; }
    LDS_WAIT(); asm volatile("" ::: "memory");
}

__device__ __forceinline__ void rms_row_bf16(const float* xrow, const float* g, bf16* orow, int lane) {
    const f32x4* xr = (const f32x4*)xrow + lane; f32x4 v[4]; float s = 0.f;
#pragma unroll
    for (int j = 0; j < 4; ++j) { v[j] = xr[64 * j]; s += (v[j].x * v[j].x + v[j].y * v[j].y) + (v[j].z * v[j].z + v[j].w * v[j].w); }
    const float rs = 1.0f / sqrtf(wave_sum(s) * (1.f / D) + 1e-6f);
    u32x2* o8 = (u32x2*)orow + lane;
#pragma unroll
    for (int j = 0; j < 4; ++j) { const f32x4 gv = ((const f32x4*)g)[lane + 64 * j]; u32x2 w; w.x = pk2(v[j].x * rs * gv.x, v[j].y * rs * gv.y); w.y = pk2(v[j].z * rs * gv.z, v[j].w * rs * gv.w); o8[64 * j] = w; }
}
__device__ __forceinline__ void rms_row_f32(const float* xrow, const float* g, float* orow, int lane) {
    const f32x4* xr = (const f32x4*)xrow + lane; f32x4 v[4]; float s = 0.f;
#pragma unroll
    for (int j = 0; j < 4; ++j) { v[j] = xr[64 * j]; s += (v[j].x * v[j].x + v[j].y * v[j].y) + (v[j].z * v[j].z + v[j].w * v[j].w); }
    const float rs = 1.0f / sqrtf(wave_sum(s) * (1.f / D) + 1e-6f);
    f32x4* o = (f32x4*)orow + lane;
#pragma unroll
    for (int j = 0; j < 4; ++j) { const f32x4 gv = ((const f32x4*)g)[lane + 64 * j]; o[64 * j] = v[j] * rs * gv; }
}

__device__ __forceinline__ void rope_entry(int t, int i, float& c, float& s) {
    const double invf[8] = {1.0, 0.19392274474868576, 0.03760603093086393, 0.007292664737217109, 0.001414213562373095, 0.0002742481756762073, 5.318295896944988e-05, 1.031338537721246e-05};
    double f = invf[0];
#pragma unroll
    for (int j = 1; j < 8; ++j) f = (i == j) ? invf[j] : f;
    const double ang = (double)t * f;
    const double k = __builtin_rint(ang * 0.63661977236758134308);
    double r = __builtin_fma(-k, 1.5707963267948966, ang); r = __builtin_fma(-k, 6.123233995736766e-17, r);
    const double r2 = r * r;
    double sn = r * (1.0 + r2 * (-1.0 / 6 + r2 * (1.0 / 120 + r2 * (-1.0 / 5040 + r2 * (1.0 / 362880 + r2 * (-1.0 / 39916800 + r2 * (1.0 / 6227020800.0)))))));
    double cs = 1.0 + r2 * (-0.5 + r2 * (1.0 / 24 + r2 * (-1.0 / 720 + r2 * (1.0 / 40320 + r2 * (-1.0 / 3628800 + r2 * (1.0 / 479001600.0 + r2 * (-1.0 / 87178291200.0)))))));
    const int q = ((int)(long long)k) & 3;
    const double s2 = (q == 0) ? sn : (q == 1) ? cs : (q == 2) ? -sn : -cs;
    const double c2 = (q == 0) ? cs : (q == 1) ? -sn : (q == 2) ? -cs : sn;
    c = (float)c2; s = (float)s2;
}

constexpr int N_LATE = 16 * 128 + 4 * 4 * 32 + 16 * 32 + 2 * 16 * 88 + 44 * 32;
static_assert(N_LATE == 7296 && N_LATE % 32 == 0, "late weight items");
constexpr unsigned NWU = N_LATE / 32;
__device__ __forceinline__ void late_weight_item(const Args& a, int layer, int r, LAS float* scr, int lane) {
    bf16* Wb = (bf16*)(a.ws + WS_W);
    constexpr int N_ING = 16 * 128, N_BR = 4 * 4 * 32, N_OUT = 16 * 32, N_FG = 16 * 88;
    if (r < N_ING) { const int kb = r / 128, nb = 112 + r % 128; transpose_item(a.in[I_WIN] + (size_t)layer * D * 7680, 7680, kb * 64, nb * 32, (bf16*)((char*)Wb + W_IN), (size_t)nb * 32, 1024, kb * 64, scr, lane, a.in[I_N1G] + layer * D); return; } r -= N_ING;
    if (r < N_BR) { const int n = r / 128, q = r % 128, kb = q / 32, nb = q % 32; transpose_item(a.in[I_WBR] + (size_t)layer * 4 * MW * D + (size_t)n * MW * D, D, kb * 64, nb * 32, (bf16*)((char*)Wb + W_B), (size_t)n * 1024 + nb * 32, 256, kb * 64, scr, lane); return; } r -= N_BR;
    if (r < N_OUT) { const int kb = r / 32, nb = r % 32; transpose_item(a.in[I_WOUT] + (size_t)layer * D * D, D, kb * 64, nb * 32, (bf16*)((char*)Wb + W_O), (size_t)nb * 32, 1024, kb * 64, scr, lane); return; } r -= N_OUT;
    if (r < 2 * N_FG) { const int up = r / N_FG, q = r % N_FG, kb = q / 88, nb = q % 88, n0 = nb * 32;
        transpose_item((up ? a.in[I_WFU] : a.in[I_WFG]) + (size_t)layer * D * DFF, DFF, kb * 64, n0, (bf16*)((char*)Wb + W_GU), (size_t)(n0 / 128) * 256 + (n0 % 128) + up * 128, 1024, kb * 64, scr, lane, a.in[I_N2G] + layer * D); return; } r -= 2 * N_FG;
    { const int kb = r / 32, nb = r % 32; transpose_item(a.in[I_WFD] + (size_t)layer * DFF * D, D, kb * 64, nb * 32, (bf16*)((char*)Wb + W_D), (size_t)nb * 32, DFF, kb * 64, scr, lane); }
}

__device__ __forceinline__ void phase_a(const Args& a, int layer, const float* xin, LAS unsigned char* lds, int vb, int G) {
    int tid = threadIdx.x; asm volatile("" : "+v"(tid)); const int lane = tid & 63, wave = tid >> 6;
    unsigned char* ws = a.ws;
    bf16* Wb = (bf16*)(ws + WS_W);
    LAS float* scr = (LAS float*)(lds + wave * 16384);
    const int gw = vb * 8 + wave, NGW = G * 8;
    const float* w_in = a.in[I_WIN] + (size_t)layer * D * 7680;
    const float* w_br = a.in[I_WBR] + (size_t)layer * 4 * MW * D;
    const float* w_out = a.in[I_WOUT] + (size_t)layer * D * D;
    const float* w_fg = a.in[I_WFG] + (size_t)layer * D * DFF;
    const float* w_fu = a.in[I_WFU] + (size_t)layer * D * DFF;
    const float* w_fd = a.in[I_WFD] + (size_t)layer * DFF * D;
    const float* w2 = a.in[I_W2] + (size_t)layer * 64 * MW;
    const float* a2 = a.in[I_A2] + (size_t)layer * 64 * MW;
    const float* g2 = a.in[I_G2] + (size_t)layer * 128 * MW;
    constexpr int N_INE = 16 * 112, N_LO = 8 + 8 + 16;
    for (int it = gw; it < N_INE + N_LO; it += NGW) {
        int r = it;
        if (r < N_INE) { const int kb = r / 112, nb = r % 112; transpose_item(w_in, 7680, kb * 64, nb * 32, (bf16*)((char*)Wb + W_IN), (size_t)nb * 32, 1024, kb * 64, scr, lane, a.in[I_N1G] + layer * D); continue; } r -= N_INE;
        if (r < 8) { transpose_item(w2, MW, 0, r * 32, (bf16*)((char*)Wb + W_L), (size_t)r * 32, 256, 0, scr, lane); continue; } r -= 8;
        if (r < 8) { transpose_item(a2, MW, 0, r * 32, (bf16*)((char*)Wb + W_L), (size_t)256 + r * 32, 256, 64, scr, lane); continue; } r -= 8;
        { const int kb = r / 8, nb = r % 8; transpose_item(g2, MW, kb * 64, nb * 32, (bf16*)((char*)Wb + W_L), (size_t)512 + nb * 32, 256, 128 + kb * 64, scr, lane); }
    }
    const int gt = vb * 512 + tid, NGT = G * 512;
    for (int i = gt; i < 768 * 32; i += NGT) { const int row = i >> 5, ch = i & 31, blk = row >> 8; const int lo = blk == 0 ? 0 : (blk == 1 ? 64 : 128), hi = blk == 0 ? 64 : (blk == 1 ? 128 : 256);
        if (ch * 8 < lo || ch * 8 >= hi) *(u32x4*)((char*)Wb + W_L + (size_t)row * 512 + ch * 16) = (u32x4){0u, 0u, 0u, 0u}; }
    if (layer == 1) {
        const float* v1 = a.in[I_V1]; const float* v2 = a.in[I_V2];
        for (int i = gt; i < 256 * 256; i += NGT) { const int c = i >> 8, k = i & 255; float s = 0.f;
#pragma unroll 8
            for (int j = 0; j < 32; ++j) s += v1[k * 32 + j] * v2[j * 256 + c];
            ((bf16*)((char*)Wb + W_V))[i] = (bf16)f2bf(s); }
    } else {
        float2* rope = (float2*)(ws + WS_ROPE);
        for (int i = gt; i < SEQ * 8; i += NGT) { float c, s; rope_entry(i >> 3, i & 7, c, s); rope[i] = make_float2(c, s); }
    }
    if (layer == 0) { bf16* H = (bf16*)(ws + WS_H); float* RQ = (float*)(ws + WS_RSQ1);
        for (int m = gw; m < M; m += NGW) { const f32x4* xr = (const f32x4*)(xin + (size_t)m * D) + lane; u32x2* o8 = (u32x2*)(H + (size_t)m * D) + lane; float sq = 0.f;
#pragma unroll
            for (int j = 0; j < 4; ++j) { const f32x4 v = xr[64 * j]; sq += (v.x * v.x + v.y * v.y) + (v.z * v.z + v.w * v.w); u32x2 w; w.x = cvt_pk_bf16(v.x, v.y); w.y = cvt_pk_bf16(v.z, v.w); o8[64 * j] = w; }
            sq = wave_sum(sq); if (lane == 0) *(f32x4*)(RQ + (size_t)m * 4) = (f32x4){sq, 0.f, 0.f, 0.f}; } }
}

__device__ __forceinline__ void phase_c(const Args& a, int layer, LAS unsigned char* lds, int vb, int G) {
    int tid = threadIdx.x; asm volatile("" : "+v"(tid)); const int lane = tid & 63, wave = tid >> 6;
    unsigned char* ws = a.ws;
    bf16* PM = (bf16*)(ws + WS_PM); bf16* LA = (bf16*)(ws + WS_LA);
    const float2* rope = (const float2*)(ws + WS_ROPE);
    float* KMP = (float*)(ws + WS_KMP);
    const float* mu = a.in[I_MU] + layer * 1024;
    LAS float* red = (LAS float*)lds;
    const int c4 = 4 * lane, l15 = lane & 15; const bool rot = l15 < 4, lower = l15 < 2;
    const f32x4 mu_l = *(const f32x4*)(mu + 768 + c4), mu_v = *(const f32x4*)(mu + 512 + c4);
    for (int u = vb; u < 256; u += G) {
        const int b = u >> 5, hb = u & 31; const int t0 = hb * 128 + wave * 16; const size_t row0 = (size_t)b * SEQ + t0;
        f32x4 ksum = {0.f, 0.f, 0.f, 0.f};
        f32x4 xp = {0.f, 0.f, 0.f, 0.f}, vp = xp;
        if (t0 > 0) { xp = ld4bf(PM + (row0 - 1) * PMW + C_RW + 768 + c4); if (layer) vp = ld4bf(PM + (row0 - 1) * PMW + C_RW + 512 + c4); }
        for (int i = 0; i < 16; ++i) {
            const size_t row = row0 + i; const int t = t0 + i;
            bf16* pq = PM + row * PMW + C_MB + c4;
            const f32x4 x = ld4bf(PM + row * PMW + C_RW + 768 + c4);
            f32x4 v4 = {0.f, 0.f, 0.f, 0.f}; if (layer) v4 = ld4bf(PM + row * PMW + C_RW + 512 + c4);
            f32x4 q4 = ld4bf(pq), k4 = ld4bf(pq + 256);
            { float qa[4] = {q4.x, q4.y, q4.z, q4.w}, ka[4] = {k4.x, k4.y, k4.z, k4.w}, qo[4], ko[4];
#pragma unroll
                for (int j = 0; j < 4; ++j) { qo[j] = dpp_xor2(qa[j]); ko[j] = dpp_xor2(ka[j]); }
                if (rot) { const float2* rp = rope + (size_t)t * 8 + (l15 & 1) * 4;
#pragma unroll
                    for (int j = 0; j < 4; ++j) { const float2 cs = rp[j]; const float sg = lower ? -cs.y : cs.y; qa[j] = qa[j] * cs.x + qo[j] * sg; ka[j] = ka[j] * cs.x + ko[j] * sg; }
                    q4 = (f32x4){qa[0], qa[1], qa[2], qa[3]}; k4 = (f32x4){ka[0], ka[1], ka[2], ka[3]};
                    st4bf(pq, q4); st4bf(pq + 256, k4); } }
            { u32x2 w; w.x = cvt_pk_bf16(k4.x, k4.y); w.y = cvt_pk_bf16(k4.z, k4.w); ksum += (f32x4){bflo(w.x), bfhi(w.x), bflo(w.y), bfhi(w.y)}; }
            { const f32x4 xs = x + (xp - x) * mu_l; f32x4 o;
#pragma unroll
                for (int j = 0; j < 4; ++j) { const float e = __expf(2.0f * xs[j]); const float th = 1.0f - 2.0f * __builtin_amdgcn_rcpf(1.0f + e); o[j] = lane < 16 ? th : (lane < 32 ? xs[j] : sigmoidf_(xs[j])); }
                st4bf(LA + row * 512 + c4, o); xp = x;
                if (layer) { st4bf(LA + row * 512 + 256 + c4, v4 + (vp - v4) * mu_v); vp = v4; } }
        }
        *(LAS f32x4*)(red + wave * 256 + c4) = ksum;
        __syncthreads();
        if (tid < 256) { float sacc = 0.f;
#pragma unroll
            for (int w8 = 0; w8 < 8; ++w8) sacc += red[w8 * 256 + tid];
            KMP[((size_t)(b * 4 + (tid >> 6)) * 32 + hb) * 64 + (tid & 63)] = sacc; }
        __syncthreads();
    }
}

constexpr int TC = 16;
#define DPP_SHR(x, n) __builtin_bit_cast(float, __builtin_amdgcn_update_dpp(0, __builtin_bit_cast(int, (x)), 0x110 + (n), 0xF, 0xF, true))
#define DPP_BC15(x) __builtin_bit_cast(float, __builtin_amdgcn_update_dpp(0, __builtin_bit_cast(int, (x)), 0x15F, 0xF, 0xF, true))
typedef short bf16x4v __attribute__((ext_vector_type(4)));
__device__ __forceinline__ bf16x4v frag4(f32x4 z) { return __builtin_bit_cast(bf16x4v, (u32x2){cvt_pk_bf16(z[0], z[1]), cvt_pk_bf16(z[2], z[3])}); }
#define MM16(xt, y) __builtin_amdgcn_mfma_f32_16x16x16bf16_1k(frag4(xt), frag4(y), (f32x4){0.f, 0.f, 0.f, 0.f}, 0, 0, 0)
__device__ __forceinline__ void phase_d2(const Args& a, int layer, LAS unsigned char* lds, int vb, int G) {
    int tid = threadIdx.x; asm volatile("" : "+v"(tid)); const int lane = tid & 63, wave = tid >> 6;
    LAS unsigned short* TL = (LAS unsigned short*)(lds + wave * 8192);
    unsigned char* ws = a.ws;
    bf16* PM = (bf16*)(ws + WS_PM); bf16* LO = (bf16*)(ws + WS_LO); bf16* VF = (bf16*)(ws + WS_VF); float* BON = (float*)(ws + WS_BON);
    const int s = lane & 15, g = lane >> 4;
    const float* mu = a.in[I_MU] + layer * 1024;
#define LDB16(dst, p) do { const u32x4 a_ = *(const u32x4*)((p) + 8 * g), b_ = *(const u32x4*)((p) + 32 + 8 * g); \
        dst[0] = bflo(a_.x); dst[1] = bfhi(a_.x); dst[2] = bflo(a_.y); dst[3] = bfhi(a_.y); dst[4] = bflo(a_.z); dst[5] = bfhi(a_.z); dst[6] = bflo(a_.w); dst[7] = bfhi(a_.w); \
        dst[8] = bflo(b_.x); dst[9] = bfhi(b_.x); dst[10] = bflo(b_.y); dst[11] = bfhi(b_.y); dst[12] = bflo(b_.z); dst[13] = bfhi(b_.z); dst[14] = bflo(b_.w); dst[15] = bfhi(b_.w); } while (0)
#define LDC16(dst, p) do { const f32x4 a_ = *(const f32x4*)((p) + 8 * g), b_ = *(const f32x4*)((p) + 8 * g + 4), c_ = *(const f32x4*)((p) + 32 + 8 * g), d_ = *(const f32x4*)((p) + 36 + 8 * g); \
        dst[0] = a_.x; dst[1] = a_.y; dst[2] = a_.z; dst[3] = a_.w; dst[4] = b_.x; dst[5] = b_.y; dst[6] = b_.z; dst[7] = b_.w; dst[8] = c_.x; dst[9] = c_.y; dst[10] = c_.z; dst[11] = c_.w; dst[12] = d_.x; dst[13] = d_.y; dst[14] = d_.z; dst[15] = d_.w; } while (0)
#define STB16(p, src) do { u32x4 a_, b_; a_.x = cvt_pk_bf16(src[0], src[1]); a_.y = cvt_pk_bf16(src[2], src[3]); a_.z = cvt_pk_bf16(src[4], src[5]); a_.w = cvt_pk_bf16(src[6], src[7]); \
        b_.x = cvt_pk_bf16(src[8], src[9]); b_.y = cvt_pk_bf16(src[10], src[11]); b_.z = cvt_pk_bf16(src[12], src[13]); b_.w = cvt_pk_bf16(src[14], src[15]); \
        *(u32x4*)((p) + 8 * g) = a_; *(u32x4*)((p) + 32 + 8 * g) = b_; } while (0)
#define PK8(src, o) __builtin_bit_cast(bf16x8, (u32x4){cvt_pk_bf16(src[(o)], src[(o) + 1]), cvt_pk_bf16(src[(o) + 2], src[(o) + 3]), cvt_pk_bf16(src[(o) + 4], src[(o) + 5]), cvt_pk_bf16(src[(o) + 6], src[(o) + 7])})
#define SUM64(x) do { x += __shfl_xor(x, 16); x += __shfl_xor(x, 32); } while (0)
    const int gw = vb * 8 + wave, NGW = G * 8;
    for (int task = gw; task < 8192; task += NGW) {
        const int chain = task >> 8, ch = task & 255, b = chain >> 2, h = chain & 3;
        const int t = ch * 16 + s; const size_t row = (size_t)b * SEQ + t;
        const bf16* pr = PM + row * PMW + C_RW + h * 64; const bf16* pp = (t > 0) ? pr - PMW : pr; const float pz = (t > 0) ? 1.f : 0.f;
        bf16* lo = LO + row * 1024 + h * 64;
        float lw[16], kk[16], bv[16], km[16], rr[16], vv[16];
        { float x0[16], xp[16], c0[16], c1[16], asg[16];
            LDB16(x0, pr); LDB16(xp, pp); LDC16(c0, mu + h * 64);
#pragma unroll
            for (int j = 0; j < 16; ++j) rr[j] = x0[j] + (xp[j] * pz - x0[j]) * c0[j];
            LDB16(x0, pr + 256); LDB16(xp, pp + 256); LDC16(c0, mu + 256 + h * 64);
            float ks[16];
#pragma unroll
            for (int j = 0; j < 16; ++j) ks[j] = x0[j] + (xp[j] * pz - x0[j]) * c0[j];
            LDB16(x0, pr + 512); LDB16(xp, pp + 512); LDC16(c0, mu + 512 + h * 64);
#pragma unroll
            for (int j = 0; j < 16; ++j) vv[j] = x0[j] + (xp[j] * pz - x0[j]) * c0[j];
            LDB16(x0, lo); LDC16(c0, a.in[I_W0] + layer * 256 + h * 64);
#pragma unroll
            for (int j = 0; j < 16; ++j) { const float wlog = -softplusf_(-(c0[j] + x0[j])) - 0.5f; lw[j] = -__expf(wlog); }
            LDB16(x0, lo + 256); LDC16(c0, a.in[I_A0] + layer * 256 + h * 64);
#pragma unroll
            for (int j = 0; j < 16; ++j) asg[j] = sigmoidf_(c0[j] + x0[j]);
            if (layer) { LDB16(x0, lo + 768); LDB16(xp, VF + row * 256 + h * 64); LDC16(c0, a.in[I_V0] + h * 64);
#pragma unroll
                for (int j = 0; j < 16; ++j) vv[j] += (xp[j] - vv[j]) * sigmoidf_(c0[j] + x0[j]); }
            else STB16(VF + row * 256 + h * 64, vv);
            STB16(lo + 768, vv);
            LDC16(c0, a.in[I_KK] + layer * 256 + h * 64); LDC16(c1, a.in[I_KA] + layer * 256 + h * 64);
            float n2 = 0.f;
#pragma unroll
            for (int j = 0; j < 16; ++j) { kk[j] = ks[j] * c0[j]; n2 += kk[j] * kk[j]; km[j] = ks[j] * (1.0f + (asg[j] - 1.0f) * c1[j]); }
            SUM64(n2); const float rn = 1.0f / fmaxf(sqrtf(n2), 1e-12f);
            LDC16(c0, a.in[I_RK] + layer * 256 + h * 64);
            float bon = 0.f;
#pragma unroll
            for (int j = 0; j < 16; ++j) { kk[j] *= rn; bv[j] = kk[j] * asg[j]; bon += rr[j] * km[j] * c0[j]; }
            SUM64(bon); if (g == 0) BON[row * 4 + h] = bon; }
        unsigned char* se = ws + WS_RS + (size_t)task * RS_ENTRY;
        float al[16], bh[16], kh[16], rh[16];
#pragma unroll
        for (int j = 0; j < 16; ++j) { float cs = lw[j]; cs += DPP_SHR(cs, 1); cs += DPP_SHR(cs, 2); cs += DPP_SHR(cs, 4); cs += DPP_SHR(cs, 8);
            const float Gt = __expf(cs), Gi = __expf(-cs), Gp = __expf(cs - lw[j]);
            al[j] = Gp * kk[j]; bh[j] = bv[j] * Gi; kh[j] = km[j] * Gi; rh[j] = Gt * rr[j];
            if (s == 15) ((float*)(se + 12800))[(j < 8 ? 8 * g + j : 24 + 8 * g + j)] = Gt; }
        { bf16* at = (bf16*)se + s * 72; STB16(at, al); bf16* rt = (bf16*)(se + 2304) + s * 72; STB16(rt, rh);
#pragma unroll
            for (int j = 0; j < 16; ++j) { const int k = (j < 8 ? 8 * g + j : 24 + 8 * g + j); TL[k * 16 + s] = f2bf(-bh[j]); TL[1024 + k * 16 + s] = f2bf(kh[j]); TL[2048 + k * 16 + s] = f2bf(vv[j]); }
#pragma unroll
            for (int q = 0; q < 6; ++q) ((u32x4*)(se + 4608))[q * 64 + lane] = ((const LAS u32x4*)TL)[q * 64 + lane]; }
        const bf16x8 al0 = PK8(al, 0), al1 = PK8(al, 8), bh0 = PK8(bh, 0), bh1 = PK8(bh, 8), kh0 = PK8(kh, 0), kh1 = PK8(kh, 8), rh0 = PK8(rh, 0), rh1 = PK8(rh, 8);
#define GRAM(x0_, x1_, y0_, y1_) __builtin_amdgcn_mfma_f32_16x16x32_bf16(x1_, y1_, __builtin_amdgcn_mfma_f32_16x16x32_bf16(x0_, y0_, (f32x4){0.f, 0.f, 0.f, 0.f}, 0, 0, 0), 0, 0, 0)
        f32x4 N = GRAM(bh0, bh1, al0, al1), NT = GRAM(al0, al1, bh0, bh1), QT = GRAM(al0, al1, kh0, kh1), BR = GRAM(bh0, bh1, rh0, rh1), KR = GRAM(kh0, kh1, rh0, rh1);
        f32x4 ID;
#pragma unroll
        for (int r = 0; r < 4; ++r) { const int rw = 4 * g + r; N[r] = rw < s ? N[r] : 0.f; NT[r] = s < rw ? NT[r] : 0.f; QT[r] = s < rw ? QT[r] : 0.f; BR[r] = rw <= s ? -BR[r] : 0.f; KR[r] = rw <= s ? KR[r] : 0.f; ID[r] = rw == s ? 1.f : 0.f; }
        const f32x4 N2 = MM16(NT, N), N2T = MM16(N, NT); const f32x4 N4 = MM16(N2T, N2), N4T = MM16(N2, N2T); const f32x4 N8 = MM16(N4T, N4);
        f32x4 X = MM16(ID + N4T, ID + N8); X = MM16(ID + N2T, X); const f32x4 T = MM16(ID - NT, X);
        const f32x4 QTm = MM16(QT, T);
        { u32x2* sm = (u32x2*)(se + 10752) + lane;
            sm[0] = (u32x2){cvt_pk_bf16(T[0], T[1]), cvt_pk_bf16(T[2], T[3])}; sm[64] = (u32x2){cvt_pk_bf16(QTm[0], QTm[1]), cvt_pk_bf16(QTm[2], QTm[3])};
            sm[128] = (u32x2){cvt_pk_bf16(BR[0], BR[1]), cvt_pk_bf16(BR[2], BR[3])}; sm[192] = (u32x2){cvt_pk_bf16(KR[0], KR[1]), cvt_pk_bf16(KR[2], KR[3])}; }
    }
#undef GRAM
#undef LDB16
#undef LDC16
#undef STB16
#undef PK8
#undef SUM64
}

constexpr int RWS = (int)RS_ENTRY;
__device__ __forceinline__ void rwkv_chain(const Args& a, int layer, int chain, LAS unsigned char* L) {
    int tid = threadIdx.x; asm volatile("" : "+v"(tid)); const int lane = tid & 63, w = __builtin_amdgcn_readfirstlane(tid >> 6);
    const int b = chain >> 2, h = chain & 3;
    unsigned char* ws = a.ws;
    const unsigned char* RS = ws + WS_RS + (size_t)chain * 256 * RS_ENTRY;
    constexpr int NCH = 256;
    if (w >= 4) {
        const int lw = w - 4;
#define RW_DMA(cn) do { const int cn_ = (cn) < NCH ? (cn) : NCH - 1; const unsigned char* src_ = RS + (size_t)cn_ * RS_ENTRY + lane * 16; LAS unsigned char* dst_ = L + ((cn) & 7) * RWS; \
            __builtin_amdgcn_global_load_lds((const unsigned*)(src_ + lw * 1024), (LAS unsigned*)(dst_ + lw * 1024), 16, 0, 0); \
            __builtin_amdgcn_global_load_lds((const unsigned*)(src_ + (lw + 4) * 1024), (LAS unsigned*)(dst_ + (lw + 4) * 1024), 16, 0, 0); \
            __builtin_amdgcn_global_load_lds((const unsigned*)(src_ + (lw + 8) * 1024), (LAS unsigned*)(dst_ + (lw + 8) * 1024), 16, 0, 0); \
            if (lw == 0 && lane < 48) __builtin_amdgcn_global_load_lds((const unsigned*)(src_ + 12 * 1024), (LAS unsigned*)(dst_ + 12 * 1024), 16, 0, 0); } while (0)
#define RW_WAIT() do { if (lw == 0) asm volatile("s_waitcnt vmcnt(24)" ::: "memory"); else asm volatile("s_waitcnt vmcnt(18)" ::: "memory"); } while (0)
        RW_DMA(0); RW_DMA(1); RW_DMA(2); RW_DMA(3); RW_DMA(4); RW_DMA(5); RW_DMA(6);
        RW_WAIT(); LBAR();
        for (int c = 0; c < NCH; ++c) { RW_DMA(c + 7); RW_WAIT(); LBAR(); }
        asm volatile("s_waitcnt vmcnt(0)" ::: "memory");
        LBAR();
#undef RW_DMA
#undef RW_WAIT
    } else {
        const int s16 = lane & 15, cg = lane >> 4;
        bf16* PMo = (bf16*)(ws + WS_PM) + (size_t)b * SEQ * PMW + C_RW + h * 64 + 16 * w + s16;
        f32x4 S0 = {0.f, 0.f, 0.f, 0.f}, S1 = S0, S2 = S0, S3 = S0;
        LBAR();
        for (int c = 0; c < NCH; ++c) {
            const LAS unsigned char* E = L + (c & 7) * RWS;
            const LAS bf16* AT = (const LAS bf16*)E + s16 * 72 + 4 * cg; const LAS bf16* RT = (const LAS bf16*)(E + 2304) + s16 * 72 + 4 * cg;
            const LAS bf16* BT = (const LAS bf16*)(E + 4608) + s16 * 16 + 4 * cg; const LAS bf16* KT = (const LAS bf16*)(E + 6656) + s16 * 16 + 4 * cg;
            const bf16x4v vt = *(const LAS bf16x4v*)((const LAS bf16*)(E + 8704) + (16 * w + s16) * 16 + 4 * cg);
            const LAS bf16x4v* SM = (const LAS bf16x4v*)(E + 10752) + lane; const bf16x4v tc = SM[0], qc = SM[64], brc = SM[128], krc = SM[192];
            const LAS float* GC = (const LAS float*)(E + 12800) + 4 * cg;
            const bf16x4v s0b = frag4(S0), s1b = frag4(S1), s2b = frag4(S2), s3b = frag4(S3);
            const f32x4 Z = {0.f, 0.f, 0.f, 0.f};
            f32x4 p1 = __builtin_amdgcn_mfma_f32_16x16x16bf16_1k(*(const LAS bf16x4v*)(AT), s0b, Z, 0, 0, 0);
            p1 = __builtin_amdgcn_mfma_f32_16x16x16bf16_1k(*(const LAS bf16x4v*)(AT + 16), s1b, p1, 0, 0, 0);
            p1 = __builtin_amdgcn_mfma_f32_16x16x16bf16_1k(*(const LAS bf16x4v*)(AT + 32), s2b, p1, 0, 0, 0);
            p1 = __builtin_amdgcn_mfma_f32_16x16x16bf16_1k(*(const LAS bf16x4v*)(AT + 48), s3b, p1, 0, 0, 0);
            f32x4 y = __builtin_amdgcn_mfma_f32_16x16x16bf16_1k(krc, vt, Z, 0, 0, 0);
            y = __builtin_amdgcn_mfma_f32_16x16x16bf16_1k(*(const LAS bf16x4v*)(RT), s0b, y, 0, 0, 0);
            y = __builtin_amdgcn_mfma_f32_16x16x16bf16_1k(*(const LAS bf16x4v*)(RT + 16), s1b, y, 0, 0, 0);
            y = __builtin_amdgcn_mfma_f32_16x16x16bf16_1k(*(const LAS bf16x4v*)(RT + 32), s2b, y, 0, 0, 0);
            y = __builtin_amdgcn_mfma_f32_16x16x16bf16_1k(*(const LAS bf16x4v*)(RT + 48), s3b, y, 0, 0, 0);
            f32x4 u = __builtin_amdgcn_mfma_f32_16x16x16bf16_1k(qc, vt, Z, 0, 0, 0);
            u = __builtin_amdgcn_mfma_f32_16x16x16bf16_1k(tc, frag4(p1), u, 0, 0, 0);
            const bf16x4v ub = frag4(u);
            y = __builtin_amdgcn_mfma_f32_16x16x16bf16_1k(brc, ub, y, 0, 0, 0);
#define RW_UPD(Sx, kt) do { f32x4 n_ = __builtin_amdgcn_mfma_f32_16x16x16bf16_1k(*(const LAS bf16x4v*)(KT + (kt) * 256), vt, Sx, 0, 0, 0); \
                n_ = __builtin_amdgcn_mfma_f32_16x16x16bf16_1k(*(const LAS bf16x4v*)(BT + (kt) * 256), ub, n_, 0, 0, 0); Sx = n_ * *(const LAS f32x4*)(GC + 16 * (kt)); } while (0)
            RW_UPD(S0, 0); RW_UPD(S1, 1); RW_UPD(S2, 2); RW_UPD(S3, 3);
#undef RW_UPD
            bf16* yo = PMo + (size_t)(c * 16 + 4 * cg) * PMW;
#pragma unroll
            for (int r = 0; r < 4; ++r) yo[(size_t)r * PMW] = (bf16)f2bf(y[r]);
            LBAR();
        }
        LBAR();
    }
}

__device__ __forceinline__ void phase_e2(const Args& a, int layer, int vb, int G) {
    int tid = threadIdx.x; asm volatile("" : "+v"(tid)); const int lane = tid & 63, wave = tid >> 6;
    unsigned char* ws = a.ws;
    const bf16* LO = (const bf16*)(ws + WS_LO); const float* BON = (const float*)(ws + WS_BON); bf16* PM = (bf16*)(ws + WS_PM);
    const int c4 = 4 * lane, head = lane >> 4;
    const f32x4 gnw = *(const f32x4*)(a.in[I_GNW] + layer * 256 + c4), gnb = *(const f32x4*)(a.in[I_GNB] + layer * 256 + c4);
    for (int tok = vb * 8 + wave; tok < M; tok += G * 8) {
        const size_t row = (size_t)tok;
        bf16* yp = PM + row * PMW + C_RW + c4; const f32x4 y = ld4bf(yp); const f32x4 vf = ld4bf(LO + row * 1024 + 768 + c4), g = ld4bf(LO + row * 1024 + 512 + c4); const float bon = BON[row * 4 + head];
        const float mean = dpp_sum16((y.x + y.y) + (y.z + y.w)) * (1.f / 64); const f32x4 d = y - mean;
        const float var = dpp_sum16((d.x * d.x + d.y * d.y) + (d.z * d.z + d.w * d.w)) * (1.f / 64);
        const f32x4 yn = d * (1.0f / sqrtf(var + 64e-5f)) * gnw + gnb;
        st4bf(yp, (yn + bon * vf) * g);
    }
}

typedef short bf16x4 __attribute__((ext_vector_type(4)));
constexpr int HQS = 72, HES = 20;
constexpr int HG_QT = 0, HG_KT = HG_QT + 16 * HQS * 2, HG_KE = HG_KT + 16 * HQS * 2, HG_IT = HG_KE + 64 * HES * 2, HG_DEC = HG_IT + 64 * HES * 2, HG_O = HG_DEC + 256, HG_BUF = HG_O + 4096;
__device__ __forceinline__ void hgrn_chain(const Args& a, int layer, int bh, LAS unsigned char* L) {
    int tid = threadIdx.x; asm volatile("" : "+v"(tid)); const int lane = tid & 63, w = __builtin_amdgcn_readfirstlane(tid >> 6);
    const int b = bh >> 2, h = bh & 3;
    unsigned char* ws = a.ws;
    const bf16* PM = (const bf16*)(ws + WS_PM); bf16* PMo = (bf16*)(ws + WS_PM);
    const size_t rowb = (size_t)b * SEQ;
    constexpr int NCH = SEQ / 16;
    const int s16 = lane & 15, cg = lane >> 4;
    constexpr int RAWS = 528, RAWSZ = 16 * RAWS, HG_RAW = 2 * HG_BUF;
    const int ld_tok = tid >> 5, ld_arr = (tid & 31) >> 3, ld_c8 = tid & 7;
    const bf16* ld_src = PM + (rowb + ld_tok) * PMW + C_HG + h * 64 + ld_arr * 256 + ld_c8 * 8;
    const int ld_dst = ld_tok * RAWS + ld_arr * 128 + ld_c8 * 16;
    float lb[2], oml[2];
#pragma unroll
    for (int r = 0; r < 2; ++r) { const int k = (2 * w + r) * 4 + cg; float v = 0.f; if (layer) { const float l0 = a.in[I_LB][h * 64 + k], l1 = a.in[I_LB][256 + h * 64 + k]; v = 1.0f / (1.0f + expf(l0 - l1)); } lb[r] = v; oml[r] = 1.0f - v; }
    const f32x4 gng4 = *(const f32x4*)(a.in[I_HGN] + layer * 256 + h * 64 + 4 * s16);
    const f32x2 lb2 = {lb[0], lb[1]}, oml2 = {oml[0], oml[1]};
    u32x4 pf[8];
#define HG_LOAD(set, cn) do { const int cn_ = (cn) < NCH ? (cn) : NCH - 1; pf[set] = *(const u32x4*)(ld_src + (size_t)cn_ * 16 * PMW); } while (0)
#define HG_STAGE(set, cn) do { *(LAS u32x4*)(L + HG_RAW + ((cn) & 3) * RAWSZ + ld_dst) = pf[set]; } while (0)
#define HG_PROD(cn) do { { LAS unsigned char* B_ = L + ((cn) & 1) * HG_BUF; const int k0_ = (2 * w) * 4 + cg, k1_ = k0_ + 4; \
        const LAS bf16* R_ = (const LAS bf16*)(L + HG_RAW + ((cn) & 3) * RAWSZ + s16 * RAWS); const unsigned rq0_ = R_[k0_], rq1_ = R_[k1_], rf0_ = R_[64 + k0_], rf1_ = R_[64 + k1_], ri0_ = R_[128 + k0_], ri1_ = R_[128 + k1_]; \
        const f32x2 fl_ = {bflo(rf0_), bflo(rf1_)}; \
        f32x2 e_, inv_, lf_; e_.x = __expf(-fabsf(fl_.x)); e_.y = __expf(-fabsf(fl_.y)); inv_.x = __builtin_amdgcn_rcpf(1.0f + e_.x); inv_.y = __builtin_amdgcn_rcpf(1.0f + e_.y); \
        const f32x2 ei_ = e_ * inv_; f32x2 sg_, ns_; sg_.x = fl_.x >= 0.f ? inv_.x : ei_.x; sg_.y = fl_.y >= 0.f ? inv_.y : ei_.y; ns_.x = fl_.x >= 0.f ? ei_.x : inv_.x; ns_.y = fl_.y >= 0.f ? ei_.y : inv_.y; \
        const f32x2 f_ = lb2 + oml2 * sg_, key_ = oml2 * ns_; lf_.x = __logf(f_.x); lf_.y = __logf(f_.y); \
        float b0_ = lf_.x, b1_ = lf_.y; b0_ += DPP_SHR(b0_, 1); b1_ += DPP_SHR(b1_, 1); b0_ += DPP_SHR(b0_, 2); b1_ += DPP_SHR(b1_, 2); b0_ += DPP_SHR(b0_, 4); b1_ += DPP_SHR(b1_, 4); b0_ += DPP_SHR(b0_, 8); b1_ += DPP_SHR(b1_, 8); \
        const float be0_ = DPP_BC15(b0_), be1_ = DPP_BC15(b1_);                         \
        f32x2 eb_, en_, de_; eb_.x = __expf(b0_); eb_.y = __expf(b1_); en_.x = __expf(fminf(-b0_, 80.f)); en_.y = __expf(fminf(-b1_, 80.f)); de_.x = __expf(be0_); de_.y = __expf(be1_); \
        const f32x2 qt_ = (f32x2){bflo(rq0_), bflo(rq1_)} * eb_, kt_ = key_ * en_, ke_ = kt_ * de_; \
        const unsigned wq_ = cvt_pk_bf16(qt_.x, qt_.y), wk_ = cvt_pk_bf16(kt_.x, kt_.y), we_ = cvt_pk_bf16(ke_.x, ke_.y); \
        LAS bf16* QT_ = (LAS bf16*)(B_ + HG_QT) + s16 * HQS; LAS bf16* KT_ = (LAS bf16*)(B_ + HG_KT) + s16 * HQS; LAS bf16* KE_ = (LAS bf16*)(B_ + HG_KE) + s16; LAS bf16* IT_ = (LAS bf16*)(B_ + HG_IT) + s16; \
        QT_[k0_] = (bf16)(wq_ & 0xffffu); QT_[k1_] = (bf16)(wq_ >> 16); KT_[k0_] = (bf16)(wk_ & 0xffffu); KT_[k1_] = (bf16)(wk_ >> 16); \
        KE_[k0_ * HES] = (bf16)(we_ & 0xffffu); KE_[k1_ * HES] = (bf16)(we_ >> 16); IT_[k0_ * HES] = (bf16)ri0_; IT_[k1_ * HES] = (bf16)ri1_; \
        if (s16 == 0) { ((LAS float*)(B_ + HG_DEC))[k0_] = de_.x; ((LAS float*)(B_ + HG_DEC))[k1_] = de_.y; } } } while (0)
#define HG_POST(cn) do { if (w >= 4) { const LAS float* O_ = (const LAS float*)(L + ((cn) & 1) * HG_BUF + HG_O); const int c_ = 4 * (w - 4) + cg; \
        const f32x4 o_ = *(const LAS f32x4*)(O_ + c_ * 64 + 4 * s16); const float ms_ = dpp_sum16((o_.x * o_.x + o_.y * o_.y) + (o_.z * o_.z + o_.w * o_.w)) * (1.f / 64); \
        const u32x2 gw_ = *(const LAS u32x2*)(L + HG_RAW + ((cn) & 3) * RAWSZ + c_ * RAWS + 384 + 8 * s16); const f32x4 g_ = {bflo(gw_.x), bfhi(gw_.x), bflo(gw_.y), bfhi(gw_.y)}; f32x4 sg_; \
        _Pragma("unroll") for (int j_ = 0; j_ < 4; ++j_) sg_[j_] = g_[j_] * sigmoidf_(g_[j_]); \
        st4bf(PMo + (rowb + (cn) * 16 + c_) * PMW + C_HG + h * 64 + 4 * s16, o_ * __builtin_amdgcn_rsqf(ms_ + 1e-6f) * gng4 * sg_); } } while (0)
    f32x4 S0 = {0.f, 0.f, 0.f, 0.f}, S1 = S0, S2 = S0, S3 = S0;
    HG_LOAD(0, 0); HG_LOAD(1, 1); HG_LOAD(2, 2); HG_LOAD(3, 3); HG_LOAD(4, 4); HG_LOAD(5, 5); HG_LOAD(6, 6); HG_LOAD(7, 7);
    HG_STAGE(0, 0); HG_STAGE(1, 1); HG_LOAD(0, 8); HG_LOAD(1, 9);
    LBAR();
    HG_PROD(0);
    LBAR();
#define HG_ITER(i) do { const int n = g0 + (i); HG_STAGE(((i) + 2) & 7, n + 2); HG_LOAD(((i) + 2) & 7, n + 10); if (n + 1 < NCH) HG_PROD(n + 1); hg_mfma(n); if (n > 0) HG_POST(n - 1); LBAR(); } while (0)
    auto hg_mfma = [&](int n) __attribute__((always_inline)) {
        if (w < 4) {
            LAS unsigned char* B = L + (n & 1) * HG_BUF;
            const LAS bf16* QT = (const LAS bf16*)(B + HG_QT); const LAS bf16* KT = (const LAS bf16*)(B + HG_KT); const LAS bf16* KE = (const LAS bf16*)(B + HG_KE); const LAS bf16* IT = (const LAS bf16*)(B + HG_IT);
            const LAS float* DEC = (const LAS float*)(B + HG_DEC); LAS float* O = (LAS float*)(B + HG_O);
            f32x4 sc = {0.f, 0.f, 0.f, 0.f};
#pragma unroll
            for (int ks = 0; ks < 2; ++ks) { const bf16x8 af = *(const LAS bf16x8*)(KT + s16 * HQS + ks * 32 + cg * 8), bfr = *(const LAS bf16x8*)(QT + s16 * HQS + ks * 32 + cg * 8);
                sc = __builtin_amdgcn_mfma_f32_16x16x32_bf16(af, bfr, sc, 0, 0, 0); }
            bf16x4 pf; { float m0 = (4 * cg + 0 <= s16) ? sc[0] : 0.f, m1 = (4 * cg + 1 <= s16) ? sc[1] : 0.f, m2 = (4 * cg + 2 <= s16) ? sc[2] : 0.f, m3 = (4 * cg + 3 <= s16) ? sc[3] : 0.f;
                const unsigned u0 = cvt_pk_bf16(m0, m1), u1 = cvt_pk_bf16(m2, m3); pf = __builtin_bit_cast(bf16x4, (u32x2){u0, u1}); }
            const bf16x4 ifr = *(const LAS bf16x4*)(IT + (16 * w + s16) * HES + 4 * cg);
            f32x4 oacc = {0.f, 0.f, 0.f, 0.f};
            oacc = __builtin_amdgcn_mfma_f32_16x16x16bf16_1k(pf, ifr, oacc, 0, 0, 0);
#define HG_KT_STEP(Sx, kt) do { const bf16x4 qa_ = *(const LAS bf16x4*)(QT + s16 * HQS + 16 * (kt) + 4 * cg); \
                const bf16x4 sb_ = __builtin_bit_cast(bf16x4, (u32x2){cvt_pk_bf16(Sx[0], Sx[1]), cvt_pk_bf16(Sx[2], Sx[3])}); \
                oacc = __builtin_amdgcn_mfma_f32_16x16x16bf16_1k(qa_, sb_, oacc, 0, 0, 0); \
                const bf16x4 ka_ = *(const LAS bf16x4*)(KE + (16 * (kt) + s16) * HES + 4 * cg); const f32x4 dc_ = *(const LAS f32x4*)(DEC + 16 * (kt) + 4 * cg); \
                Sx = __builtin_amdgcn_mfma_f32_16x16x16bf16_1k(ka_, ifr, Sx * dc_, 0, 0, 0); } while (0)
            HG_KT_STEP(S0, 0); HG_KT_STEP(S1, 1); HG_KT_STEP(S2, 2); HG_KT_STEP(S3, 3);
#undef HG_KT_STEP
#pragma unroll
            for (int r = 0; r < 4; ++r) O[(4 * cg + r) * 64 + 16 * w + s16] = oacc[r];
        }
    };
    for (int g0 = 0; g0 < NCH; g0 += 8) { HG_ITER(0); HG_ITER(1); HG_ITER(2); HG_ITER(3); HG_ITER(4); HG_ITER(5); HG_ITER(6); HG_ITER(7); }
    HG_POST(NCH - 1);
    LBAR();
#undef HG_ITER
#undef HG_STAGE
#undef HG_LOAD
#undef HG_PROD
#undef HG_POST
}

#include <hip/hip_bf16.h>
namespace moba_body {
using bf16=__hip_bfloat16;
using bf16x8=__attribute__((ext_vector_type(8)))short;
using s16x4=__attribute__((ext_vector_type(4)))short;
using f32x16=__attribute__((ext_vector_type(16)))float;
using u32x4=__attribute__((ext_vector_type(4)))unsigned;
constexpr int SEQ=4096,D=64,PIN=3584,POUT=3584;
constexpr int NW=8,QBLK=32,QB=QBLK*NW,KVBLK=64,NQB=SEQ/QB;
__device__ __forceinline__ int crow(int r,int hi){return (r&3)+8*(r>>2)+4*hi;}
#define SBAR() __builtin_amdgcn_sched_barrier(0)
__device__ __forceinline__ void cmask(f32x16&p0,f32x16&p1,int jb,int qrel,int hi){
  const float NEG=-INFINITY; int kb=64*jb+4*hi;
  #pragma unroll
  for(int r=0;r<16;++r){int kv=kb+(r&3)+8*(r>>2); if(kv>qrel)p0[r]=NEG; if(kv+32>qrel)p1[r]=NEG;}
}

constexpr int NSLOT=3, SLOTB=8192;
constexpr int LDS_K=0, LDS_V=NSLOT*SLOTB, LDS_WS=2*NSLOT*SLOTB, LDS_OST=LDS_WS+NW*64*4, LDS_BYTES=LDS_OST+NW*4096;
constexpr float C2=0.125f*1.4426950408889634f;
__device__ __forceinline__ void glds16(const void*gbase,unsigned voff,unsigned lds_dst){unsigned keep;
  asm volatile("s_mov_b32 %0, m0\n\ts_mov_b32 m0, %2\n\ts_nop 0\n\tglobal_load_lds_dwordx4 %1, %3\n\ts_mov_b32 m0, %0":"=&s"(keep):"v"(voff),"s"(lds_dst),"s"(gbase):"memory");}
__device__ __forceinline__ float max3f(float a,float b,float c){float r;asm("v_max3_f32 %0, %1, %2, %3":"=v"(r):"v"(a),"v"(b),"v"(c));return r;}
__device__ __forceinline__ float max2f(float a,float b){float r;asm("v_max_f32_e32 %0, %1, %2":"=v"(r):"v"(a),"v"(b));return r;}
__device__ __forceinline__ float fadd_s(float a,float b){float r;asm("v_add_f32_e32 %0, %1, %2":"=v"(r):"v"(a),"v"(b));return r;}
__device__ __forceinline__ float fsub_s(float a,float b){float r;asm("v_sub_f32_e32 %0, %1, %2":"=v"(r):"v"(a),"v"(b));return r;}
typedef float f32x2_t __attribute__((ext_vector_type(2))); typedef __bf16 bf16x2_t __attribute__((ext_vector_type(2)));
__device__ __forceinline__ unsigned cvtpk_s(float lo,float hi){f32x2_t v={lo,hi};bf16x2_t b=__builtin_convertvector(v,bf16x2_t);return __builtin_bit_cast(unsigned,b);}
#define WAIT_BAR(N) asm volatile("s_waitcnt vmcnt(" #N ") lgkmcnt(0)\n\ts_barrier":::"memory")

__device__ __forceinline__ void qkt(f32x16&p0,f32x16&p1,const char*Kslot,const bf16x8*qr,const f32x16&negm,int r32,int hi){
  const char*kb=Kslot+hi*1024+r32*16;
  #pragma unroll
  for(int d0=0;d0<4;++d0){
    const bf16x8 b0=*reinterpret_cast<const bf16x8*>(kb+d0*2048);
    const bf16x8 b1=*reinterpret_cast<const bf16x8*>(kb+d0*2048+512);
    if(d0==0){p0=__builtin_amdgcn_mfma_f32_32x32x16_bf16(b0,qr[0],negm,0,0,0);p1=__builtin_amdgcn_mfma_f32_32x32x16_bf16(b1,qr[0],negm,0,0,0);}
    else{p0=__builtin_amdgcn_mfma_f32_32x32x16_bf16(b0,qr[d0],p0,0,0,0);p1=__builtin_amdgcn_mfma_f32_32x32x16_bf16(b1,qr[d0],p1,0,0,0);}}
}
typedef __attribute__((address_space(3))) const char* lds_cptr;
typedef short v4i16_t __attribute__((ext_vector_type(4)));
__device__ __forceinline__ void kload8(bf16x8*kf,lds_cptr kp){
  kf[0]=*(const __attribute__((address_space(3))) bf16x8*)(kp);      kf[1]=*(const __attribute__((address_space(3))) bf16x8*)(kp+512);
  kf[2]=*(const __attribute__((address_space(3))) bf16x8*)(kp+2048); kf[3]=*(const __attribute__((address_space(3))) bf16x8*)(kp+2560);
  kf[4]=*(const __attribute__((address_space(3))) bf16x8*)(kp+4096); kf[5]=*(const __attribute__((address_space(3))) bf16x8*)(kp+4608);
  kf[6]=*(const __attribute__((address_space(3))) bf16x8*)(kp+6144); kf[7]=*(const __attribute__((address_space(3))) bf16x8*)(kp+6656);
}
__device__ __forceinline__ void kload2(bf16x8*kf,lds_cptr kp,int j){ kf[2*j]=*(const __attribute__((address_space(3))) bf16x8*)(kp+j*2048); kf[2*j+1]=*(const __attribute__((address_space(3))) bf16x8*)(kp+j*2048+512); }
__device__ __forceinline__ s16x4 vtr(lds_cptr p){ return __builtin_bit_cast(s16x4,__builtin_amdgcn_ds_read_tr16_b64_v4i16((__attribute__((address_space(3))) v4i16_t*)p)); }
__device__ __forceinline__ float rowmax(const f32x16&p0,const f32x16&p1){
  float a=max3f(p0[0],p0[1],p1[0]),b=max3f(p0[2],p0[3],p1[1]);a=max3f(a,p1[2],p1[3]);
  #pragma unroll
  for(int r=4;r<16;r+=4){a=max3f(a,p0[r],p0[r+1]);b=max3f(b,p0[r+2],p0[r+3]);a=max3f(a,p1[r],p1[r+1]);b=max3f(b,p1[r+2],p1[r+3]);}
  const float m=max2f(a,b);
  auto rr=__builtin_amdgcn_permlane32_swap(__float_as_uint(m),__float_as_uint(m),false,false);
  return max2f(__uint_as_float(rr[0]),__uint_as_float(rr[1]));
}
__device__ __forceinline__ void pv(f32x16*o,int vb,bf16x8 pa0,bf16x8 pa1,bf16x8 pa2,bf16x8 pa3){
  #pragma unroll
  for(int d0=0;d0<2;++d0){s16x4 lo[4],hi[4];
    #pragma unroll
    for(int ks=0;ks<4;++ks){
      asm volatile("ds_read_b64_tr_b16 %0,%1 offset:%c2":"=&v"(lo[ks]):"v"(vb),"i"(d0*4096+ks*1024):"memory");
      asm volatile("ds_read_b64_tr_b16 %0,%1 offset:%c2":"=&v"(hi[ks]):"v"(vb),"i"(d0*4096+ks*1024+512):"memory");}
    asm volatile("s_waitcnt lgkmcnt(0)":::"memory");SBAR();
    #define PK(k) (bf16x8){lo[k][0],lo[k][1],lo[k][2],lo[k][3],hi[k][0],hi[k][1],hi[k][2],hi[k][3]}
    o[d0]=__builtin_amdgcn_mfma_f32_32x32x16_bf16(pa0,PK(0),o[d0],0,0,0);
    o[d0]=__builtin_amdgcn_mfma_f32_32x32x16_bf16(pa1,PK(1),o[d0],0,0,0);
    o[d0]=__builtin_amdgcn_mfma_f32_32x32x16_bf16(pa2,PK(2),o[d0],0,0,0);
    o[d0]=__builtin_amdgcn_mfma_f32_32x32x16_bf16(pa3,PK(3),o[d0],0,0,0);
    #undef PK
  }
}

#ifndef ATTN_STORE16
#define ATTN_STORE16(p,v) (*(u32x4*)(p)=(v))
#endif
template<int THRL> __device__ __forceinline__ void attn_unit(int b,int h,int qb,const bf16*Q,const bf16*__restrict__ K,const bf16*__restrict__ V,bf16*O,const float*__restrict__ KMP,char*shm){
  int tid=threadIdx.x; asm volatile("":"+v"(tid));
  const int lane=tid&63,r32=lane&31,hi=lane>>5; const int wid=__builtin_amdgcn_readfirstlane(tid>>6);
  const long rowbase=(long)b*SEQ; const int q0=qb*QB;
  const bf16*Qw=Q+(rowbase+q0+wid*QBLK)*PIN+h*D;
  const bf16*Kh=K+rowbase*PIN+h*D,*Vh=V+rowbase*PIN+h*D;
  const unsigned lds0=(unsigned)(uintptr_t)shm;
  float*wsf=(float*)(shm+LDS_WS)+wid*64;
  const unsigned koff=(unsigned)(lane*PIN+wid*8)*2u;
  const unsigned voff=(unsigned)((16*(wid&3)+(lane>>2))*PIN+(wid>>2)*32+(lane&3)*8)*2u;
  const unsigned kdst=lds0+LDS_K+wid*1024, vdst=lds0+LDS_V+wid*1024;
  #define DMA_K(t,slot) glds16(Kh,koff+(unsigned)(t)*(unsigned)(KVBLK*PIN*2),(unsigned)__builtin_amdgcn_readfirstlane(kdst+(slot)))
  #define DMA_V(t,slot) glds16(Vh,voff+(unsigned)(t)*(unsigned)(KVBLK*PIN*2),(unsigned)__builtin_amdgcn_readfirstlane(vdst+(slot)))
  const int vb0=(int)(lds0+LDS_V)+((lane>>4)&1)*32+(lane&3)*8+(4*hi+((lane&15)>>2))*64;
  const char*Kbase=shm+LDS_K; bf16x8 kf[8];
  const lds_cptr shm3=(lds_cptr)shm; const lds_cptr kp0=shm3+LDS_K+hi*1024+r32*16; const lds_cptr vp0=shm3+LDS_V+((lane>>4)&1)*32+(lane&3)*8+(4*hi+((lane&15)>>2))*64;
  const int NT=(q0+QB)/KVBLK;
  DMA_K(0,0);DMA_V(0,0);DMA_K(1,SLOTB);
  bf16x8 qr[4];
  #pragma unroll
  for(int d0=0;d0<4;++d0)qr[d0]=*reinterpret_cast<const bf16x8*>(&Qw[(long)r32*PIN+d0*16+hi*8]);
  unsigned sel=0u;
  { float qf[32];
    #pragma unroll
    for(int d0=0;d0<4;++d0){
      #pragma unroll
      for(int e=0;e<8;++e)qf[d0*8+e]=__uint_as_float(((unsigned)(unsigned short)qr[d0][e])<<16);}
    float b0=-INFINITY,b1=-INFINITY,b2=-INFINITY; int i0=-1,i1=-1,i2=-1;
    for(int j=0;j<qb;++j){
      const float*kp=KMP+((long)(b*4+h)*32+2*j)*64+8*hi; float g=0.f;
      #pragma unroll
      for(int d0=0;d0<4;++d0){ const float4 a0=*reinterpret_cast<const float4*>(kp+16*d0),a1=*reinterpret_cast<const float4*>(kp+16*d0+4),c0=*reinterpret_cast<const float4*>(kp+64+16*d0),c1=*reinterpret_cast<const float4*>(kp+64+16*d0+4);
        g+=qf[d0*8+0]*(a0.x+c0.x);g+=qf[d0*8+1]*(a0.y+c0.y);g+=qf[d0*8+2]*(a0.z+c0.z);g+=qf[d0*8+3]*(a0.w+c0.w);
        g+=qf[d0*8+4]*(a1.x+c1.x);g+=qf[d0*8+5]*(a1.y+c1.y);g+=qf[d0*8+6]*(a1.z+c1.z);g+=qf[d0*8+7]*(a1.w+c1.w);}
      { auto rr=__builtin_amdgcn_permlane32_swap(__float_as_uint(g),__float_as_uint(g),false,false); g=__uint_as_float(rr[0])+__uint_as_float(rr[1]); }
      if(g>b0){b2=b1;i2=i1;b1=b0;i1=i0;b0=g;i0=j;} else if(g>b1){b2=b1;i2=i1;b1=g;i1=j;} else if(g>b2){b2=g;i2=j;}
    }
    if(i0>=0)sel|=1u<<i0; if(i1>=0)sel|=1u<<i1; if(i2>=0)sel|=1u<<i2;
    #pragma unroll
    for(int d0=0;d0<4;++d0){ u32x4 w;
      w[0]=cvtpk_s(qf[d0*8+0]*C2,qf[d0*8+1]*C2);w[1]=cvtpk_s(qf[d0*8+2]*C2,qf[d0*8+3]*C2);w[2]=cvtpk_s(qf[d0*8+4]*C2,qf[d0*8+5]*C2);w[3]=cvtpk_s(qf[d0*8+6]*C2,qf[d0*8+7]*C2);
      qr[d0]=__builtin_bit_cast(bf16x8,w);} }
  float mhat=0.f,l_reg=0.f;f32x16 o[2];o[0]=f32x16{};o[1]=f32x16{};f32x16 negm=f32x16{};asm volatile("":"+v"(negm));
  const int qrel=wid*QBLK+r32;
  #define PMASK(P0,P1,t) do{ if(!((sel>>((t)>>2))&1u)){ _Pragma("unroll") for(int r_=0;r_<16;++r_){P0[r_]=-INFINITY;P1[r_]=-INFINITY;} } }while(0)
  #define CMASK(P0,P1,t) do{int jb_=(t)-(NT-4); if(jb_>=0)cmask(P0,P1,jb_,qrel,hi); else PMASK(P0,P1,t);}while(0)
  bool resc=false;
  #define START(P0,P1) do{ const float rm=rowmax(P0,P1); resc=false; \
    { const float dl=__builtin_fmaxf(rm,-64.f); mhat=fadd_s(mhat,dl); \
      _Pragma("unroll") for(int r=0;r<16;++r){P0[r]=fsub_s(P0[r],dl);P1[r]=fsub_s(P1[r],dl);} \
      _Pragma("unroll") for(int r=0;r<16;++r)negm[r]=-mhat; asm volatile("":"+v"(negm)); } \
    _Pragma("unroll") for(int r=0;r<16;++r)P0[r]=__builtin_amdgcn_exp2f(P0[r]); }while(0)
  #define RESC() do{ if(resc){ asm volatile("s_waitcnt lgkmcnt(0)":::"memory"); \
      _Pragma("unroll") for(int d_=0;d_<2;++d_) _Pragma("unroll") for(int r=0;r<16;++r)o[d_][r]*=wsf[crow(r,hi)]; } }while(0)
  f32x16 pA0,pA1,pB0,pB1;
  int sl_prev=0,sl_cur=0,sl_next=SLOTB;
  #define ROT() do{sl_prev=sl_cur;sl_cur=sl_next;sl_next=(sl_next==(NSLOT-1)*SLOTB)?0:sl_next+SLOTB;}while(0)
  DMA_K(2,2*SLOTB);
  WAIT_BAR(3);
  qkt(pA0,pA1,Kbase,qr,negm,r32,hi);asm volatile("s_nop 15\n\ts_nop 7":"+v"(pA0),"+v"(pA1));CMASK(pA0,pA1,0);
  START(pA0,pA1);
  _Pragma("unroll") for(int r=0;r<16;++r)pA1[r]=__builtin_amdgcn_exp2f(pA1[r]);
  WAIT_BAR(0);
  DMA_K(3,0);DMA_V(1,SLOTB);
  ROT();
  kload8(kf,kp0+sl_cur);
  WAIT_BAR(2);
  s16x4 vlo[8],vhi[8]; u32x4 pw0,pw1,pw2,pw3;
  #define PKW(P,B) cvtpk_s(P[B],P[B+1])
  #define PAF(k) __builtin_bit_cast(bf16x8,pw##k)
  #define VFR(i) (bf16x8){vlo[i][0],vlo[i][1],vlo[i][2],vlo[i][3],vhi[i][0],vhi[i][1],vhi[i][2],vhi[i][3]}
  #define PIN(x) asm volatile("":"+v"(x))
  #define MX3(a,b,c) __builtin_fmaxf(__builtin_fmaxf((a),(b)),(c))
  #define GAPA(MF,A0,A1,A2,A3,W0,W1,PW) do{ MF; sacc+=A0; sacc+=A1; sacc+=A2; sacc+=A3; PIN(sacc); W0; W1; PIN(PW); SBAR(); }while(0)
  #define EX(v) __builtin_amdgcn_exp2f(v)
  #define GAPB(MF,X,B) do{ MF; X[B]=EX(X[B]); X[B+1]=EX(X[B+1]); X[B+2]=EX(X[B+2]); X[B+3]=EX(X[B+3]); PIN(X); SBAR(); }while(0)
  #define VRD(i) do{ vlo[i]=vtr(vp_+(((i)>>2)*4096+((i)&3)*1024)); vhi[i]=vtr(vp_+(((i)>>2)*4096+((i)&3)*1024+512)); }while(0)
  #define KRD(G,j) do{ if(G){ kload2(kf,kp0+sl_next,j); SBAR(); } }while(0)
  #define STEP(C0,C1,P0,P1,t,GK,GV,GL) do{ SBAR(); \
    const lds_cptr vp_=vp0+sl_prev; \
    VRD(0); SBAR(); float sacc=(P0[0]+P0[1]); \
    GAPA(C0=__builtin_amdgcn_mfma_f32_32x32x16_bf16(kf[0],qr[0],negm,0,0,0), P0[2],P0[3],P0[4],P0[5],     pw0[0]=PKW(P0,0), pw0[1]=PKW(P0,2), pw0); \
    VRD(4); SBAR(); GAPA(C1=__builtin_amdgcn_mfma_f32_32x32x16_bf16(kf[1],qr[0],negm,0,0,0), P0[6],P0[7],P0[8],P0[9],     pw0[2]=PKW(P0,4), pw0[3]=PKW(P0,6), pw0); \
    VRD(1); SBAR(); GAPA(C0=__builtin_amdgcn_mfma_f32_32x32x16_bf16(kf[2],qr[1],C0,0,0,0),   P0[10],P0[11],P0[12],P0[13], pw1[0]=PKW(P0,8), pw1[1]=PKW(P0,10), pw1); \
    VRD(5); SBAR(); GAPA(C1=__builtin_amdgcn_mfma_f32_32x32x16_bf16(kf[3],qr[1],C1,0,0,0),   P0[14],P0[15],P1[0],P1[1],   pw1[2]=PKW(P0,12),pw1[3]=PKW(P0,14), pw1); \
    VRD(2); SBAR(); GAPA(C0=__builtin_amdgcn_mfma_f32_32x32x16_bf16(kf[4],qr[2],C0,0,0,0),   P1[2],P1[3],P1[4],P1[5],     pw2[0]=PKW(P1,0), pw2[1]=PKW(P1,2), pw2); \
    VRD(6); SBAR(); GAPA(C1=__builtin_amdgcn_mfma_f32_32x32x16_bf16(kf[5],qr[2],C1,0,0,0),   P1[6],P1[7],P1[8],P1[9],     pw2[2]=PKW(P1,4), pw2[3]=PKW(P1,6), pw2); \
    VRD(3); SBAR(); GAPA(C0=__builtin_amdgcn_mfma_f32_32x32x16_bf16(kf[6],qr[3],C0,0,0,0),   P1[10],P1[11],P1[12],P1[13], pw3[0]=PKW(P1,8), pw3[1]=PKW(P1,10), pw3); \
    VRD(7); SBAR(); GAPA(C1=__builtin_amdgcn_mfma_f32_32x32x16_bf16(kf[7],qr[3],C1,0,0,0),   P1[14],P1[15],0.f,0.f,       pw3[2]=PKW(P1,12),pw3[3]=PKW(P1,14), pw3); \
    l_reg+=sacc; \
    if(GK){DMA_K((t)+3,sl_cur);} if(GV){DMA_V((t)+1,sl_next);} \
    CMASK(C0,C1,t); \
    { float a=MX3(C0[0],C0[1],C1[0]),b=MX3(C0[2],C0[3],C1[1]); a=MX3(a,C1[2],C1[3]); \
      _Pragma("unroll") for(int r=4;r<16;r+=4){a=MX3(a,C0[r],C0[r+1]);b=MX3(b,C0[r+2],C0[r+3]);a=MX3(a,C1[r],C1[r+1]);b=MX3(b,C1[r+2],C1[r+3]);} \
      float rm=__builtin_fmaxf(a,b); { auto rr=__builtin_amdgcn_permlane32_swap(__float_as_uint(rm),__float_as_uint(rm),false,false); rm=__builtin_fmaxf(__uint_as_float(rr[0]),__uint_as_float(rr[1])); } \
      resc=false; \
      if(__builtin_expect(__any(rm>(float)THRL),0)){ const float dl=__builtin_fmaxf(rm,0.f); mhat+=dl; \
        _Pragma("unroll") for(int r=0;r<16;++r){C0[r]-=dl;C1[r]-=dl;} \
        _Pragma("unroll") for(int r=0;r<16;++r)negm[r]=-mhat; asm volatile("":"+v"(negm)); \
        const float f=__builtin_amdgcn_exp2f(-dl); l_reg*=f; if(hi==0)wsf[r32]=f; resc=true; } } \
    SBAR(); \
    GAPB(o[0]=__builtin_amdgcn_mfma_f32_32x32x16_bf16(PAF(0),VFR(0),o[0],0,0,0), C0,0); \
    GAPB(o[1]=__builtin_amdgcn_mfma_f32_32x32x16_bf16(PAF(0),VFR(4),o[1],0,0,0), C0,4); \
    KRD(GL,0); GAPB(o[0]=__builtin_amdgcn_mfma_f32_32x32x16_bf16(PAF(1),VFR(1),o[0],0,0,0), C0,8); \
    KRD(GL,1); GAPB(o[1]=__builtin_amdgcn_mfma_f32_32x32x16_bf16(PAF(1),VFR(5),o[1],0,0,0), C0,12); \
    KRD(GL,2); GAPB(o[0]=__builtin_amdgcn_mfma_f32_32x32x16_bf16(PAF(2),VFR(2),o[0],0,0,0), C1,0); \
    KRD(GL,3); GAPB(o[1]=__builtin_amdgcn_mfma_f32_32x32x16_bf16(PAF(2),VFR(6),o[1],0,0,0), C1,4); \
    GAPB(o[0]=__builtin_amdgcn_mfma_f32_32x32x16_bf16(PAF(3),VFR(3),o[0],0,0,0), C1,8); \
    GAPB(o[1]=__builtin_amdgcn_mfma_f32_32x32x16_bf16(PAF(3),VFR(7),o[1],0,0,0), C1,12); \
    }while(0)
  int t=1;
  #undef CMASK
  #define CMASK(P0,P1,t) PMASK(P0,P1,t)
  for(;t+5<NT;t+=2){
    STEP(pB0,pB1,pA0,pA1,t,true,true,true);     WAIT_BAR(2); RESC(); ROT();
    STEP(pA0,pA1,pB0,pB1,t+1,true,true,true);   WAIT_BAR(2); RESC(); ROT();
  }
  #undef CMASK
  #define CMASK(P0,P1,t) do{int jb_=(t)-(NT-4); if(jb_>=0)cmask(P0,P1,jb_,qrel,hi); else PMASK(P0,P1,t);}while(0)
  #define ENDW(tt) do{ if((tt)+3<NT){WAIT_BAR(2);} else if((tt)+2<NT){WAIT_BAR(1);} else {WAIT_BAR(0);} }while(0)
  for(;t+1<NT;t+=2){
    STEP(pB0,pB1,pA0,pA1,t,(t+3<NT),(t+1<NT),(t+1<NT));       ENDW(t);   RESC(); ROT();
    STEP(pA0,pA1,pB0,pB1,t+1,(t+4<NT),(t+2<NT),(t+2<NT));     ENDW(t+1); RESC(); ROT();
  }
  STEP(pB0,pB1,pA0,pA1,NT-1,false,false,false); RESC();
  { float sacc=pB0[0]+pB0[1]; _Pragma("unroll") for(int r=2;r<16;++r)sacc+=pB0[r]; _Pragma("unroll") for(int r=0;r<16;++r)sacc+=pB1[r]; l_reg+=sacc;
    pw0=(u32x4){PKW(pB0,0),PKW(pB0,2),PKW(pB0,4),PKW(pB0,6)};pw1=(u32x4){PKW(pB0,8),PKW(pB0,10),PKW(pB0,12),PKW(pB0,14)};pw2=(u32x4){PKW(pB1,0),PKW(pB1,2),PKW(pB1,4),PKW(pB1,6)};pw3=(u32x4){PKW(pB1,8),PKW(pB1,10),PKW(pB1,12),PKW(pB1,14)};
    SBAR(); pv(o,vb0+sl_cur,PAF(0),PAF(1),PAF(2),PAF(3)); }
  #undef PKW
  #undef PAF
  #undef VFR
  #undef PIN
  #undef MX3
  #undef GAPA
  #undef GAPB
  #undef EX
  #undef VRD
  #undef KRD
  #undef STEP
  #undef ENDW
  {auto rr=__builtin_amdgcn_permlane32_swap(__float_as_uint(l_reg),__float_as_uint(l_reg),false,false);l_reg=__uint_as_float(rr[0])+__uint_as_float(rr[1]);}
  if(hi==0)wsf[32+r32]=l_reg;asm volatile("s_waitcnt lgkmcnt(0)":::"memory");
  float rli[16];
  #pragma unroll
  for(int r=0;r<16;++r)rli[r]=__builtin_amdgcn_rcpf(wsf[32+crow(r,hi)]);
  bf16*Ow=O+(rowbase+q0+wid*QBLK)*POUT+h*D;
  { bf16*stg=(bf16*)(shm+LDS_OST)+wid*2048;
    #pragma unroll
    for(int r=0;r<16;++r){const int orow=crow(r,hi);
      #pragma unroll
      for(int d0=0;d0<2;++d0)stg[orow*64+d0*32+r32]=__float2bfloat16(o[d0][r]*rli[r]);}
    asm volatile("s_waitcnt lgkmcnt(0)":::"memory");
    #pragma unroll
    for(int i=0;i<4;++i){const int row=i*8+(lane>>3),ch=lane&7; const u32x4 v=*(const u32x4*)(stg+row*64+ch*8); ATTN_STORE16(Ow+(long)row*POUT+ch*8,v);} }
  asm volatile("s_waitcnt lgkmcnt(0)\n\ts_barrier":::"memory");
  #undef DMA_K
  #undef DMA_V
  #undef CMASK
  #undef PMASK
  #undef START
  #undef RESC
  #undef ROT
}
constexpr int ATTN_LDS_BYTES=LDS_BYTES;
#undef SBAR
#undef WAIT_BAR
}

typedef float f32x16 __attribute__((ext_vector_type(16)));
__device__ __forceinline__ void sb_unit(const Args& a, int bh, int qb) {
    int tid = threadIdx.x; asm volatile("" : "+v"(tid));
    const int lane = tid & 63, wid = tid >> 6, r32 = lane & 31, hh = lane >> 5;
    const int b = bh >> 2, h = bh & 3;
    unsigned char* ws = a.ws;
    const bf16* PM = (const bf16*)(ws + WS_PM); bf16* PMo = (bf16*)(ws + WS_PM);
    const size_t rowb = (size_t)b * SEQ;
    const int t0 = qb * 256 + wid * 32, t = t0 + r32;
    const bf16* Kb = PM + rowb * PMW + C_SB + 256 + h * 64; const bf16* Vb = PM + rowb * PMW + C_SB + 512 + h * 64;
    bf16x8 qf[4];
    { const bf16* qp = PM + (rowb + t) * PMW + C_SB + h * 64 + 8 * hh;
#pragma unroll
        for (int ks = 0; ks < 4; ++ks) { const u32x4 x = *(const u32x4*)(qp + 16 * ks); u32x4 y;
            y.x = cvt_pk_bf16(bflo(x.x) * 0.125f, bfhi(x.x) * 0.125f); y.y = cvt_pk_bf16(bflo(x.y) * 0.125f, bfhi(x.y) * 0.125f);
            y.z = cvt_pk_bf16(bflo(x.z) * 0.125f, bfhi(x.z) * 0.125f); y.w = cvt_pk_bf16(bflo(x.w) * 0.125f, bfhi(x.w) * 0.125f); qf[ks] = __builtin_bit_cast(bf16x8, y); } }
    f32x16 o0, o1;
#pragma unroll
    for (int i = 0; i < 16; ++i) { o0[i] = 0.f; o1[i] = 0.f; }
    float carry = 0.f;
    bf16x8 kn[4]; unsigned vn[2][2][8];
#define SB_LOAD(kt_) do { const int s0_ = (kt_) * 32; const bf16* kp_ = Kb + (size_t)(s0_ + r32) * PMW + 8 * hh; \
        _Pragma("unroll") for (int ks_ = 0; ks_ < 4; ++ks_) kn[ks_] = *(const bf16x8*)(kp_ + 16 * ks_); \
        const bf16* vp_ = Vb + (size_t)(s0_ + 4 * hh) * PMW + r32; \
        _Pragma("unroll") for (int s_ = 0; s_ < 2; ++s_) _Pragma("unroll") for (int j_ = 0; j_ < 8; ++j_) { const int k0_ = 16 * s_ + 8 * (j_ >> 2) + (j_ & 3); vn[0][s_][j_] = vp_[(size_t)k0_ * PMW]; vn[1][s_][j_] = vp_[(size_t)k0_ * PMW + 32]; } } while (0)
    SB_LOAD(t0 >> 5);
    for (int kt = t0 >> 5; kt >= 0; --kt) {
        const int s0 = kt * 32;
        f32x16 z;
#pragma unroll
        for (int i = 0; i < 16; ++i) z[i] = 0.f;
        bf16x8 kf[4];
#pragma unroll
        for (int ks = 0; ks < 4; ++ks) kf[ks] = kn[ks];
        unsigned vw[2][2][4];
#pragma unroll
        for (int nt = 0; nt < 2; ++nt)
#pragma unroll
            for (int s_ = 0; s_ < 2; ++s_)
#pragma unroll
                for (int jp = 0; jp < 4; ++jp) vw[nt][s_][jp] = vn[nt][s_][2 * jp] | (vn[nt][s_][2 * jp + 1] << 16);
        if (kt > 0) SB_LOAD(kt - 1);
#pragma unroll
        for (int ks = 0; ks < 4; ++ks) z = __builtin_amdgcn_mfma_f32_32x32x16_bf16(kf[ks], qf[ks], z, 0, 0, 0);
        float ls[16], ln[16];
#pragma unroll
        for (int i = 0; i < 16; ++i) { const int key = s0 + (i & 3) + 8 * (i >> 2) + 4 * hh; const bool ok = key < t; const float zz = z[i];
            const float l1p = __logf(1.0f + __expf(-fabsf(zz)));
            ls[i] = ok ? (fminf(zz, 0.f) - l1p) : -INFINITY; ln[i] = ok ? (fminf(-zz, 0.f) - l1p) : 0.f; }
        float gs[4], pg[4];
#pragma unroll
        for (int m = 0; m < 4; ++m) { gs[m] = (ln[4 * m] + ln[4 * m + 1]) + (ln[4 * m + 2] + ln[4 * m + 3]); pg[m] = __shfl_xor(gs[m], 32); }
        float T[4]; T[3] = 0.f; T[2] = gs[3] + pg[3]; T[1] = T[2] + (gs[2] + pg[2]); T[0] = T[1] + (gs[1] + pg[1]);
        const float total = T[0] + (gs[0] + pg[0]);
        float att[16];
#pragma unroll
        for (int m = 0; m < 4; ++m) { float cb = carry + T[m] + (hh == 0 ? pg[m] : 0.f);
#pragma unroll
            for (int e = 3; e >= 0; --e) { att[4 * m + e] = __expf(ls[4 * m + e] + cb); cb += ln[4 * m + e]; } }
        carry += total;
#pragma unroll
        for (int s_ = 0; s_ < 2; ++s_) { u32x4 aw; aw.x = cvt_pk_bf16(att[8 * s_], att[8 * s_ + 1]); aw.y = cvt_pk_bf16(att[8 * s_ + 2], att[8 * s_ + 3]); aw.z = cvt_pk_bf16(att[8 * s_ + 4], att[8 * s_ + 5]); aw.w = cvt_pk_bf16(att[8 * s_ + 6], att[8 * s_ + 7]);
            const bf16x8 af = __builtin_bit_cast(bf16x8, aw);
            o0 = __builtin_amdgcn_mfma_f32_32x32x16_bf16(af, __builtin_bit_cast(bf16x8, (u32x4){vw[0][s_][0], vw[0][s_][1], vw[0][s_][2], vw[0][s_][3]}), o0, 0, 0, 0);
            o1 = __builtin_amdgcn_mfma_f32_32x32x16_bf16(af, __builtin_bit_cast(bf16x8, (u32x4){vw[1][s_][0], vw[1][s_][1], vw[1][s_][2], vw[1][s_][3]}), o1, 0, 0, 0); }
        if (__all(carry < -110.f)) break;
    }
#undef SB_LOAD
    bf16* yp = PMo + (rowb + t0 + 4 * hh) * PMW + C_SB + h * 64 + r32;
#pragma unroll
    for (int i = 0; i < 16; ++i) { const size_t ro = (size_t)((i & 3) + 8 * (i >> 2)) * PMW; yp[ro] = (bf16)f2bf(o0[i]); yp[ro + 32] = (bf16)f2bf(o1[i]); }
}

__device__ __forceinline__ void phase_e(const Args& a, int layer_rep, LAS unsigned char* lds, volatile LAS unsigned* MISC, int vb) {
    const int layer = layer_rep & 1;
    LAS float* L = (LAS float*)lds;
    unsigned* work = (unsigned*)(a.ws + WS_CTL) + CW_WORK + 64 * layer_rep;
    for (int c = vb; c < 64; c += (int)gridDim.x) { if (c < 32) rwkv_chain(a, layer, c, lds); else hgrn_chain(a, layer, c - 32, (LAS unsigned char*)L); }
    for (;;) {
        __syncthreads();
        if (threadIdx.x == 0) MISC[0] = __hip_atomic_fetch_add(work, 1u, __ATOMIC_RELAXED, __HIP_MEMORY_SCOPE_AGENT);
        __syncthreads();
        const unsigned u = (unsigned)__builtin_amdgcn_readfirstlane((int)MISC[0]);
        if (u >= 1024u + NWU) break;
        if (u < NWU) { int tl = threadIdx.x; asm volatile("" : "+v"(tl)); const int wv = tl >> 6, ln = tl & 63; LAS float* scr = (LAS float*)(lds + wv * 16384);
#pragma unroll 1
            for (int it = (int)u * 32 + wv; it < (int)(u + 1u) * 32; it += 8) late_weight_item(a, layer, it, scr, ln); }
        else if (u < NWU + 512u) { const unsigned v = u - NWU; const int bh = (int)(v & 31u), qb = 15 - (int)(v >> 5); const moba_body::bf16* pm = (const moba_body::bf16*)(a.ws + WS_PM);
            moba_body::attn_unit<8>(bh >> 2, bh & 3, qb, pm + C_MB, pm + C_MB + 256, pm + C_MB + 512, (moba_body::bf16*)(a.ws + WS_PM) + C_MB, (const float*)(a.ws + WS_KMP), (char*)lds); }
        else { const unsigned v = u - NWU - 512u; sb_unit(a, (int)(v & 31u), 15 - (int)(v >> 5)); }
    }
}

#if MK_ONE_LAUNCH
#define SEAM() xcd_barrier(bar)
#else
#define SEAM() do {} while (0)
#endif
#define IN(k) (lo <= (k) && (k) < hi)
#define BOTH(k) (IN(k) && IN((k) + 1))
template <int LAYER>
__device__ __forceinline__ void layer_phases(const Args& args, LAS unsigned char* lds, volatile LAS unsigned* MISC, const XcdBarrier& bar, int lo, int hi, int vb0, int G0) {
    constexpr int layer = LAYER;
    unsigned char* ws = args.ws;
    float* xres = args.out;
        const int pb = layer * PPL;
        const float* xin = layer ? (const float*)args.out : args.in[I_X];
        const char* Wb = (const char*)(ws + WS_W);
        if (IN(pb + 0)) { const int vb = opaque_s(vb0), G = opaque_s(G0); for (int rep = 0; rep < (REPEAT_PH == 0 ? 2 : 1); ++rep) { phase_a(args, layer, xin, lds, vb, G); if (rep == 0 && REPEAT_PH == 0) SEAM(); } if (BOTH(pb + 0)) SEAM(); }
        if (IN(pb + 1)) { const int vb = opaque_s(vb0), G = opaque_s(G0);
            pg8::PlainOrder S{LAYER == 0 ? (const char*)(ws + WS_H) : (const char*)xres, Wb + W_IN, 2048u, 2048u, 16, 128, 14, G, vb};
            pg8::EpiBf16S E{(bf16*)(ws + WS_PM), PMW, (const float*)(ws + WS_RSQ1), lds};
            for (int rep = 0; rep < (REPEAT_PH == 1 ? 2 : 1); ++rep) { pg8::gemm_phase<pg8::EpiBf16S, pg8::PlainOrder, true>(lds, S, E); if (rep == 0 && REPEAT_PH == 1) SEAM(); }
            if (BOTH(pb + 1)) SEAM();
        }
        if (IN(pb + 2)) { const int vb = opaque_s(vb0), G = opaque_s(G0); for (int rep = 0; rep < (REPEAT_PH == 2 ? 2 : 1); ++rep) { phase_c(args, layer, lds, vb, G); if (rep == 0 && REPEAT_PH == 2) SEAM(); } if (BOTH(pb + 2)) SEAM(); }
        if (IN(pb + 3)) { const int vb = opaque_s(vb0), G = opaque_s(G0);
            pg8::LoraOrder S{(const char*)(ws + WS_LA), Wb + W_L, Wb + W_V, layer ? 4 : 3, G, vb};
            pg8::EpiBf16 E{(bf16*)(ws + WS_LO), 1024};
            for (int rep = 0; rep < (REPEAT_PH == 3 ? 2 : 1); ++rep) { pg8::gemm_phase<pg8::EpiBf16, pg8::LoraOrder, true>(lds, S, E); if (rep == 0 && REPEAT_PH == 3) SEAM(); }
            if (BOTH(pb + 3)) SEAM();
        }
        if (IN(pb + 4)) { const int vb = opaque_s(vb0), G = opaque_s(G0); for (int rep = 0; rep < (REPEAT_PH == 4 ? 2 : 1); ++rep) { phase_d2(args, layer, lds, vb, G); if (rep == 0 && REPEAT_PH == 4) SEAM(); } if (BOTH(pb + 4)) SEAM(); }
        if (IN(pb + 5)) { const int vb = opaque_s(vb0); for (int rep = 0; rep < (REPEAT_PH == 5 ? 2 : 1); ++rep) { phase_e(args, layer + 2 * rep, lds, MISC, vb); if (rep == 0 && REPEAT_PH == 5) SEAM(); } if (BOTH(pb + 5)) SEAM(); }
        if (IN(pb + 6)) { const int vb = opaque_s(vb0), G = opaque_s(G0); for (int rep = 0; rep < (REPEAT_PH == 6 ? 2 : 1); ++rep) { phase_e2(args, layer, vb, G); if (rep == 0 && REPEAT_PH == 6) SEAM(); } if (BOTH(pb + 6)) SEAM(); }
        if (IN(pb + 7)) { const int vb = opaque_s(vb0), G = opaque_s(G0);
            pg8::MergeOrder S{LAYER == 0 ? (const char*)(ws + WS_H) : (const char*)xres, (const char*)(ws + WS_PM), Wb + W_IN + (size_t)PMW * 2048, Wb + W_B, G, vb};
            pg8::EpiMerge E{(u32x4*)(ws + WS_LA) + (size_t)vb * 8192, (bf16*)(ws + WS_LO), (const float*)(ws + WS_RSQ1), lds};
            for (int rep = 0; rep < (REPEAT_PH == 7 ? 2 : 1); ++rep) { pg8::gemm_phase<pg8::EpiMerge, pg8::MergeOrder, true>(lds, S, E); if (rep == 0 && REPEAT_PH == 7) SEAM(); }
            if (BOTH(pb + 7)) SEAM();
        }
        if (IN(pb + 8)) { const int vb = opaque_s(vb0), G = opaque_s(G0);
            pg8::PlainOrder S{(const char*)(ws + WS_LO), Wb + W_O, 2048u, 2048u, 16, 128, 4, G, vb};
            pg8::EpiResNorm<true, LAYER != 0, true> E{(const void*)xin, LAYER == 0 ? (void*)xres : (void*)(ws + WS_H), (float*)(ws + WS_RSQ2), lds};
            pg8::gemm_phase<pg8::EpiResNorm<true, LAYER != 0, true>, pg8::PlainOrder, true>(lds, S, E);
            if (BOTH(pb + 8)) SEAM();
        }
        if (IN(pb + 10)) { const int vb = opaque_s(vb0), G = opaque_s(G0);
            pg8::PlainOrder S{LAYER == 0 ? (const char*)xres : (const char*)(ws + WS_H), Wb + W_GU, 2048u, 2048u, 16, 128, 22, G, vb};
            pg8::EpiSwiGLU E{(bf16*)(ws + WS_PM), (const float*)(ws + WS_RSQ2), lds};
            for (int rep = 0; rep < (REPEAT_PH == 10 ? 2 : 1); ++rep) { pg8::gemm_phase<pg8::EpiSwiGLU, pg8::PlainOrder, true>(lds, S, E); if (rep == 0 && REPEAT_PH == 10) SEAM(); }
            if (BOTH(pb + 10)) SEAM();
        }
        if (IN(pb + 11)) { const int vb = opaque_s(vb0), G = opaque_s(G0);
            pg8::PlainOrder S{(const char*)(ws + WS_PM), Wb + W_D, (unsigned)(DFF * 2), (unsigned)(DFF * 2), DFF / 64, 128, 4, G, vb};
            if constexpr (LAYER == 0) { pg8::EpiResNorm<true, true, true> E{(const void*)xres, (void*)xres, (float*)(ws + WS_RSQ1), lds};
                pg8::gemm_phase<pg8::EpiResNorm<true, true, true>, pg8::PlainOrder, true>(lds, S, E); }
            else { pg8::EpiResFinal E{(const bf16*)(ws + WS_H), xres, args.in[I_FG], (float*)(ws + WS_RSQ1), (unsigned*)(ws + WS_CTL) + CW_XCH, lds};
                pg8::gemm_phase<pg8::EpiResFinal, pg8::PlainOrder, true>(lds, S, E); }
            if (BOTH(pb + 11)) SEAM();
        }
}

__global__ void __launch_bounds__(512, 2) skel_fwd(Args args) {
    extern __shared__ __attribute__((aligned(16))) unsigned char lds_raw[];
    LAS unsigned char* lds = (LAS unsigned char*)lds_raw;
    volatile LAS unsigned* MISC = (volatile LAS unsigned*)(lds + MISC_OFF);
    const int tid = threadIdx.x;
    const int G0 = gridDim.x, vb0 = blockIdx.x;
    unsigned char* ws = args.ws;
    unsigned* ctl = (unsigned*)(ws + WS_CTL);
    for (int u = tid; u < (LDS_BYTES - LDSCTL_OFF) / 4; u += 512) ((LAS unsigned*)(lds + LDSCTL_OFF))[u] = 0u;
    __syncthreads();
#if MK_ONE_LAUNCH
    XcdBarrier bar = xcd_barrier_post(ctl + CW_BAR, MISC + 8);
#else
    XcdBarrier bar; bar.bar = ctl + CW_BAR; bar.x = 0; bar.st = MISC + 8;
#endif
    const int lo = args.ph_lo, hi = args.ph_hi;
    float* xres = args.out;
    layer_phases<0>(args, lds, MISC, bar, lo, hi, vb0, G0);
    layer_phases<1>(args, lds, MISC, bar, lo, hi, vb0, G0);
#undef IN
#undef BOTH
#undef SEAM
}

extern "C" void kernel_launch(void* const* d_in, const int* in_sizes, int n_in, void* d_out, int out_size, void* d_ws, size_t ws_size, hipStream_t stream) {
    static int grid = 0;
    if (grid == 0) {
        if (n_in != 26 || in_sizes[0] != M * D || out_size != M * D || ws_size < WS_END) { fprintf(stderr, "kernel_launch: unexpected shapes (n_in %d, in0 %d, out %d, ws %zu); nothing launched\n", n_in, n_in > 0 ? in_sizes[0] : -1, out_size, ws_size); grid = -1; return; }
        int dev = 0, cus = 0, per_cu = 0;
        if (hipGetDevice(&dev) != hipSuccess || hipDeviceGetAttribute(&cus, hipDeviceAttributeMultiprocessorCount, dev) != hipSuccess) { grid = -1; return; }
        if (hipFuncSetAttribute((const void*)skel_fwd, hipFuncAttributeMaxDynamicSharedMemorySize, LDS_BYTES) != hipSuccess) { fprintf(stderr, "kernel_launch: hipFuncSetAttribute failed\n"); grid = -1; return; }
        if (hipOccupancyMaxActiveBlocksPerMultiprocessor(&per_cu, (const void*)skel_fwd, 512, LDS_BYTES) != hipSuccess || per_cu < 1) fprintf(stderr, "kernel_launch: occupancy query reports %d\n", per_cu);
        (void)hipGetLastError();
        grid = cus;
    }
    if (grid < 0) return;
    if (hipMemsetAsync((char*)d_ws + WS_CTL, 0, CTL_ZERO_BYTES, stream) != hipSuccess) return;
    Args a{};
    for (int i = 0; i < 26; ++i) a.in[i] = (const float*)d_in[i];
    a.out = (float*)d_out; a.ws = (unsigned char*)d_ws;
#if MK_ONE_LAUNCH
    a.ph_lo = 0; a.ph_hi = NPH;
    hipLaunchKernelGGL(skel_fwd, dim3(grid), dim3(512), LDS_BYTES, stream, a);
#else
    for (int p = 0; p < NPH; ++p) { a.ph_lo = p; a.ph_hi = p + 1; hipLaunchKernelGGL(skel_fwd, dim3(grid), dim3(512), LDS_BYTES, stream, a); }
#endif
}
```

```cpp
#include <hip/hip_runtime.h>
#include <cstdio>
#include <cstdint>

#ifndef REPEAT_PH
#define REPEAT_PH -1
#endif
#ifndef MK_ONE_LAUNCH
#define MK_ONE_LAUNCH 1
#endif

#define LAS __attribute__((address_space(3)))
#define GAS __attribute__((address_space(1)))
typedef unsigned short bf16;
typedef short bf16x8 __attribute__((ext_vector_type(8)));
typedef float f32x4 __attribute__((ext_vector_type(4)));
typedef float f32x2 __attribute__((ext_vector_type(2)));
typedef unsigned u32x4 __attribute__((ext_vector_type(4)));
typedef unsigned u32x2 __attribute__((ext_vector_type(2)));

constexpr int D = 1024, NBATCH = 8, SEQ = 4096, M = NBATCH * SEQ, DFF = 2816, NH = 4, HD = 64, MW = 256;
constexpr int PMW = 3584;
constexpr int C_SB = 0, C_RW = 768, C_MB = 1792, C_HG = 2560;
constexpr int PPL = 12, NPH = 2 * PPL;

constexpr size_t MiB = 1u << 20;
constexpr size_t WS_CTL = 0, CTL_ZERO_BYTES = 1 * MiB;
constexpr size_t WS_ROPE = 1 * MiB;
constexpr size_t WS_KMP = 1 * MiB + 512 * 1024;
constexpr size_t WS_BON = 2 * MiB;
constexpr size_t WS_RSQ1 = 2 * MiB + 512 * 1024;
constexpr size_t WS_RSQ2 = 3 * MiB;
constexpr size_t WS_W = 4 * MiB;
constexpr size_t W_IN = 0, W_B = 15728640, W_O = W_B + 2097152, W_GU = W_O + 2097152, W_D = W_GU + 11534336, W_L = W_D + 5767168, W_V = W_L + 393216, W_END = W_V + 131072;
static_assert(W_END == 36 * MiB, "weights");
constexpr size_t WS_H = 40 * MiB;
constexpr size_t WS_PM = 104 * MiB;
constexpr size_t WS_LA = 328 * MiB;
constexpr size_t RS_ENTRY = 13056;
constexpr size_t WS_RS = 328 * MiB;
constexpr size_t WS_LO = 432 * MiB;
constexpr size_t WS_VF = 496 * MiB;
constexpr size_t WS_END = 512 * MiB;
static_assert(WS_RS + 8192 * RS_ENTRY <= WS_LO, "rwkv chunk stream");
constexpr int CW_TMO = 0;
constexpr int CW_BAR = 4096;
constexpr int CW_XCH = 32768;
constexpr int CW_WORK = 16384;

constexpr int RING_BYTES = 131072;
constexpr int LDSCTL_OFF = RING_BYTES, MISC_OFF = LDSCTL_OFF + 320;
constexpr int LDS_XP = RING_BYTES + 1024, LDS_RSL = LDS_XP + 4096;
constexpr int LDS_BYTES = 147456;

__device__ __forceinline__ unsigned f2bf(float f) { unsigned u = __builtin_bit_cast(unsigned, f); return (u + 0x7fffu + ((u >> 16) & 1u)) >> 16; }
__device__ __forceinline__ unsigned pk2(float lo, float hi) { return f2bf(lo) | (f2bf(hi) << 16); }
__device__ __forceinline__ float bf2f(unsigned short b) { return __builtin_bit_cast(float, ((unsigned)b) << 16); }
__device__ __forceinline__ float bflo(unsigned w) { return __builtin_bit_cast(float, w << 16); }
__device__ __forceinline__ float bfhi(unsigned w) { return __builtin_bit_cast(float, w & 0xffff0000u); }
typedef __bf16 bf16x2_t __attribute__((ext_vector_type(2)));
__device__ __forceinline__ unsigned cvt_pk_bf16(float lo, float hi) { f32x2 v = {lo, hi}; bf16x2_t b = __builtin_convertvector(v, bf16x2_t); return __builtin_bit_cast(unsigned, b); }
__device__ __forceinline__ float wave_sum(float v) {
#pragma unroll
    for (int o = 1; o < 64; o <<= 1) v += __shfl_xor(v, o);
    return v;
}
__device__ __forceinline__ float sigmoidf_(float x) { return __builtin_amdgcn_rcpf(1.0f + __expf(-x)); }
#define LDS_WAIT() asm volatile("s_waitcnt lgkmcnt(0)" ::: "memory")
#define LBAR() do { asm volatile("s_waitcnt lgkmcnt(0)" ::: "memory"); __builtin_amdgcn_s_barrier(); asm volatile("" ::: "memory"); } while (0)
__device__ __forceinline__ f32x4 ld4bf(const bf16* p) { const u32x2 w = *(const u32x2*)p; return (f32x4){bflo(w.x), bfhi(w.x), bflo(w.y), bfhi(w.y)}; }
__device__ __forceinline__ float dpp_sum16(float x);
__device__ __forceinline__ int opaque_s(int v) { asm volatile("" : "+s"(v)); return v; }

__device__ __forceinline__ void st4bf(bf16* p, f32x4 v) { u32x2 w; w.x = cvt_pk_bf16(v.x, v.y); w.y = cvt_pk_bf16(v.z, v.w); *(u32x2*)p = w; }
__device__ __forceinline__ float dpp_sum16(float x) {
    x += __builtin_bit_cast(float, __builtin_amdgcn_update_dpp(0, __builtin_bit_cast(int, x), 0xB1, 0xF, 0xF, true));
    x += __builtin_bit_cast(float, __builtin_amdgcn_update_dpp(0, __builtin_bit_cast(int, x), 0x4E, 0xF, 0xF, true));
    x += __builtin_bit_cast(float, __builtin_amdgcn_update_dpp(0, __builtin_bit_cast(int, x), 0x141, 0xF, 0xF, true));
    x += __builtin_bit_cast(float, __builtin_amdgcn_update_dpp(0, __builtin_bit_cast(int, x), 0x140, 0xF, 0xF, true));
    return x;
}
__device__ __forceinline__ float dpp_xor2(float x) { int r; asm volatile("s_nop 1\n\tv_mov_b32_dpp %0, %1 quad_perm:[2,3,0,1] row_mask:0xf bank_mask:0xf\n\ts_nop 0" : "=&v"(r) : "v"(__builtin_bit_cast(int, x))); return __builtin_bit_cast(float, r); }
__device__ __forceinline__ float softplusf_(float x) { return fmaxf(x, 0.f) + __logf(1.0f + __expf(-fabsf(x))); }
#define XB_TMO      128
#define XB_XCNT(j)  (256  + 64 * (j))
#define XB_XSUB(j)  (1280 + 64 * (j))
#define XB_XGEN(j)  (2304 + 64 * (j))
#define XB_TOP      3328
#define XB_TOPGEN   3392
#define XCD_BAR_WORDS 3456
#define XB_SPIN_CAP (1u << 22)
__device__ __forceinline__ unsigned xb_ld(unsigned* p)              { return __hip_atomic_load(p, __ATOMIC_RELAXED, __HIP_MEMORY_SCOPE_AGENT); }
__device__ __forceinline__ unsigned xb_add(unsigned* p, unsigned v) { return __hip_atomic_fetch_add(p, v, __ATOMIC_RELAXED, __HIP_MEMORY_SCOPE_AGENT); }
__device__ __forceinline__ unsigned xb_xcc_id() { return (unsigned)__builtin_amdgcn_s_getreg((3 << 11) | 20) & 0xFu; }
#define XB_SPIN(cond, bar) do { unsigned _sp = 0; while (cond) { __builtin_amdgcn_s_sleep(1); \
    if ((++_sp & 255u) == 0u) { if (xb_ld(&(bar)[XB_TMO])) break; if (_sp > XB_SPIN_CAP) { atomicAdd(&(bar)[XB_TMO], 1u); break; } } } } while (0)
struct XcdBarrier { unsigned* bar; unsigned x; volatile LAS unsigned* st; };
__device__ __forceinline__ XcdBarrier xcd_barrier_post(unsigned* bar, volatile LAS unsigned* st) {
    XcdBarrier b; b.bar = bar; b.x = xb_xcc_id(); b.st = st;
    if (threadIdx.x == 0) (void)xb_add(&bar[XB_XCNT(b.x)], 1u);
    return b;
}
__device__ __forceinline__ void xcd_barrier_complete(unsigned* bar, unsigned x, unsigned& nloc, unsigned& nx) {
    const unsigned G = gridDim.x * gridDim.y * gridDim.z;
    unsigned sum, cnt, mine, sp = 0u;
    for (;;) {
        sum = 0u; cnt = 0u; mine = 0u;
#pragma unroll
        for (unsigned j = 0; j < 16; ++j) { const unsigned c = xb_ld(&bar[XB_XCNT(j)]); sum += c; cnt += (c > 0u) ? 1u : 0u; mine = (j == x) ? c : mine; }
        if (sum == G) break;
        __builtin_amdgcn_s_sleep(1);
        if ((++sp & 255u) == 0u) { if (xb_ld(&bar[XB_TMO])) break; if (sp > XB_SPIN_CAP) { atomicAdd(&bar[XB_TMO], 1u); break; } }
    }
    nloc = mine > 0u ? mine : 1u; nx = cnt > 0u ? cnt : 1u;
}
__device__ __forceinline__ void xcd_barrier(const XcdBarrier& b) {
    asm volatile("s_waitcnt vmcnt(0)" ::: "memory");
    __syncthreads();
    if (threadIdx.x == 0) {
        unsigned* bar = b.bar;
        __builtin_amdgcn_s_waitcnt(0);
        unsigned nloc = b.st[0], nx = b.st[1];
        if (nloc == 0u) { xcd_barrier_complete(bar, b.x, nloc, nx); b.st[0] = nloc; b.st[1] = nx; }
        const unsigned old = xb_add(&bar[XB_XSUB(b.x)], 1u);
        const unsigned gen = old / nloc;
        if (old + 1u == (gen + 1u) * nloc) {
            __builtin_amdgcn_fence(__ATOMIC_RELEASE, "agent");
            asm volatile("s_waitcnt vmcnt(0)" ::: "memory");
            const unsigned og = xb_add(&bar[XB_TOP], 1u);
            const unsigned tg = og / nx;
            if (og + 1u == (tg + 1u) * nx) xb_add(&bar[XB_TOPGEN], 1u);
            else XB_SPIN(xb_ld(&bar[XB_TOPGEN]) == tg, bar);
            __builtin_amdgcn_fence(__ATOMIC_ACQUIRE, "agent");
            xb_add(&bar[XB_XGEN(b.x)], 1u);
            asm volatile("s_waitcnt vmcnt(0)" ::: "memory");
        } else {
            XB_SPIN(xb_ld(&bar[XB_XGEN(b.x)]) == gen, bar);
            __builtin_amdgcn_fence(__ATOMIC_ACQUIRE, "agent");
            asm volatile("s_waitcnt vmcnt(0)" ::: "memory");
        }
    }
    __syncthreads();
}

namespace pg8 {
constexpr int BM = 256, BK = 64, HALF = 128, HTB = HALF * BK * 2, STAGE_BYTES = 8 * HTB, NXCD = 8, WGM = 8;
__host__ __device__ __forceinline__ int lds_byte(int r, int c) { const int st = (r >> 4) * 2 + (c >> 5), rr = r & 15, cc = c & 31, ob = rr * 64 + cc * 2; return st * 1024 + (ob ^ (((ob >> 9) & 1) << 5)); }
__host__ __device__ __forceinline__ void stage_rc(int b, int& R, int& C) { const int st = b / 1024, sb = b % 1024, swz = sb ^ (((sb >> 9) & 1) << 5); R = (st >> 1) * 16 + swz / 64; C = (st & 1) * 32 + (swz % 64) / 2; }
__host__ __device__ __forceinline__ int perm32(int rho) { const int n = rho >> 4, i = rho & 15; return 8 * (i >> 2) + 4 * n + (i & 3); }

struct GU { const char* a; const char* b; unsigned lda2, ldb2; int nt, pm, pn, sub; };

__device__ __forceinline__ void tile_of(int L, int nM, int nN, int& pm, int& pn) {
    const int nwg = nM * nN;
    int wgid = L; { const int q = nwg / NXCD, r = nwg % NXCD, xcd = wgid % NXCD, off = wgid / NXCD; wgid = (xcd < r ? xcd * (q + 1) : r * (q + 1) + (xcd - r) * q) + off; }
    const int nig = WGM * nN, gid = wgid / nig, fm = gid * WGM, gsz = (nM - fm) < WGM ? (nM - fm) : WGM;
    pm = fm + ((wgid % nig) % gsz); pn = (wgid % nig) / gsz;
}

template <class Epi, class Sched, bool ALIGN_EPI>
__device__ __forceinline__ void gemm_phase(LAS unsigned char* lds, const Sched& S, const Epi& E) {
    int tid = threadIdx.x; asm volatile("" : "+v"(tid));
    const int wid = __builtin_amdgcn_readfirstlane(tid >> 6), lane = tid & 63, wr = wid >> 2, wc = wid & 3, fr = lane & 15, fq = lane >> 4;
    unsigned Rr, Rb, C2;
    { int R, C; stage_rc(tid * 16, R, C); Rr = (unsigned)R; Rb = (unsigned)(Epi::PERM ? ((R & ~31) + perm32(R & 31)) : R); C2 = (unsigned)C * 2u; }
    const size_t kstep = (size_t)(BK * 2);
    const unsigned ldsw = (unsigned)wid * 1024u;
    const int aoff = lds_byte(wr * 64 + fr, fq * 8), boff = lds_byte(wc * 32 + fr, fq * 8);
#define PG8_SA(b, h) (((b) * 2 + (h)) * HTB)
#define PG8_SB(b, h) ((4 + (b) * 2 + (h)) * HTB)
#define PG8_STAGE(bufoff, gbase, R, ld) do { const unsigned _v0 = (R) * (ld) + C2; \
        __builtin_amdgcn_global_load_lds((const unsigned*)((const char*)(gbase) + _v0), (LAS unsigned*)(lds + (bufoff) + ldsw), 16, 0, 0); \
        __builtin_amdgcn_global_load_lds((const unsigned*)((const char*)(gbase) + _v0 + 64u * (ld)), (LAS unsigned*)(lds + (bufoff) + ldsw + 8192), 16, 0, 0); } while (0)
#define PG8_LDA(dst, b, h) do { _Pragma("unroll") for (int m = 0; m < 4; ++m) _Pragma("unroll") for (int k = 0; k < 2; ++k) dst[m][k] = *(const LAS bf16x8*)(lds + PG8_SA(b, h) + aoff + m * 2048 + k * 1024); } while (0)
#define PG8_LDB(dst, b, h) do { _Pragma("unroll") for (int n = 0; n < 2; ++n) _Pragma("unroll") for (int k = 0; k < 2; ++k) dst[n][k] = *(const LAS bf16x8*)(lds + PG8_SB(b, h) + boff + n * 2048 + k * 1024); } while (0)
#define PG8_MMA(ai, bj, At, Bt) do { __builtin_amdgcn_s_setprio(1); _Pragma("unroll") for (int m = 0; m < 4; ++m) _Pragma("unroll") for (int n = 0; n < 2; ++n) _Pragma("unroll") for (int k = 0; k < 2; ++k) \
        acc[ai][bj][m][n] = __builtin_amdgcn_mfma_f32_16x16x32_bf16(Bt[n][k], At[m][k], acc[ai][bj][m][n], 0, 0, 0); __builtin_amdgcn_s_setprio(0); } while (0)
#define PG8_WAIT_V(n) asm volatile("s_waitcnt vmcnt(" #n ")" ::: "memory")
#define PG8_WAIT_E() asm volatile("s_waitcnt vmcnt(%0)" :: "n"(8 + Epi::EOPS) : "memory")
#define PG8_PAIR(W1, W2, a1, a2, b2, a3, b3, xldA, xldB) do { \
              \
            PG8_LDB(B0, 0, 0); PG8_LDB(B1, 0, 1); PG8_SCHED; PG8_LDA(At, 0, 0); PG8_STAGE(PG8_SA(1, 1), (a1) + (size_t)HALF * ldA, Rr, ldA); \
            W1; PG8_WAIT_L(0); PG8_BAR; PG8_MMA(0, 0, At, B0); PG8_MMA(0, 1, At, B1); PG8_BAR; PG8_SCHED; \
              \
            PG8_LDA(At, 0, 1); PG8_STAGE(PG8_SB(0, 0), (b2), Rb, (xldB)); PG8_STAGE(PG8_SB(0, 1), (b2) + (size_t)HALF * (xldB), Rb, (xldB)); PG8_STAGE(PG8_SA(0, 0), (a2), Rr, (xldA)); \
            W2; PG8_WAIT_L(0); PG8_BAR; PG8_MMA(1, 0, At, B0); PG8_MMA(1, 1, At, B1); PG8_BAR; PG8_SCHED; \
              \
            PG8_LDB(B0, 1, 0); PG8_LDB(B1, 1, 1); PG8_SCHED; PG8_LDA(At, 1, 0); PG8_STAGE(PG8_SA(0, 1), (a2) + (size_t)HALF * (xldA), Rr, (xldA)); \
            PG8_WAIT_V(8); PG8_WAIT_L(0); PG8_BAR; PG8_MMA(0, 0, At, B0); PG8_MMA(0, 1, At, B1); PG8_BAR; PG8_SCHED; \
              \
            PG8_LDA(At, 1, 1); PG8_STAGE(PG8_SB(1, 0), (b3), Rb, (xldB)); PG8_STAGE(PG8_SB(1, 1), (b3) + (size_t)HALF * (xldB), Rb, (xldB)); PG8_STAGE(PG8_SA(1, 0), (a3), Rr, (xldA)); \
            PG8_WAIT_V(8); PG8_WAIT_L(0); PG8_BAR; PG8_MMA(1, 0, At, B0); PG8_MMA(1, 1, At, B1); PG8_BAR; PG8_SCHED; } while (0)
#define PG8_WAIT_L(n) asm volatile("s_waitcnt lgkmcnt(" #n ")" ::: "memory")
#define PG8_BAR __builtin_amdgcn_s_barrier()
#define PG8_SCHED __builtin_amdgcn_sched_barrier(0)
    GU cur, nxt; int ui = 0;
    if (!S.next(0, cur)) return;
    f32x4 acc[2][2][4][2];
#pragma unroll
    for (int a = 0; a < 2; ++a)
#pragma unroll
        for (int b = 0; b < 2; ++b)
#pragma unroll
            for (int m = 0; m < 4; ++m)
#pragma unroll
                for (int n = 0; n < 2; ++n) acc[a][b][m][n] = (f32x4){0.f, 0.f, 0.f, 0.f};
    bf16x8 At[4][2], B0[2][2], B1[2][2];
    const char* cA = cur.a; const char* cB = cur.b;
    unsigned ldA = cur.lda2, ldB = cur.ldb2;
    PG8_STAGE(PG8_SB(0, 0), cB, Rb, ldB); PG8_STAGE(PG8_SB(0, 1), cB + (size_t)HALF * ldB, Rb, ldB); PG8_STAGE(PG8_SA(0, 0), cA, Rr, ldA); PG8_STAGE(PG8_SA(0, 1), cA + (size_t)HALF * ldA, Rr, ldA);
    if (wr == 1) PG8_BAR;
    PG8_WAIT_V(2); PG8_BAR;
    PG8_STAGE(PG8_SB(1, 0), cB + kstep, Rb, ldB); PG8_STAGE(PG8_SA(1, 0), cA + kstep, Rr, ldA); PG8_STAGE(PG8_SB(1, 1), cB + (size_t)HALF * ldB + kstep, Rb, ldB);
    PG8_WAIT_V(6); PG8_BAR;
    PG8_PAIR(PG8_WAIT_V(8), PG8_WAIT_V(8), cA + kstep, cA + 2 * kstep, cB + 2 * kstep, cA + 3 * kstep, cB + 3 * kstep, ldA, ldB);
    for (;;) {
        const bool has_next = S.next(ui + 1, nxt);
        const char* nA = has_next ? nxt.a : cA; const char* nB = has_next ? nxt.b : cB;
        const unsigned nldA = has_next ? nxt.lda2 : ldA, nldB = has_next ? nxt.ldb2 : ldB;
        const int nt = cur.nt;
        for (int t = 2; t < nt; t += 2) {
            const bool last = (t == nt - 2);
            const char* a1 = cA + (size_t)(t + 1) * kstep;
            const char* a2 = last ? nA : cA + (size_t)(t + 2) * kstep; const char* b2 = last ? nB : cB + (size_t)(t + 2) * kstep;
            const char* a3 = a2 + kstep; const char* b3 = b2 + kstep;
            const unsigned xldA = last ? nldA : ldA, xldB = last ? nldB : ldB;
            PG8_PAIR(PG8_WAIT_V(8), PG8_WAIT_V(8), a1, a2, b2, a3, b3, xldA, xldB);
        }
        if constexpr (ALIGN_EPI) { if (wr == 0) PG8_BAR; }
        E(acc, cur, wr, wc, fr, fq);
        if (!has_next) break;
#pragma unroll
        for (int a = 0; a < 2; ++a)
#pragma unroll
            for (int b = 0; b < 2; ++b)
#pragma unroll
                for (int m = 0; m < 4; ++m)
#pragma unroll
                    for (int n = 0; n < 2; ++n) acc[a][b][m][n] = (f32x4){0.f, 0.f, 0.f, 0.f};
        cur = nxt; cA = nA; cB = nB; ldA = nldA; ldB = nldB; ++ui;
        if constexpr (ALIGN_EPI) { if (wr == 1) PG8_BAR; }
        PG8_PAIR(PG8_WAIT_E(), PG8_WAIT_E(), cA + kstep, cA + 2 * kstep, cB + 2 * kstep, cA + 3 * kstep, cB + 3 * kstep, ldA, ldB);
    }
    PG8_WAIT_V(0);
    if constexpr (!ALIGN_EPI) { if (wr == 0) PG8_BAR; }
    PG8_BAR;
#undef PG8_SA
#undef PG8_SB
#undef PG8_STAGE
#undef PG8_LDA
#undef PG8_LDB
#undef PG8_MMA
#undef PG8_WAIT_V
#undef PG8_WAIT_E
#undef PG8_PAIR
#undef PG8_WAIT_L
#undef PG8_BAR
#undef PG8_SCHED
}

struct PlainOrder {
    const char* A; const char* B; unsigned lda2, ldb2; int nt, nM, nN, G, c;
    __device__ __forceinline__ bool next(int i, GU& u) const {
        const int L = i * G + c; if (L >= nM * nN) return false;
        int pm, pn; tile_of(L, nM, nN, pm, pn);
        u.pm = pm; u.pn = pn; u.sub = 0; u.nt = nt; u.lda2 = lda2; u.ldb2 = ldb2;
        u.a = A + (size_t)pm * 256 * lda2; u.b = B + (size_t)pn * 256 * ldb2; return true;
    }
};
struct LoraOrder {
    const char* A; const char* Bl; const char* Bv; int nN, G, c;
    __device__ __forceinline__ bool next(int i, GU& u) const {
        const int L = i * G + c; if (L >= 128 * nN) return false;
        int pm, pn; tile_of(L, 128, nN, pm, pn);
        u.pm = pm; u.pn = pn; u.sub = 0; u.nt = 4; u.lda2 = 1024; u.ldb2 = 512;
        u.a = A + (size_t)pm * 256 * 1024 + (pn == 3 ? 512 : 0); u.b = (pn == 3) ? Bv : Bl + (size_t)pn * 256 * 512; return true;
    }
};
struct MergeOrder {
    const char* Hh; const char* Yy; const char* Wg; const char* Wb; int G, c;
    __device__ __forceinline__ bool next(int i, GU& u) const {
        const int ti = i >> 3, sub = i & 7, n = sub >> 1;
        const int L = ti * G + c; if (L >= 512) return false;
        int pm, pn; tile_of(L, 128, 4, pm, pn);
        u.pm = pm; u.pn = pn; u.sub = sub; u.lda2 = 2048;
        if ((sub & 1) == 0) { u.a = Hh + (size_t)pm * 256 * 2048; u.b = Wg + (size_t)(n * 1024 + pn * 256) * 2048; u.ldb2 = 2048; u.nt = 16; }
        else { const int co = n == 0 ? C_SB : (n == 1 ? C_RW : (n == 2 ? C_MB : C_HG)); u.a = Yy + (size_t)pm * 256 * (PMW * 2) + co * 2; u.lda2 = PMW * 2; u.b = Wb + (size_t)(n * 1024 + pn * 256) * 512; u.ldb2 = 512; u.nt = 4; }
        return true;
    }
};

__device__ __forceinline__ void unit_row_scales(const float* rsq, int pm, LAS unsigned char* ldsx, int tid, int wr, int fr, float (&rs)[2][4]) {
    LAS float* RSL = (LAS float*)(ldsx + LDS_RSL);
    if (tid < 256) { const f32x4 q = *(const f32x4*)(rsq + (size_t)(pm * 256 + tid) * 4); RSL[tid] = 1.0f / sqrtf(((q.x + q.y) + (q.z + q.w)) * (1.f / D) + 1e-6f); }
    LBAR();
#pragma unroll
    for (int ai = 0; ai < 2; ++ai)
#pragma unroll
        for (int m = 0; m < 4; ++m) rs[ai][m] = RSL[ai * HALF + wr * 64 + m * 16 + fr];
}
struct EpiBf16S {
    static constexpr int EOPS = 16; static constexpr bool PERM = true;
    bf16* O; int ldc; const float* rsq; LAS unsigned char* ldsx;
    __device__ __forceinline__ void operator()(const f32x4 (&acc)[2][2][4][2], const GU& u, int wr, int wc, int fr, int fq) const {
        int tid = threadIdx.x; asm volatile("" : "+v"(tid));
        fr = tid & 15; fq = (tid >> 4) & 3;
        float rs[2][4]; unit_row_scales(rsq, u.pm, ldsx, tid, wr, fr, rs);
        const int row0 = u.pm * BM + wr * 64 + fr, col0 = u.pn * BM + wc * 32 + 8 * fq;
#pragma unroll
        for (int ai = 0; ai < 2; ++ai)
#pragma unroll
            for (int m = 0; m < 4; ++m) { bf16* rowp = O + (size_t)(row0 + ai * HALF + m * 16) * ldc + col0; const float r_ = rs[ai][m];
#pragma unroll
                for (int bj = 0; bj < 2; ++bj) { const f32x4 v0 = acc[ai][bj][m][0] * r_, v1 = acc[ai][bj][m][1] * r_;
                    u32x4 w; w.x = cvt_pk_bf16(v0[0], v0[1]); w.y = cvt_pk_bf16(v0[2], v0[3]); w.z = cvt_pk_bf16(v1[0], v1[1]); w.w = cvt_pk_bf16(v1[2], v1[3]);
                    *(u32x4*)(rowp + bj * HALF) = w; } }
    }
};
struct EpiBf16 {
    static constexpr int EOPS = 16; static constexpr bool PERM = true;
    bf16* O; int ldc;
    __device__ __forceinline__ void operator()(const f32x4 (&acc)[2][2][4][2], const GU& u, int wr, int wc, int fr, int fq) const {
        { int tid = threadIdx.x; asm volatile("" : "+v"(tid)); fr = tid & 15; fq = (tid >> 4) & 3; }
        const int row0 = u.pm * BM + wr * 64 + fr, col0 = u.pn * BM + wc * 32 + 8 * fq;
#pragma unroll
        for (int ai = 0; ai < 2; ++ai)
#pragma unroll
            for (int m = 0; m < 4; ++m) { bf16* rowp = O + (size_t)(row0 + ai * HALF + m * 16) * ldc + col0;
#pragma unroll
                for (int bj = 0; bj < 2; ++bj) { const f32x4 v0 = acc[ai][bj][m][0], v1 = acc[ai][bj][m][1];
                    u32x4 w; w.x = cvt_pk_bf16(v0[0], v0[1]); w.y = cvt_pk_bf16(v0[2], v0[3]); w.z = cvt_pk_bf16(v1[0], v1[1]); w.w = cvt_pk_bf16(v1[2], v1[3]);
                    *(u32x4*)(rowp + bj * HALF) = w; } }
    }
};
struct EpiSwiGLU {
    static constexpr int EOPS = 8; static constexpr bool PERM = true;
    bf16* O; const float* rsq; LAS unsigned char* ldsx;
    __device__ __forceinline__ void operator()(const f32x4 (&acc)[2][2][4][2], const GU& u, int wr, int wc, int fr, int fq) const {
        int tid = threadIdx.x; asm volatile("" : "+v"(tid));
        fr = tid & 15; fq = (tid >> 4) & 3;
        float rs[2][4]; unit_row_scales(rsq, u.pm, ldsx, tid, wr, fr, rs);
        const int row0 = u.pm * BM + wr * 64 + fr, col0 = u.pn * HALF + wc * 32 + 8 * fq;
#pragma unroll
        for (int ai = 0; ai < 2; ++ai)
#pragma unroll
            for (int m = 0; m < 4; ++m) { bf16* rowp = O + (size_t)(row0 + ai * HALF + m * 16) * DFF + col0;
                float r[8];
#pragma unroll
                for (int n = 0; n < 2; ++n)
#pragma unroll
                    for (int j = 0; j < 4; ++j) { const float g = acc[ai][0][m][n][j] * rs[ai][m], up = acc[ai][1][m][n][j] * rs[ai][m]; r[n * 4 + j] = g * sigmoidf_(g) * up; }
                u32x4 w; w.x = cvt_pk_bf16(r[0], r[1]); w.y = cvt_pk_bf16(r[2], r[3]); w.z = cvt_pk_bf16(r[4], r[5]); w.w = cvt_pk_bf16(r[6], r[7]);
                *(u32x4*)rowp = w; }
    }
};
template <bool EMIT, bool IN16, bool OUT16>
struct EpiResNorm {
    static constexpr int EOPS = 16; static constexpr bool PERM = true;
    const void* base; void* out; float* rsq; LAS unsigned char* ldsx;
    __device__ __forceinline__ void operator()(const f32x4 (&acc)[2][2][4][2], const GU& u, int wr, int wc, int fr, int fq) const {
        int tid = threadIdx.x; asm volatile("" : "+v"(tid));
        fr = tid & 15; fq = (tid >> 4) & 3;
        const int row0 = u.pm * BM + wr * 64 + fr, col0 = u.pn * BM + wc * 32 + 8 * fq;
        LAS float* P = (LAS float*)(ldsx + LDS_XP);
#pragma unroll
        for (int ai = 0; ai < 2; ++ai)
#pragma unroll
            for (int m = 0; m < 4; ++m) { const size_t off = (size_t)(row0 + ai * HALF + m * 16) * D + col0; float sq = 0.f;
                f32x4 bs[2][2];
#pragma unroll
                for (int bj = 0; bj < 2; ++bj) {
                    if constexpr (IN16) { const u32x4 w = *(const u32x4*)((const bf16*)base + off + bj * HALF);
                        bs[bj][0] = (f32x4){bflo(w.x), bfhi(w.x), bflo(w.y), bfhi(w.y)}; bs[bj][1] = (f32x4){bflo(w.z), bfhi(w.z), bflo(w.w), bfhi(w.w)}; }
                    else { bs[bj][0] = *(const f32x4*)((const float*)base + off + bj * HALF); bs[bj][1] = *(const f32x4*)((const float*)base + off + bj * HALF + 4); } }
#pragma unroll
                for (int bj = 0; bj < 2; ++bj) { const f32x4 x0 = bs[bj][0] + acc[ai][bj][m][0], x1 = bs[bj][1] + acc[ai][bj][m][1];
                    if constexpr (OUT16) { u32x4 w; w.x = cvt_pk_bf16(x0.x, x0.y); w.y = cvt_pk_bf16(x0.z, x0.w); w.z = cvt_pk_bf16(x1.x, x1.y); w.w = cvt_pk_bf16(x1.z, x1.w); *(u32x4*)((bf16*)out + off + bj * HALF) = w; }
                    else { *(f32x4*)((float*)out + off + bj * HALF) = x0; *(f32x4*)((float*)out + off + bj * HALF + 4) = x1; }
                    if constexpr (EMIT) sq += ((x0.x * x0.x + x0.y * x0.y) + (x0.z * x0.z + x0.w * x0.w)) + ((x1.x * x1.x + x1.y * x1.y) + (x1.z * x1.z + x1.w * x1.w)); }
                if constexpr (EMIT) { sq += __shfl_xor(sq, 16); sq += __shfl_xor(sq, 32); if (fq == 0) P[(ai * HALF + wr * 64 + m * 16 + fr) * 4 + wc] = sq; } }
        if constexpr (EMIT) { LBAR();
            if (tid < 256) { const f32x4 p = *(const LAS f32x4*)(P + tid * 4); rsq[(size_t)(u.pm * BM + tid) * 4 + u.pn] = (p.x + p.y) + (p.z + p.w); }
            LBAR(); }
    }
};
struct EpiResFinal {
    static constexpr int EOPS = 32; static constexpr bool PERM = true;
    const bf16* base; float* out; const float* g; float* rsq; unsigned* cnt; LAS unsigned char* ldsx;
    __device__ __forceinline__ void operator()(f32x4 (&acc)[2][2][4][2], const GU& u, int wr, int wc, int fr, int fq) const {
        int tid = threadIdx.x; asm volatile("" : "+v"(tid));
        fr = tid & 15; fq = (tid >> 4) & 3;
        const int row0 = u.pm * BM + wr * 64 + fr, col0 = u.pn * BM + wc * 32 + 8 * fq;
        LAS float* P = (LAS float*)(ldsx + LDS_XP);
        LAS float* RSL = (LAS float*)(ldsx + LDS_RSL);
#pragma unroll
        for (int ai = 0; ai < 2; ++ai)
#pragma unroll
            for (int m = 0; m < 4; ++m) { const size_t off = (size_t)(row0 + ai * HALF + m * 16) * D + col0; float sq = 0.f;
                u32x4 w[2];
#pragma unroll
                for (int bj = 0; bj < 2; ++bj) w[bj] = *(const u32x4*)(base + off + bj * HALF);
#pragma unroll
                for (int bj = 0; bj < 2; ++bj) { const f32x4 x0 = (f32x4){bflo(w[bj].x), bfhi(w[bj].x), bflo(w[bj].y), bfhi(w[bj].y)} + acc[ai][bj][m][0], x1 = (f32x4){bflo(w[bj].z), bfhi(w[bj].z), bflo(w[bj].w), bfhi(w[bj].w)} + acc[ai][bj][m][1];
                    acc[ai][bj][m][0] = x0; acc[ai][bj][m][1] = x1;
                    sq += ((x0.x * x0.x + x0.y * x0.y) + (x0.z * x0.z + x0.w * x0.w)) + ((x1.x * x1.x + x1.y * x1.y) + (x1.z * x1.z + x1.w * x1.w)); }
                sq += __shfl_xor(sq, 16); sq += __shfl_xor(sq, 32); if (fq == 0) P[(ai * HALF + wr * 64 + m * 16 + fr) * 4 + wc] = sq; }
        LBAR();
        if (tid < 256) { const f32x4 p = *(const LAS f32x4*)(P + tid * 4); rsq[(size_t)(u.pm * BM + tid) * 4 + u.pn] = (p.x + p.y) + (p.z + p.w); }
        asm volatile("s_waitcnt vmcnt(0)" ::: "memory");
        LBAR();
        if (tid == 0) { unsigned* c = cnt + u.pm * 16;
            __builtin_amdgcn_fence(__ATOMIC_RELEASE, "agent");
            asm volatile("s_waitcnt vmcnt(0)" ::: "memory");
            (void)xb_add(c, 1u);
            unsigned sp = 0u; while (xb_ld(c) < 4u) { __builtin_amdgcn_s_sleep(1); if (++sp > XB_SPIN_CAP) break; }
            __builtin_amdgcn_fence(__ATOMIC_ACQUIRE, "agent");
            asm volatile("s_waitcnt vmcnt(0)" ::: "memory"); }
        LBAR();
        if (tid < 256) { const f32x4 q = *(const f32x4*)(rsq + (size_t)(u.pm * BM + tid) * 4); RSL[tid] = 1.0f / sqrtf(((q.x + q.y) + (q.z + q.w)) * (1.f / D) + 1e-6f); }
        LBAR();
        f32x4 gv[2][2];
#pragma unroll
        for (int bj = 0; bj < 2; ++bj)
#pragma unroll
            for (int n = 0; n < 2; ++n) gv[bj][n] = *(const f32x4*)(g + col0 + bj * HALF + n * 4);
#pragma unroll
        for (int ai = 0; ai < 2; ++ai)
#pragma unroll
            for (int m = 0; m < 4; ++m) { const size_t off = (size_t)(row0 + ai * HALF + m * 16) * D + col0; const float r_ = RSL[ai * HALF + wr * 64 + m * 16 + fr];
#pragma unroll
                for (int bj = 0; bj < 2; ++bj) { *(f32x4*)(out + off + bj * HALF) = acc[ai][bj][m][0] * r_ * gv[bj][0]; *(f32x4*)(out + off + bj * HALF + 4) = acc[ai][bj][m][1] * r_ * gv[bj][1]; } }
    }
};
struct EpiMerge {
    static constexpr int EOPS = 16; static constexpr bool PERM = true;
    u32x4* scr; bf16* O; const float* rsq; LAS unsigned char* ldsx;
    __device__ __forceinline__ void operator()(const f32x4 (&acc)[2][2][4][2], const GU& u, int wr, int wc, int fr, int fq) const {
        int tid = threadIdx.x; asm volatile("" : "+v"(tid));
        fr = tid & 15; fq = (tid >> 4) & 3;
        if ((u.sub & 1) == 0) {
            float rs[2][4];
            if (u.sub == 0) unit_row_scales(rsq, u.pm, ldsx, tid, wr, fr, rs);
            else { const LAS float* RSL = (const LAS float*)(ldsx + LDS_RSL);
#pragma unroll
                for (int ai = 0; ai < 2; ++ai)
#pragma unroll
                    for (int m = 0; m < 4; ++m) rs[ai][m] = RSL[ai * HALF + wr * 64 + m * 16 + fr]; }
#pragma unroll
            for (int ai = 0; ai < 2; ++ai)
#pragma unroll
                for (int m = 0; m < 4; ++m)
#pragma unroll
                    for (int bj = 0; bj < 2; ++bj) { const f32x4 v0 = acc[ai][bj][m][0] * rs[ai][m], v1 = acc[ai][bj][m][1] * rs[ai][m];
                        u32x4 w; w.x = cvt_pk_bf16(sigmoidf_(v0[0]), sigmoidf_(v0[1])); w.y = cvt_pk_bf16(sigmoidf_(v0[2]), sigmoidf_(v0[3]));
                        w.z = cvt_pk_bf16(sigmoidf_(v1[0]), sigmoidf_(v1[1])); w.w = cvt_pk_bf16(sigmoidf_(v1[2]), sigmoidf_(v1[3]));
                        scr[((ai * 4 + m) * 2 + bj) * 512 + tid] = w; }
        } else {
            const bool first = (u.sub == 1);
            const int row0 = u.pm * BM + wr * 64 + fr, col0 = u.pn * BM + wc * 32 + 8 * fq;
#pragma unroll
            for (int ai = 0; ai < 2; ++ai) {
                u32x4 sg[4][2], pv[4][2];
#pragma unroll
                for (int m = 0; m < 4; ++m)
#pragma unroll
                    for (int bj = 0; bj < 2; ++bj) { sg[m][bj] = scr[((ai * 4 + m) * 2 + bj) * 512 + tid];
                        pv[m][bj] = first ? (u32x4){0u, 0u, 0u, 0u} : *(const u32x4*)(O + (size_t)(row0 + ai * HALF + m * 16) * D + col0 + bj * HALF); }
#pragma unroll
                for (int m = 0; m < 4; ++m) { bf16* rowp = O + (size_t)(row0 + ai * HALF + m * 16) * D + col0;
#pragma unroll
                    for (int bj = 0; bj < 2; ++bj) { const f32x4 v0 = acc[ai][bj][m][0], v1 = acc[ai][bj][m][1];
                        const u32x4 s = sg[m][bj], p = pv[m][bj];
                        float r[8];
                        r[0] = bflo(s.x) * v0[0] + bflo(p.x); r[1] = bfhi(s.x) * v0[1] + bfhi(p.x); r[2] = bflo(s.y) * v0[2] + bflo(p.y); r[3] = bfhi(s.y) * v0[3] + bfhi(p.y);
                        r[4] = bflo(s.z) * v1[0] + bflo(p.z); r[5] = bfhi(s.z) * v1[1] + bfhi(p.z); r[6] = bflo(s.w) * v1[2] + bflo(p.w); r[7] = bfhi(s.w) * v1[3] + bfhi(p.w);
                        u32x4 w; w.x = cvt_pk_bf16(r[0], r[1]); w.y = cvt_pk_bf16(r[2], r[3]); w.z = cvt_pk_bf16(r[4], r[5]); w.w = cvt_pk_bf16(r[6], r[7]);
                        *(u32x4*)(rowp + bj * HALF) = w; } }
            }
        }
    }
};
}

struct Args { const float* in[26]; float* out; unsigned char* ws; int ph_lo, ph_hi; };
enum { I_X = 0, I_N1G, I_WIN, I_MU, I_W0, I_W2, I_A0, I_A2, I_G2, I_KK, I_KA, I_RK, I_GNW, I_GNB, I_V0, I_V1, I_V2, I_LB, I_HGN, I_WBR, I_WOUT, I_N2G, I_WFG, I_WFU, I_WFD, I_FG };

__device__ __forceinline__ void transpose_item(const float* W, int ldw, int k0, int n0, bf16* WT, size_t drow0, int ldt, int dk0, LAS float* scr, int lane, const float* gk = nullptr) {
#pragma unroll 8
    for (int i = 0; i < 32; ++i) { const int kk = 2 * i + (lane >> 5); float w = W[(size_t)(k0 + kk) * ldw + n0 + (lane & 31)]; if (gk) w *= gk[k0 + kk]; scr[kk * 33 + (lane & 31)] = w; }
    LDS_WAIT(); asm volatile("" ::: "memory");
    const int c = lane & 7;
#pragma unroll
    for (int j = 0; j < 4; ++j) { const int n = (lane >> 3) + 8 * j; const LAS float* s = scr + (8 * c) * 33 + n;
        u32x4 o; o.x = pk2(s[0 * 33], s[1 * 33]); o.y = pk2(s[2 * 33], s[3 * 33]); o.z = pk2(s[4 * 33], s[5 * 33]); o.w = pk2(s[6 * 33], s[7 * 33]);
        *(u32x4*)(WT + (drow0 + n) * (size_t)ldt + dk0 + 8 * c) = o; }
    LDS_WAIT(); asm volatile("" ::: "memory");
}

__device__ __forceinline__ void rms_row_bf16(const float* xrow, const float* g, bf16* orow, int lane) {
    const f32x4* xr = (const f32x4*)xrow + lane; f32x4 v[4]; float s = 0.f;
#pragma unroll
    for (int j = 0; j < 4; ++j) { v[j] = xr[64 * j]; s += (v[j].x * v[j].x + v[j].y * v[j].y) + (v[j].z * v[j].z + v[j].w * v[j].w); }
    const float rs = 1.0f / sqrtf(wave_sum(s) * (1.f / D) + 1e-6f);
    u32x2* o8 = (u32x2*)orow + lane;
#pragma unroll
    for (int j = 0; j < 4; ++j) { const f32x4 gv = ((const f32x4*)g)[lane + 64 * j]; u32x2 w; w.x = pk2(v[j].x * rs * gv.x, v[j].y * rs * gv.y); w.y = pk2(v[j].z * rs * gv.z, v[j].w * rs * gv.w); o8[64 * j] = w; }
}
__device__ __forceinline__ void rms_row_f32(const float* xrow, const float* g, float* orow, int lane) {
    const f32x4* xr = (const f32x4*)xrow + lane; f32x4 v[4]; float s = 0.f;
#pragma unroll
    for (int j = 0; j < 4; ++j) { v[j] = xr[64 * j]; s += (v[j].x * v[j].x + v[j].y * v[j].y) + (v[j].z * v[j].z + v[j].w * v[j].w); }
    const float rs = 1.0f / sqrtf(wave_sum(s) * (1.f / D) + 1e-6f);
    f32x4* o = (f32x4*)orow + lane;
#pragma unroll
    for (int j = 0; j < 4; ++j) { const f32x4 gv = ((const f32x4*)g)[lane + 64 * j]; o[64 * j] = v[j] * rs * gv; }
}

__device__ __forceinline__ void rope_entry(int t, int i, float& c, float& s) {
    const double invf[8] = {1.0, 0.19392274474868576, 0.03760603093086393, 0.007292664737217109, 0.001414213562373095, 0.0002742481756762073, 5.318295896944988e-05, 1.031338537721246e-05};
    double f = invf[0];
#pragma unroll
    for (int j = 1; j < 8; ++j) f = (i == j) ? invf[j] : f;
    const double ang = (double)t * f;
    const double k = __builtin_rint(ang * 0.63661977236758134308);
    double r = __builtin_fma(-k, 1.5707963267948966, ang); r = __builtin_fma(-k, 6.123233995736766e-17, r);
    const double r2 = r * r;
    double sn = r * (1.0 + r2 * (-1.0 / 6 + r2 * (1.0 / 120 + r2 * (-1.0 / 5040 + r2 * (1.0 / 362880 + r2 * (-1.0 / 39916800 + r2 * (1.0 / 6227020800.0)))))));
    double cs = 1.0 + r2 * (-0.5 + r2 * (1.0 / 24 + r2 * (-1.0 / 720 + r2 * (1.0 / 40320 + r2 * (-1.0 / 3628800 + r2 * (1.0 / 479001600.0 + r2 * (-1.0 / 87178291200.0)))))));
    const int q = ((int)(long long)k) & 3;
    const double s2 = (q == 0) ? sn : (q == 1) ? cs : (q == 2) ? -sn : -cs;
    const double c2 = (q == 0) ? cs : (q == 1) ? -sn : (q == 2) ? -cs : sn;
    c = (float)c2; s = (float)s2;
}

constexpr int N_LATE = 16 * 128 + 4 * 4 * 32 + 16 * 32 + 2 * 16 * 88 + 44 * 32;
static_assert(N_LATE == 7296 && N_LATE % 32 == 0, "late weight items");
constexpr unsigned NWU = N_LATE / 32;
__device__ __forceinline__ void late_weight_item(const Args& a, int layer, int r, LAS float* scr, int lane) {
    bf16* Wb = (bf16*)(a.ws + WS_W);
    constexpr int N_ING = 16 * 128, N_BR = 4 * 4 * 32, N_OUT = 16 * 32, N_FG = 16 * 88;
    if (r < N_ING) { const int kb = r / 128, nb = 112 + r % 128; transpose_item(a.in[I_WIN] + (size_t)layer * D * 7680, 7680, kb * 64, nb * 32, (bf16*)((char*)Wb + W_IN), (size_t)nb * 32, 1024, kb * 64, scr, lane, a.in[I_N1G] + layer * D); return; } r -= N_ING;
    if (r < N_BR) { const int n = r / 128, q = r % 128, kb = q / 32, nb = q % 32; transpose_item(a.in[I_WBR] + (size_t)layer * 4 * MW * D + (size_t)n * MW * D, D, kb * 64, nb * 32, (bf16*)((char*)Wb + W_B), (size_t)n * 1024 + nb * 32, 256, kb * 64, scr, lane); return; } r -= N_BR;
    if (r < N_OUT) { const int kb = r / 32, nb = r % 32; transpose_item(a.in[I_WOUT] + (size_t)layer * D * D, D, kb * 64, nb * 32, (bf16*)((char*)Wb + W_O), (size_t)nb * 32, 1024, kb * 64, scr, lane); return; } r -= N_OUT;
    if (r < 2 * N_FG) { const int up = r / N_FG, q = r % N_FG, kb = q / 88, nb = q % 88, n0 = nb * 32;
        transpose_item((up ? a.in[I_WFU] : a.in[I_WFG]) + (size_t)layer * D * DFF, DFF, kb * 64, n0, (bf16*)((char*)Wb + W_GU), (size_t)(n0 / 128) * 256 + (n0 % 128) + up * 128, 1024, kb * 64, scr, lane, a.in[I_N2G] + layer * D); return; } r -= 2 * N_FG;
    { const int kb = r / 32, nb = r % 32; transpose_item(a.in[I_WFD] + (size_t)layer * DFF * D, D, kb * 64, nb * 32, (bf16*)((char*)Wb + W_D), (size_t)nb * 32, DFF, kb * 64, scr, lane); }
}

__device__ __forceinline__ void phase_a(const Args& a, int layer, const float* xin, LAS unsigned char* lds, int vb, int G) {
    int tid = threadIdx.x; asm volatile("" : "+v"(tid)); const int lane = tid & 63, wave = tid >> 6;
    unsigned char* ws = a.ws;
    bf16* Wb = (bf16*)(ws + WS_W);
    LAS float* scr = (LAS float*)(lds + wave * 16384);
    const int gw = vb * 8 + wave, NGW = G * 8;
    const float* w_in = a.in[I_WIN] + (size_t)layer * D * 7680;
    const float* w_br = a.in[I_WBR] + (size_t)layer * 4 * MW * D;
    const float* w_out = a.in[I_WOUT] + (size_t)layer * D * D;
    const float* w_fg = a.in[I_WFG] + (size_t)layer * D * DFF;
    const float* w_fu = a.in[I_WFU] + (size_t)layer * D * DFF;
    const float* w_fd = a.in[I_WFD] + (size_t)layer * DFF * D;
    const float* w2 = a.in[I_W2] + (size_t)layer * 64 * MW;
    const float* a2 = a.in[I_A2] + (size_t)layer * 64 * MW;
    const float* g2 = a.in[I_G2] + (size_t)layer * 128 * MW;
    constexpr int N_INE = 16 * 112, N_LO = 8 + 8 + 16;
    for (int it = gw; it < N_INE + N_LO; it += NGW) {
        int r = it;
        if (r < N_INE) { const int kb = r / 112, nb = r % 112; transpose_item(w_in, 7680, kb * 64, nb * 32, (bf16*)((char*)Wb + W_IN), (size_t)nb * 32, 1024, kb * 64, scr, lane, a.in[I_N1G] + layer * D); continue; } r -= N_INE;
        if (r < 8) { transpose_item(w2, MW, 0, r * 32, (bf16*)((char*)Wb + W_L), (size_t)r * 32, 256, 0, scr, lane); continue; } r -= 8;
        if (r < 8) { transpose_item(a2, MW, 0, r * 32, (bf16*)((char*)Wb + W_L), (size_t)256 + r * 32, 256, 64, scr, lane); continue; } r -= 8;
        { const int kb = r / 8, nb = r % 8; transpose_item(g2, MW, kb * 64, nb * 32, (bf16*)((char*)Wb + W_L), (size_t)512 + nb * 32, 256, 128 + kb * 64, scr, lane); }
    }
    const int gt = vb * 512 + tid, NGT = G * 512;
    for (int i = gt; i < 768 * 32; i += NGT) { const int row = i >> 5, ch = i & 31, blk = row >> 8; const int lo = blk == 0 ? 0 : (blk == 1 ? 64 : 128), hi = blk == 0 ? 64 : (blk == 1 ? 128 : 256);
        if (ch * 8 < lo || ch * 8 >= hi) *(u32x4*)((char*)Wb + W_L + (size_t)row * 512 + ch * 16) = (u32x4){0u, 0u, 0u, 0u}; }
    if (layer == 1) {
        const float* v1 = a.in[I_V1]; const float* v2 = a.in[I_V2];
        for (int i = gt; i < 256 * 256; i += NGT) { const int c = i >> 8, k = i & 255; float s = 0.f;
#pragma unroll 8
            for (int j = 0; j < 32; ++j) s += v1[k * 32 + j] * v2[j * 256 + c];
            ((bf16*)((char*)Wb + W_V))[i] = (bf16)f2bf(s); }
    } else {
        float2* rope = (float2*)(ws + WS_ROPE);
        for (int i = gt; i < SEQ * 8; i += NGT) { float c, s; rope_entry(i >> 3, i & 7, c, s); rope[i] = make_float2(c, s); }
    }
    if (layer == 0) { bf16* H = (bf16*)(ws + WS_H); float* RQ = (float*)(ws + WS_RSQ1);
        for (int m = gw; m < M; m += NGW) { const f32x4* xr = (const f32x4*)(xin + (size_t)m * D) + lane; u32x2* o8 = (u32x2*)(H + (size_t)m * D) + lane; float sq = 0.f;
#pragma unroll
            for (int j = 0; j < 4; ++j) { const f32x4 v = xr[64 * j]; sq += (v.x * v.x + v.y * v.y) + (v.z * v.z + v.w * v.w); u32x2 w; w.x = cvt_pk_bf16(v.x, v.y); w.y = cvt_pk_bf16(v.z, v.w); o8[64 * j] = w; }
            sq = wave_sum(sq); if (lane == 0) *(f32x4*)(RQ + (size_t)m * 4) = (f32x4){sq, 0.f, 0.f, 0.f}; } }
}

__device__ __forceinline__ void phase_c(const Args& a, int layer, LAS unsigned char* lds, int vb, int G) {
    int tid = threadIdx.x; asm volatile("" : "+v"(tid)); const int lane = tid & 63, wave = tid >> 6;
    unsigned char* ws = a.ws;
    bf16* PM = (bf16*)(ws + WS_PM); bf16* LA = (bf16*)(ws + WS_LA);
    const float2* rope = (const float2*)(ws + WS_ROPE);
    float* KMP = (float*)(ws + WS_KMP);
    const float* mu = a.in[I_MU] + layer * 1024;
    LAS float* red = (LAS float*)lds;
    const int c4 = 4 * lane, l15 = lane & 15; const bool rot = l15 < 4, lower = l15 < 2;
    const f32x4 mu_l = *(const f32x4*)(mu + 768 + c4), mu_v = *(const f32x4*)(mu + 512 + c4);
    for (int u = vb; u < 256; u += G) {
        const int b = u >> 5, hb = u & 31; const int t0 = hb * 128 + wave * 16; const size_t row0 = (size_t)b * SEQ + t0;
        f32x4 ksum = {0.f, 0.f, 0.f, 0.f};
        f32x4 xp = {0.f, 0.f, 0.f, 0.f}, vp = xp;
        if (t0 > 0) { xp = ld4bf(PM + (row0 - 1) * PMW + C_RW + 768 + c4); if (layer) vp = ld4bf(PM + (row0 - 1) * PMW + C_RW + 512 + c4); }
        for (int i = 0; i < 16; ++i) {
            const size_t row = row0 + i; const int t = t0 + i;
            bf16* pq = PM + row * PMW + C_MB + c4;
            const f32x4 x = ld4bf(PM + row * PMW + C_RW + 768 + c4);
            f32x4 v4 = {0.f, 0.f, 0.f, 0.f}; if (layer) v4 = ld4bf(PM + row * PMW + C_RW + 512 + c4);
            f32x4 q4 = ld4bf(pq), k4 = ld4bf(pq + 256);
            { float qa[4] = {q4.x, q4.y, q4.z, q4.w}, ka[4] = {k4.x, k4.y, k4.z, k4.w}, qo[4], ko[4];
#pragma unroll
                for (int j = 0; j < 4; ++j) { qo[j] = dpp_xor2(qa[j]); ko[j] = dpp_xor2(ka[j]); }
                if (rot) { const float2* rp = rope + (size_t)t * 8 + (l15 & 1) * 4;
#pragma unroll
                    for (int j = 0; j < 4; ++j) { const float2 cs = rp[j]; const float sg = lower ? -cs.y : cs.y; qa[j] = qa[j] * cs.x + qo[j] * sg; ka[j] = ka[j] * cs.x + ko[j] * sg; }
                    q4 = (f32x4){qa[0], qa[1], qa[2], qa[3]}; k4 = (f32x4){ka[0], ka[1], ka[2], ka[3]};
                    st4bf(pq, q4); st4bf(pq + 256, k4); } }
            { u32x2 w; w.x = cvt_pk_bf16(k4.x, k4.y); w.y = cvt_pk_bf16(k4.z, k4.w); ksum += (f32x4){bflo(w.x), bfhi(w.x), bflo(w.y), bfhi(w.y)}; }
            { const f32x4 xs = x + (xp - x) * mu_l; f32x4 o;
#pragma unroll
                for (int j = 0; j < 4; ++j) { const float e = __expf(2.0f * xs[j]); const float th = 1.0f - 2.0f * __builtin_amdgcn_rcpf(1.0f + e); o[j] = lane < 16 ? th : (lane < 32 ? xs[j] : sigmoidf_(xs[j])); }
                st4bf(LA + row * 512 + c4, o); xp = x;
                if (layer) { st4bf(LA + row * 512 + 256 + c4, v4 + (vp - v4) * mu_v); vp = v4; } }
        }
        *(LAS f32x4*)(red + wave * 256 + c4) = ksum;
        __syncthreads();
        if (tid < 256) { float sacc = 0.f;
#pragma unroll
            for (int w8 = 0; w8 < 8; ++w8) sacc += red[w8 * 256 + tid];
            KMP[((size_t)(b * 4 + (tid >> 6)) * 32 + hb) * 64 + (tid & 63)] = sacc; }
        __syncthreads();
    }
}

constexpr int TC = 16;
#define DPP_SHR(x, n) __builtin_bit_cast(float, __builtin_amdgcn_update_dpp(0, __builtin_bit_cast(int, (x)), 0x110 + (n), 0xF, 0xF, true))
#define DPP_BC15(x) __builtin_bit_cast(float, __builtin_amdgcn_update_dpp(0, __builtin_bit_cast(int, (x)), 0x15F, 0xF, 0xF, true))
typedef short bf16x4v __attribute__((ext_vector_type(4)));
__device__ __forceinline__ bf16x4v frag4(f32x4 z) { return __builtin_bit_cast(bf16x4v, (u32x2){cvt_pk_bf16(z[0], z[1]), cvt_pk_bf16(z[2], z[3])}); }
#define MM16(xt, y) __builtin_amdgcn_mfma_f32_16x16x16bf16_1k(frag4(xt), frag4(y), (f32x4){0.f, 0.f, 0.f, 0.f}, 0, 0, 0)
__device__ __forceinline__ void phase_d2(const Args& a, int layer, LAS unsigned char* lds, int vb, int G) {
    int tid = threadIdx.x; asm volatile("" : "+v"(tid)); const int lane = tid & 63, wave = tid >> 6;
    LAS unsigned short* TL = (LAS unsigned short*)(lds + wave * 8192);
    unsigned char* ws = a.ws;
    bf16* PM = (bf16*)(ws + WS_PM); bf16* LO = (bf16*)(ws + WS_LO); bf16* VF = (bf16*)(ws + WS_VF); float* BON = (float*)(ws + WS_BON);
    const int s = lane & 15, g = lane >> 4;
    const float* mu = a.in[I_MU] + layer * 1024;
#define LDB16(dst, p) do { const u32x4 a_ = *(const u32x4*)((p) + 8 * g), b_ = *(const u32x4*)((p) + 32 + 8 * g); \
        dst[0] = bflo(a_.x); dst[1] = bfhi(a_.x); dst[2] = bflo(a_.y); dst[3] = bfhi(a_.y); dst[4] = bflo(a_.z); dst[5] = bfhi(a_.z); dst[6] = bflo(a_.w); dst[7] = bfhi(a_.w); \
        dst[8] = bflo(b_.x); dst[9] = bfhi(b_.x); dst[10] = bflo(b_.y); dst[11] = bfhi(b_.y); dst[12] = bflo(b_.z); dst[13] = bfhi(b_.z); dst[14] = bflo(b_.w); dst[15] = bfhi(b_.w); } while (0)
#define LDC16(dst, p) do { const f32x4 a_ = *(const f32x4*)((p) + 8 * g), b_ = *(const f32x4*)((p) + 8 * g + 4), c_ = *(const f32x4*)((p) + 32 + 8 * g), d_ = *(const f32x4*)((p) + 36 + 8 * g); \
        dst[0] = a_.x; dst[1] = a_.y; dst[2] = a_.z; dst[3] = a_.w; dst[4] = b_.x; dst[5] = b_.y; dst[6] = b_.z; dst[7] = b_.w; dst[8] = c_.x; dst[9] = c_.y; dst[10] = c_.z; dst[11] = c_.w; dst[12] = d_.x; dst[13] = d_.y; dst[14] = d_.z; dst[15] = d_.w; } while (0)
#define STB16(p, src) do { u32x4 a_, b_; a_.x = cvt_pk_bf16(src[0], src[1]); a_.y = cvt_pk_bf16(src[2], src[3]); a_.z = cvt_pk_bf16(src[4], src[5]); a_.w = cvt_pk_bf16(src[6], src[7]); \
        b_.x = cvt_pk_bf16(src[8], src[9]); b_.y = cvt_pk_bf16(src[10], src[11]); b_.z = cvt_pk_bf16(src[12], src[13]); b_.w = cvt_pk_bf16(src[14], src[15]); \
        *(u32x4*)((p) + 8 * g) = a_; *(u32x4*)((p) + 32 + 8 * g) = b_; } while (0)
#define PK8(src, o) __builtin_bit_cast(bf16x8, (u32x4){cvt_pk_bf16(src[(o)], src[(o) + 1]), cvt_pk_bf16(src[(o) + 2], src[(o) + 3]), cvt_pk_bf16(src[(o) + 4], src[(o) + 5]), cvt_pk_bf16(src[(o) + 6], src[(o) + 7])})
#define SUM64(x) do { x += __shfl_xor(x, 16); x += __shfl_xor(x, 32); } while (0)
    const int gw = vb * 8 + wave, NGW = G * 8;
    for (int task = gw; task < 8192; task += NGW) {
        const int chain = task >> 8, ch = task & 255, b = chain >> 2, h = chain & 3;
        const int t = ch * 16 + s; const size_t row = (size_t)b * SEQ + t;
        const bf16* pr = PM + row * PMW + C_RW + h * 64; const bf16* pp = (t > 0) ? pr - PMW : pr; const float pz = (t > 0) ? 1.f : 0.f;
        bf16* lo = LO + row * 1024 + h * 64;
        float lw[16], kk[16], bv[16], km[16], rr[16], vv[16];
        { float x0[16], xp[16], c0[16], c1[16], asg[16];
            LDB16(x0, pr); LDB16(xp, pp); LDC16(c0, mu + h * 64);
#pragma unroll
            for (int j = 0; j < 16; ++j) rr[j] = x0[j] + (xp[j] * pz - x0[j]) * c0[j];
            LDB16(x0, pr + 256); LDB16(xp, pp + 256); LDC16(c0, mu + 256 + h * 64);
            float ks[16];
#pragma unroll
            for (int j = 0; j < 16; ++j) ks[j] = x0[j] + (xp[j] * pz - x0[j]) * c0[j];
            LDB16(x0, pr + 512); LDB16(xp, pp + 512); LDC16(c0, mu + 512 + h * 64);
#pragma unroll
            for (int j = 0; j < 16; ++j) vv[j] = x0[j] + (xp[j] * pz - x0[j]) * c0[j];
            LDB16(x0, lo); LDC16(c0, a.in[I_W0] + layer * 256 + h * 64);
#pragma unroll
            for (int j = 0; j < 16; ++j) { const float wlog = -softplusf_(-(c0[j] + x0[j])) - 0.5f; lw[j] = -__expf(wlog); }
            LDB16(x0, lo + 256); LDC16(c0, a.in[I_A0] + layer * 256 + h * 64);
#pragma unroll
            for (int j = 0; j < 16; ++j) asg[j] = sigmoidf_(c0[j] + x0[j]);
            if (layer) { LDB16(x0, lo + 768); LDB16(xp, VF + row * 256 + h * 64); LDC16(c0, a.in[I_V0] + h * 64);
#pragma unroll
                for (int j = 0; j < 16; ++j) vv[j] += (xp[j] - vv[j]) * sigmoidf_(c0[j] + x0[j]); }
            else STB16(VF + row * 256 + h * 64, vv);
            STB16(lo + 768, vv);
            LDC16(c0, a.in[I_KK] + layer * 256 + h * 64); LDC16(c1, a.in[I_KA] + layer * 256 + h * 64);
            float n2 = 0.f;
#pragma unroll
            for (int j = 0; j < 16; ++j) { kk[j] = ks[j] * c0[j]; n2 += kk[j] * kk[j]; km[j] = ks[j] * (1.0f + (asg[j] - 1.0f) * c1[j]); }
            SUM64(n2); const float rn = 1.0f / fmaxf(sqrtf(n2), 1e-12f);
            LDC16(c0, a.in[I_RK] + layer * 256 + h * 64);
            float bon = 0.f;
#pragma unroll
            for (int j = 0; j < 16; ++j) { kk[j] *= rn; bv[j] = kk[j] * asg[j]; bon += rr[j] * km[j] * c0[j]; }
            SUM64(bon); if (g == 0) BON[row * 4 + h] = bon; }
        unsigned char* se = ws + WS_RS + (size_t)task * RS_ENTRY;
        float al[16], bh[16], kh[16], rh[16];
#pragma unroll
        for (int j = 0; j < 16; ++j) { float cs = lw[j]; cs += DPP_SHR(cs, 1); cs += DPP_SHR(cs, 2); cs += DPP_SHR(cs, 4); cs += DPP_SHR(cs, 8);
            const float Gt = __expf(cs), Gi = __expf(-cs), Gp = __expf(cs - lw[j]);
            al[j] = Gp * kk[j]; bh[j] = bv[j] * Gi; kh[j] = km[j] * Gi; rh[j] = Gt * rr[j];
            if (s == 15) ((float*)(se + 12800))[(j < 8 ? 8 * g + j : 24 + 8 * g + j)] = Gt; }
        { bf16* at = (bf16*)se + s * 72; STB16(at, al); bf16* rt = (bf16*)(se + 2304) + s * 72; STB16(rt, rh);
#pragma unroll
            for (int j = 0; j < 16; ++j) { const int k = (j < 8 ? 8 * g + j : 24 + 8 * g + j); TL[k * 16 + s] = f2bf(-bh[j]); TL[1024 + k * 16 + s] = f2bf(kh[j]); TL[2048 + k * 16 + s] = f2bf(vv[j]); }
#pragma unroll
            for (int q = 0; q < 6; ++q) ((u32x4*)(se + 4608))[q * 64 + lane] = ((const LAS u32x4*)TL)[q * 64 + lane]; }
        const bf16x8 al0 = PK8(al, 0), al1 = PK8(al, 8), bh0 = PK8(bh, 0), bh1 = PK8(bh, 8), kh0 = PK8(kh, 0), kh1 = PK8(kh, 8), rh0 = PK8(rh, 0), rh1 = PK8(rh, 8);
#define GRAM(x0_, x1_, y0_, y1_) __builtin_amdgcn_mfma_f32_16x16x32_bf16(x1_, y1_, __builtin_amdgcn_mfma_f32_16x16x32_bf16(x0_, y0_, (f32x4){0.f, 0.f, 0.f, 0.f}, 0, 0, 0), 0, 0, 0)
        f32x4 N = GRAM(bh0, bh1, al0, al1), NT = GRAM(al0, al1, bh0, bh1), QT = GRAM(al0, al1, kh0, kh1), BR = GRAM(bh0, bh1, rh0, rh1), KR = GRAM(kh0, kh1, rh0, rh1);
        f32x4 ID;
#pragma unroll
        for (int r = 0; r < 4; ++r) { const int rw = 4 * g + r; N[r] = rw < s ? N[r] : 0.f; NT[r] = s < rw ? NT[r] : 0.f; QT[r] = s < rw ? QT[r] : 0.f; BR[r] = rw <= s ? -BR[r] : 0.f; KR[r] = rw <= s ? KR[r] : 0.f; ID[r] = rw == s ? 1.f : 0.f; }
        const f32x4 N2 = MM16(NT, N), N2T = MM16(N, NT); const f32x4 N4 = MM16(N2T, N2), N4T = MM16(N2, N2T); const f32x4 N8 = MM16(N4T, N4);
        f32x4 X = MM16(ID + N4T, ID + N8); X = MM16(ID + N2T, X); const f32x4 T = MM16(ID - NT, X);
        const f32x4 QTm = MM16(QT, T);
        { u32x2* sm = (u32x2*)(se + 10752) + lane;
            sm[0] = (u32x2){cvt_pk_bf16(T[0], T[1]), cvt_pk_bf16(T[2], T[3])}; sm[64] = (u32x2){cvt_pk_bf16(QTm[0], QTm[1]), cvt_pk_bf16(QTm[2], QTm[3])};
            sm[128] = (u32x2){cvt_pk_bf16(BR[0], BR[1]), cvt_pk_bf16(BR[2], BR[3])}; sm[192] = (u32x2){cvt_pk_bf16(KR[0], KR[1]), cvt_pk_bf16(KR[2], KR[3])}; }
    }
#undef GRAM
#undef LDB16
#undef LDC16
#undef STB16
#undef PK8
#undef SUM64
}

constexpr int RWS = (int)RS_ENTRY;
__device__ __forceinline__ void rwkv_chain(const Args& a, int layer, int chain, LAS unsigned char* L) {
    int tid = threadIdx.x; asm volatile("" : "+v"(tid)); const int lane = tid & 63, w = __builtin_amdgcn_readfirstlane(tid >> 6);
    const int b = chain >> 2, h = chain & 3;
    unsigned char* ws = a.ws;
    const unsigned char* RS = ws + WS_RS + (size_t)chain * 256 * RS_ENTRY;
    constexpr int NCH = 256;
    if (w >= 4) {
        const int lw = w - 4;
#define RW_DMA(cn) do { const int cn_ = (cn) < NCH ? (cn) : NCH - 1; const unsigned char* src_ = RS + (size_t)cn_ * RS_ENTRY + lane * 16; LAS unsigned char* dst_ = L + ((cn) & 7) * RWS; \
            __builtin_amdgcn_global_load_lds((const unsigned*)(src_ + lw * 1024), (LAS unsigned*)(dst_ + lw * 1024), 16, 0, 0); \
            __builtin_amdgcn_global_load_lds((const unsigned*)(src_ + (lw + 4) * 1024), (LAS unsigned*)(dst_ + (lw + 4) * 1024), 16, 0, 0); \
            __builtin_amdgcn_global_load_lds((const unsigned*)(src_ + (lw + 8) * 1024), (LAS unsigned*)(dst_ + (lw + 8) * 1024), 16, 0, 0); \
            if (lw == 0 && lane < 48) __builtin_amdgcn_global_load_lds((const unsigned*)(src_ + 12 * 1024), (LAS unsigned*)(dst_ + 12 * 1024), 16, 0, 0); } while (0)
#define RW_WAIT() do { if (lw == 0) asm volatile("s_waitcnt vmcnt(24)" ::: "memory"); else asm volatile("s_waitcnt vmcnt(18)" ::: "memory"); } while (0)
        RW_DMA(0); RW_DMA(1); RW_DMA(2); RW_DMA(3); RW_DMA(4); RW_DMA(5); RW_DMA(6);
        RW_WAIT(); LBAR();
        for (int c = 0; c < NCH; ++c) { RW_DMA(c + 7); RW_WAIT(); LBAR(); }
        asm volatile("s_waitcnt vmcnt(0)" ::: "memory");
        LBAR();
#undef RW_DMA
#undef RW_WAIT
    } else {
        const int s16 = lane & 15, cg = lane >> 4;
        bf16* PMo = (bf16*)(ws + WS_PM) + (size_t)b * SEQ * PMW + C_RW + h * 64 + 16 * w + s16;
        f32x4 S0 = {0.f, 0.f, 0.f, 0.f}, S1 = S0, S2 = S0, S3 = S0;
        LBAR();
        for (int c = 0; c < NCH; ++c) {
            const LAS unsigned char* E = L + (c & 7) * RWS;
            const LAS bf16* AT = (const LAS bf16*)E + s16 * 72 + 4 * cg; const LAS bf16* RT = (const LAS bf16*)(E + 2304) + s16 * 72 + 4 * cg;
            const LAS bf16* BT = (const LAS bf16*)(E + 4608) + s16 * 16 + 4 * cg; const LAS bf16* KT = (const LAS bf16*)(E + 6656) + s16 * 16 + 4 * cg;
            const bf16x4v vt = *(const LAS bf16x4v*)((const LAS bf16*)(E + 8704) + (16 * w + s16) * 16 + 4 * cg);
            const LAS bf16x4v* SM = (const LAS bf16x4v*)(E + 10752) + lane; const bf16x4v tc = SM[0], qc = SM[64], brc = SM[128], krc = SM[192];
            const LAS float* GC = (const LAS float*)(E + 12800) + 4 * cg;
            const bf16x4v s0b = frag4(S0), s1b = frag4(S1), s2b = frag4(S2), s3b = frag4(S3);
            const f32x4 Z = {0.f, 0.f, 0.f, 0.f};
            f32x4 p1 = __builtin_amdgcn_mfma_f32_16x16x16bf16_1k(*(const LAS bf16x4v*)(AT), s0b, Z, 0, 0, 0);
            p1 = __builtin_amdgcn_mfma_f32_16x16x16bf16_1k(*(const LAS bf16x4v*)(AT + 16), s1b, p1, 0, 0, 0);
            p1 = __builtin_amdgcn_mfma_f32_16x16x16bf16_1k(*(const LAS bf16x4v*)(AT + 32), s2b, p1, 0, 0, 0);
            p1 = __builtin_amdgcn_mfma_f32_16x16x16bf16_1k(*(const LAS bf16x4v*)(AT + 48), s3b, p1, 0, 0, 0);
            f32x4 y = __builtin_amdgcn_mfma_f32_16x16x16bf16_1k(krc, vt, Z, 0, 0, 0);
            y = __builtin_amdgcn_mfma_f32_16x16x16bf16_1k(*(const LAS bf16x4v*)(RT), s0b, y, 0, 0, 0);
            y = __builtin_amdgcn_mfma_f32_16x16x16bf16_1k(*(const LAS bf16x4v*)(RT + 16), s1b, y, 0, 0, 0);
            y = __builtin_amdgcn_mfma_f32_16x16x16bf16_1k(*(const LAS bf16x4v*)(RT + 32), s2b, y, 0, 0, 0);
            y = __builtin_amdgcn_mfma_f32_16x16x16bf16_1k(*(const LAS bf16x4v*)(RT + 48), s3b, y, 0, 0, 0);
            f32x4 u = __builtin_amdgcn_mfma_f32_16x16x16bf16_1k(qc, vt, Z, 0, 0, 0);
            u = __builtin_amdgcn_mfma_f32_16x16x16bf16_1k(tc, frag4(p1), u, 0, 0, 0);
            const bf16x4v ub = frag4(u);
            y = __builtin_amdgcn_mfma_f32_16x16x16bf16_1k(brc, ub, y, 0, 0, 0);
#define RW_UPD(Sx, kt) do { f32x4 n_ = __builtin_amdgcn_mfma_f32_16x16x16bf16_1k(*(const LAS bf16x4v*)(KT + (kt) * 256), vt, Sx, 0, 0, 0); \
                n_ = __builtin_amdgcn_mfma_f32_16x16x16bf16_1k(*(const LAS bf16x4v*)(BT + (kt) * 256), ub, n_, 0, 0, 0); Sx = n_ * *(const LAS f32x4*)(GC + 16 * (kt)); } while (0)
            RW_UPD(S0, 0); RW_UPD(S1, 1); RW_UPD(S2, 2); RW_UPD(S3, 3);
#undef RW_UPD
            bf16* yo = PMo + (size_t)(c * 16 + 4 * cg) * PMW;
#pragma unroll
            for (int r = 0; r < 4; ++r) yo[(size_t)r * PMW] = (bf16)f2bf(y[r]);
            LBAR();
        }
        LBAR();
    }
}

__device__ __forceinline__ void phase_e2(const Args& a, int layer, int vb, int G) {
    int tid = threadIdx.x; asm volatile("" : "+v"(tid)); const int lane = tid & 63, wave = tid >> 6;
    unsigned char* ws = a.ws;
    const bf16* LO = (const bf16*)(ws + WS_LO); const float* BON = (const float*)(ws + WS_BON); bf16* PM = (bf16*)(ws + WS_PM);
    const int c4 = 4 * lane, head = lane >> 4;
    const f32x4 gnw = *(const f32x4*)(a.in[I_GNW] + layer * 256 + c4), gnb = *(const f32x4*)(a.in[I_GNB] + layer * 256 + c4);
    for (int tok = vb * 8 + wave; tok < M; tok += G * 8) {
        const size_t row = (size_t)tok;
        bf16* yp = PM + row * PMW + C_RW + c4; const f32x4 y = ld4bf(yp); const f32x4 vf = ld4bf(LO + row * 1024 + 768 + c4), g = ld4bf(LO + row * 1024 + 512 + c4); const float bon = BON[row * 4 + head];
        const float mean = dpp_sum16((y.x + y.y) + (y.z + y.w)) * (1.f / 64); const f32x4 d = y - mean;
        const float var = dpp_sum16((d.x * d.x + d.y * d.y) + (d.z * d.z + d.w * d.w)) * (1.f / 64);
        const f32x4 yn = d * (1.0f / sqrtf(var + 64e-5f)) * gnw + gnb;
        st4bf(yp, (yn + bon * vf) * g);
    }
}

typedef short bf16x4 __attribute__((ext_vector_type(4)));
constexpr int HQS = 72, HES = 20;
constexpr int HG_QT = 0, HG_KT = HG_QT + 16 * HQS * 2, HG_KE = HG_KT + 16 * HQS * 2, HG_IT = HG_KE + 64 * HES * 2, HG_DEC = HG_IT + 64 * HES * 2, HG_O = HG_DEC + 256, HG_BUF = HG_O + 4096;
__device__ __forceinline__ void hgrn_chain(const Args& a, int layer, int bh, LAS unsigned char* L) {
    int tid = threadIdx.x; asm volatile("" : "+v"(tid)); const int lane = tid & 63, w = __builtin_amdgcn_readfirstlane(tid >> 6);
    const int b = bh >> 2, h = bh & 3;
    unsigned char* ws = a.ws;
    const bf16* PM = (const bf16*)(ws + WS_PM); bf16* PMo = (bf16*)(ws + WS_PM);
    const size_t rowb = (size_t)b * SEQ;
    constexpr int NCH = SEQ / 16;
    const int s16 = lane & 15, cg = lane >> 4;
    constexpr int RAWS = 528, RAWSZ = 16 * RAWS, HG_RAW = 2 * HG_BUF;
    const int ld_tok = tid >> 5, ld_arr = (tid & 31) >> 3, ld_c8 = tid & 7;
    const bf16* ld_src = PM + (rowb + ld_tok) * PMW + C_HG + h * 64 + ld_arr * 256 + ld_c8 * 8;
    const int ld_dst = ld_tok * RAWS + ld_arr * 128 + ld_c8 * 16;
    float lb[2], oml[2];
#pragma unroll
    for (int r = 0; r < 2; ++r) { const int k = (2 * w + r) * 4 + cg; float v = 0.f; if (layer) { const float l0 = a.in[I_LB][h * 64 + k], l1 = a.in[I_LB][256 + h * 64 + k]; v = 1.0f / (1.0f + expf(l0 - l1)); } lb[r] = v; oml[r] = 1.0f - v; }
    const f32x4 gng4 = *(const f32x4*)(a.in[I_HGN] + layer * 256 + h * 64 + 4 * s16);
    const f32x2 lb2 = {lb[0], lb[1]}, oml2 = {oml[0], oml[1]};
    u32x4 pf[8];
#define HG_LOAD(set, cn) do { const int cn_ = (cn) < NCH ? (cn) : NCH - 1; pf[set] = *(const u32x4*)(ld_src + (size_t)cn_ * 16 * PMW); } while (0)
#define HG_STAGE(set, cn) do { *(LAS u32x4*)(L + HG_RAW + ((cn) & 3) * RAWSZ + ld_dst) = pf[set]; } while (0)
#define HG_PROD(cn) do { { LAS unsigned char* B_ = L + ((cn) & 1) * HG_BUF; const int k0_ = (2 * w) * 4 + cg, k1_ = k0_ + 4; \
        const LAS bf16* R_ = (const LAS bf16*)(L + HG_RAW + ((cn) & 3) * RAWSZ + s16 * RAWS); const unsigned rq0_ = R_[k0_], rq1_ = R_[k1_], rf0_ = R_[64 + k0_], rf1_ = R_[64 + k1_], ri0_ = R_[128 + k0_], ri1_ = R_[128 + k1_]; \
        const f32x2 fl_ = {bflo(rf0_), bflo(rf1_)}; \
        f32x2 e_, inv_, lf_; e_.x = __expf(-fabsf(fl_.x)); e_.y = __expf(-fabsf(fl_.y)); inv_.x = __builtin_amdgcn_rcpf(1.0f + e_.x); inv_.y = __builtin_amdgcn_rcpf(1.0f + e_.y); \
        const f32x2 ei_ = e_ * inv_; f32x2 sg_, ns_; sg_.x = fl_.x >= 0.f ? inv_.x : ei_.x; sg_.y = fl_.y >= 0.f ? inv_.y : ei_.y; ns_.x = fl_.x >= 0.f ? ei_.x : inv_.x; ns_.y = fl_.y >= 0.f ? ei_.y : inv_.y; \
        const f32x2 f_ = lb2 + oml2 * sg_, key_ = oml2 * ns_; lf_.x = __logf(f_.x); lf_.y = __logf(f_.y); \
        float b0_ = lf_.x, b1_ = lf_.y; b0_ += DPP_SHR(b0_, 1); b1_ += DPP_SHR(b1_, 1); b0_ += DPP_SHR(b0_, 2); b1_ += DPP_SHR(b1_, 2); b0_ += DPP_SHR(b0_, 4); b1_ += DPP_SHR(b1_, 4); b0_ += DPP_SHR(b0_, 8); b1_ += DPP_SHR(b1_, 8); \
        const float be0_ = DPP_BC15(b0_), be1_ = DPP_BC15(b1_);                         \
        f32x2 eb_, en_, de_; eb_.x = __expf(b0_); eb_.y = __expf(b1_); en_.x = __expf(fminf(-b0_, 80.f)); en_.y = __expf(fminf(-b1_, 80.f)); de_.x = __expf(be0_); de_.y = __expf(be1_); \
        const f32x2 qt_ = (f32x2){bflo(rq0_), bflo(rq1_)} * eb_, kt_ = key_ * en_, ke_ = kt_ * de_; \
        const unsigned wq_ = cvt_pk_bf16(qt_.x, qt_.y), wk_ = cvt_pk_bf16(kt_.x, kt_.y), we_ = cvt_pk_bf16(ke_.x, ke_.y); \
        LAS bf16* QT_ = (LAS bf16*)(B_ + HG_QT) + s16 * HQS; LAS bf16* KT_ = (LAS bf16*)(B_ + HG_KT) + s16 * HQS; LAS bf16* KE_ = (LAS bf16*)(B_ + HG_KE) + s16; LAS bf16* IT_ = (LAS bf16*)(B_ + HG_IT) + s16; \
        QT_[k0_] = (bf16)(wq_ & 0xffffu); QT_[k1_] = (bf16)(wq_ >> 16); KT_[k0_] = (bf16)(wk_ & 0xffffu); KT_[k1_] = (bf16)(wk_ >> 16); \
        KE_[k0_ * HES] = (bf16)(we_ & 0xffffu); KE_[k1_ * HES] = (bf16)(we_ >> 16); IT_[k0_ * HES] = (bf16)ri0_; IT_[k1_ * HES] = (bf16)ri1_; \
        if (s16 == 0) { ((LAS float*)(B_ + HG_DEC))[k0_] = de_.x; ((LAS float*)(B_ + HG_DEC))[k1_] = de_.y; } } } while (0)
#define HG_POST(cn) do { if (w >= 4) { const LAS float* O_ = (const LAS float*)(L + ((cn) & 1) * HG_BUF + HG_O); const int c_ = 4 * (w - 4) + cg; \
        const f32x4 o_ = *(const LAS f32x4*)(O_ + c_ * 64 + 4 * s16); const float ms_ = dpp_sum16((o_.x * o_.x + o_.y * o_.y) + (o_.z * o_.z + o_.w * o_.w)) * (1.f / 64); \
        const u32x2 gw_ = *(const LAS u32x2*)(L + HG_RAW + ((cn) & 3) * RAWSZ + c_ * RAWS + 384 + 8 * s16); const f32x4 g_ = {bflo(gw_.x), bfhi(gw_.x), bflo(gw_.y), bfhi(gw_.y)}; f32x4 sg_; \
        _Pragma("unroll") for (int j_ = 0; j_ < 4; ++j_) sg_[j_] = g_[j_] * sigmoidf_(g_[j_]); \
        st4bf(PMo + (rowb + (cn) * 16 + c_) * PMW + C_HG + h * 64 + 4 * s16, o_ * __builtin_amdgcn_rsqf(ms_ + 1e-6f) * gng4 * sg_); } } while (0)
    f32x4 S0 = {0.f, 0.f, 0.f, 0.f}, S1 = S0, S2 = S0, S3 = S0;
    HG_LOAD(0, 0); HG_LOAD(1, 1); HG_LOAD(2, 2); HG_LOAD(3, 3); HG_LOAD(4, 4); HG_LOAD(5, 5); HG_LOAD(6, 6); HG_LOAD(7, 7);
    HG_STAGE(0, 0); HG_STAGE(1, 1); HG_LOAD(0, 8); HG_LOAD(1, 9);
    LBAR();
    HG_PROD(0);
    LBAR();
#define HG_ITER(i) do { const int n = g0 + (i); HG_STAGE(((i) + 2) & 7, n + 2); HG_LOAD(((i) + 2) & 7, n + 10); if (n + 1 < NCH) HG_PROD(n + 1); hg_mfma(n); if (n > 0) HG_POST(n - 1); LBAR(); } while (0)
    auto hg_mfma = [&](int n) __attribute__((always_inline)) {
        if (w < 4) {
            LAS unsigned char* B = L + (n & 1) * HG_BUF;
            const LAS bf16* QT = (const LAS bf16*)(B + HG_QT); const LAS bf16* KT = (const LAS bf16*)(B + HG_KT); const LAS bf16* KE = (const LAS bf16*)(B + HG_KE); const LAS bf16* IT = (const LAS bf16*)(B + HG_IT);
            const LAS float* DEC = (const LAS float*)(B + HG_DEC); LAS float* O = (LAS float*)(B + HG_O);
            f32x4 sc = {0.f, 0.f, 0.f, 0.f};
#pragma unroll
            for (int ks = 0; ks < 2; ++ks) { const bf16x8 af = *(const LAS bf16x8*)(KT + s16 * HQS + ks * 32 + cg * 8), bfr = *(const LAS bf16x8*)(QT + s16 * HQS + ks * 32 + cg * 8);
                sc = __builtin_amdgcn_mfma_f32_16x16x32_bf16(af, bfr, sc, 0, 0, 0); }
            bf16x4 pf; { float m0 = (4 * cg + 0 <= s16) ? sc[0] : 0.f, m1 = (4 * cg + 1 <= s16) ? sc[1] : 0.f, m2 = (4 * cg + 2 <= s16) ? sc[2] : 0.f, m3 = (4 * cg + 3 <= s16) ? sc[3] : 0.f;
                const unsigned u0 = cvt_pk_bf16(m0, m1), u1 = cvt_pk_bf16(m2, m3); pf = __builtin_bit_cast(bf16x4, (u32x2){u0, u1}); }
            const bf16x4 ifr = *(const LAS bf16x4*)(IT + (16 * w + s16) * HES + 4 * cg);
            f32x4 oacc = {0.f, 0.f, 0.f, 0.f};
            oacc = __builtin_amdgcn_mfma_f32_16x16x16bf16_1k(pf, ifr, oacc, 0, 0, 0);
#define HG_KT_STEP(Sx, kt) do { const bf16x4 qa_ = *(const LAS bf16x4*)(QT + s16 * HQS + 16 * (kt) + 4 * cg); \
                const bf16x4 sb_ = __builtin_bit_cast(bf16x4, (u32x2){cvt_pk_bf16(Sx[0], Sx[1]), cvt_pk_bf16(Sx[2], Sx[3])}); \
                oacc = __builtin_amdgcn_mfma_f32_16x16x16bf16_1k(qa_, sb_, oacc, 0, 0, 0); \
                const bf16x4 ka_ = *(const LAS bf16x4*)(KE + (16 * (kt) + s16) * HES + 4 * cg); const f32x4 dc_ = *(const LAS f32x4*)(DEC + 16 * (kt) + 4 * cg); \
                Sx = __builtin_amdgcn_mfma_f32_16x16x16bf16_1k(ka_, ifr, Sx * dc_, 0, 0, 0); } while (0)
            HG_KT_STEP(S0, 0); HG_KT_STEP(S1, 1); HG_KT_STEP(S2, 2); HG_KT_STEP(S3, 3);
#undef HG_KT_STEP
#pragma unroll
            for (int r = 0; r < 4; ++r) O[(4 * cg + r) * 64 + 16 * w + s16] = oacc[r];
        }
    };
    for (int g0 = 0; g0 < NCH; g0 += 8) { HG_ITER(0); HG_ITER(1); HG_ITER(2); HG_ITER(3); HG_ITER(4); HG_ITER(5); HG_ITER(6); HG_ITER(7); }
    HG_POST(NCH - 1);
    LBAR();
#undef HG_ITER
#undef HG_STAGE
#undef HG_LOAD
#undef HG_PROD
#undef HG_POST
}

#include <hip/hip_bf16.h>
namespace moba_body {
using bf16=__hip_bfloat16;
using bf16x8=__attribute__((ext_vector_type(8)))short;
using s16x4=__attribute__((ext_vector_type(4)))short;
using f32x16=__attribute__((ext_vector_type(16)))float;
using u32x4=__attribute__((ext_vector_type(4)))unsigned;
constexpr int SEQ=4096,D=64,PIN=3584,POUT=3584;
constexpr int NW=8,QBLK=32,QB=QBLK*NW,KVBLK=64,NQB=SEQ/QB;
__device__ __forceinline__ int crow(int r,int hi){return (r&3)+8*(r>>2)+4*hi;}
#define SBAR() __builtin_amdgcn_sched_barrier(0)
__device__ __forceinline__ void cmask(f32x16&p0,f32x16&p1,int jb,int qrel,int hi){
  const float NEG=-INFINITY; int kb=64*jb+4*hi;
  #pragma unroll
  for(int r=0;r<16;++r){int kv=kb+(r&3)+8*(r>>2); if(kv>qrel)p0[r]=NEG; if(kv+32>qrel)p1[r]=NEG;}
}

constexpr int NSLOT=3, SLOTB=8192;
constexpr int LDS_K=0, LDS_V=NSLOT*SLOTB, LDS_WS=2*NSLOT*SLOTB, LDS_OST=LDS_WS+NW*64*4, LDS_BYTES=LDS_OST+NW*4096;
constexpr float C2=0.125f*1.4426950408889634f;
__device__ __forceinline__ void glds16(const void*gbase,unsigned voff,unsigned lds_dst){unsigned keep;
  asm volatile("s_mov_b32 %0, m0\n\ts_mov_b32 m0, %2\n\ts_nop 0\n\tglobal_load_lds_dwordx4 %1, %3\n\ts_mov_b32 m0, %0":"=&s"(keep):"v"(voff),"s"(lds_dst),"s"(gbase):"memory");}
__device__ __forceinline__ float max3f(float a,float b,float c){float r;asm("v_max3_f32 %0, %1, %2, %3":"=v"(r):"v"(a),"v"(b),"v"(c));return r;}
__device__ __forceinline__ float max2f(float a,float b){float r;asm("v_max_f32_e32 %0, %1, %2":"=v"(r):"v"(a),"v"(b));return r;}
__device__ __forceinline__ float fadd_s(float a,float b){float r;asm("v_add_f32_e32 %0, %1, %2":"=v"(r):"v"(a),"v"(b));return r;}
__device__ __forceinline__ float fsub_s(float a,float b){float r;asm("v_sub_f32_e32 %0, %1, %2":"=v"(r):"v"(a),"v"(b));return r;}
typedef float f32x2_t __attribute__((ext_vector_type(2))); typedef __bf16 bf16x2_t __attribute__((ext_vector_type(2)));
__device__ __forceinline__ unsigned cvtpk_s(float lo,float hi){f32x2_t v={lo,hi};bf16x2_t b=__builtin_convertvector(v,bf16x2_t);return __builtin_bit_cast(unsigned,b);}
#define WAIT_BAR(N) asm volatile("s_waitcnt vmcnt(" #N ") lgkmcnt(0)\n\ts_barrier":::"memory")

__device__ __forceinline__ void qkt(f32x16&p0,f32x16&p1,const char*Kslot,const bf16x8*qr,const f32x16&negm,int r32,int hi){
  const char*kb=Kslot+hi*1024+r32*16;
  #pragma unroll
  for(int d0=0;d0<4;++d0){
    const bf16x8 b0=*reinterpret_cast<const bf16x8*>(kb+d0*2048);
    const bf16x8 b1=*reinterpret_cast<const bf16x8*>(kb+d0*2048+512);
    if(d0==0){p0=__builtin_amdgcn_mfma_f32_32x32x16_bf16(b0,qr[0],negm,0,0,0);p1=__builtin_amdgcn_mfma_f32_32x32x16_bf16(b1,qr[0],negm,0,0,0);}
    else{p0=__builtin_amdgcn_mfma_f32_32x32x16_bf16(b0,qr[d0],p0,0,0,0);p1=__builtin_amdgcn_mfma_f32_32x32x16_bf16(b1,qr[d0],p1,0,0,0);}}
}
typedef __attribute__((address_space(3))) const char* lds_cptr;
typedef short v4i16_t __attribute__((ext_vector_type(4)));
__device__ __forceinline__ void kload8(bf16x8*kf,lds_cptr kp){
  kf[0]=*(const __attribute__((address_space(3))) bf16x8*)(kp);      kf[1]=*(const __attribute__((address_space(3))) bf16x8*)(kp+512);
  kf[2]=*(const __attribute__((address_space(3))) bf16x8*)(kp+2048); kf[3]=*(const __attribute__((address_space(3))) bf16x8*)(kp+2560);
  kf[4]=*(const __attribute__((address_space(3))) bf16x8*)(kp+4096); kf[5]=*(const __attribute__((address_space(3))) bf16x8*)(kp+4608);
  kf[6]=*(const __attribute__((address_space(3))) bf16x8*)(kp+6144); kf[7]=*(const __attribute__((address_space(3))) bf16x8*)(kp+6656);
}
__device__ __forceinline__ void kload2(bf16x8*kf,lds_cptr kp,int j){ kf[2*j]=*(const __attribute__((address_space(3))) bf16x8*)(kp+j*2048); kf[2*j+1]=*(const __attribute__((address_space(3))) bf16x8*)(kp+j*2048+512); }
__device__ __forceinline__ s16x4 vtr(lds_cptr p){ return __builtin_bit_cast(s16x4,__builtin_amdgcn_ds_read_tr16_b64_v4i16((__attribute__((address_space(3))) v4i16_t*)p)); }
__device__ __forceinline__ float rowmax(const f32x16&p0,const f32x16&p1){
  float a=max3f(p0[0],p0[1],p1[0]),b=max3f(p0[2],p0[3],p1[1]);a=max3f(a,p1[2],p1[3]);
  #pragma unroll
  for(int r=4;r<16;r+=4){a=max3f(a,p0[r],p0[r+1]);b=max3f(b,p0[r+2],p0[r+3]);a=max3f(a,p1[r],p1[r+1]);b=max3f(b,p1[r+2],p1[r+3]);}
  const float m=max2f(a,b);
  auto rr=__builtin_amdgcn_permlane32_swap(__float_as_uint(m),__float_as_uint(m),false,false);
  return max2f(__uint_as_float(rr[0]),__uint_as_float(rr[1]));
}
__device__ __forceinline__ void pv(f32x16*o,int vb,bf16x8 pa0,bf16x8 pa1,bf16x8 pa2,bf16x8 pa3){
  #pragma unroll
  for(int d0=0;d0<2;++d0){s16x4 lo[4],hi[4];
    #pragma unroll
    for(int ks=0;ks<4;++ks){
      asm volatile("ds_read_b64_tr_b16 %0,%1 offset:%c2":"=&v"(lo[ks]):"v"(vb),"i"(d0*4096+ks*1024):"memory");
      asm volatile("ds_read_b64_tr_b16 %0,%1 offset:%c2":"=&v"(hi[ks]):"v"(vb),"i"(d0*4096+ks*1024+512):"memory");}
    asm volatile("s_waitcnt lgkmcnt(0)":::"memory");SBAR();
    #define PK(k) (bf16x8){lo[k][0],lo[k][1],lo[k][2],lo[k][3],hi[k][0],hi[k][1],hi[k][2],hi[k][3]}
    o[d0]=__builtin_amdgcn_mfma_f32_32x32x16_bf16(pa0,PK(0),o[d0],0,0,0);
    o[d0]=__builtin_amdgcn_mfma_f32_32x32x16_bf16(pa1,PK(1),o[d0],0,0,0);
    o[d0]=__builtin_amdgcn_mfma_f32_32x32x16_bf16(pa2,PK(2),o[d0],0,0,0);
    o[d0]=__builtin_amdgcn_mfma_f32_32x32x16_bf16(pa3,PK(3),o[d0],0,0,0);
    #undef PK
  }
}

#ifndef ATTN_STORE16
#define ATTN_STORE16(p,v) (*(u32x4*)(p)=(v))
#endif
template<int THRL> __device__ __forceinline__ void attn_unit(int b,int h,int qb,const bf16*Q,const bf16*__restrict__ K,const bf16*__restrict__ V,bf16*O,const float*__restrict__ KMP,char*shm){
  int tid=threadIdx.x; asm volatile("":"+v"(tid));
  const int lane=tid&63,r32=lane&31,hi=lane>>5; const int wid=__builtin_amdgcn_readfirstlane(tid>>6);
  const long rowbase=(long)b*SEQ; const int q0=qb*QB;
  const bf16*Qw=Q+(rowbase+q0+wid*QBLK)*PIN+h*D;
  const bf16*Kh=K+rowbase*PIN+h*D,*Vh=V+rowbase*PIN+h*D;
  const unsigned lds0=(unsigned)(uintptr_t)shm;
  float*wsf=(float*)(shm+LDS_WS)+wid*64;
  const unsigned koff=(unsigned)(lane*PIN+wid*8)*2u;
  const unsigned voff=(unsigned)((16*(wid&3)+(lane>>2))*PIN+(wid>>2)*32+(lane&3)*8)*2u;
  const unsigned kdst=lds0+LDS_K+wid*1024, vdst=lds0+LDS_V+wid*1024;
  #define DMA_K(t,slot) glds16(Kh,koff+(unsigned)(t)*(unsigned)(KVBLK*PIN*2),(unsigned)__builtin_amdgcn_readfirstlane(kdst+(slot)))
  #define DMA_V(t,slot) glds16(Vh,voff+(unsigned)(t)*(unsigned)(KVBLK*PIN*2),(unsigned)__builtin_amdgcn_readfirstlane(vdst+(slot)))
  const int vb0=(int)(lds0+LDS_V)+((lane>>4)&1)*32+(lane&3)*8+(4*hi+((lane&15)>>2))*64;
  const char*Kbase=shm+LDS_K; bf16x8 kf[8];
  const lds_cptr shm3=(lds_cptr)shm; const lds_cptr kp0=shm3+LDS_K+hi*1024+r32*16; const lds_cptr vp0=shm3+LDS_V+((lane>>4)&1)*32+(lane&3)*8+(4*hi+((lane&15)>>2))*64;
  const int NT=(q0+QB)/KVBLK;
  DMA_K(0,0);DMA_V(0,0);DMA_K(1,SLOTB);
  bf16x8 qr[4];
  #pragma unroll
  for(int d0=0;d0<4;++d0)qr[d0]=*reinterpret_cast<const bf16x8*>(&Qw[(long)r32*PIN+d0*16+hi*8]);
  unsigned sel=0u;
  { float qf[32];
    #pragma unroll
    for(int d0=0;d0<4;++d0){
      #pragma unroll
      for(int e=0;e<8;++e)qf[d0*8+e]=__uint_as_float(((unsigned)(unsigned short)qr[d0][e])<<16);}
    float b0=-INFINITY,b1=-INFINITY,b2=-INFINITY; int i0=-1,i1=-1,i2=-1;
    for(int j=0;j<qb;++j){
      const float*kp=KMP+((long)(b*4+h)*32+2*j)*64+8*hi; float g=0.f;
      #pragma unroll
      for(int d0=0;d0<4;++d0){ const float4 a0=*reinterpret_cast<const float4*>(kp+16*d0),a1=*reinterpret_cast<const float4*>(kp+16*d0+4),c0=*reinterpret_cast<const float4*>(kp+64+16*d0),c1=*reinterpret_cast<const float4*>(kp+64+16*d0+4);
        g+=qf[d0*8+0]*(a0.x+c0.x);g+=qf[d0*8+1]*(a0.y+c0.y);g+=qf[d0*8+2]*(a0.z+c0.z);g+=qf[d0*8+3]*(a0.w+c0.w);
        g+=qf[d0*8+4]*(a1.x+c1.x);g+=qf[d0*8+5]*(a1.y+c1.y);g+=qf[d0*8+6]*(a1.z+c1.z);g+=qf[d0*8+7]*(a1.w+c1.w);}
      { auto rr=__builtin_amdgcn_permlane32_swap(__float_as_uint(g),__float_as_uint(g),false,false); g=__uint_as_float(rr[0])+__uint_as_float(rr[1]); }
      if(g>b0){b2=b1;i2=i1;b1=b0;i1=i0;b0=g;i0=j;} else if(g>b1){b2=b1;i2=i1;b1=g;i1=j;} else if(g>b2){b2=g;i2=j;}
    }
    if(i0>=0)sel|=1u<<i0; if(i1>=0)sel|=1u<<i1; if(i2>=0)sel|=1u<<i2;
    #pragma unroll
    for(int d0=0;d0<4;++d0){ u32x4 w;
      w[0]=cvtpk_s(qf[d0*8+0]*C2,qf[d0*8+1]*C2);w[1]=cvtpk_s(qf[d0*8+2]*C2,qf[d0*8+3]*C2);w[2]=cvtpk_s(qf[d0*8+4]*C2,qf[d0*8+5]*C2);w[3]=cvtpk_s(qf[d0*8+6]*C2,qf[d0*8+7]*C2);
      qr[d0]=__builtin_bit_cast(bf16x8,w);} }
  float mhat=0.f,l_reg=0.f;f32x16 o[2];o[0]=f32x16{};o[1]=f32x16{};f32x16 negm=f32x16{};asm volatile("":"+v"(negm));
  const int qrel=wid*QBLK+r32;
  #define PMASK(P0,P1,t) do{ if(!((sel>>((t)>>2))&1u)){ _Pragma("unroll") for(int r_=0;r_<16;++r_){P0[r_]=-INFINITY;P1[r_]=-INFINITY;} } }while(0)
  #define CMASK(P0,P1,t) do{int jb_=(t)-(NT-4); if(jb_>=0)cmask(P0,P1,jb_,qrel,hi); else PMASK(P0,P1,t);}while(0)
  bool resc=false;
  #define START(P0,P1) do{ const float rm=rowmax(P0,P1); resc=false; \
    { const float dl=__builtin_fmaxf(rm,-64.f); mhat=fadd_s(mhat,dl); \
      _Pragma("unroll") for(int r=0;r<16;++r){P0[r]=fsub_s(P0[r],dl);P1[r]=fsub_s(P1[r],dl);} \
      _Pragma("unroll") for(int r=0;r<16;++r)negm[r]=-mhat; asm volatile("":"+v"(negm)); } \
    _Pragma("unroll") for(int r=0;r<16;++r)P0[r]=__builtin_amdgcn_exp2f(P0[r]); }while(0)
  #define RESC() do{ if(resc){ asm volatile("s_waitcnt lgkmcnt(0)":::"memory"); \
      _Pragma("unroll") for(int d_=0;d_<2;++d_) _Pragma("unroll") for(int r=0;r<16;++r)o[d_][r]*=wsf[crow(r,hi)]; } }while(0)
  f32x16 pA0,pA1,pB0,pB1;
  int sl_prev=0,sl_cur=0,sl_next=SLOTB;
  #define ROT() do{sl_prev=sl_cur;sl_cur=sl_next;sl_next=(sl_next==(NSLOT-1)*SLOTB)?0:sl_next+SLOTB;}while(0)
  DMA_K(2,2*SLOTB);
  WAIT_BAR(3);
  qkt(pA0,pA1,Kbase,qr,negm,r32,hi);asm volatile("s_nop 15\n\ts_nop 7":"+v"(pA0),"+v"(pA1));CMASK(pA0,pA1,0);
  START(pA0,pA1);
  _Pragma("unroll") for(int r=0;r<16;++r)pA1[r]=__builtin_amdgcn_exp2f(pA1[r]);
  WAIT_BAR(0);
  DMA_K(3,0);DMA_V(1,SLOTB);
  ROT();
  kload8(kf,kp0+sl_cur);
  WAIT_BAR(2);
  s16x4 vlo[8],vhi[8]; u32x4 pw0,pw1,pw2,pw3;
  #define PKW(P,B) cvtpk_s(P[B],P[B+1])
  #define PAF(k) __builtin_bit_cast(bf16x8,pw##k)
  #define VFR(i) (bf16x8){vlo[i][0],vlo[i][1],vlo[i][2],vlo[i][3],vhi[i][0],vhi[i][1],vhi[i][2],vhi[i][3]}
  #define PIN(x) asm volatile("":"+v"(x))
  #define MX3(a,b,c) __builtin_fmaxf(__builtin_fmaxf((a),(b)),(c))
  #define GAPA(MF,A0,A1,A2,A3,W0,W1,PW) do{ MF; sacc+=A0; sacc+=A1; sacc+=A2; sacc+=A3; PIN(sacc); W0; W1; PIN(PW); SBAR(); }while(0)
  #define EX(v) __builtin_amdgcn_exp2f(v)
  #define GAPB(MF,X,B) do{ MF; X[B]=EX(X[B]); X[B+1]=EX(X[B+1]); X[B+2]=EX(X[B+2]); X[B+3]=EX(X[B+3]); PIN(X); SBAR(); }while(0)
  #define VRD(i) do{ vlo[i]=vtr(vp_+(((i)>>2)*4096+((i)&3)*1024)); vhi[i]=vtr(vp_+(((i)>>2)*4096+((i)&3)*1024+512)); }while(0)
  #define KRD(G,j) do{ if(G){ kload2(kf,kp0+sl_next,j); SBAR(); } }while(0)
  #define STEP(C0,C1,P0,P1,t,GK,GV,GL) do{ SBAR(); \
    const lds_cptr vp_=vp0+sl_prev; \
    VRD(0); SBAR(); float sacc=(P0[0]+P0[1]); \
    GAPA(C0=__builtin_amdgcn_mfma_f32_32x32x16_bf16(kf[0],qr[0],negm,0,0,0), P0[2],P0[3],P0[4],P0[5],     pw0[0]=PKW(P0,0), pw0[1]=PKW(P0,2), pw0); \
    VRD(4); SBAR(); GAPA(C1=__builtin_amdgcn_mfma_f32_32x32x16_bf16(kf[1],qr[0],negm,0,0,0), P0[6],P0[7],P0[8],P0[9],     pw0[2]=PKW(P0,4), pw0[3]=PKW(P0,6), pw0); \
    VRD(1); SBAR(); GAPA(C0=__builtin_amdgcn_mfma_f32_32x32x16_bf16(kf[2],qr[1],C0,0,0,0),   P0[10],P0[11],P0[12],P0[13], pw1[0]=PKW(P0,8), pw1[1]=PKW(P0,10), pw1); \
    VRD(5); SBAR(); GAPA(C1=__builtin_amdgcn_mfma_f32_32x32x16_bf16(kf[3],qr[1],C1,0,0,0),   P0[14],P0[15],P1[0],P1[1],   pw1[2]=PKW(P0,12),pw1[3]=PKW(P0,14), pw1); \
    VRD(2); SBAR(); GAPA(C0=__builtin_amdgcn_mfma_f32_32x32x16_bf16(kf[4],qr[2],C0,0,0,0),   P1[2],P1[3],P1[4],P1[5],     pw2[0]=PKW(P1,0), pw2[1]=PKW(P1,2), pw2); \
    VRD(6); SBAR(); GAPA(C1=__builtin_amdgcn_mfma_f32_32x32x16_bf16(kf[5],qr[2],C1,0,0,0),   P1[6],P1[7],P1[8],P1[9],     pw2[2]=PKW(P1,4), pw2[3]=PKW(P1,6), pw2); \
    VRD(3); SBAR(); GAPA(C0=__builtin_amdgcn_mfma_f32_32x32x16_bf16(kf[6],qr[3],C0,0,0,0),   P1[10],P1[11],P1[12],P1[13], pw3[0]=PKW(P1,8), pw3[1]=PKW(P1,10), pw3); \
    VRD(7); SBAR(); GAPA(C1=__builtin_amdgcn_mfma_f32_32x32x16_bf16(kf[7],qr[3],C1,0,0,0),   P1[14],P1[15],0.f,0.f,       pw3[2]=PKW(P1,12),pw3[3]=PKW(P1,14), pw3); \
    l_reg+=sacc; \
    if(GK){DMA_K((t)+3,sl_cur);} if(GV){DMA_V((t)+1,sl_next);} \
    CMASK(C0,C1,t); \
    { float a=MX3(C0[0],C0[1],C1[0]),b=MX3(C0[2],C0[3],C1[1]); a=MX3(a,C1[2],C1[3]); \
      _Pragma("unroll") for(int r=4;r<16;r+=4){a=MX3(a,C0[r],C0[r+1]);b=MX3(b,C0[r+2],C0[r+3]);a=MX3(a,C1[r],C1[r+1]);b=MX3(b,C1[r+2],C1[r+3]);} \
      float rm=__builtin_fmaxf(a,b); { auto rr=__builtin_amdgcn_permlane32_swap(__float_as_uint(rm),__float_as_uint(rm),false,false); rm=__builtin_fmaxf(__uint_as_float(rr[0]),__uint_as_float(rr[1])); } \
      resc=false; \
      if(__builtin_expect(__any(rm>(float)THRL),0)){ const float dl=__builtin_fmaxf(rm,0.f); mhat+=dl; \
        _Pragma("unroll") for(int r=0;r<16;++r){C0[r]-=dl;C1[r]-=dl;} \
        _Pragma("unroll") for(int r=0;r<16;++r)negm[r]=-mhat; asm volatile("":"+v"(negm)); \
        const float f=__builtin_amdgcn_exp2f(-dl); l_reg*=f; if(hi==0)wsf[r32]=f; resc=true; } } \
    SBAR(); \
    GAPB(o[0]=__builtin_amdgcn_mfma_f32_32x32x16_bf16(PAF(0),VFR(0),o[0],0,0,0), C0,0); \
    GAPB(o[1]=__builtin_amdgcn_mfma_f32_32x32x16_bf16(PAF(0),VFR(4),o[1],0,0,0), C0,4); \
    KRD(GL,0); GAPB(o[0]=__builtin_amdgcn_mfma_f32_32x32x16_bf16(PAF(1),VFR(1),o[0],0,0,0), C0,8); \
    KRD(GL,1); GAPB(o[1]=__builtin_amdgcn_mfma_f32_32x32x16_bf16(PAF(1),VFR(5),o[1],0,0,0), C0,12); \
    KRD(GL,2); GAPB(o[0]=__builtin_amdgcn_mfma_f32_32x32x16_bf16(PAF(2),VFR(2),o[0],0,0,0), C1,0); \
    KRD(GL,3); GAPB(o[1]=__builtin_amdgcn_mfma_f32_32x32x16_bf16(PAF(2),VFR(6),o[1],0,0,0), C1,4); \
    GAPB(o[0]=__builtin_amdgcn_mfma_f32_32x32x16_bf16(PAF(3),VFR(3),o[0],0,0,0), C1,8); \
    GAPB(o[1]=__builtin_amdgcn_mfma_f32_32x32x16_bf16(PAF(3),VFR(7),o[1],0,0,0), C1,12); \
    }while(0)
  int t=1;
  #undef CMASK
  #define CMASK(P0,P1,t) PMASK(P0,P1,t)
  for(;t+5<NT;t+=2){
    STEP(pB0,pB1,pA0,pA1,t,true,true,true);     WAIT_BAR(2); RESC(); ROT();
    STEP(pA0,pA1,pB0,pB1,t+1,true,true,true);   WAIT_BAR(2); RESC(); ROT();
  }
  #undef CMASK
  #define CMASK(P0,P1,t) do{int jb_=(t)-(NT-4); if(jb_>=0)cmask(P0,P1,jb_,qrel,hi); else PMASK(P0,P1,t);}while(0)
  #define ENDW(tt) do{ if((tt)+3<NT){WAIT_BAR(2);} else if((tt)+2<NT){WAIT_BAR(1);} else {WAIT_BAR(0);} }while(0)
  for(;t+1<NT;t+=2){
    STEP(pB0,pB1,pA0,pA1,t,(t+3<NT),(t+1<NT),(t+1<NT));       ENDW(t);   RESC(); ROT();
    STEP(pA0,pA1,pB0,pB1,t+1,(t+4<NT),(t+2<NT),(t+2<NT));     ENDW(t+1); RESC(); ROT();
  }
  STEP(pB0,pB1,pA0,pA1,NT-1,false,false,false); RESC();
  { float sacc=pB0[0]+pB0[1]; _Pragma("unroll") for(int r=2;r<16;++r)sacc+=pB0[r]; _Pragma("unroll") for(int r=0;r<16;++r)sacc+=pB1[r]; l_reg+=sacc;
    pw0=(u32x4){PKW(pB0,0),PKW(pB0,2),PKW(pB0,4),PKW(pB0,6)};pw1=(u32x4){PKW(pB0,8),PKW(pB0,10),PKW(pB0,12),PKW(pB0,14)};pw2=(u32x4){PKW(pB1,0),PKW(pB1,2),PKW(pB1,4),PKW(pB1,6)};pw3=(u32x4){PKW(pB1,8),PKW(pB1,10),PKW(pB1,12),PKW(pB1,14)};
    SBAR(); pv(o,vb0+sl_cur,PAF(0),PAF(1),PAF(2),PAF(3)); }
  #undef PKW
  #undef PAF
  #undef VFR
  #undef PIN
  #undef MX3
  #undef GAPA
  #undef GAPB
  #undef EX
  #undef VRD
  #undef KRD
  #undef STEP
  #undef ENDW
  {auto rr=__builtin_amdgcn_permlane32_swap(__float_as_uint(l_reg),__float_as_uint(l_reg),false,false);l_reg=__uint_as_float(rr[0])+__uint_as_float(rr[1]);}
  if(hi==0)wsf[32+r32]=l_reg;asm volatile("s_waitcnt lgkmcnt(0)":::"memory");
  float rli[16];
  #pragma unroll
  for(int r=0;r<16;++r)rli[r]=__builtin_amdgcn_rcpf(wsf[32+crow(r,hi)]);
  bf16*Ow=O+(rowbase+q0+wid*QBLK)*POUT+h*D;
  { bf16*stg=(bf16*)(shm+LDS_OST)+wid*2048;
    #pragma unroll
    for(int r=0;r<16;++r){const int orow=crow(r,hi);
      #pragma unroll
      for(int d0=0;d0<2;++d0)stg[orow*64+d0*32+r32]=__float2bfloat16(o[d0][r]*rli[r]);}
    asm volatile("s_waitcnt lgkmcnt(0)":::"memory");
    #pragma unroll
    for(int i=0;i<4;++i){const int row=i*8+(lane>>3),ch=lane&7; const u32x4 v=*(const u32x4*)(stg+row*64+ch*8); ATTN_STORE16(Ow+(long)row*POUT+ch*8,v);} }
  asm volatile("s_waitcnt lgkmcnt(0)\n\ts_barrier":::"memory");
  #undef DMA_K
  #undef DMA_V
  #undef CMASK
  #undef PMASK
  #undef START
  #undef RESC
  #undef ROT
}
constexpr int ATTN_LDS_BYTES=LDS_BYTES;
#undef SBAR
#undef WAIT_BAR
}

typedef float f32x16 __attribute__((ext_vector_type(16)));
__device__ __forceinline__ void sb_unit(const Args& a, int bh, int qb, LAS unsigned char* lds) {
    int tid = threadIdx.x; asm volatile("" : "+v"(tid));
    const int lane = tid & 63, wid = tid >> 6, r32 = lane & 31, hh = lane >> 5;
    const int b = bh >> 2, h = bh & 3;
    unsigned char* ws = a.ws;
    const bf16* PM = (const bf16*)(ws + WS_PM); bf16* PMo = (bf16*)(ws + WS_PM);
    const size_t rowb = (size_t)b * SEQ;
    const int t0 = qb * 256 + wid * 32, t = t0 + r32;
    const bf16* Kb = PM + rowb * PMW + C_SB + 256 + h * 64; const bf16* Vb = PM + rowb * PMW + C_SB + 512 + h * 64;
    bf16x8 qf[4];
    { const bf16* qp = PM + (rowb + t) * PMW + C_SB + h * 64 + 8 * hh;
#pragma unroll
        for (int ks = 0; ks < 4; ++ks) { const u32x4 x = *(const u32x4*)(qp + 16 * ks); u32x4 y;
            y.x = cvt_pk_bf16(bflo(x.x) * 0.125f, bfhi(x.x) * 0.125f); y.y = cvt_pk_bf16(bflo(x.y) * 0.125f, bfhi(x.y) * 0.125f);
            y.z = cvt_pk_bf16(bflo(x.z) * 0.125f, bfhi(x.z) * 0.125f); y.w = cvt_pk_bf16(bflo(x.w) * 0.125f, bfhi(x.w) * 0.125f); qf[ks] = __builtin_bit_cast(bf16x8, y); } }
    f32x16 o0, o1;
#pragma unroll
    for (int i = 0; i < 16; ++i) { o0[i] = 0.f; o1[i] = 0.f; }
    float carry = 0.f;
    bf16x8 kn[4]; u32x4 vn[4];
    LAS unsigned short* VT = (LAS unsigned short*)(lds + wid * 4608);
    const int vkey = lane >> 3, vd0 = 8 * (lane & 7);
#define SB_LOAD(kt_) do { const int s0_ = (kt_) * 32; const bf16* kp_ = Kb + (size_t)(s0_ + r32) * PMW + 8 * hh; \
        _Pragma("unroll") for (int ks_ = 0; ks_ < 4; ++ks_) kn[ks_] = *(const bf16x8*)(kp_ + 16 * ks_); \
        const bf16* vp_ = Vb + (size_t)(s0_ + vkey) * PMW + vd0; \
        _Pragma("unroll") for (int q_ = 0; q_ < 4; ++q_) vn[q_] = *(const u32x4*)(vp_ + (size_t)(8 * q_) * PMW); } while (0)
    SB_LOAD(t0 >> 5);
    for (int kt = t0 >> 5; kt >= 0; --kt) {
        const int s0 = kt * 32;
        f32x16 z;
#pragma unroll
        for (int i = 0; i < 16; ++i) z[i] = 0.f;
        bf16x8 kf[4];
#pragma unroll
        for (int ks = 0; ks < 4; ++ks) kf[ks] = kn[ks];
        unsigned vw[2][2][4];
#pragma unroll
        for (int q = 0; q < 4; ++q) { LAS unsigned short* w_ = VT + vd0 * 36 + vkey + 8 * q; const u32x4 x = vn[q];
            w_[0] = (unsigned short)x.x; w_[36] = (unsigned short)(x.x >> 16); w_[72] = (unsigned short)x.y; w_[108] = (unsigned short)(x.y >> 16);
            w_[144] = (unsigned short)x.z; w_[180] = (unsigned short)(x.z >> 16); w_[216] = (unsigned short)x.w; w_[252] = (unsigned short)(x.w >> 16); }
#pragma unroll
        for (int nt = 0; nt < 2; ++nt)
#pragma unroll
            for (int s_ = 0; s_ < 2; ++s_)
#pragma unroll
                for (int c = 0; c < 2; ++c) { const u32x2 r_ = *(const LAS u32x2*)(VT + (r32 + 32 * nt) * 36 + 16 * s_ + 8 * c + 4 * hh); vw[nt][s_][2 * c] = r_.x; vw[nt][s_][2 * c + 1] = r_.y; }
        if (kt > 0) SB_LOAD(kt - 1);
#pragma unroll
        for (int ks = 0; ks < 4; ++ks) z = __builtin_amdgcn_mfma_f32_32x32x16_bf16(kf[ks], qf[ks], z, 0, 0, 0);
        float ls[16], ln[16];
#pragma unroll
        for (int i = 0; i < 16; ++i) { const int key = s0 + (i & 3) + 8 * (i >> 2) + 4 * hh; const bool ok = key < t; const float zz = z[i];
            const float l1p = __logf(1.0f + __expf(-fabsf(zz)));
            ls[i] = ok ? (fminf(zz, 0.f) - l1p) : -INFINITY; ln[i] = ok ? (fminf(-zz, 0.f) - l1p) : 0.f; }
        float gs[4], pg[4];
#pragma unroll
        for (int m = 0; m < 4; ++m) { gs[m] = (ln[4 * m] + ln[4 * m + 1]) + (ln[4 * m + 2] + ln[4 * m + 3]); pg[m] = __shfl_xor(gs[m], 32); }
        float T[4]; T[3] = 0.f; T[2] = gs[3] + pg[3]; T[1] = T[2] + (gs[2] + pg[2]); T[0] = T[1] + (gs[1] + pg[1]);
        const float total = T[0] + (gs[0] + pg[0]);
        float att[16];
#pragma unroll
        for (int m = 0; m < 4; ++m) { float cb = carry + T[m] + (hh == 0 ? pg[m] : 0.f);
#pragma unroll
            for (int e = 3; e >= 0; --e) { att[4 * m + e] = __expf(ls[4 * m + e] + cb); cb += ln[4 * m + e]; } }
        carry += total;
#pragma unroll
        for (int s_ = 0; s_ < 2; ++s_) { u32x4 aw; aw.x = cvt_pk_bf16(att[8 * s_], att[8 * s_ + 1]); aw.y = cvt_pk_bf16(att[8 * s_ + 2], att[8 * s_ + 3]); aw.z = cvt_pk_bf16(att[8 * s_ + 4], att[8 * s_ + 5]); aw.w = cvt_pk_bf16(att[8 * s_ + 6], att[8 * s_ + 7]);
            const bf16x8 af = __builtin_bit_cast(bf16x8, aw);
            o0 = __builtin_amdgcn_mfma_f32_32x32x16_bf16(af, __builtin_bit_cast(bf16x8, (u32x4){vw[0][s_][0], vw[0][s_][1], vw[0][s_][2], vw[0][s_][3]}), o0, 0, 0, 0);
            o1 = __builtin_amdgcn_mfma_f32_32x32x16_bf16(af, __builtin_bit_cast(bf16x8, (u32x4){vw[1][s_][0], vw[1][s_][1], vw[1][s_][2], vw[1][s_][3]}), o1, 0, 0, 0); }
        if (__all(carry < -110.f)) break;
    }
#undef SB_LOAD
    bf16* yp = PMo + (rowb + t0 + 4 * hh) * PMW + C_SB + h * 64 + r32;
#pragma unroll
    for (int i = 0; i < 16; ++i) { const size_t ro = (size_t)((i & 3) + 8 * (i >> 2)) * PMW; yp[ro] = (bf16)f2bf(o0[i]); yp[ro + 32] = (bf16)f2bf(o1[i]); }
}

__device__ __forceinline__ void phase_e(const Args& a, int layer_rep, LAS unsigned char* lds, volatile LAS unsigned* MISC, int vb) {
    const int layer = layer_rep & 1;
    LAS float* L = (LAS float*)lds;
    unsigned* work = (unsigned*)(a.ws + WS_CTL) + CW_WORK + 64 * layer_rep;
    for (int c = vb; c < 64; c += (int)gridDim.x) { if (c < 32) rwkv_chain(a, layer, c, lds); else hgrn_chain(a, layer, c - 32, (LAS unsigned char*)L); }
    for (;;) {
        __syncthreads();
        if (threadIdx.x == 0) MISC[0] = __hip_atomic_fetch_add(work, 1u, __ATOMIC_RELAXED, __HIP_MEMORY_SCOPE_AGENT);
        __syncthreads();
        const unsigned u = (unsigned)__builtin_amdgcn_readfirstlane((int)MISC[0]);
        if (u >= 1024u + NWU) break;
        if (u < NWU) { int tl = threadIdx.x; asm volatile("" : "+v"(tl)); const int wv = tl >> 6, ln = tl & 63; LAS float* scr = (LAS float*)(lds + wv * 16384);
#pragma unroll 1
            for (int it = (int)u * 32 + wv; it < (int)(u + 1u) * 32; it += 8) late_weight_item(a, layer, it, scr, ln); }
        else if (u < NWU + 512u) { const unsigned v = u - NWU; const int bh = (int)(v & 31u), qb = 15 - (int)(v >> 5); const moba_body::bf16* pm = (const moba_body::bf16*)(a.ws + WS_PM);
            moba_body::attn_unit<8>(bh >> 2, bh & 3, qb, pm + C_MB, pm + C_MB + 256, pm + C_MB + 512, (moba_body::bf16*)(a.ws + WS_PM) + C_MB, (const float*)(a.ws + WS_KMP), (char*)lds); }
        else { const unsigned v = u - NWU - 512u; sb_unit(a, (int)(v & 31u), 15 - (int)(v >> 5), lds); }
    }
}

#if MK_ONE_LAUNCH
#define SEAM() xcd_barrier(bar)
#else
#define SEAM() do {} while (0)
#endif
#define IN(k) (lo <= (k) && (k) < hi)
#define BOTH(k) (IN(k) && IN((k) + 1))
template <int LAYER>
__device__ __forceinline__ void layer_phases(const Args& args, LAS unsigned char* lds, volatile LAS unsigned* MISC, const XcdBarrier& bar, int lo, int hi, int vb0, int G0) {
    constexpr int layer = LAYER;
    unsigned char* ws = args.ws;
    float* xres = args.out;
        const int pb = layer * PPL;
        const float* xin = layer ? (const float*)args.out : args.in[I_X];
        const char* Wb = (const char*)(ws + WS_W);
        if (IN(pb + 0)) { const int vb = opaque_s(vb0), G = opaque_s(G0); for (int rep = 0; rep < (REPEAT_PH == 0 ? 2 : 1); ++rep) { phase_a(args, layer, xin, lds, vb, G); if (rep == 0 && REPEAT_PH == 0) SEAM(); } if (BOTH(pb + 0)) SEAM(); }
        if (IN(pb + 1)) { const int vb = opaque_s(vb0), G = opaque_s(G0);
            pg8::PlainOrder S{LAYER == 0 ? (const char*)(ws + WS_H) : (const char*)xres, Wb + W_IN, 2048u, 2048u, 16, 128, 14, G, vb};
            pg8::EpiBf16S E{(bf16*)(ws + WS_PM), PMW, (const float*)(ws + WS_RSQ1), lds};
            for (int rep = 0; rep < (REPEAT_PH == 1 ? 2 : 1); ++rep) { pg8::gemm_phase<pg8::EpiBf16S, pg8::PlainOrder, true>(lds, S, E); if (rep == 0 && REPEAT_PH == 1) SEAM(); }
            if (BOTH(pb + 1)) SEAM();
        }
        if (IN(pb + 2)) { const int vb = opaque_s(vb0), G = opaque_s(G0); for (int rep = 0; rep < (REPEAT_PH == 2 ? 2 : 1); ++rep) { phase_c(args, layer, lds, vb, G); if (rep == 0 && REPEAT_PH == 2) SEAM(); } if (BOTH(pb + 2)) SEAM(); }
        if (IN(pb + 3)) { const int vb = opaque_s(vb0), G = opaque_s(G0);
            pg8::LoraOrder S{(const char*)(ws + WS_LA), Wb + W_L, Wb + W_V, layer ? 4 : 3, G, vb};
            pg8::EpiBf16 E{(bf16*)(ws + WS_LO), 1024};
            for (int rep = 0; rep < (REPEAT_PH == 3 ? 2 : 1); ++rep) { pg8::gemm_phase<pg8::EpiBf16, pg8::LoraOrder, true>(lds, S, E); if (rep == 0 && REPEAT_PH == 3) SEAM(); }
            if (BOTH(pb + 3)) SEAM();
        }
        if (IN(pb + 4)) { const int vb = opaque_s(vb0), G = opaque_s(G0); for (int rep = 0; rep < (REPEAT_PH == 4 ? 2 : 1); ++rep) { phase_d2(args, layer, lds, vb, G); if (rep == 0 && REPEAT_PH == 4) SEAM(); } if (BOTH(pb + 4)) SEAM(); }
        if (IN(pb + 5)) { const int vb = opaque_s(vb0); for (int rep = 0; rep < (REPEAT_PH == 5 ? 2 : 1); ++rep) { phase_e(args, layer + 2 * rep, lds, MISC, vb); if (rep == 0 && REPEAT_PH == 5) SEAM(); } if (BOTH(pb + 5)) SEAM(); }
        if (IN(pb + 6)) { const int vb = opaque_s(vb0), G = opaque_s(G0); for (int rep = 0; rep < (REPEAT_PH == 6 ? 2 : 1); ++rep) { phase_e2(args, layer, vb, G); if (rep == 0 && REPEAT_PH == 6) SEAM(); } if (BOTH(pb + 6)) SEAM(); }
        if (IN(pb + 7)) { const int vb = opaque_s(vb0), G = opaque_s(G0);
            pg8::MergeOrder S{LAYER == 0 ? (const char*)(ws + WS_H) : (const char*)xres, (const char*)(ws + WS_PM), Wb + W_IN + (size_t)PMW * 2048, Wb + W_B, G, vb};
            pg8::EpiMerge E{(u32x4*)(ws + WS_LA) + (size_t)vb * 8192, (bf16*)(ws + WS_LO), (const float*)(ws + WS_RSQ1), lds};
            for (int rep = 0; rep < (REPEAT_PH == 7 ? 2 : 1); ++rep) { pg8::gemm_phase<pg8::EpiMerge, pg8::MergeOrder, true>(lds, S, E); if (rep == 0 && REPEAT_PH == 7) SEAM(); }
            if (BOTH(pb + 7)) SEAM();
        }
        if (IN(pb + 8)) { const int vb = opaque_s(vb0), G = opaque_s(G0);
            pg8::PlainOrder S{(const char*)(ws + WS_LO), Wb + W_O, 2048u, 2048u, 16, 128, 4, G, vb};
            pg8::EpiResNorm<true, LAYER != 0, true> E{(const void*)xin, LAYER == 0 ? (void*)xres : (void*)(ws + WS_H), (float*)(ws + WS_RSQ2), lds};
            pg8::gemm_phase<pg8::EpiResNorm<true, LAYER != 0, true>, pg8::PlainOrder, true>(lds, S, E);
            if (BOTH(pb + 8)) SEAM();
        }
        if (IN(pb + 10)) { const int vb = opaque_s(vb0), G = opaque_s(G0);
            pg8::PlainOrder S{LAYER == 0 ? (const char*)xres : (const char*)(ws + WS_H), Wb + W_GU, 2048u, 2048u, 16, 128, 22, G, vb};
            pg8::EpiSwiGLU E{(bf16*)(ws + WS_PM), (const float*)(ws + WS_RSQ2), lds};
            for (int rep = 0; rep < (REPEAT_PH == 10 ? 2 : 1); ++rep) { pg8::gemm_phase<pg8::EpiSwiGLU, pg8::PlainOrder, true>(lds, S, E); if (rep == 0 && REPEAT_PH == 10) SEAM(); }
            if (BOTH(pb + 10)) SEAM();
        }
        if (IN(pb + 11)) { const int vb = opaque_s(vb0), G = opaque_s(G0);
            pg8::PlainOrder S{(const char*)(ws + WS_PM), Wb + W_D, (unsigned)(DFF * 2), (unsigned)(DFF * 2), DFF / 64, 128, 4, G, vb};
            if constexpr (LAYER == 0) { pg8::EpiResNorm<true, true, true> E{(const void*)xres, (void*)xres, (float*)(ws + WS_RSQ1), lds};
                pg8::gemm_phase<pg8::EpiResNorm<true, true, true>, pg8::PlainOrder, true>(lds, S, E); }
            else { pg8::EpiResFinal E{(const bf16*)(ws + WS_H), xres, args.in[I_FG], (float*)(ws + WS_RSQ1), (unsigned*)(ws + WS_CTL) + CW_XCH, lds};
                pg8::gemm_phase<pg8::EpiResFinal, pg8::PlainOrder, true>(lds, S, E); }
            if (BOTH(pb + 11)) SEAM();
        }
}

__global__ void __launch_bounds__(512, 2) skel_fwd(Args args) {
    extern __shared__ __attribute__((aligned(16))) unsigned char lds_raw[];
    LAS unsigned char* lds = (LAS unsigned char*)lds_raw;
    volatile LAS unsigned* MISC = (volatile LAS unsigned*)(lds + MISC_OFF);
    const int tid = threadIdx.x;
    const int G0 = gridDim.x, vb0 = blockIdx.x;
    unsigned char* ws = args.ws;
    unsigned* ctl = (unsigned*)(ws + WS_CTL);
    for (int u = tid; u < (LDS_BYTES - LDSCTL_OFF) / 4; u += 512) ((LAS unsigned*)(lds + LDSCTL_OFF))[u] = 0u;
    __syncthreads();
#if MK_ONE_LAUNCH
    XcdBarrier bar = xcd_barrier_post(ctl + CW_BAR, MISC + 8);
#else
    XcdBarrier bar; bar.bar = ctl + CW_BAR; bar.x = 0; bar.st = MISC + 8;
#endif
    const int lo = args.ph_lo, hi = args.ph_hi;
    layer_phases<0>(args, lds, MISC, bar, lo, hi, vb0, G0);
    layer_phases<1>(args, lds, MISC, bar, lo, hi, vb0, G0);
#undef IN
#undef BOTH
#undef SEAM
}

extern "C" void kernel_launch(void* const* d_in, const int* in_sizes, int n_in, void* d_out, int out_size, void* d_ws, size_t ws_size, hipStream_t stream) {
    static int grid = 0;
    if (grid == 0) {
        if (n_in != 26 || in_sizes[0] != M * D || out_size != M * D || ws_size < WS_END) { fprintf(stderr, "kernel_launch: unexpected shapes (n_in %d, in0 %d, out %d, ws %zu); nothing launched\n", n_in, n_in > 0 ? in_sizes[0] : -1, out_size, ws_size); grid = -1; return; }
        int dev = 0, cus = 0, per_cu = 0;
        if (hipGetDevice(&dev) != hipSuccess || hipDeviceGetAttribute(&cus, hipDeviceAttributeMultiprocessorCount, dev) != hipSuccess) { grid = -1; return; }
        if (hipFuncSetAttribute((const void*)skel_fwd, hipFuncAttributeMaxDynamicSharedMemorySize, LDS_BYTES) != hipSuccess) { fprintf(stderr, "kernel_launch: hipFuncSetAttribute failed\n"); grid = -1; return; }
        if (hipOccupancyMaxActiveBlocksPerMultiprocessor(&per_cu, (const void*)skel_fwd, 512, LDS_BYTES) != hipSuccess || per_cu < 1) fprintf(stderr, "kernel_launch: occupancy query reports %d\n", per_cu);
        (void)hipGetLastError();
        grid = cus;
    }
    if (grid < 0) return;
    if (hipMemsetAsync((char*)d_ws + WS_CTL, 0, CTL_ZERO_BYTES, stream) != hipSuccess) return;
    Args a{};
    for (int i = 0; i < 26; ++i) a.in[i] = (const float*)d_in[i];
    a.out = (float*)d_out; a.ws = (unsigned char*)d_ws;
#if MK_ONE_LAUNCH
    a.ph_lo = 0; a.ph_hi = NPH;
    hipLaunchKernelGGL(skel_fwd, dim3(grid), dim3(512), LDS_BYTES, stream, a);
#else
    for (int p = 0; p < NPH; ++p) { a.ph_lo = p; a.ph_hi = p + 1; hipLaunchKernelGGL(skel_fwd, dim3(grid), dim3(512), LDS_BYTES, stream, a); }
#endif
}
```
